# Optimizing an MI355X kernel written in HIP

```python
import jax, jax.numpy as jnp
from jax import lax
import numpy as np

D_MODEL = 1024
BATCH = 4
SEQ = 4096
DEPTH = 2

N_MIXERS = 2
N_A = (DEPTH + 1) // 2
N_B = DEPTH // 2
EPS = 1e-6

MLA_HEADS = 16
MLA_Q_LORA = 384
MLA_KV_LORA = 256
MLA_NOPE = 64
MLA_ROPE = 32
MLA_V = 64
MLA_IN = MLA_Q_LORA + MLA_KV_LORA + MLA_ROPE
ROPE_THETA = 10000.0
Q_BLOCK = 128

HG_HEADS = 8
HG_DK = 128
HG_DV = D_MODEL // HG_HEADS
HG_WIDTH = HG_HEADS * HG_DK
HG_VWIDTH = HG_HEADS * HG_DV
HG_IN = 2 * HG_WIDTH + 2 * HG_VWIDTH
HG_CHUNK = 64

D_FF = 3584
N_EXPERTS = 8
TOP_K = 2
D_FF_EXPERT = 3584

kernel_name = 'hybrid_mla_hgrn2_moe'


def rms_norm(x, g):
    xf = x.astype(jnp.float32)
    y = xf * lax.rsqrt(jnp.mean(xf * xf, axis=-1, keepdims=True) + EPS)
    return (y * g.astype(jnp.float32)).astype(x.dtype)


def rope_tables(positions):
    inv_freq = ROPE_THETA ** (-jnp.arange(0, MLA_ROPE, 2, dtype=jnp.float32) / MLA_ROPE)
    ang = positions.astype(jnp.float32)[..., None] * inv_freq
    return jnp.cos(ang), jnp.sin(ang)


def apply_rope(x, cos, sin):
    xf = x.astype(jnp.float32)
    half = MLA_ROPE // 2
    x1, x2 = xf[..., :half], xf[..., half:]
    return jnp.concatenate([x1 * cos - x2 * sin, x2 * cos + x1 * sin], axis=-1).astype(x.dtype)


def causal_latent_attention(qn, qr, kn, kr, v):
    B, S, H, _ = qn.shape
    nb = S // Q_BLOCK
    scale = (MLA_NOPE + MLA_ROPE) ** -0.5
    qn_b = qn.reshape(B, nb, Q_BLOCK, H, MLA_NOPE).transpose(1, 0, 2, 3, 4)
    qr_b = qr.reshape(B, nb, Q_BLOCK, H, MLA_ROPE).transpose(1, 0, 2, 3, 4)
    key_idx = jnp.arange(S)

    def block(args):
        qn_i, qr_i, blk = args
        s = (jnp.einsum('bqhd,bkhd->bhqk', qn_i, kn)
             + jnp.einsum('bqhr,bkr->bhqk', qr_i, kr)).astype(jnp.float32) * scale
        q_idx = blk * Q_BLOCK + jnp.arange(Q_BLOCK)
        mask = key_idx[None, :] <= q_idx[:, None]
        s = jnp.where(mask, s, -jnp.inf)
        p = jax.nn.softmax(s, axis=-1).astype(v.dtype)
        return jnp.einsum('bhqk,bkhd->bqhd', p, v)

    out = lax.map(block, (qn_b, qr_b, jnp.arange(nb)))
    return out.transpose(1, 0, 2, 3, 4).reshape(B, S, H * MLA_V)


def mla_mixer(hn, cos, sin, w_in, q_norm_g, w_q_up, kv_norm_g, w_kv_up, w_o):
    B, S, _ = hn.shape
    proj = hn @ w_in
    c_q = proj[..., :MLA_Q_LORA]
    c_kv = proj[..., MLA_Q_LORA:MLA_Q_LORA + MLA_KV_LORA]
    k_r = proj[..., MLA_Q_LORA + MLA_KV_LORA:]
    q = (rms_norm(c_q, q_norm_g) @ w_q_up).reshape(B, S, MLA_HEADS, MLA_NOPE + MLA_ROPE)
    qn, qr = q[..., :MLA_NOPE], q[..., MLA_NOPE:]
    qr = apply_rope(qr, cos[:, :, None, :], sin[:, :, None, :])
    kr = apply_rope(k_r, cos, sin)
    kv = (rms_norm(c_kv, kv_norm_g) @ w_kv_up).reshape(B, S, MLA_HEADS, MLA_NOPE + MLA_V)
    kn, v = kv[..., :MLA_NOPE], kv[..., MLA_NOPE:]
    o = causal_latent_attention(qn, qr, kn, kr, v)
    return o @ w_o


def hgrn2_chunked(q, k, v, log_f):
    B, S, H, dk = q.shape
    dv = v.shape[-1]
    C = HG_CHUNK
    N = S // C
    to_chunks = lambda a: a.reshape(B, N, C, H, a.shape[-1]).transpose(0, 3, 1, 2, 4)
    q, k, v, log_f = to_chunks(q), to_chunks(k), to_chunks(v), to_chunks(log_f)
    b = jnp.cumsum(log_f, axis=3)
    b_last = b[:, :, :, -1:, :]
    qd = q * jnp.exp(b)
    kd = k * jnp.exp(-b)
    A = jnp.einsum('bhnck,bhnsk->bhncs', qd, kd)
    tril = jnp.tril(jnp.ones((C, C), dtype=bool))
    A = jnp.where(tril, A, 0.0)
    o_intra = jnp.einsum('bhncs,bhnsv->bhncv', A, v)
    kv = jnp.einsum('bhnsk,bhnsv->bhnkv', k * jnp.exp(b_last - b), v)
    decay = jnp.exp(b_last[:, :, :, 0, :])

    def step(state, inp):
        d, kv_n = inp
        return d[..., None] * state + kv_n, state

    _, s_prev = lax.scan(step, jnp.zeros((B, H, dk, dv), jnp.float32),
                         (jnp.moveaxis(decay, 2, 0), jnp.moveaxis(kv, 2, 0)))
    s_prev = jnp.moveaxis(s_prev, 0, 2)
    o = o_intra + jnp.einsum('bhnck,bhnkv->bhncv', qd, s_prev)
    return o.transpose(0, 2, 3, 1, 4).reshape(B, S, H, dv)


def hgrn2_mixer(hn, lb, w_in, out_norm_g, w_o):
    B, S, _ = hn.shape
    proj = hn @ w_in
    q = proj[..., :HG_WIDTH]
    f_pre = proj[..., HG_WIDTH:2 * HG_WIDTH]
    i_in = proj[..., 2 * HG_WIDTH:2 * HG_WIDTH + HG_VWIDTH]
    g = proj[..., 2 * HG_WIDTH + HG_VWIDTH:]
    heads_k = lambda a: a.astype(jnp.float32).reshape(B, S, HG_HEADS, HG_DK)
    heads_v = lambda a: a.astype(jnp.float32).reshape(B, S, HG_HEADS, HG_DV)
    lb = lb.astype(jnp.float32).reshape(HG_HEADS, HG_DK)
    f = lb + (1.0 - lb) * jax.nn.sigmoid(heads_k(f_pre))
    log_f = jnp.log(f)
    k = 1.0 - f
    o = hgrn2_chunked(heads_k(q) * HG_DK ** -0.5, k, heads_v(i_in), log_f)
    o = rms_norm(o, out_norm_g) * jax.nn.silu(heads_v(g))
    return o.reshape(B, S, HG_VWIDTH).astype(hn.dtype) @ w_o


def swiglu(t, w_gate, w_up, w_down):
    return (jax.nn.silu(t @ w_gate) * (t @ w_up)) @ w_down


def moe_ffn(hn, router, w_gate, w_up, w_down):
    B, S, D = hn.shape
    t = hn.reshape(B * S, D)
    logits = (t @ router).astype(jnp.float32)
    vals, idx = lax.top_k(logits, TOP_K)
    w = jax.nn.softmax(vals, axis=-1)
    gate = jnp.sum(jax.nn.one_hot(idx, N_EXPERTS, dtype=jnp.float32) * w[..., None], axis=1)
    gate = gate.astype(t.dtype)
    y = jnp.zeros_like(t)
    for e in range(N_EXPERTS):
        y = y + gate[:, e:e + 1] * swiglu(t, w_gate[e], w_up[e], w_down[e])
    return y.reshape(B, S, D)


def _w(key, shape, fan_in):
    return jax.random.normal(key, shape, jnp.float32) * (fan_in ** -0.5)


def _gain(key, shape):
    return 1.0 + 0.02 * jax.random.normal(key, shape, jnp.float32)


def setup_inputs(seed: int = 0) -> dict:
    key = jax.random.key(seed)
    ks = jax.random.split(key, 26)
    x = jax.random.normal(ks[0], (BATCH, SEQ, D_MODEL), jnp.float32)
    offset = jax.random.randint(ks[1], (BATCH, 1), 0, 1024, dtype=jnp.int32)
    positions = jnp.arange(SEQ, dtype=jnp.int32)[None, :] + offset
    return {
        'x': x,
        'positions': positions,
        'mix_norm': _gain(ks[2], (DEPTH, D_MODEL)),
        'ffn_norm': _gain(ks[3], (DEPTH, D_MODEL)),
        'final_norm': _gain(ks[4], (D_MODEL,)),
        'mla_w_in': _w(ks[5], (N_A, D_MODEL, MLA_IN), D_MODEL),
        'mla_q_norm': _gain(ks[6], (N_A, MLA_Q_LORA)),
        'mla_w_q_up': _w(ks[7], (N_A, MLA_Q_LORA, MLA_HEADS * (MLA_NOPE + MLA_ROPE)), MLA_Q_LORA),
        'mla_kv_norm': _gain(ks[8], (N_A, MLA_KV_LORA)),
        'mla_w_kv_up': _w(ks[9], (N_A, MLA_KV_LORA, MLA_HEADS * (MLA_NOPE + MLA_V)), MLA_KV_LORA),
        'mla_w_o': _w(ks[10], (N_A, MLA_HEADS * MLA_V, D_MODEL), MLA_HEADS * MLA_V),
        'hgrn_w_in': _w(ks[11], (N_B, D_MODEL, HG_IN), D_MODEL),
        'hgrn_lower_bounds': 0.5 * jax.random.normal(ks[12], (DEPTH, HG_WIDTH), jnp.float32),
        'hgrn_out_norm': _gain(ks[13], (N_B, HG_DV)),
        'hgrn_w_o': _w(ks[14], (N_B, HG_VWIDTH, D_MODEL), HG_VWIDTH),
        'ffn_w_gate': _w(ks[15], (N_A, D_MODEL, D_FF), D_MODEL),
        'ffn_w_up': _w(ks[16], (N_A, D_MODEL, D_FF), D_MODEL),
        'ffn_w_down': _w(ks[17], (N_A, D_FF, D_MODEL), D_FF),
        'moe_router': _w(ks[18], (N_B, D_MODEL, N_EXPERTS), D_MODEL),
        'moe_w_gate': _w(ks[19], (N_B, N_EXPERTS, D_MODEL, D_FF_EXPERT), D_MODEL),
        'moe_w_up': _w(ks[20], (N_B, N_EXPERTS, D_MODEL, D_FF_EXPERT), D_MODEL),
        'moe_w_down': _w(ks[21], (N_B, N_EXPERTS, D_FF_EXPERT, D_MODEL), D_FF_EXPERT),
    }


def reference(x, positions, mix_norm, ffn_norm, final_norm,
              mla_w_in, mla_q_norm, mla_w_q_up, mla_kv_norm, mla_w_kv_up, mla_w_o,
              hgrn_w_in, hgrn_lower_bounds, hgrn_out_norm, hgrn_w_o,
              ffn_w_gate, ffn_w_up, ffn_w_down,
              moe_router, moe_w_gate, moe_w_up, moe_w_down):
    cos, sin = rope_tables(positions)
    lb_all = jnp.cumsum(jax.nn.softmax(hgrn_lower_bounds.astype(jnp.float32), axis=0), axis=0)
    lb_all = lb_all - lb_all[0:1]
    h = x
    for i in range(DEPTH):
        j = i // N_MIXERS
        hn = rms_norm(h, mix_norm[i])
        if i % N_MIXERS == 0:
            h = h + mla_mixer(hn, cos, sin, mla_w_in[j], mla_q_norm[j], mla_w_q_up[j],
                              mla_kv_norm[j], mla_w_kv_up[j], mla_w_o[j])
        else:
            h = h + hgrn2_mixer(hn, lb_all[i], hgrn_w_in[j], hgrn_out_norm[j], hgrn_w_o[j])
        hn = rms_norm(h, ffn_norm[i])
        if i % 2 == 0:
            h = h + swiglu(hn, ffn_w_gate[j], ffn_w_up[j], ffn_w_down[j])
        else:
            h = h + moe_ffn(hn, moe_router[j], moe_w_gate[j], moe_w_up[j], moe_w_down[j])
    return rms_norm(h, final_norm)
```

```cpp
#include <hip/hip_runtime.h>
#include <cstdio>
#include <cstdint>

#ifndef MK_N_LAUNCHES
#define MK_N_LAUNCHES 18
#endif

namespace pg8 {
#define PG8_LAS __attribute__((address_space(3)))
typedef unsigned short bf16_t;
typedef short bf16x8 __attribute__((ext_vector_type(8)));
typedef float f32x4 __attribute__((ext_vector_type(4)));
typedef unsigned u32x4 __attribute__((ext_vector_type(4)));
constexpr int BM = 256, BK = 64, HALF = 128, HTB = HALF * BK * 2, STAGE_BYTES = 8 * HTB, NXCD = 8, WGM = 8;

__host__ __device__ __forceinline__ int lds_byte(int r, int c) { const int st = (r >> 4) * 2 + (c >> 5), rr = r & 15, cc = c & 31, ob = rr * 64 + cc * 2; return st * 1024 + (ob ^ (((ob >> 9) & 1) << 5)); }
__host__ __device__ __forceinline__ void stage_rc(int b, int& R, int& C) { const int st = b / 1024, sb = b % 1024, swz = sb ^ (((sb >> 9) & 1) << 5); R = (st >> 1) * 16 + swz / 64; C = (st & 1) * 32 + (swz % 64) / 2; }
__host__ __device__ __forceinline__ int perm32(int rho) { const int n = rho >> 4, i = rho & 15; return 8 * (i >> 2) + 4 * n + (i & 3); }

struct Unit { int pm, pn; };
struct Gemm { const bf16_t* A; const bf16_t* Bt; int M, N, K; };

struct StaticOrder {
    int nM, nN, nwg, G, c;
    __host__ __device__ void init(int M, int N, int G_, int c_) { nM = M / BM; nN = N / BM; nwg = nM * nN; G = G_; c = c_; }
    __host__ __device__ bool next(int i, Unit& u) const {
        const long L = (long)i * G + c; if (L >= nwg) return false;
        int wgid = (int)L; { const int q = nwg / NXCD, r = nwg % NXCD, xcd = wgid % NXCD, off = wgid / NXCD; wgid = (xcd < r ? xcd * (q + 1) : r * (q + 1) + (xcd - r) * q) + off; }
        const int nig = WGM * nN, gid = wgid / nig, fm = gid * WGM, gsz = (nM - fm) < WGM ? (nM - fm) : WGM;
        u.pm = fm + ((wgid % nig) % gsz); u.pn = (wgid % nig) / gsz; return true;
    }
    __device__ __forceinline__ void a_ready(const Unit&) const {}
    __device__ __forceinline__ void done(const Unit&) const {}
    __device__ __forceinline__ int arow(const Unit&, int) const { return 0; }
};

__device__ __forceinline__ unsigned cvt_pk_bf16(float lo, float hi) { unsigned r; asm volatile("v_cvt_pk_bf16_f32 %0, %1, %2" : "=v"(r) : "v"(lo), "v"(hi)); return r; }

struct EpiStoreBf16 {
    static constexpr bool PERM = true, AFTER_DRAIN = false;
    bf16_t* O; int ldc; int nN;
    __device__ __forceinline__ void operator()(const f32x4 (&acc)[2][2][4][2], const Unit& u, int wr, int wc, int fr, int fq) const {
        const int pnl = u.pn % nN; const int row0 = u.pm * BM + wr * 64 + fr, col0 = pnl * BM + wc * 32 + 8 * fq;
#pragma unroll
        for (int ai = 0; ai < 2; ++ai)
#pragma unroll
            for (int m = 0; m < 4; ++m) { bf16_t* rowp = O + (size_t)(row0 + ai * HALF + m * 16) * ldc + col0;
#pragma unroll
                for (int bj = 0; bj < 2; ++bj) { const f32x4 v0 = acc[ai][bj][m][0], v1 = acc[ai][bj][m][1];
                    u32x4 w; w.x = cvt_pk_bf16(v0[0], v0[1]); w.y = cvt_pk_bf16(v0[2], v0[3]); w.z = cvt_pk_bf16(v1[0], v1[1]); w.w = cvt_pk_bf16(v1[2], v1[3]);
                    *(u32x4*)(rowp + bj * HALF) = w; } }
    }
};
__device__ __forceinline__ float silu_f(float x) { return x * __builtin_amdgcn_rcpf(1.0f + __builtin_amdgcn_exp2f(-1.4426950408889634f * x)); }
struct EpiSwiGLU {
    static constexpr bool PERM = true, AFTER_DRAIN = false;
    bf16_t* O; int ldc; int nN;
    __device__ __forceinline__ void operator()(const f32x4 (&acc)[2][2][4][2], const Unit& u, int wr, int wc, int fr, int fq) const {
        const int pnl = u.pn % nN; const int row0 = u.pm * BM + wr * 64 + fr, col0 = pnl * HALF + wc * 32 + 8 * fq;
#pragma unroll
        for (int ai = 0; ai < 2; ++ai)
#pragma unroll
            for (int m = 0; m < 4; ++m) { bf16_t* rowp = O + (size_t)(row0 + ai * HALF + m * 16) * ldc + col0;
                const f32x4 g0 = acc[ai][0][m][0], g1 = acc[ai][0][m][1], u0 = acc[ai][1][m][0], u1 = acc[ai][1][m][1];
                u32x4 w; w.x = cvt_pk_bf16(silu_f(g0[0]) * u0[0], silu_f(g0[1]) * u0[1]); w.y = cvt_pk_bf16(silu_f(g0[2]) * u0[2], silu_f(g0[3]) * u0[3]);
                w.z = cvt_pk_bf16(silu_f(g1[0]) * u1[0], silu_f(g1[1]) * u1[1]); w.w = cvt_pk_bf16(silu_f(g1[2]) * u1[2], silu_f(g1[3]) * u1[3]);
                *(u32x4*)rowp = w; }
    }
};
struct EpiF32Res {
    static constexpr bool PERM = false, AFTER_DRAIN = false;
    const float* base; float* out; int ldc; int nN;
    __device__ __forceinline__ void operator()(const f32x4 (&acc)[2][2][4][2], const Unit& u, int wr, int wc, int fr, int fq) const {
        const int pnl = u.pn % nN; const int row0 = u.pm * BM + wr * 64 + fr, col0 = pnl * BM + wc * 32 + 4 * fq;
#pragma unroll
        for (int ai = 0; ai < 2; ++ai)
#pragma unroll
            for (int m = 0; m < 4; ++m) { const size_t off = (size_t)(row0 + ai * HALF + m * 16) * ldc + col0;
#pragma unroll
                for (int bj = 0; bj < 2; ++bj)
#pragma unroll
                    for (int n = 0; n < 2; ++n) { f32x4 v = acc[ai][bj][m][n]; if (base) v += *(const f32x4*)(base + off + bj * HALF + n * 16); *(f32x4*)(out + off + bj * HALF + n * 16) = v; } }
    }
};

template <class Epi, class Sched, bool ALIGN_EPI = true, bool GATHER = false>
__device__ __forceinline__ void gemm_phase(PG8_LAS unsigned char* lds, const Gemm g, const Sched& S, const Epi& E) {
    const int tid = threadIdx.x, wid = __builtin_amdgcn_readfirstlane(tid >> 6), lane = tid & 63, wr = wid >> 2, wc = wid & 3, fr = lane & 15, fq = lane >> 4;
    const int K = g.K, nt = K / BK;
    unsigned voffA[2], voffB[2]; int RA[2], CA[2];
#pragma unroll
    for (int i = 0; i < 2; ++i) { int R, C; stage_rc(tid * 16 + i * 8192, R, C); const int Rb = Epi::PERM ? ((R & ~31) + perm32(R & 31)) : R;
        voffA[i] = (unsigned)(R * K + C) * 2u; voffB[i] = (unsigned)(Rb * K + C) * 2u; RA[i] = R; CA[i] = C; }
    unsigned vAc[2][2], vAn[2][2];
    const size_t kstep = (size_t)(BK * 2);
    const size_t hstep = (size_t)HALF * K * 2;
    const size_t tstep = 2 * hstep;
    const size_t hstepA = GATHER ? (size_t)0 : hstep;
    const unsigned ldsw = (unsigned)wid * 1024u;
    const int aoff = lds_byte(wr * 64 + fr, fq * 8), boff = lds_byte(wc * 32 + fr, fq * 8);
#define PG8_SA(b, h) (((b) * 2 + (h)) * HTB)
#define PG8_SB(b, h) ((4 + (b) * 2 + (h)) * HTB)
#define PG8_STAGE(bufoff, gbase, voff) do { _Pragma("unroll") for (int _i = 0; _i < 2; ++_i) \
        __builtin_amdgcn_global_load_lds((const unsigned*)((const char*)(gbase) + (voff)[_i]), (PG8_LAS unsigned*)(lds + (bufoff) + ldsw + _i * 8192), 16, 0, 0); } while (0)
#define PG8_STAGE_A(bufoff, gbase, h, nx) do { _Pragma("unroll") for (int _i = 0; _i < 2; ++_i) { const unsigned _vo = GATHER ? ((nx) ? vAn[h][_i] : vAc[h][_i]) : voffA[_i]; \
        __builtin_amdgcn_global_load_lds((const unsigned*)((const char*)(gbase) + _vo), (PG8_LAS unsigned*)(lds + (bufoff) + ldsw + _i * 8192), 16, 0, 0); } } while (0)
#define PG8_GATH(dst, un) do { _Pragma("unroll") for (int _h = 0; _h < 2; ++_h) _Pragma("unroll") for (int _i = 0; _i < 2; ++_i) \
        dst[_h][_i] = (unsigned)(S.arow(un, _h * HALF + RA[_i]) * K + CA[_i]) * 2u; } while (0)
#define PG8_LDA(dst, b, h) do { _Pragma("unroll") for (int m = 0; m < 4; ++m) _Pragma("unroll") for (int k = 0; k < 2; ++k) dst[m][k] = *(const PG8_LAS bf16x8*)(lds + PG8_SA(b, h) + aoff + m * 2048 + k * 1024); } while (0)
#define PG8_LDB(dst, b, h) do { _Pragma("unroll") for (int n = 0; n < 2; ++n) _Pragma("unroll") for (int k = 0; k < 2; ++k) dst[n][k] = *(const PG8_LAS bf16x8*)(lds + PG8_SB(b, h) + boff + n * 2048 + k * 1024); } while (0)
#define PG8_MMA(ai, bj, At, Bt) do { __builtin_amdgcn_s_setprio(1); _Pragma("unroll") for (int m = 0; m < 4; ++m) _Pragma("unroll") for (int n = 0; n < 2; ++n) _Pragma("unroll") for (int k = 0; k < 2; ++k) \
        acc[ai][bj][m][n] = __builtin_amdgcn_mfma_f32_16x16x32_bf16(Bt[n][k], At[m][k], acc[ai][bj][m][n], 0, 0, 0); __builtin_amdgcn_s_setprio(0); } while (0)
#define PG8_WAIT_V(n) asm volatile("s_waitcnt vmcnt(" #n ")" ::: "memory")
#define PG8_WAIT_L(n) asm volatile("s_waitcnt lgkmcnt(" #n ")" ::: "memory")
#define PG8_BAR __builtin_amdgcn_s_barrier()
#define PG8_SCHED __builtin_amdgcn_sched_barrier(0)
    Unit cur, nxt; int ui = 0;
    if (!S.next(0, cur)) return;
    f32x4 acc[2][2][4][2];
#pragma unroll
    for (int a = 0; a < 2; ++a)
#pragma unroll
        for (int b = 0; b < 2; ++b)
#pragma unroll
            for (int m = 0; m < 4; ++m)
#pragma unroll
                for (int n = 0; n < 2; ++n) acc[a][b][m][n] = (f32x4){0.f, 0.f, 0.f, 0.f};
    bf16x8 At[4][2], B0[2][2], B1[2][2];
    const char* cA = GATHER ? (const char*)g.A : (const char*)g.A + (size_t)cur.pm * tstep; const char* cB = (const char*)g.Bt + (size_t)cur.pn * tstep;
    if (GATHER) { PG8_GATH(vAc, cur); }
    S.a_ready(cur);
    PG8_STAGE(PG8_SB(0, 0), cB, voffB); PG8_STAGE(PG8_SB(0, 1), cB + hstep, voffB); PG8_STAGE_A(PG8_SA(0, 0), cA, 0, false); PG8_STAGE_A(PG8_SA(0, 1), cA + hstepA, 1, false);
    if (wr == 1) PG8_BAR;
    PG8_WAIT_V(2); PG8_BAR;
    PG8_STAGE(PG8_SB(1, 0), cB + kstep, voffB); PG8_STAGE_A(PG8_SA(1, 0), cA + kstep, 0, false); PG8_STAGE(PG8_SB(1, 1), cB + hstep + kstep, voffB);
    PG8_WAIT_V(6); PG8_BAR;
    for (;;) {
        const bool has_next = S.next(ui + 1, nxt);
        const char* nA = GATHER ? (const char*)g.A : (has_next ? (const char*)g.A + (size_t)nxt.pm * tstep : cA); const char* nB = has_next ? (const char*)g.Bt + (size_t)nxt.pn * tstep : cB;
        if (GATHER) { if (has_next) { PG8_GATH(vAn, nxt); } else {
#pragma unroll
                for (int _h = 0; _h < 2; ++_h)
#pragma unroll
                    for (int _i = 0; _i < 2; ++_i) vAn[_h][_i] = vAc[_h][_i]; } }
        for (int t = 0; t < nt; t += 2) {
            const bool last = (t == nt - 2);
            const char* a1 = cA + (size_t)(t + 1) * kstep;
            const char* a2 = last ? nA : cA + (size_t)(t + 2) * kstep; const char* b2 = last ? nB : cB + (size_t)(t + 2) * kstep;
            const char* a3 = a2 + kstep; const char* b3 = b2 + kstep;
            if (last && has_next) S.a_ready(nxt);
            PG8_LDB(B0, 0, 0); PG8_LDB(B1, 0, 1); PG8_SCHED; PG8_LDA(At, 0, 0); PG8_STAGE_A(PG8_SA(1, 1), a1 + hstepA, 1, false);
            PG8_WAIT_V(8); PG8_WAIT_L(0); PG8_BAR; PG8_MMA(0, 0, At, B0); PG8_MMA(0, 1, At, B1); PG8_BAR; PG8_SCHED;
            PG8_LDA(At, 0, 1); PG8_STAGE(PG8_SB(0, 0), b2, voffB); PG8_STAGE(PG8_SB(0, 1), b2 + hstep, voffB); PG8_STAGE_A(PG8_SA(0, 0), a2, 0, last);
            PG8_WAIT_V(8); PG8_WAIT_L(0); PG8_BAR; PG8_MMA(1, 0, At, B0); PG8_MMA(1, 1, At, B1); PG8_BAR; PG8_SCHED;
            PG8_LDB(B0, 1, 0); PG8_LDB(B1, 1, 1); PG8_SCHED; PG8_LDA(At, 1, 0); PG8_STAGE_A(PG8_SA(0, 1), a2 + hstepA, 1, last);
            PG8_WAIT_V(8); PG8_WAIT_L(0); PG8_BAR; PG8_MMA(0, 0, At, B0); PG8_MMA(0, 1, At, B1); PG8_BAR; PG8_SCHED;
            PG8_LDA(At, 1, 1); PG8_STAGE(PG8_SB(1, 0), b3, voffB); PG8_STAGE(PG8_SB(1, 1), b3 + hstep, voffB); PG8_STAGE_A(PG8_SA(1, 0), a3, 0, last);
            PG8_WAIT_V(8); PG8_WAIT_L(0); PG8_BAR; PG8_MMA(1, 0, At, B0); PG8_MMA(1, 1, At, B1); PG8_BAR; PG8_SCHED;
        }
        if constexpr (ALIGN_EPI) { if (wr == 0) PG8_BAR; }
        E(acc, cur, wr, wc, fr, fq); S.done(cur);
        if (!has_next) break;
#pragma unroll
        for (int a = 0; a < 2; ++a)
#pragma unroll
            for (int b = 0; b < 2; ++b)
#pragma unroll
                for (int m = 0; m < 4; ++m)
#pragma unroll
                    for (int n = 0; n < 2; ++n) acc[a][b][m][n] = (f32x4){0.f, 0.f, 0.f, 0.f};
        cur = nxt; cA = nA; cB = nB; ++ui;
        if (GATHER) {
#pragma unroll
            for (int _h = 0; _h < 2; ++_h)
#pragma unroll
                for (int _i = 0; _i < 2; ++_i) vAc[_h][_i] = vAn[_h][_i]; }
        if constexpr (ALIGN_EPI) { if (wr == 1) PG8_BAR; }
    }
    PG8_WAIT_V(0);
    if constexpr (!ALIGN_EPI) { if (wr == 0) PG8_BAR; }
    PG8_BAR;
#undef PG8_SA
#undef PG8_SB
#undef PG8_STAGE
#undef PG8_STAGE_A
#undef PG8_GATH
#undef PG8_LDA
#undef PG8_LDB
#undef PG8_MMA
#undef PG8_WAIT_V
#undef PG8_WAIT_L
#undef PG8_BAR
#undef PG8_SCHED
}
}

constexpr int NWAVES = 8;
constexpr int N_LAUNCHES = MK_N_LAUNCHES;
constexpr int NPHASE = 18;
constexpr int BATCH = 4, SEQ = 4096, D = 1024, M = BATCH * SEQ;
constexpr int NH = 16, QL = 384, KVL = 256, NOPE = 64, ROPE = 32, VD = 64, MLA_IN = 672, MLA_INP = 768, QW = NH * 96, KVW = NH * 128;
constexpr int HGH = 8, DK = 128, DV = 128, HG_IN = 4096;
constexpr int FF = 3584, NE = 8, CAP = 16384;
constexpr int MAXSLOT = 2 * M + NE * 256;
constexpr float EPS = 1e-6f;

constexpr size_t MiB = 1u << 20;
constexpr size_t WS_CTL = 0, CTL_ZERO_BYTES = 1 * MiB;
constexpr size_t WS_ROWLIST = 1 * MiB;
constexpr size_t WS_TOK = WS_ROWLIST + 512 * 1024;
constexpr size_t WS_COS = 2 * MiB, WS_SIN = 3 * MiB;
constexpr size_t WS_WMLAIN = 4 * MiB;
constexpr size_t WS_WQUP = 6 * MiB;
constexpr size_t WS_WKVUP = 8 * MiB;
constexpr size_t WS_WO0 = 9 * MiB;
constexpr size_t WS_WFGU = 11 * MiB;
constexpr size_t WS_WFDN = 25 * MiB;
constexpr size_t WS_WHIN = 32 * MiB;
constexpr size_t WS_WHO = 40 * MiB;
constexpr size_t WS_WMGU = 42 * MiB;
constexpr size_t WS_WMDN = 154 * MiB;
constexpr size_t WS_ACTS = 210 * MiB;
constexpr size_t WS_HN = WS_ACTS;
constexpr size_t WS_PROJ = WS_ACTS + 32 * MiB;
constexpr size_t WS_CQN = WS_PROJ + 24 * MiB;
constexpr size_t WS_CKVN = WS_CQN + 12 * MiB;
constexpr size_t WS_KR = WS_CKVN + 8 * MiB;
constexpr size_t WS_Q = WS_KR + 1 * MiB;
constexpr size_t WS_KV = WS_Q + 48 * MiB;
constexpr size_t WS_O = WS_KV + 64 * MiB;
constexpr size_t WS_FACT = WS_ACTS + 32 * MiB;
constexpr size_t WS_HPROJ = WS_ACTS + 32 * MiB;
constexpr size_t WS_HOF = WS_HPROJ + 128 * MiB;
constexpr size_t WS_HON = WS_HOF + 64 * MiB;
constexpr size_t WS_HN3 = 4 * MiB;
constexpr size_t WS_MACT = WS_ACTS;
constexpr size_t WS_Y = WS_WMGU;
constexpr size_t WS_END = 472 * MiB;
static_assert(WS_O + (size_t)M * 1024 * 2 <= WS_END && WS_HON + (size_t)M * 1024 * 2 <= WS_END && WS_MACT + (size_t)MAXSLOT * FF * 2 <= WS_END, "d_ws map");
static_assert(WS_HN3 + (size_t)M * 1024 * 2 <= WS_WHO, "hn3 overlay");
constexpr int CW_CNT = 64;
constexpr int CW_BAR = 4096;

constexpr int RING_OFF = 0, RING_BYTES = 131072;
constexpr int LDSCTL_OFF = RING_BYTES, MISC_OFF = LDSCTL_OFF + 320;
constexpr int LDS_BYTES = 147456;

#define GAS __attribute__((address_space(1)))
#define LAS __attribute__((address_space(3)))
typedef unsigned short bf16;
typedef unsigned v4u __attribute__((ext_vector_type(4)));
typedef unsigned v2u __attribute__((ext_vector_type(2)));
typedef float f32x4 __attribute__((ext_vector_type(4)));
typedef GAS unsigned gu32;
#define RLX_AGENT __ATOMIC_RELAXED, __HIP_MEMORY_SCOPE_AGENT
#define LDS_WAIT() asm volatile("s_waitcnt lgkmcnt(0)" ::: "memory")
__device__ __forceinline__ unsigned f2bf(float f) { unsigned u = __builtin_bit_cast(unsigned, f); return (u + 0x7fffu + ((u >> 16) & 1u)) >> 16; }
__device__ __forceinline__ unsigned pk2(float lo, float hi) { return f2bf(lo) | (f2bf(hi) << 16); }
__device__ __forceinline__ float bf2f(unsigned short b) { return __builtin_bit_cast(float, (unsigned)b << 16); }

#define XB_TMO      128
#define XB_XCNT(j)  (256  + 64 * (j))
#define XB_XSUB(j)  (1280 + 64 * (j))
#define XB_XGEN(j)  (2304 + 64 * (j))
#define XB_TOP      3328
#define XB_TOPGEN   3392
#define XCD_BAR_WORDS 3456
#define XB_SPIN_CAP (1u << 24)
__device__ __forceinline__ unsigned xb_ld(unsigned* p)              { return __hip_atomic_load(p, __ATOMIC_RELAXED, __HIP_MEMORY_SCOPE_AGENT); }
__device__ __forceinline__ unsigned xb_add(unsigned* p, unsigned v) { return __hip_atomic_fetch_add(p, v, __ATOMIC_RELAXED, __HIP_MEMORY_SCOPE_AGENT); }
__device__ __forceinline__ unsigned xb_xcc_id() { return (unsigned)__builtin_amdgcn_s_getreg((3 << 11) | 20) & 0xFu; }
#define XB_SPIN(cond, bar) do { unsigned _sp = 0; while (cond) { __builtin_amdgcn_s_sleep(1); \
    if ((++_sp & 255u) == 0u) { if (xb_ld(&(bar)[XB_TMO])) break; if (_sp > XB_SPIN_CAP) { atomicAdd(&(bar)[XB_TMO], 1u); break; } } } } while (0)
struct XcdBarrier { unsigned* bar; unsigned x; volatile LAS unsigned* st; };
__device__ __forceinline__ XcdBarrier xcd_barrier_post(unsigned* bar, volatile LAS unsigned* st) {
    XcdBarrier b; b.bar = bar; b.x = xb_xcc_id(); b.st = st;
    if (threadIdx.x == 0) (void)xb_add(&bar[XB_XCNT(b.x)], 1u);
    return b;
}
__device__ __forceinline__ void xcd_barrier_complete(unsigned* bar, unsigned x, unsigned& nloc, unsigned& nx) {
    const unsigned G = gridDim.x * gridDim.y * gridDim.z;
    unsigned sum, cnt, mine, sp = 0u;
    for (;;) {
        sum = 0u; cnt = 0u; mine = 0u;
#pragma unroll
        for (unsigned j = 0; j < 16; ++j) { const unsigned c = xb_ld(&bar[XB_XCNT(j)]); sum += c; cnt += (c > 0u) ? 1u : 0u; mine = (j == x) ? c : mine; }
        if (sum == G) break;
        __builtin_amdgcn_s_sleep(1);
        if ((++sp & 255u) == 0u) { if (xb_ld(&bar[XB_TMO])) break; if (sp > XB_SPIN_CAP) { atomicAdd(&bar[XB_TMO], 1u); break; } }
    }
    nloc = mine > 0u ? mine : 1u; nx = cnt > 0u ? cnt : 1u;
}
__device__ __forceinline__ void xcd_barrier(const XcdBarrier& b) {
    asm volatile("s_waitcnt vmcnt(0)" ::: "memory");
    __syncthreads();
    if (threadIdx.x == 0) {
        unsigned* bar = b.bar;
        __builtin_amdgcn_s_waitcnt(0);
        unsigned nloc = b.st[0], nx = b.st[1];
        if (nloc == 0u) { xcd_barrier_complete(bar, b.x, nloc, nx); b.st[0] = nloc; b.st[1] = nx; }
        const unsigned old = xb_add(&bar[XB_XSUB(b.x)], 1u);
        const unsigned gen = old / nloc;
        if (old + 1u == (gen + 1u) * nloc) {
            __builtin_amdgcn_fence(__ATOMIC_RELEASE, "agent");
            asm volatile("s_waitcnt vmcnt(0)" ::: "memory");
            const unsigned og = xb_add(&bar[XB_TOP], 1u);
            const unsigned tg = og / nx;
            if (og + 1u == (tg + 1u) * nx) xb_add(&bar[XB_TOPGEN], 1u);
            else XB_SPIN(xb_ld(&bar[XB_TOPGEN]) == tg, bar);
            __builtin_amdgcn_fence(__ATOMIC_ACQUIRE, "agent");
            xb_add(&bar[XB_XGEN(b.x)], 1u);
            asm volatile("s_waitcnt vmcnt(0)" ::: "memory");
        } else {
            XB_SPIN(xb_ld(&bar[XB_XGEN(b.x)]) == gen, bar);
            __builtin_amdgcn_fence(__ATOMIC_ACQUIRE, "agent");
            asm volatile("s_waitcnt vmcnt(0)" ::: "memory");
        }
    }
    __syncthreads();
}

__device__ __forceinline__ float wave_sum(float v) {
#pragma unroll
    for (int o = 1; o < 64; o <<= 1) v += __shfl_xor(v, o);
    return v;
}
__device__ __forceinline__ int dst_row(int n, int mode) { return mode == 0 ? n : (((n >> 7) << 8) + (n & 127) + (mode == 2 ? 128 : 0)); }
__device__ __forceinline__ void tr_item(const float* W, int K, int N, bf16* WT, int mode, LAS float* scr, int item, int lane) {
    const int nblk = N / 32, kb = item / nblk, nb = item % nblk, k0 = 64 * kb, n0 = 32 * nb;
#pragma unroll 8
    for (int i = 0; i < 32; ++i) { const int kk = 2 * i + (lane >> 5); scr[kk * 33 + (lane & 31)] = W[(size_t)(k0 + kk) * N + n0 + (lane & 31)]; }
    LDS_WAIT(); asm volatile("" ::: "memory");
    const int c = lane & 7;
#pragma unroll
    for (int j = 0; j < 4; ++j) { const int n = (lane >> 3) + 8 * j; const LAS float* s = scr + (8 * c) * 33 + n;
        v4u o; o.x = pk2(s[0 * 33], s[1 * 33]); o.y = pk2(s[2 * 33], s[3 * 33]); o.z = pk2(s[4 * 33], s[5 * 33]); o.w = pk2(s[6 * 33], s[7 * 33]);
        *(v4u*)(WT + (size_t)dst_row(n0 + n, mode) * K + k0 + 8 * c) = o; }
    LDS_WAIT(); asm volatile("" ::: "memory");
}
__device__ __forceinline__ void rms_row_to_bf16(const float* xrow, const float* gain, bf16* orow, int lane) {
    const f32x4* xr = (const f32x4*)xrow + lane; const f32x4* gr = (const f32x4*)gain + lane;
    f32x4 v[4]; float s = 0.f;
#pragma unroll
    for (int j = 0; j < 4; ++j) { v[j] = xr[64 * j]; s += (v[j].x * v[j].x + v[j].y * v[j].y) + (v[j].z * v[j].z + v[j].w * v[j].w); }
    const float rstd = 1.f / sqrtf(wave_sum(s) * (1.f / 1024.f) + EPS);
    unsigned long long* o8 = (unsigned long long*)orow + lane;
#pragma unroll
    for (int j = 0; j < 4; ++j) { const f32x4 g = gr[64 * j];
        o8[64 * j] = (unsigned long long)pk2(v[j].x * rstd * g.x, v[j].y * rstd * g.y) | ((unsigned long long)pk2(v[j].z * rstd * g.z, v[j].w * rstd * g.w) << 32); }
}
__device__ __forceinline__ float sigmoid_f(float x) { return 1.0f / (1.0f + __expf(-x)); }

struct MoeOrder {
    pg8::StaticOrder so; int nN; volatile LAS int* mt; const int* rowlist;
    __device__ __forceinline__ void init(volatile LAS int* mt_, int nN_, int G, int c, const int* rl) { mt = mt_; nN = nN_; rowlist = rl; so.init(mt_[8] * 256, nN_ * 256, G, c); }
    __device__ __forceinline__ bool next(int i, pg8::Unit& u) const {
        if (!so.next(i, u)) return false;
        int e = 0;
#pragma unroll
        for (int j = 1; j < 8; ++j) e += (u.pm >= mt[j]) ? 1 : 0;
        u.pn = e * nN + u.pn; return true;
    }
    __device__ __forceinline__ void a_ready(const pg8::Unit&) const {}
    __device__ __forceinline__ void done(const pg8::Unit&) const {}
    __device__ __forceinline__ int arow(const pg8::Unit& u, int r) const { const int e = u.pn / nN; const int lr = (u.pm - mt[e]) * 256 + r; return lr < mt[9 + e] ? rowlist[e * CAP + lr] : 0; }
};

struct Args { const float* in[22]; const int* pos; float* out; unsigned char* ws; int ph_lo, ph_hi, li, pad; };

__global__ void __launch_bounds__(NWAVES * 64, 2) fwd_kernel(Args args) {
    extern __shared__ __attribute__((aligned(16))) unsigned char lds[];
    LAS unsigned char* L = (LAS unsigned char*)lds;
    volatile LAS unsigned* MISC = (volatile LAS unsigned*)(L + MISC_OFF);
    const int tid = threadIdx.x, lane = tid & 63, wave = __builtin_amdgcn_readfirstlane(tid >> 6);
    const int G = gridDim.x;
    const int gw = blockIdx.x * NWAVES + wave, NGW = G * NWAVES;
    unsigned char* ws = args.ws;
    gu32* ctl = (gu32*)(ws + WS_CTL);
    for (int u = tid; u < (LDS_BYTES - LDSCTL_OFF) / 4; u += NWAVES * 64) ((LAS unsigned*)(L + LDSCTL_OFF))[u] = 0u;
    __syncthreads();
    XcdBarrier bar; bar.bar = (unsigned*)(ctl + CW_BAR); bar.x = 0; bar.st = nullptr;
    if (N_LAUNCHES == 1) bar = xcd_barrier_post((unsigned*)(ctl + CW_BAR), MISC + 8);
#define GRID_BAR() do { if (N_LAUNCHES == 1) xcd_barrier(bar); } while (0)
    const int lo = args.ph_lo, hi = args.ph_hi;
#define IN(k) (lo <= (k) && (k) < hi)
#define BOTH(k) (IN(k) && IN((k) + 1))
    const float* x = args.in[0];
    float* H = args.out;

    if (IN(0)) {
        LAS float* scr = (LAS float*)(L + RING_OFF + wave * 16384);
        constexpr int I_MOE = (1024 / 64) * (3584 / 32);
        constexpr int NITEMS = 16 * 21 + 6 * 48 + 4 * 64 + 16 * 32 + 2 * 1792 + 1792 + 16 * 128 + 16 * 32 + 24 * I_MOE;
        for (int it = gw; it < NITEMS; it += NGW) {
            int r = it;
#define JOB(W, K_, N_, WT, mode) { const int ni = ((K_) / 64) * ((N_) / 32); if (r < ni) { tr_item((W), (K_), (N_), (bf16*)(ws + (WT)), (mode), scr, r, lane); continue; } r -= ni; }
            JOB(args.in[5], 1024, 672, WS_WMLAIN, 0)
            JOB(args.in[7], 384, 1536, WS_WQUP, 0)
            JOB(args.in[9], 256, 2048, WS_WKVUP, 0)
            JOB(args.in[10], 1024, 1024, WS_WO0, 0)
            JOB(args.in[15], 1024, 3584, WS_WFGU, 1)
            JOB(args.in[16], 1024, 3584, WS_WFGU, 2)
            JOB(args.in[17], 3584, 1024, WS_WFDN, 0)
            JOB(args.in[11], 1024, 4096, WS_WHIN, 0)
            JOB(args.in[14], 1024, 1024, WS_WHO, 0)
#undef JOB
            if (r < 8 * I_MOE) { const int e = r / I_MOE; tr_item(args.in[19] + (size_t)e * 1024 * 3584, 1024, 3584, (bf16*)(ws + WS_WMGU) + (size_t)e * 7168 * 1024, 1, scr, r % I_MOE, lane); continue; } r -= 8 * I_MOE;
            if (r < 8 * I_MOE) { const int e = r / I_MOE; tr_item(args.in[20] + (size_t)e * 1024 * 3584, 1024, 3584, (bf16*)(ws + WS_WMGU) + (size_t)e * 7168 * 1024, 2, scr, r % I_MOE, lane); continue; } r -= 8 * I_MOE;
            { const int e = r / I_MOE; tr_item(args.in[21] + (size_t)e * 3584 * 1024, 3584, 1024, (bf16*)(ws + WS_WMDN) + (size_t)e * 1024 * 3584, 0, scr, r % I_MOE, lane); }
        }
        { v4u* z = (v4u*)((bf16*)(ws + WS_WMLAIN) + (size_t)MLA_IN * 1024); const int n16 = (MLA_INP - MLA_IN) * 1024 * 2 / 16;
          for (int i = blockIdx.x * NWAVES * 64 + tid; i < n16; i += G * NWAVES * 64) z[i] = (v4u){0u, 0u, 0u, 0u}; }
        for (int m = gw; m < M; m += NGW) rms_row_to_bf16(x + (size_t)m * D, args.in[2], (bf16*)(ws + WS_HN) + (size_t)m * D, lane);
        if (BOTH(0)) GRID_BAR();
    }
    if (IN(1)) {
        pg8::Gemm g{(const bf16*)(ws + WS_HN), (const bf16*)(ws + WS_WMLAIN), M, MLA_INP, 1024}; pg8::StaticOrder S; S.init(M, MLA_INP, G, (int)blockIdx.x);
        pg8::EpiStoreBf16 E{(bf16*)(ws + WS_PROJ), MLA_INP, MLA_INP / 256};
        pg8::gemm_phase<pg8::EpiStoreBf16, pg8::StaticOrder, true, false>(L + RING_OFF, g, S, E);
        if (BOTH(1)) GRID_BAR();
    }
    if (IN(2)) {
        const bf16* P = (const bf16*)(ws + WS_PROJ);
        for (int m = gw; m < M; m += NGW) {
            const bf16* pr = P + (size_t)m * MLA_INP;
            float cq[6]; float s = 0.f;
#pragma unroll
            for (int j = 0; j < 6; ++j) { cq[j] = bf2f(pr[j * 64 + lane]); s += cq[j] * cq[j]; }
            const float rq = 1.f / sqrtf(wave_sum(s) * (1.f / QL) + EPS);
            bf16* oq = (bf16*)(ws + WS_CQN) + (size_t)m * QL;
#pragma unroll
            for (int j = 0; j < 6; ++j) oq[j * 64 + lane] = (bf16)f2bf(cq[j] * rq * args.in[6][j * 64 + lane]);
            float ck[4]; s = 0.f;
#pragma unroll
            for (int j = 0; j < 4; ++j) { ck[j] = bf2f(pr[QL + j * 64 + lane]); s += ck[j] * ck[j]; }
            const float rk = 1.f / sqrtf(wave_sum(s) * (1.f / KVL) + EPS);
            bf16* ok = (bf16*)(ws + WS_CKVN) + (size_t)m * KVL;
#pragma unroll
            for (int j = 0; j < 4; ++j) ok[j * 64 + lane] = (bf16)f2bf(ck[j] * rk * args.in[8][j * 64 + lane]);
            if (lane < 16) {
                const float invf = exp2f(-(float)lane * (13.287712379549449f / 16.0f));
                const float ang = (float)args.pos[m] * invf;
                const double rev = (double)ang * 0.15915494309189535; const float fr = (float)(rev - rint(rev));
                const float sn = __builtin_amdgcn_sinf(fr), cs = __builtin_amdgcn_cosf(fr);
                ((float*)(ws + WS_COS))[(size_t)m * 16 + lane] = cs; ((float*)(ws + WS_SIN))[(size_t)m * 16 + lane] = sn;
                const float x1 = bf2f(pr[QL + KVL + lane]), x2 = bf2f(pr[QL + KVL + 16 + lane]);
                bf16* okr = (bf16*)(ws + WS_KR) + (size_t)m * 32;
                okr[lane] = (bf16)f2bf(x1 * cs - x2 * sn); okr[16 + lane] = (bf16)f2bf(x2 * cs + x1 * sn);
            }
        }
        if (BOTH(2)) GRID_BAR();
    }
    if (IN(3)) {
        { pg8::Gemm g{(const bf16*)(ws + WS_CQN), (const bf16*)(ws + WS_WQUP), M, QW, QL}; pg8::StaticOrder S; S.init(M, QW, G, (int)blockIdx.x);
          pg8::EpiStoreBf16 E{(bf16*)(ws + WS_Q), QW, QW / 256};
          pg8::gemm_phase<pg8::EpiStoreBf16, pg8::StaticOrder, true, false>(L + RING_OFF, g, S, E); }
        { pg8::Gemm g{(const bf16*)(ws + WS_CKVN), (const bf16*)(ws + WS_WKVUP), M, KVW, KVL}; pg8::StaticOrder S; S.init(M, KVW, G, (int)blockIdx.x);
          pg8::EpiStoreBf16 E{(bf16*)(ws + WS_KV), KVW, KVW / 256};
          pg8::gemm_phase<pg8::EpiStoreBf16, pg8::StaticOrder, true, false>(L + RING_OFF, g, S, E); }
        if (BOTH(3)) GRID_BAR();
    }
    if (IN(4)) {
        LAS float* Ks = (LAS float*)(L + RING_OFF);
        LAS float* Vs = (LAS float*)(L + RING_OFF + 32 * 96 * 4);
        const bf16* Qb = (const bf16*)(ws + WS_Q); const bf16* KVb = (const bf16*)(ws + WS_KV); const bf16* KRb = (const bf16*)(ws + WS_KR);
        const float* COS = (const float*)(ws + WS_COS); const float* SIN = (const float*)(ws + WS_SIN);
        const float sc = 0.10206207261596577f * 1.4426950408889634f;
        for (int uu = blockIdx.x; uu < 512; uu += G) {
            const int bh = uu >> 3, j8 = uu & 7, qb = (j8 & 1) ? 7 - (j8 >> 1) : (j8 >> 1);
            const int b = bh >> 4, h = bh & 15;
            const int qi = qb * 512 + tid; const size_t row = (size_t)b * SEQ + qi;
            float q[96];
            { const bf16* qp = Qb + row * QW + h * 96;
#pragma unroll
              for (int d = 0; d < 96; ++d) q[d] = bf2f(qp[d]);
#pragma unroll
              for (int i = 0; i < 16; ++i) { const float cs = COS[row * 16 + i], sn = SIN[row * 16 + i]; const float x1 = q[64 + i], x2 = q[80 + i]; q[64 + i] = x1 * cs - x2 * sn; q[80 + i] = x2 * cs + x1 * sn; }
#pragma unroll
              for (int d = 0; d < 96; ++d) q[d] *= sc; }
            float o[64];
#pragma unroll
            for (int d = 0; d < 64; ++d) o[d] = 0.f;
            float mrun = -1e30f, lrun = 0.f;
            const int nkt = (qb + 1) * 16;
            for (int kt = 0; kt < nkt; ++kt) {
                __syncthreads();
                for (int i = tid; i < 32 * 160; i += 512) { const int kk = i / 160, c = i % 160; const size_t krow = (size_t)b * SEQ + kt * 32 + kk;
                    if (c < 64) Ks[kk * 96 + c] = bf2f(KVb[krow * KVW + h * 128 + c]);
                    else if (c < 96) Ks[kk * 96 + c] = bf2f(KRb[krow * 32 + (c - 64)]);
                    else Vs[kk * 64 + (c - 96)] = bf2f(KVb[krow * KVW + h * 128 + 64 + (c - 96)]); }
                __syncthreads();
                for (int gq = 0; gq < 8; ++gq) {
                    float sv[4];
#pragma unroll
                    for (int j = 0; j < 4; ++j) { const LAS f32x4* kp = (const LAS f32x4*)(Ks + (gq * 4 + j) * 96); float a = 0.f;
#pragma unroll
                        for (int d4 = 0; d4 < 24; ++d4) { const f32x4 kv = kp[d4]; a += q[4 * d4] * kv.x + q[4 * d4 + 1] * kv.y + q[4 * d4 + 2] * kv.z + q[4 * d4 + 3] * kv.w; }
                        sv[j] = (kt * 32 + gq * 4 + j <= qi) ? a : -1e30f; }
                    const float mx = fmaxf(fmaxf(sv[0], sv[1]), fmaxf(sv[2], sv[3])); const float mn = fmaxf(mrun, mx);
                    const float al = __builtin_amdgcn_exp2f(mrun - mn); mrun = mn;
                    float p[4];
#pragma unroll
                    for (int j = 0; j < 4; ++j) p[j] = __builtin_amdgcn_exp2f(sv[j] - mn);
                    lrun = lrun * al + ((p[0] + p[1]) + (p[2] + p[3]));
#pragma unroll
                    for (int d4 = 0; d4 < 16; ++d4) { f32x4 a = (f32x4){o[4 * d4], o[4 * d4 + 1], o[4 * d4 + 2], o[4 * d4 + 3]} * al;
#pragma unroll
                        for (int j = 0; j < 4; ++j) a += p[j] * *(const LAS f32x4*)(Vs + (gq * 4 + j) * 64 + 4 * d4);
                        o[4 * d4] = a.x; o[4 * d4 + 1] = a.y; o[4 * d4 + 2] = a.z; o[4 * d4 + 3] = a.w; }
                }
            }
            const float inv = 1.0f / lrun;
            bf16* op = (bf16*)(ws + WS_O) + row * 1024 + h * 64;
#pragma unroll
            for (int d = 0; d < 64; d += 2) *(unsigned*)(op + d) = pk2(o[d] * inv, o[d + 1] * inv);
        }
        __syncthreads();
        if (BOTH(4)) GRID_BAR();
    }
    if (IN(5)) {
        pg8::Gemm g{(const bf16*)(ws + WS_O), (const bf16*)(ws + WS_WO0), M, D, D}; pg8::StaticOrder S; S.init(M, D, G, (int)blockIdx.x);
        pg8::EpiF32Res E{x, H, D, D / 256};
        pg8::gemm_phase<pg8::EpiF32Res, pg8::StaticOrder, true, false>(L + RING_OFF, g, S, E);
        if (BOTH(5)) GRID_BAR();
    }
    if (IN(6)) {
        for (int m = gw; m < M; m += NGW) rms_row_to_bf16(H + (size_t)m * D, args.in[3], (bf16*)(ws + WS_HN) + (size_t)m * D, lane);
        if (BOTH(6)) GRID_BAR();
    }
    if (IN(7)) {
        pg8::Gemm g{(const bf16*)(ws + WS_HN), (const bf16*)(ws + WS_WFGU), M, 2 * FF, D}; pg8::StaticOrder S; S.init(M, 2 * FF, G, (int)blockIdx.x);
        pg8::EpiSwiGLU E{(bf16*)(ws + WS_FACT), FF, 2 * FF / 256};
        pg8::gemm_phase<pg8::EpiSwiGLU, pg8::StaticOrder, true, false>(L + RING_OFF, g, S, E);
        if (BOTH(7)) GRID_BAR();
    }
    if (IN(8)) {
        pg8::Gemm g{(const bf16*)(ws + WS_FACT), (const bf16*)(ws + WS_WFDN), M, D, FF}; pg8::StaticOrder S; S.init(M, D, G, (int)blockIdx.x);
        pg8::EpiF32Res E{H, H, D, D / 256};
        pg8::gemm_phase<pg8::EpiF32Res, pg8::StaticOrder, true, false>(L + RING_OFF, g, S, E);
        if (BOTH(8)) GRID_BAR();
    }
    if (IN(9)) {
        for (int m = gw; m < M; m += NGW) rms_row_to_bf16(H + (size_t)m * D, args.in[2] + D, (bf16*)(ws + WS_HN) + (size_t)m * D, lane);
        if (BOTH(9)) GRID_BAR();
    }
    if (IN(10)) {
        pg8::Gemm g{(const bf16*)(ws + WS_HN), (const bf16*)(ws + WS_WHIN), M, HG_IN, D}; pg8::StaticOrder S; S.init(M, HG_IN, G, (int)blockIdx.x);
        pg8::EpiStoreBf16 E{(bf16*)(ws + WS_HPROJ), HG_IN, HG_IN / 256};
        pg8::gemm_phase<pg8::EpiStoreBf16, pg8::StaticOrder, true, false>(L + RING_OFF, g, S, E);
        if (BOTH(10)) GRID_BAR();
    }
    if (IN(11)) {
        LAS float* fS = (LAS float*)(L + RING_OFF);
        LAS float* qS = fS + 32 * 128;
        LAS float* vS = qS + 32 * 128;
        const bf16* HP = (const bf16*)(ws + WS_HPROJ); float* HO = (float*)(ws + WS_HOF);
        const int kq = lane & 15, vv = wave * 4 + (lane >> 4);
        for (int uu = blockIdx.x; uu < 128; uu += G) {
            const int b = uu >> 5, h = (uu >> 2) & 7, vs = uu & 3;
            float St[8];
#pragma unroll
            for (int j = 0; j < 8; ++j) St[j] = 0.f;
            for (int c = 0; c < SEQ / 32; ++c) {
                __syncthreads();
                for (int i = tid; i < 32 * 128; i += 512) { const int tt = i >> 7, k = i & 127; const size_t row = (size_t)b * SEQ + c * 32 + tt;
                    const float lbp0 = args.in[12][h * 128 + k], lbp1 = args.in[12][1024 + h * 128 + k]; const float lb = sigmoid_f(lbp1 - lbp0);
                    const float fp = bf2f(HP[row * HG_IN + 1024 + h * 128 + k]);
                    fS[i] = lb + (1.0f - lb) * sigmoid_f(fp);
                    qS[i] = bf2f(HP[row * HG_IN + h * 128 + k]) * 0.08838834764831845f; }
                for (int i = tid; i < 32 * 32; i += 512) { const int tt = i >> 5, v = i & 31; const size_t row = (size_t)b * SEQ + c * 32 + tt;
                    vS[i] = bf2f(HP[row * HG_IN + 2048 + h * 128 + vs * 32 + v]); }
                __syncthreads();
                for (int tt = 0; tt < 32; ++tt) {
                    const f32x4 f0 = *(const LAS f32x4*)(fS + tt * 128 + kq * 8), f1 = *(const LAS f32x4*)(fS + tt * 128 + kq * 8 + 4);
                    const f32x4 q0 = *(const LAS f32x4*)(qS + tt * 128 + kq * 8), q1 = *(const LAS f32x4*)(qS + tt * 128 + kq * 8 + 4);
                    const float vt = vS[tt * 32 + vv];
                    const float fv[8] = {f0.x, f0.y, f0.z, f0.w, f1.x, f1.y, f1.z, f1.w}; const float qv[8] = {q0.x, q0.y, q0.z, q0.w, q1.x, q1.y, q1.z, q1.w};
                    float a = 0.f;
#pragma unroll
                    for (int j = 0; j < 8; ++j) { St[j] = fv[j] * St[j] + (1.0f - fv[j]) * vt; a += St[j] * qv[j]; }
                    a += __shfl_xor(a, 1); a += __shfl_xor(a, 2); a += __shfl_xor(a, 4); a += __shfl_xor(a, 8);
                    if (kq == 0) HO[((size_t)b * SEQ + c * 32 + tt) * 1024 + h * 128 + vs * 32 + vv] = a;
                }
            }
        }
        __syncthreads();
        if (BOTH(11)) GRID_BAR();
    }
    if (IN(12)) {
        const float* HO = (const float*)(ws + WS_HOF); const bf16* HP = (const bf16*)(ws + WS_HPROJ);
        for (int m = gw; m < M; m += NGW) {
#pragma unroll
            for (int h = 0; h < 8; ++h) {
                const float o0 = HO[(size_t)m * 1024 + h * 128 + lane], o1 = HO[(size_t)m * 1024 + h * 128 + 64 + lane];
                const float rs = 1.f / sqrtf(wave_sum(o0 * o0 + o1 * o1) * (1.f / 128.f) + EPS);
                const float g0 = bf2f(HP[(size_t)m * HG_IN + 3072 + h * 128 + lane]), g1 = bf2f(HP[(size_t)m * HG_IN + 3072 + h * 128 + 64 + lane]);
                bf16* op = (bf16*)(ws + WS_HON) + (size_t)m * 1024 + h * 128;
                op[lane] = (bf16)f2bf(o0 * rs * args.in[13][lane] * (g0 * sigmoid_f(g0)));
                op[64 + lane] = (bf16)f2bf(o1 * rs * args.in[13][64 + lane] * (g1 * sigmoid_f(g1)));
            }
        }
        if (BOTH(12)) GRID_BAR();
    }
    if (IN(13)) {
        pg8::Gemm g{(const bf16*)(ws + WS_HON), (const bf16*)(ws + WS_WHO), M, D, D}; pg8::StaticOrder S; S.init(M, D, G, (int)blockIdx.x);
        pg8::EpiF32Res E{H, H, D, D / 256};
        pg8::gemm_phase<pg8::EpiF32Res, pg8::StaticOrder, true, false>(L + RING_OFF, g, S, E);
        if (BOTH(13)) GRID_BAR();
    }
    if (IN(14)) {
        const float* gn = args.in[3] + D; const float* RT = args.in[18];
        int* rowlist = (int*)(ws + WS_ROWLIST); v4u* tok = (v4u*)(ws + WS_TOK);
        for (int m = gw; m < M; m += NGW) {
            const f32x4* xr = (const f32x4*)(H + (size_t)m * D) + lane; const f32x4* gr = (const f32x4*)gn + lane;
            f32x4 v[4]; float s = 0.f;
#pragma unroll
            for (int j = 0; j < 4; ++j) { v[j] = xr[64 * j]; s += (v[j].x * v[j].x + v[j].y * v[j].y) + (v[j].z * v[j].z + v[j].w * v[j].w); }
            const float rstd = 1.f / sqrtf(wave_sum(s) * (1.f / 1024.f) + EPS);
            float lg[8];
#pragma unroll
            for (int e = 0; e < 8; ++e) lg[e] = 0.f;
            unsigned long long* o8 = (unsigned long long*)((bf16*)(ws + WS_HN3) + (size_t)m * D) + lane;
#pragma unroll
            for (int j = 0; j < 4; ++j) { const f32x4 g = gr[64 * j]; const f32x4 t = (f32x4){v[j].x * rstd * g.x, v[j].y * rstd * g.y, v[j].z * rstd * g.z, v[j].w * rstd * g.w};
                o8[64 * j] = (unsigned long long)pk2(t.x, t.y) | ((unsigned long long)pk2(t.z, t.w) << 32);
                const int k0 = 4 * (lane + 64 * j);
#pragma unroll
                for (int kk = 0; kk < 4; ++kk) { const f32x4 r0 = *(const f32x4*)(RT + (size_t)(k0 + kk) * 8), r1 = *(const f32x4*)(RT + (size_t)(k0 + kk) * 8 + 4); const float tv = t[kk];
                    lg[0] += tv * r0.x; lg[1] += tv * r0.y; lg[2] += tv * r0.z; lg[3] += tv * r0.w; lg[4] += tv * r1.x; lg[5] += tv * r1.y; lg[6] += tv * r1.z; lg[7] += tv * r1.w; } }
#pragma unroll
            for (int e = 0; e < 8; ++e) lg[e] = wave_sum(lg[e]);
            if (lane == 0) {
                int e1 = 0; float v1 = lg[0];
#pragma unroll
                for (int e = 1; e < 8; ++e) if (lg[e] > v1) { v1 = lg[e]; e1 = e; }
                int e2 = (e1 == 0) ? 1 : 0; float v2 = lg[e2];
#pragma unroll
                for (int e = 1; e < 8; ++e) if (e != e1 && lg[e] > v2) { v2 = lg[e]; e2 = e; }
                const float w1 = 1.0f / (1.0f + __expf(v2 - v1)), w2 = 1.0f - w1;
                const unsigned p1 = __hip_atomic_fetch_add((unsigned*)(ctl + CW_CNT + 64 * e1), 1u, RLX_AGENT), p2 = __hip_atomic_fetch_add((unsigned*)(ctl + CW_CNT + 64 * e2), 1u, RLX_AGENT);
                rowlist[e1 * CAP + p1] = m; rowlist[e2 * CAP + p2] = m;
                tok[m] = (v4u){(unsigned)(e1 * CAP) + p1, (unsigned)(e2 * CAP) + p2, __builtin_bit_cast(unsigned, w1), __builtin_bit_cast(unsigned, w2)};
            }
        }
        if (BOTH(14)) GRID_BAR();
    }
    if (IN(15) || IN(16) || IN(17)) {
        if (tid == 0) { volatile LAS int* mt = (volatile LAS int*)(MISC + 16); int acc = 0;
            for (int e = 0; e < 8; ++e) { const int c = (int)__hip_atomic_load((unsigned*)(ctl + CW_CNT + 64 * e), RLX_AGENT); mt[e] = acc; mt[9 + e] = c; acc += (c + 255) >> 8; }
            mt[8] = acc; }
        __syncthreads();
    }
    if (IN(15)) {
        pg8::Gemm g{(const bf16*)(ws + WS_HN3), (const bf16*)(ws + WS_WMGU), M, 2 * FF, D};
        MoeOrder S; S.init((volatile LAS int*)(MISC + 16), 2 * FF / 256, G, (int)blockIdx.x, (const int*)(ws + WS_ROWLIST));
        pg8::EpiSwiGLU E{(bf16*)(ws + WS_MACT), FF, 2 * FF / 256};
        pg8::gemm_phase<pg8::EpiSwiGLU, MoeOrder, true, true>(L + RING_OFF, g, S, E);
        if (BOTH(15)) GRID_BAR();
    }
    if (IN(16)) {
        pg8::Gemm g{(const bf16*)(ws + WS_MACT), (const bf16*)(ws + WS_WMDN), MAXSLOT, D, FF};
        MoeOrder S; S.init((volatile LAS int*)(MISC + 16), D / 256, G, (int)blockIdx.x, (const int*)(ws + WS_ROWLIST));
        pg8::EpiStoreBf16 E{(bf16*)(ws + WS_Y), D, D / 256};
        pg8::gemm_phase<pg8::EpiStoreBf16, MoeOrder, true, false>(L + RING_OFF, g, S, E);
        if (BOTH(16)) GRID_BAR();
    }
    if (IN(17)) {
        volatile LAS int* mt = (volatile LAS int*)(MISC + 16);
        const bf16* Y = (const bf16*)(ws + WS_Y); const v4u* tok = (const v4u*)(ws + WS_TOK);
        for (int m = gw; m < M; m += NGW) {
            const v4u tk = tok[m];
            const int e1 = tk.x / CAP, e2 = tk.y / CAP; const size_t s1 = (size_t)mt[e1] * 256 + (tk.x % CAP), s2 = (size_t)mt[e2] * 256 + (tk.y % CAP);
            const unsigned zb = tk.z, wb = tk.w; const float w1 = __uint_as_float(zb), w2 = __uint_as_float(wb);
            f32x4* xr = (f32x4*)(H + (size_t)m * D) + lane; const f32x4* gr = (const f32x4*)args.in[4] + lane;
            const v2u* y1 = (const v2u*)(Y + s1 * D) + lane; const v2u* y2 = (const v2u*)(Y + s2 * D) + lane;
            f32x4 v[4]; float s = 0.f;
#pragma unroll
            for (int j = 0; j < 4; ++j) { v[j] = xr[64 * j]; const v2u a = y1[64 * j], c = y2[64 * j];
                v[j].x += w1 * bf2f((unsigned short)(a.x & 0xffffu)) + w2 * bf2f((unsigned short)(c.x & 0xffffu)); v[j].y += w1 * bf2f((unsigned short)(a.x >> 16)) + w2 * bf2f((unsigned short)(c.x >> 16));
                v[j].z += w1 * bf2f((unsigned short)(a.y & 0xffffu)) + w2 * bf2f((unsigned short)(c.y & 0xffffu)); v[j].w += w1 * bf2f((unsigned short)(a.y >> 16)) + w2 * bf2f((unsigned short)(c.y >> 16));
                s += (v[j].x * v[j].x + v[j].y * v[j].y) + (v[j].z * v[j].z + v[j].w * v[j].w); }
            const float rstd = 1.f / sqrtf(wave_sum(s) * (1.f / 1024.f) + EPS);
#pragma unroll
            for (int j = 0; j < 4; ++j) { const f32x4 g = gr[64 * j]; xr[64 * j] = (f32x4){v[j].x * rstd * g.x, v[j].y * rstd * g.y, v[j].z * rstd * g.z, v[j].w * rstd * g.w}; }
        }
    }
#undef IN
#undef BOTH
}

extern "C" void kernel_launch(void* const* d_in, const int* in_sizes, int n_in, void* d_out, int out_size, void* d_ws, size_t ws_size, hipStream_t stream) {
    static int grid = 0;
    if (grid == 0) {
        if (n_in != 22 || in_sizes[0] != M * D || out_size != M * D || ws_size < WS_END) { fprintf(stderr, "kernel_launch: unexpected shapes (n_in %d, in0 %d, out %d, ws %zu)\n", n_in, n_in > 0 ? in_sizes[0] : -1, out_size, ws_size); grid = -1; return; }
        int dev = 0, cus = 0, per_cu = 0;
        if (hipGetDevice(&dev) != hipSuccess || hipDeviceGetAttribute(&cus, hipDeviceAttributeMultiprocessorCount, dev) != hipSuccess) { grid = -1; return; }
        if (hipFuncSetAttribute((const void*)fwd_kernel, hipFuncAttributeMaxDynamicSharedMemorySize, LDS_BYTES) != hipSuccess) { fprintf(stderr, "kernel_launch: hipFuncSetAttribute failed\n"); grid = -1; return; }
        if (hipOccupancyMaxActiveBlocksPerMultiprocessor(&per_cu, (const void*)fwd_kernel, NWAVES * 64, LDS_BYTES) != hipSuccess || per_cu < 1) fprintf(stderr, "kernel_launch: occupancy query reports %d\n", per_cu);
        (void)hipGetLastError();
        grid = cus;
    }
    if (grid < 0) return;
    if (hipMemsetAsync((char*)d_ws + WS_CTL, 0, CTL_ZERO_BYTES, stream) != hipSuccess) return;
    Args a{};
    for (int i = 0; i < 22; ++i) a.in[i] = (const float*)d_in[i];
    a.pos = (const int*)d_in[1]; a.out = (float*)d_out; a.ws = (unsigned char*)d_ws;
    static_assert(N_LAUNCHES == 1 || N_LAUNCHES == NPHASE, "MK_N_LAUNCHES: 1 or 18");
    for (int li = 0; li < N_LAUNCHES; ++li) {
        a.ph_lo = (N_LAUNCHES == 1) ? 0 : li; a.ph_hi = (N_LAUNCHES == 1) ? NPHASE : li + 1; a.li = li;
        hipLaunchKernelGGL(fwd_kernel, dim3(grid), dim3(NWAVES * 64), LDS_BYTES, stream, a);
        if (hipPeekAtLastError() != hipSuccess) { fprintf(stderr, "kernel_launch: launch %d failed\n", li); break; }
    }
}
```

```cpp
#include <hip/hip_runtime.h>
#include <cstdio>
#include <cstdint>

#ifndef MK_N_LAUNCHES
#define MK_N_LAUNCHES 1
#endif

namespace pg8 {
#define PG8_LAS __attribute__((address_space(3)))
typedef unsigned short bf16_t;
typedef short bf16x8 __attribute__((ext_vector_type(8)));
typedef float f32x4 __attribute__((ext_vector_type(4)));
typedef unsigned u32x4 __attribute__((ext_vector_type(4)));
constexpr int BM = 256, BK = 64, HALF = 128, HTB = HALF * BK * 2, STAGE_BYTES = 8 * HTB, NXCD = 8, WGM = 8;

__host__ __device__ __forceinline__ int lds_byte(int r, int c) { const int st = (r >> 4) * 2 + (c >> 5), rr = r & 15, cc = c & 31, ob = rr * 64 + cc * 2; return st * 1024 + (ob ^ (((ob >> 9) & 1) << 5)); }
__host__ __device__ __forceinline__ void stage_rc(int b, int& R, int& C) { const int st = b / 1024, sb = b % 1024, swz = sb ^ (((sb >> 9) & 1) << 5); R = (st >> 1) * 16 + swz / 64; C = (st & 1) * 32 + (swz % 64) / 2; }
__host__ __device__ __forceinline__ int perm32(int rho) { const int n = rho >> 4, i = rho & 15; return 8 * (i >> 2) + 4 * n + (i & 3); }

struct Unit { int pm, pn; };
struct Gemm { const bf16_t* A; const bf16_t* Bt; int M, N, K; };

struct StaticOrder {
    int nM, nN, nwg, G, c;
    __host__ __device__ void init(int M, int N, int G_, int c_) { nM = M / BM; nN = N / BM; nwg = nM * nN; G = G_; c = c_; }
    __host__ __device__ bool next(int i, Unit& u) const {
        const long L = (long)i * G + c; if (L >= nwg) return false;
        int wgid = (int)L; { const int q = nwg / NXCD, r = nwg % NXCD, xcd = wgid % NXCD, off = wgid / NXCD; wgid = (xcd < r ? xcd * (q + 1) : r * (q + 1) + (xcd - r) * q) + off; }
        const int nig = WGM * nN, gid = wgid / nig, fm = gid * WGM, gsz = (nM - fm) < WGM ? (nM - fm) : WGM;
        u.pm = fm + ((wgid % nig) % gsz); u.pn = (wgid % nig) / gsz; return true;
    }
    __device__ __forceinline__ void a_ready(const Unit&) const {}
    __device__ __forceinline__ void done(const Unit&) const {}
    __device__ __forceinline__ int arow(const Unit&, int) const { return 0; }
};

__device__ __forceinline__ unsigned cvt_pk_bf16(float lo, float hi) { unsigned r; asm volatile("v_cvt_pk_bf16_f32 %0, %1, %2" : "=v"(r) : "v"(lo), "v"(hi)); return r; }

struct EpiStoreBf16 {
    static constexpr bool PERM = true, AFTER_DRAIN = false;
    bf16_t* O; int ldc; int nN;
    __device__ __forceinline__ void operator()(const f32x4 (&acc)[2][2][4][2], const Unit& u, int wr, int wc, int fr, int fq) const {
        const int pnl = u.pn % nN; const int row0 = u.pm * BM + wr * 64 + fr, col0 = pnl * BM + wc * 32 + 8 * fq;
#pragma unroll
        for (int ai = 0; ai < 2; ++ai)
#pragma unroll
            for (int m = 0; m < 4; ++m) { bf16_t* rowp = O + (size_t)(row0 + ai * HALF + m * 16) * ldc + col0;
#pragma unroll
                for (int bj = 0; bj < 2; ++bj) { const f32x4 v0 = acc[ai][bj][m][0], v1 = acc[ai][bj][m][1];
                    u32x4 w; w.x = cvt_pk_bf16(v0[0], v0[1]); w.y = cvt_pk_bf16(v0[2], v0[3]); w.z = cvt_pk_bf16(v1[0], v1[1]); w.w = cvt_pk_bf16(v1[2], v1[3]);
                    *(u32x4*)(rowp + bj * HALF) = w; } }
    }
};
__device__ __forceinline__ float silu_f(float x) { return x * __builtin_amdgcn_rcpf(1.0f + __builtin_amdgcn_exp2f(-1.4426950408889634f * x)); }
struct EpiSwiGLU {
    static constexpr bool PERM = true, AFTER_DRAIN = false;
    bf16_t* O; int ldc; int nN;
    __device__ __forceinline__ void operator()(const f32x4 (&acc)[2][2][4][2], const Unit& u, int wr, int wc, int fr, int fq) const {
        const int pnl = u.pn % nN; const int row0 = u.pm * BM + wr * 64 + fr, col0 = pnl * HALF + wc * 32 + 8 * fq;
#pragma unroll
        for (int ai = 0; ai < 2; ++ai)
#pragma unroll
            for (int m = 0; m < 4; ++m) { bf16_t* rowp = O + (size_t)(row0 + ai * HALF + m * 16) * ldc + col0;
                const f32x4 g0 = acc[ai][0][m][0], g1 = acc[ai][0][m][1], u0 = acc[ai][1][m][0], u1 = acc[ai][1][m][1];
                u32x4 w; w.x = cvt_pk_bf16(silu_f(g0[0]) * u0[0], silu_f(g0[1]) * u0[1]); w.y = cvt_pk_bf16(silu_f(g0[2]) * u0[2], silu_f(g0[3]) * u0[3]);
                w.z = cvt_pk_bf16(silu_f(g1[0]) * u1[0], silu_f(g1[1]) * u1[1]); w.w = cvt_pk_bf16(silu_f(g1[2]) * u1[2], silu_f(g1[3]) * u1[3]);
                *(u32x4*)rowp = w; }
    }
};
struct EpiF32Res {
    static constexpr bool PERM = false, AFTER_DRAIN = false;
    const float* base; float* out; int ldc; int nN;
    __device__ __forceinline__ void operator()(const f32x4 (&acc)[2][2][4][2], const Unit& u, int wr, int wc, int fr, int fq) const {
        const int pnl = u.pn % nN; const int row0 = u.pm * BM + wr * 64 + fr, col0 = pnl * BM + wc * 32 + 4 * fq;
#pragma unroll
        for (int ai = 0; ai < 2; ++ai)
#pragma unroll
            for (int m = 0; m < 4; ++m) { const size_t off = (size_t)(row0 + ai * HALF + m * 16) * ldc + col0;
#pragma unroll
                for (int bj = 0; bj < 2; ++bj)
#pragma unroll
                    for (int n = 0; n < 2; ++n) { f32x4 v = acc[ai][bj][m][n]; if (base) v += *(const f32x4*)(base + off + bj * HALF + n * 16); *(f32x4*)(out + off + bj * HALF + n * 16) = v; } }
    }
};

template <class Epi, class Sched, bool ALIGN_EPI = true, bool GATHER = false>
__device__ __forceinline__ void gemm_phase(PG8_LAS unsigned char* lds, const Gemm g, const Sched& S, const Epi& E) {
    const int tid = threadIdx.x, wid = __builtin_amdgcn_readfirstlane(tid >> 6), lane = tid & 63, wr = wid >> 2, wc = wid & 3, fr = lane & 15, fq = lane >> 4;
    const int K = g.K, nt = K / BK;
    unsigned voffA[2], voffB[2]; int RA[2], CA[2];
#pragma unroll
    for (int i = 0; i < 2; ++i) { int R, C; stage_rc(tid * 16 + i * 8192, R, C); const int Rb = Epi::PERM ? ((R & ~31) + perm32(R & 31)) : R;
        voffA[i] = (unsigned)(R * K + C) * 2u; voffB[i] = (unsigned)(Rb * K + C) * 2u; RA[i] = R; CA[i] = C; }
    unsigned vAc[2][2], vAn[2][2];
    const size_t kstep = (size_t)(BK * 2);
    const size_t hstep = (size_t)HALF * K * 2;
    const size_t tstep = 2 * hstep;
    const size_t hstepA = GATHER ? (size_t)0 : hstep;
    const unsigned ldsw = (unsigned)wid * 1024u;
    const int aoff = lds_byte(wr * 64 + fr, fq * 8), boff = lds_byte(wc * 32 + fr, fq * 8);
#define PG8_SA(b, h) (((b) * 2 + (h)) * HTB)
#define PG8_SB(b, h) ((4 + (b) * 2 + (h)) * HTB)
#define PG8_STAGE(bufoff, gbase, voff) do { _Pragma("unroll") for (int _i = 0; _i < 2; ++_i) \
        __builtin_amdgcn_global_load_lds((const unsigned*)((const char*)(gbase) + (voff)[_i]), (PG8_LAS unsigned*)(lds + (bufoff) + ldsw + _i * 8192), 16, 0, 0); } while (0)
#define PG8_STAGE_A(bufoff, gbase, h, nx) do { _Pragma("unroll") for (int _i = 0; _i < 2; ++_i) { const unsigned _vo = GATHER ? ((nx) ? vAn[h][_i] : vAc[h][_i]) : voffA[_i]; \
        __builtin_amdgcn_global_load_lds((const unsigned*)((const char*)(gbase) + _vo), (PG8_LAS unsigned*)(lds + (bufoff) + ldsw + _i * 8192), 16, 0, 0); } } while (0)
#define PG8_GATH(dst, un) do { _Pragma("unroll") for (int _h = 0; _h < 2; ++_h) _Pragma("unroll") for (int _i = 0; _i < 2; ++_i) \
        dst[_h][_i] = (unsigned)(S.arow(un, _h * HALF + RA[_i]) * K + CA[_i]) * 2u; } while (0)
#define PG8_LDA(dst, b, h) do { _Pragma("unroll") for (int m = 0; m < 4; ++m) _Pragma("unroll") for (int k = 0; k < 2; ++k) dst[m][k] = *(const PG8_LAS bf16x8*)(lds + PG8_SA(b, h) + aoff + m * 2048 + k * 1024); } while (0)
#define PG8_LDB(dst, b, h) do { _Pragma("unroll") for (int n = 0; n < 2; ++n) _Pragma("unroll") for (int k = 0; k < 2; ++k) dst[n][k] = *(const PG8_LAS bf16x8*)(lds + PG8_SB(b, h) + boff + n * 2048 + k * 1024); } while (0)
#define PG8_MMA(ai, bj, At, Bt) do { __builtin_amdgcn_s_setprio(1); _Pragma("unroll") for (int m = 0; m < 4; ++m) _Pragma("unroll") for (int n = 0; n < 2; ++n) _Pragma("unroll") for (int k = 0; k < 2; ++k) \
        acc[ai][bj][m][n] = __builtin_amdgcn_mfma_f32_16x16x32_bf16(Bt[n][k], At[m][k], acc[ai][bj][m][n], 0, 0, 0); __builtin_amdgcn_s_setprio(0); } while (0)
#define PG8_WAIT_V(n) asm volatile("s_waitcnt vmcnt(" #n ")" ::: "memory")
#define PG8_WAIT_L(n) asm volatile("s_waitcnt lgkmcnt(" #n ")" ::: "memory")
#define PG8_BAR __builtin_amdgcn_s_barrier()
#define PG8_SCHED __builtin_amdgcn_sched_barrier(0)
    Unit cur, nxt; int ui = 0;
    if (!S.next(0, cur)) return;
    f32x4 acc[2][2][4][2];
#pragma unroll
    for (int a = 0; a < 2; ++a)
#pragma unroll
        for (int b = 0; b < 2; ++b)
#pragma unroll
            for (int m = 0; m < 4; ++m)
#pragma unroll
                for (int n = 0; n < 2; ++n) acc[a][b][m][n] = (f32x4){0.f, 0.f, 0.f, 0.f};
    bf16x8 At[4][2], B0[2][2], B1[2][2];
    const char* cA = GATHER ? (const char*)g.A : (const char*)g.A + (size_t)cur.pm * tstep; const char* cB = (const char*)g.Bt + (size_t)cur.pn * tstep;
    if (GATHER) { PG8_GATH(vAc, cur); }
    S.a_ready(cur);
    PG8_STAGE(PG8_SB(0, 0), cB, voffB); PG8_STAGE(PG8_SB(0, 1), cB + hstep, voffB); PG8_STAGE_A(PG8_SA(0, 0), cA, 0, false); PG8_STAGE_A(PG8_SA(0, 1), cA + hstepA, 1, false);
    if (wr == 1) PG8_BAR;
    PG8_WAIT_V(2); PG8_BAR;
    PG8_STAGE(PG8_SB(1, 0), cB + kstep, voffB); PG8_STAGE_A(PG8_SA(1, 0), cA + kstep, 0, false); PG8_STAGE(PG8_SB(1, 1), cB + hstep + kstep, voffB);
    PG8_WAIT_V(6); PG8_BAR;
    for (;;) {
        const bool has_next = S.next(ui + 1, nxt);
        const char* nA = GATHER ? (const char*)g.A : (has_next ? (const char*)g.A + (size_t)nxt.pm * tstep : cA); const char* nB = has_next ? (const char*)g.Bt + (size_t)nxt.pn * tstep : cB;
        if (GATHER) { if (has_next) { PG8_GATH(vAn, nxt); } else {
#pragma unroll
                for (int _h = 0; _h < 2; ++_h)
#pragma unroll
                    for (int _i = 0; _i < 2; ++_i) vAn[_h][_i] = vAc[_h][_i]; } }
        for (int t = 0; t < nt; t += 2) {
            const bool last = (t == nt - 2);
            const char* a1 = cA + (size_t)(t + 1) * kstep;
            const char* a2 = last ? nA : cA + (size_t)(t + 2) * kstep; const char* b2 = last ? nB : cB + (size_t)(t + 2) * kstep;
            const char* a3 = a2 + kstep; const char* b3 = b2 + kstep;
            if (last && has_next) S.a_ready(nxt);
            PG8_LDB(B0, 0, 0); PG8_LDB(B1, 0, 1); PG8_SCHED; PG8_LDA(At, 0, 0); PG8_STAGE_A(PG8_SA(1, 1), a1 + hstepA, 1, false);
            PG8_WAIT_V(8); PG8_WAIT_L(0); PG8_BAR; PG8_MMA(0, 0, At, B0); PG8_MMA(0, 1, At, B1); PG8_BAR; PG8_SCHED;
            PG8_LDA(At, 0, 1); PG8_STAGE(PG8_SB(0, 0), b2, voffB); PG8_STAGE(PG8_SB(0, 1), b2 + hstep, voffB); PG8_STAGE_A(PG8_SA(0, 0), a2, 0, last);
            PG8_WAIT_V(8); PG8_WAIT_L(0); PG8_BAR; PG8_MMA(1, 0, At, B0); PG8_MMA(1, 1, At, B1); PG8_BAR; PG8_SCHED;
            PG8_LDB(B0, 1, 0); PG8_LDB(B1, 1, 1); PG8_SCHED; PG8_LDA(At, 1, 0); PG8_STAGE_A(PG8_SA(0, 1), a2 + hstepA, 1, last);
            PG8_WAIT_V(8); PG8_WAIT_L(0); PG8_BAR; PG8_MMA(0, 0, At, B0); PG8_MMA(0, 1, At, B1); PG8_BAR; PG8_SCHED;
            PG8_LDA(At, 1, 1); PG8_STAGE(PG8_SB(1, 0), b3, voffB); PG8_STAGE(PG8_SB(1, 1), b3 + hstep, voffB); PG8_STAGE_A(PG8_SA(1, 0), a3, 0, last);
            PG8_WAIT_V(8); PG8_WAIT_L(0); PG8_BAR; PG8_MMA(1, 0, At, B0); PG8_MMA(1, 1, At, B1); PG8_BAR; PG8_SCHED;
        }
        if constexpr (ALIGN_EPI) { if (wr == 0) PG8_BAR; }
        E(acc, cur, wr, wc, fr, fq); S.done(cur);
        if (!has_next) break;
#pragma unroll
        for (int a = 0; a < 2; ++a)
#pragma unroll
            for (int b = 0; b < 2; ++b)
#pragma unroll
                for (int m = 0; m < 4; ++m)
#pragma unroll
                    for (int n = 0; n < 2; ++n) acc[a][b][m][n] = (f32x4){0.f, 0.f, 0.f, 0.f};
        cur = nxt; cA = nA; cB = nB; ++ui;
        if (GATHER) {
#pragma unroll
            for (int _h = 0; _h < 2; ++_h)
#pragma unroll
                for (int _i = 0; _i < 2; ++_i) vAc[_h][_i] = vAn[_h][_i]; }
        if constexpr (ALIGN_EPI) { if (wr == 1) PG8_BAR; }
    }
    PG8_WAIT_V(0);
    if constexpr (!ALIGN_EPI) { if (wr == 0) PG8_BAR; }
    PG8_BAR;
#undef PG8_SA
#undef PG8_SB
#undef PG8_STAGE
#undef PG8_STAGE_A
#undef PG8_GATH
#undef PG8_LDA
#undef PG8_LDB
#undef PG8_MMA
#undef PG8_WAIT_V
#undef PG8_WAIT_L
#undef PG8_BAR
#undef PG8_SCHED
}
}

constexpr int NWAVES = 8;
constexpr int N_LAUNCHES = MK_N_LAUNCHES;
constexpr int NPHASE = 18;
constexpr int BATCH = 4, SEQ = 4096, D = 1024, M = BATCH * SEQ;
constexpr int NH = 16, QL = 384, KVL = 256, NOPE = 64, ROPE = 32, VD = 64, MLA_IN = 672, MLA_INP = 768, QW = NH * 96, KVW = NH * 128;
constexpr int HGH = 8, DK = 128, DV = 128, HG_IN = 4096;
constexpr int FF = 3584, NE = 8, CAP = 16384;
constexpr int MAXSLOT = 2 * M + NE * 256;
constexpr float EPS = 1e-6f;

constexpr size_t MiB = 1u << 20;
constexpr size_t WS_CTL = 0, CTL_ZERO_BYTES = 1 * MiB;
constexpr size_t WS_ROWLIST = 1 * MiB;
constexpr size_t WS_TOK = WS_ROWLIST + 512 * 1024;
constexpr size_t WS_COS = 2 * MiB, WS_SIN = 3 * MiB;
constexpr size_t WS_WMLAIN = 4 * MiB;
constexpr size_t WS_WQUP = 6 * MiB;
constexpr size_t WS_WKVUP = 8 * MiB;
constexpr size_t WS_WO0 = 9 * MiB;
constexpr size_t WS_WFGU = 11 * MiB;
constexpr size_t WS_WFDN = 25 * MiB;
constexpr size_t WS_WHIN = 32 * MiB;
constexpr size_t WS_WHO = 40 * MiB;
constexpr size_t WS_WMGU = 42 * MiB;
constexpr size_t WS_WMDN = 154 * MiB;
constexpr size_t WS_ACTS = 210 * MiB;
constexpr size_t WS_HN = WS_ACTS;
constexpr size_t WS_PROJ = WS_ACTS + 32 * MiB;
constexpr size_t WS_CQN = WS_PROJ + 24 * MiB;
constexpr size_t WS_CKVN = WS_CQN + 12 * MiB;
constexpr size_t WS_KR = WS_CKVN + 8 * MiB;
constexpr size_t WS_Q = WS_KR + 1 * MiB;
constexpr size_t WS_KV = WS_Q + 48 * MiB;
constexpr size_t WS_O = WS_KV + 64 * MiB;
constexpr size_t WS_FACT = WS_ACTS + 32 * MiB;
constexpr size_t WS_HPROJ = WS_ACTS + 32 * MiB;
constexpr size_t WS_HOF = WS_HPROJ + 128 * MiB;
constexpr size_t WS_HON = WS_HOF + 64 * MiB;
constexpr size_t WS_HN3 = 4 * MiB;
constexpr size_t WS_MACT = WS_ACTS;
constexpr size_t WS_Y = WS_WMGU;
constexpr size_t WS_END = 472 * MiB;
static_assert(WS_O + (size_t)M * 1024 * 2 <= WS_END && WS_HON + (size_t)M * 1024 * 2 <= WS_END && WS_MACT + (size_t)MAXSLOT * FF * 2 <= WS_END, "d_ws map");
static_assert(WS_HN3 + (size_t)M * 1024 * 2 <= WS_WHO, "hn3 overlay");
constexpr int CW_CNT = 64;
constexpr int CW_BAR = 4096;

constexpr int RING_OFF = 0, RING_BYTES = 131072;
constexpr int LDSCTL_OFF = RING_BYTES, MISC_OFF = LDSCTL_OFF + 320;
constexpr int LDS_BYTES = 147456;

#define GAS __attribute__((address_space(1)))
#define LAS __attribute__((address_space(3)))
typedef unsigned short bf16;
typedef unsigned v4u __attribute__((ext_vector_type(4)));
typedef unsigned v2u __attribute__((ext_vector_type(2)));
typedef float f32x4 __attribute__((ext_vector_type(4)));
typedef GAS unsigned gu32;
#define RLX_AGENT __ATOMIC_RELAXED, __HIP_MEMORY_SCOPE_AGENT
#define LDS_WAIT() asm volatile("s_waitcnt lgkmcnt(0)" ::: "memory")
__device__ __forceinline__ unsigned f2bf(float f) { unsigned u = __builtin_bit_cast(unsigned, f); return (u + 0x7fffu + ((u >> 16) & 1u)) >> 16; }
__device__ __forceinline__ unsigned pk2(float lo, float hi) { return f2bf(lo) | (f2bf(hi) << 16); }
__device__ __forceinline__ float bf2f(unsigned short b) { return __builtin_bit_cast(float, (unsigned)b << 16); }

#define XB_TMO      128
#define XB_XCNT(j)  (256  + 64 * (j))
#define XB_XSUB(j)  (1280 + 64 * (j))
#define XB_XGEN(j)  (2304 + 64 * (j))
#define XB_TOP      3328
#define XB_TOPGEN   3392
#define XCD_BAR_WORDS 3456
#define XB_SPIN_CAP (1u << 24)
__device__ __forceinline__ unsigned xb_ld(unsigned* p)              { return __hip_atomic_load(p, __ATOMIC_RELAXED, __HIP_MEMORY_SCOPE_AGENT); }
__device__ __forceinline__ unsigned xb_add(unsigned* p, unsigned v) { return __hip_atomic_fetch_add(p, v, __ATOMIC_RELAXED, __HIP_MEMORY_SCOPE_AGENT); }
__device__ __forceinline__ unsigned xb_xcc_id() { return (unsigned)__builtin_amdgcn_s_getreg((3 << 11) | 20) & 0xFu; }
#define XB_SPIN(cond, bar) do { unsigned _sp = 0; while (cond) { __builtin_amdgcn_s_sleep(1); \
    if ((++_sp & 255u) == 0u) { if (xb_ld(&(bar)[XB_TMO])) break; if (_sp > XB_SPIN_CAP) { atomicAdd(&(bar)[XB_TMO], 1u); break; } } } } while (0)
struct XcdBarrier { unsigned* bar; unsigned x; volatile LAS unsigned* st; };
__device__ __forceinline__ XcdBarrier xcd_barrier_post(unsigned* bar, volatile LAS unsigned* st) {
    XcdBarrier b; b.bar = bar; b.x = xb_xcc_id(); b.st = st;
    if (threadIdx.x == 0) (void)xb_add(&bar[XB_XCNT(b.x)], 1u);
    return b;
}
__device__ __forceinline__ void xcd_barrier_complete(unsigned* bar, unsigned x, unsigned& nloc, unsigned& nx) {
    const unsigned G = gridDim.x * gridDim.y * gridDim.z;
    unsigned sum, cnt, mine, sp = 0u;
    for (;;) {
        sum = 0u; cnt = 0u; mine = 0u;
#pragma unroll
        for (unsigned j = 0; j < 16; ++j) { const unsigned c = xb_ld(&bar[XB_XCNT(j)]); sum += c; cnt += (c > 0u) ? 1u : 0u; mine = (j == x) ? c : mine; }
        if (sum == G) break;
        __builtin_amdgcn_s_sleep(1);
        if ((++sp & 255u) == 0u) { if (xb_ld(&bar[XB_TMO])) break; if (sp > XB_SPIN_CAP) { atomicAdd(&bar[XB_TMO], 1u); break; } }
    }
    nloc = mine > 0u ? mine : 1u; nx = cnt > 0u ? cnt : 1u;
}
__device__ __forceinline__ void xcd_barrier(const XcdBarrier& b) {
    asm volatile("s_waitcnt vmcnt(0)" ::: "memory");
    __syncthreads();
    if (threadIdx.x == 0) {
        unsigned* bar = b.bar;
        __builtin_amdgcn_s_waitcnt(0);
        unsigned nloc = b.st[0], nx = b.st[1];
        if (nloc == 0u) { xcd_barrier_complete(bar, b.x, nloc, nx); b.st[0] = nloc; b.st[1] = nx; }
        const unsigned old = xb_add(&bar[XB_XSUB(b.x)], 1u);
        const unsigned gen = old / nloc;
        if (old + 1u == (gen + 1u) * nloc) {
            __builtin_amdgcn_fence(__ATOMIC_RELEASE, "agent");
            asm volatile("s_waitcnt vmcnt(0)" ::: "memory");
            const unsigned og = xb_add(&bar[XB_TOP], 1u);
            const unsigned tg = og / nx;
            if (og + 1u == (tg + 1u) * nx) xb_add(&bar[XB_TOPGEN], 1u);
            else XB_SPIN(xb_ld(&bar[XB_TOPGEN]) == tg, bar);
            __builtin_amdgcn_fence(__ATOMIC_ACQUIRE, "agent");
            xb_add(&bar[XB_XGEN(b.x)], 1u);
            asm volatile("s_waitcnt vmcnt(0)" ::: "memory");
        } else {
            XB_SPIN(xb_ld(&bar[XB_XGEN(b.x)]) == gen, bar);
            __builtin_amdgcn_fence(__ATOMIC_ACQUIRE, "agent");
            asm volatile("s_waitcnt vmcnt(0)" ::: "memory");
        }
    }
    __syncthreads();
}

__device__ __forceinline__ float wave_sum(float v) {
#pragma unroll
    for (int o = 1; o < 64; o <<= 1) v += __shfl_xor(v, o);
    return v;
}
__device__ __forceinline__ int dst_row(int n, int mode) { return mode == 0 ? n : (((n >> 7) << 8) + (n & 127) + (mode == 2 ? 128 : 0)); }
__device__ __forceinline__ void tr_item(const float* W, int K, int N, bf16* WT, int mode, LAS float* scr, int item, int lane) {
    const int nblk = N / 32, kb = item / nblk, nb = item % nblk, k0 = 64 * kb, n0 = 32 * nb;
#pragma unroll 8
    for (int i = 0; i < 32; ++i) { const int kk = 2 * i + (lane >> 5); scr[kk * 33 + (lane & 31)] = W[(size_t)(k0 + kk) * N + n0 + (lane & 31)]; }
    LDS_WAIT(); asm volatile("" ::: "memory");
    const int c = lane & 7;
#pragma unroll
    for (int j = 0; j < 4; ++j) { const int n = (lane >> 3) + 8 * j; const LAS float* s = scr + (8 * c) * 33 + n;
        v4u o; o.x = pk2(s[0 * 33], s[1 * 33]); o.y = pk2(s[2 * 33], s[3 * 33]); o.z = pk2(s[4 * 33], s[5 * 33]); o.w = pk2(s[6 * 33], s[7 * 33]);
        *(v4u*)(WT + (size_t)dst_row(n0 + n, mode) * K + k0 + 8 * c) = o; }
    LDS_WAIT(); asm volatile("" ::: "memory");
}
__device__ __forceinline__ void rms_row_to_bf16(const float* xrow, const float* gain, bf16* orow, int lane) {
    const f32x4* xr = (const f32x4*)xrow + lane; const f32x4* gr = (const f32x4*)gain + lane;
    f32x4 v[4]; float s = 0.f;
#pragma unroll
    for (int j = 0; j < 4; ++j) { v[j] = xr[64 * j]; s += (v[j].x * v[j].x + v[j].y * v[j].y) + (v[j].z * v[j].z + v[j].w * v[j].w); }
    const float rstd = 1.f / sqrtf(wave_sum(s) * (1.f / 1024.f) + EPS);
    unsigned long long* o8 = (unsigned long long*)orow + lane;
#pragma unroll
    for (int j = 0; j < 4; ++j) { const f32x4 g = gr[64 * j];
        o8[64 * j] = (unsigned long long)pk2(v[j].x * rstd * g.x, v[j].y * rstd * g.y) | ((unsigned long long)pk2(v[j].z * rstd * g.z, v[j].w * rstd * g.w) << 32); }
}
__device__ __forceinline__ float sigmoid_f(float x) { return 1.0f / (1.0f + __expf(-x)); }

struct MoeOrder {
    pg8::StaticOrder so; int nN; volatile LAS int* mt; const int* rowlist;
    __device__ __forceinline__ void init(volatile LAS int* mt_, int nN_, int G, int c, const int* rl) { mt = mt_; nN = nN_; rowlist = rl; so.init(mt_[8] * 256, nN_ * 256, G, c); }
    __device__ __forceinline__ bool next(int i, pg8::Unit& u) const {
        if (!so.next(i, u)) return false;
        int e = 0;
#pragma unroll
        for (int j = 1; j < 8; ++j) e += (u.pm >= mt[j]) ? 1 : 0;
        u.pn = e * nN + u.pn; return true;
    }
    __device__ __forceinline__ void a_ready(const pg8::Unit&) const {}
    __device__ __forceinline__ void done(const pg8::Unit&) const {}
    __device__ __forceinline__ int arow(const pg8::Unit& u, int r) const { const int e = u.pn / nN; const int lr = (u.pm - mt[e]) * 256 + r; return lr < mt[9 + e] ? rowlist[e * CAP + lr] : 0; }
};

struct Args { const float* in[22]; const int* pos; float* out; unsigned char* ws; int ph_lo, ph_hi, li, pad; };

__global__ void __launch_bounds__(NWAVES * 64, 2) fwd_kernel(Args args) {
    extern __shared__ __attribute__((aligned(16))) unsigned char lds[];
    LAS unsigned char* L = (LAS unsigned char*)lds;
    volatile LAS unsigned* MISC = (volatile LAS unsigned*)(L + MISC_OFF);
    const int tid = threadIdx.x, lane = tid & 63, wave = __builtin_amdgcn_readfirstlane(tid >> 6);
    const int G = gridDim.x;
    const int gw = blockIdx.x * NWAVES + wave, NGW = G * NWAVES;
    unsigned char* ws = args.ws;
    gu32* ctl = (gu32*)(ws + WS_CTL);
    for (int u = tid; u < (LDS_BYTES - LDSCTL_OFF) / 4; u += NWAVES * 64) ((LAS unsigned*)(L + LDSCTL_OFF))[u] = 0u;
    __syncthreads();
    XcdBarrier bar; bar.bar = (unsigned*)(ctl + CW_BAR); bar.x = 0; bar.st = nullptr;
    if (N_LAUNCHES == 1) bar = xcd_barrier_post((unsigned*)(ctl + CW_BAR), MISC + 8);
#define GRID_BAR() do { if (N_LAUNCHES == 1) xcd_barrier(bar); } while (0)
    const int lo = args.ph_lo, hi = args.ph_hi;
#define IN(k) (lo <= (k) && (k) < hi)
#define BOTH(k) (IN(k) && IN((k) + 1))
    const float* x = args.in[0];
    float* H = args.out;

    if (IN(0)) {
        LAS float* scr = (LAS float*)(L + RING_OFF + wave * 16384);
        constexpr int I_MOE = (1024 / 64) * (3584 / 32);
        constexpr int NITEMS = 16 * 21 + 6 * 48 + 4 * 64 + 16 * 32 + 2 * 1792 + 1792 + 16 * 128 + 16 * 32 + 24 * I_MOE;
        for (int it = gw; it < NITEMS; it += NGW) {
            int r = it;
#define JOB(W, K_, N_, WT, mode) { const int ni = ((K_) / 64) * ((N_) / 32); if (r < ni) { tr_item((W), (K_), (N_), (bf16*)(ws + (WT)), (mode), scr, r, lane); continue; } r -= ni; }
            JOB(args.in[5], 1024, 672, WS_WMLAIN, 0)
            JOB(args.in[7], 384, 1536, WS_WQUP, 0)
            JOB(args.in[9], 256, 2048, WS_WKVUP, 0)
            JOB(args.in[10], 1024, 1024, WS_WO0, 0)
            JOB(args.in[15], 1024, 3584, WS_WFGU, 1)
            JOB(args.in[16], 1024, 3584, WS_WFGU, 2)
            JOB(args.in[17], 3584, 1024, WS_WFDN, 0)
            JOB(args.in[11], 1024, 4096, WS_WHIN, 0)
            JOB(args.in[14], 1024, 1024, WS_WHO, 0)
#undef JOB
            if (r < 8 * I_MOE) { const int e = r / I_MOE; tr_item(args.in[19] + (size_t)e * 1024 * 3584, 1024, 3584, (bf16*)(ws + WS_WMGU) + (size_t)e * 7168 * 1024, 1, scr, r % I_MOE, lane); continue; } r -= 8 * I_MOE;
            if (r < 8 * I_MOE) { const int e = r / I_MOE; tr_item(args.in[20] + (size_t)e * 1024 * 3584, 1024, 3584, (bf16*)(ws + WS_WMGU) + (size_t)e * 7168 * 1024, 2, scr, r % I_MOE, lane); continue; } r -= 8 * I_MOE;
            { const int e = r / I_MOE; tr_item(args.in[21] + (size_t)e * 3584 * 1024, 3584, 1024, (bf16*)(ws + WS_WMDN) + (size_t)e * 1024 * 3584, 0, scr, r % I_MOE, lane); }
        }
        { v4u* z = (v4u*)((bf16*)(ws + WS_WMLAIN) + (size_t)MLA_IN * 1024); const int n16 = (MLA_INP - MLA_IN) * 1024 * 2 / 16;
          for (int i = blockIdx.x * NWAVES * 64 + tid; i < n16; i += G * NWAVES * 64) z[i] = (v4u){0u, 0u, 0u, 0u}; }
        for (int m = gw; m < M; m += NGW) rms_row_to_bf16(x + (size_t)m * D, args.in[2], (bf16*)(ws + WS_HN) + (size_t)m * D, lane);
        if (BOTH(0)) GRID_BAR();
    }
    if (IN(1)) {
        pg8::Gemm g{(const bf16*)(ws + WS_HN), (const bf16*)(ws + WS_WMLAIN), M, MLA_INP, 1024}; pg8::StaticOrder S; S.init(M, MLA_INP, G, (int)blockIdx.x);
        pg8::EpiStoreBf16 E{(bf16*)(ws + WS_PROJ), MLA_INP, MLA_INP / 256};
        pg8::gemm_phase<pg8::EpiStoreBf16, pg8::StaticOrder, true, false>(L + RING_OFF, g, S, E);
        if (BOTH(1)) GRID_BAR();
    }
    if (IN(2)) {
        const bf16* P = (const bf16*)(ws + WS_PROJ);
        for (int m = gw; m < M; m += NGW) {
            const bf16* pr = P + (size_t)m * MLA_INP;
            float cq[6]; float s = 0.f;
#pragma unroll
            for (int j = 0; j < 6; ++j) { cq[j] = bf2f(pr[j * 64 + lane]); s += cq[j] * cq[j]; }
            const float rq = 1.f / sqrtf(wave_sum(s) * (1.f / QL) + EPS);
            bf16* oq = (bf16*)(ws + WS_CQN) + (size_t)m * QL;
#pragma unroll
            for (int j = 0; j < 6; ++j) oq[j * 64 + lane] = (bf16)f2bf(cq[j] * rq * args.in[6][j * 64 + lane]);
            float ck[4]; s = 0.f;
#pragma unroll
            for (int j = 0; j < 4; ++j) { ck[j] = bf2f(pr[QL + j * 64 + lane]); s += ck[j] * ck[j]; }
            const float rk = 1.f / sqrtf(wave_sum(s) * (1.f / KVL) + EPS);
            bf16* ok = (bf16*)(ws + WS_CKVN) + (size_t)m * KVL;
#pragma unroll
            for (int j = 0; j < 4; ++j) ok[j * 64 + lane] = (bf16)f2bf(ck[j] * rk * args.in[8][j * 64 + lane]);
            if (lane < 16) {
                const float invf = exp2f(-(float)lane * (13.287712379549449f / 16.0f));
                const float ang = (float)args.pos[m] * invf;
                const double rev = (double)ang * 0.15915494309189535; const float fr = (float)(rev - rint(rev));
                const float sn = __builtin_amdgcn_sinf(fr), cs = __builtin_amdgcn_cosf(fr);
                ((float*)(ws + WS_COS))[(size_t)m * 16 + lane] = cs; ((float*)(ws + WS_SIN))[(size_t)m * 16 + lane] = sn;
                const float x1 = bf2f(pr[QL + KVL + lane]), x2 = bf2f(pr[QL + KVL + 16 + lane]);
                bf16* okr = (bf16*)(ws + WS_KR) + (size_t)m * 32;
                okr[lane] = (bf16)f2bf(x1 * cs - x2 * sn); okr[16 + lane] = (bf16)f2bf(x2 * cs + x1 * sn);
            }
        }
        if (BOTH(2)) GRID_BAR();
    }
    if (IN(3)) {
        { pg8::Gemm g{(const bf16*)(ws + WS_CQN), (const bf16*)(ws + WS_WQUP), M, QW, QL}; pg8::StaticOrder S; S.init(M, QW, G, (int)blockIdx.x);
          pg8::EpiStoreBf16 E{(bf16*)(ws + WS_Q), QW, QW / 256};
          pg8::gemm_phase<pg8::EpiStoreBf16, pg8::StaticOrder, true, false>(L + RING_OFF, g, S, E); }
        { pg8::Gemm g{(const bf16*)(ws + WS_CKVN), (const bf16*)(ws + WS_WKVUP), M, KVW, KVL}; pg8::StaticOrder S; S.init(M, KVW, G, (int)blockIdx.x);
          pg8::EpiStoreBf16 E{(bf16*)(ws + WS_KV), KVW, KVW / 256};
          pg8::gemm_phase<pg8::EpiStoreBf16, pg8::StaticOrder, true, false>(L + RING_OFF, g, S, E); }
        if (BOTH(3)) GRID_BAR();
    }
    if (IN(4)) {
        LAS float* Ks = (LAS float*)(L + RING_OFF);
        LAS float* Vs = (LAS float*)(L + RING_OFF + 32 * 96 * 4);
        const bf16* Qb = (const bf16*)(ws + WS_Q); const bf16* KVb = (const bf16*)(ws + WS_KV); const bf16* KRb = (const bf16*)(ws + WS_KR);
        const float* COS = (const float*)(ws + WS_COS); const float* SIN = (const float*)(ws + WS_SIN);
        const float sc = 0.10206207261596577f * 1.4426950408889634f;
        for (int uu = blockIdx.x; uu < 512; uu += G) {
            const int bh = uu >> 3, j8 = uu & 7, qb = (j8 & 1) ? 7 - (j8 >> 1) : (j8 >> 1);
            const int b = bh >> 4, h = bh & 15;
            const int qi = qb * 512 + tid; const size_t row = (size_t)b * SEQ + qi;
            float q[96];
            { const bf16* qp = Qb + row * QW + h * 96;
#pragma unroll
              for (int d = 0; d < 96; ++d) q[d] = bf2f(qp[d]);
#pragma unroll
              for (int i = 0; i < 16; ++i) { const float cs = COS[row * 16 + i], sn = SIN[row * 16 + i]; const float x1 = q[64 + i], x2 = q[80 + i]; q[64 + i] = x1 * cs - x2 * sn; q[80 + i] = x2 * cs + x1 * sn; }
#pragma unroll
              for (int d = 0; d < 96; ++d) q[d] *= sc; }
            float o[64];
#pragma unroll
            for (int d = 0; d < 64; ++d) o[d] = 0.f;
            float mrun = -1e30f, lrun = 0.f;
            const int nkt = (qb + 1) * 16;
            for (int kt = 0; kt < nkt; ++kt) {
                __syncthreads();
                for (int i = tid; i < 32 * 160; i += 512) { const int kk = i / 160, c = i % 160; const size_t krow = (size_t)b * SEQ + kt * 32 + kk;
                    if (c < 64) Ks[kk * 96 + c] = bf2f(KVb[krow * KVW + h * 128 + c]);
                    else if (c < 96) Ks[kk * 96 + c] = bf2f(KRb[krow * 32 + (c - 64)]);
                    else Vs[kk * 64 + (c - 96)] = bf2f(KVb[krow * KVW + h * 128 + 64 + (c - 96)]); }
                __syncthreads();
                for (int gq = 0; gq < 8; ++gq) {
                    float sv[4];
#pragma unroll
                    for (int j = 0; j < 4; ++j) { const LAS f32x4* kp = (const LAS f32x4*)(Ks + (gq * 4 + j) * 96); float a = 0.f;
#pragma unroll
                        for (int d4 = 0; d4 < 24; ++d4) { const f32x4 kv = kp[d4]; a += q[4 * d4] * kv.x + q[4 * d4 + 1] * kv.y + q[4 * d4 + 2] * kv.z + q[4 * d4 + 3] * kv.w; }
                        sv[j] = (kt * 32 + gq * 4 + j <= qi) ? a : -1e30f; }
                    const float mx = fmaxf(fmaxf(sv[0], sv[1]), fmaxf(sv[2], sv[3])); const float mn = fmaxf(mrun, mx);
                    const float al = __builtin_amdgcn_exp2f(mrun - mn); mrun = mn;
                    float p[4];
#pragma unroll
                    for (int j = 0; j < 4; ++j) p[j] = __builtin_amdgcn_exp2f(sv[j] - mn);
                    lrun = lrun * al + ((p[0] + p[1]) + (p[2] + p[3]));
#pragma unroll
                    for (int d4 = 0; d4 < 16; ++d4) { f32x4 a = (f32x4){o[4 * d4], o[4 * d4 + 1], o[4 * d4 + 2], o[4 * d4 + 3]} * al;
#pragma unroll
                        for (int j = 0; j < 4; ++j) a += p[j] * *(const LAS f32x4*)(Vs + (gq * 4 + j) * 64 + 4 * d4);
                        o[4 * d4] = a.x; o[4 * d4 + 1] = a.y; o[4 * d4 + 2] = a.z; o[4 * d4 + 3] = a.w; }
                }
            }
            const float inv = 1.0f / lrun;
            bf16* op = (bf16*)(ws + WS_O) + row * 1024 + h * 64;
#pragma unroll
            for (int d = 0; d < 64; d += 2) *(unsigned*)(op + d) = pk2(o[d] * inv, o[d + 1] * inv);
        }
        __syncthreads();
        if (BOTH(4)) GRID_BAR();
    }
    if (IN(5)) {
        pg8::Gemm g{(const bf16*)(ws + WS_O), (const bf16*)(ws + WS_WO0), M, D, D}; pg8::StaticOrder S; S.init(M, D, G, (int)blockIdx.x);
        pg8::EpiF32Res E{x, H, D, D / 256};
        pg8::gemm_phase<pg8::EpiF32Res, pg8::StaticOrder, true, false>(L + RING_OFF, g, S, E);
        if (BOTH(5)) GRID_BAR();
    }
    if (IN(6)) {
        for (int m = gw; m < M; m += NGW) rms_row_to_bf16(H + (size_t)m * D, args.in[3], (bf16*)(ws + WS_HN) + (size_t)m * D, lane);
        if (BOTH(6)) GRID_BAR();
    }
    if (IN(7)) {
        pg8::Gemm g{(const bf16*)(ws + WS_HN), (const bf16*)(ws + WS_WFGU), M, 2 * FF, D}; pg8::StaticOrder S; S.init(M, 2 * FF, G, (int)blockIdx.x);
        pg8::EpiSwiGLU E{(bf16*)(ws + WS_FACT), FF, 2 * FF / 256};
        pg8::gemm_phase<pg8::EpiSwiGLU, pg8::StaticOrder, true, false>(L + RING_OFF, g, S, E);
        if (BOTH(7)) GRID_BAR();
    }
    if (IN(8)) {
        pg8::Gemm g{(const bf16*)(ws + WS_FACT), (const bf16*)(ws + WS_WFDN), M, D, FF}; pg8::StaticOrder S; S.init(M, D, G, (int)blockIdx.x);
        pg8::EpiF32Res E{H, H, D, D / 256};
        pg8::gemm_phase<pg8::EpiF32Res, pg8::StaticOrder, true, false>(L + RING_OFF, g, S, E);
        if (BOTH(8)) GRID_BAR();
    }
    if (IN(9)) {
        for (int m = gw; m < M; m += NGW) rms_row_to_bf16(H + (size_t)m * D, args.in[2] + D, (bf16*)(ws + WS_HN) + (size_t)m * D, lane);
        if (BOTH(9)) GRID_BAR();
    }
    if (IN(10)) {
        pg8::Gemm g{(const bf16*)(ws + WS_HN), (const bf16*)(ws + WS_WHIN), M, HG_IN, D}; pg8::StaticOrder S; S.init(M, HG_IN, G, (int)blockIdx.x);
        pg8::EpiStoreBf16 E{(bf16*)(ws + WS_HPROJ), HG_IN, HG_IN / 256};
        pg8::gemm_phase<pg8::EpiStoreBf16, pg8::StaticOrder, true, false>(L + RING_OFF, g, S, E);
        if (BOTH(10)) GRID_BAR();
    }
    if (IN(11)) {
        LAS float* fS = (LAS float*)(L + RING_OFF);
        LAS float* qS = fS + 32 * 128;
        LAS float* vS = qS + 32 * 128;
        const bf16* HP = (const bf16*)(ws + WS_HPROJ); float* HO = (float*)(ws + WS_HOF);
        const int kq = lane & 15, vv = wave * 4 + (lane >> 4);
        for (int uu = blockIdx.x; uu < 128; uu += G) {
            const int b = uu >> 5, h = (uu >> 2) & 7, vs = uu & 3;
            float St[8];
#pragma unroll
            for (int j = 0; j < 8; ++j) St[j] = 0.f;
            for (int c = 0; c < SEQ / 32; ++c) {
                __syncthreads();
                for (int i = tid; i < 32 * 128; i += 512) { const int tt = i >> 7, k = i & 127; const size_t row = (size_t)b * SEQ + c * 32 + tt;
                    const float lbp0 = args.in[12][h * 128 + k], lbp1 = args.in[12][1024 + h * 128 + k]; const float lb = sigmoid_f(lbp1 - lbp0);
                    const float fp = bf2f(HP[row * HG_IN + 1024 + h * 128 + k]);
                    fS[i] = lb + (1.0f - lb) * sigmoid_f(fp);
                    qS[i] = bf2f(HP[row * HG_IN + h * 128 + k]) * 0.08838834764831845f; }
                for (int i = tid; i < 32 * 32; i += 512) { const int tt = i >> 5, v = i & 31; const size_t row = (size_t)b * SEQ + c * 32 + tt;
                    vS[i] = bf2f(HP[row * HG_IN + 2048 + h * 128 + vs * 32 + v]); }
                __syncthreads();
                for (int tt = 0; tt < 32; ++tt) {
                    const f32x4 f0 = *(const LAS f32x4*)(fS + tt * 128 + kq * 8), f1 = *(const LAS f32x4*)(fS + tt * 128 + kq * 8 + 4);
                    const f32x4 q0 = *(const LAS f32x4*)(qS + tt * 128 + kq * 8), q1 = *(const LAS f32x4*)(qS + tt * 128 + kq * 8 + 4);
                    const float vt = vS[tt * 32 + vv];
                    const float fv[8] = {f0.x, f0.y, f0.z, f0.w, f1.x, f1.y, f1.z, f1.w}; const float qv[8] = {q0.x, q0.y, q0.z, q0.w, q1.x, q1.y, q1.z, q1.w};
                    float a = 0.f;
#pragma unroll
                    for (int j = 0; j < 8; ++j) { St[j] = fv[j] * St[j] + (1.0f - fv[j]) * vt; a += St[j] * qv[j]; }
                    a += __shfl_xor(a, 1); a += __shfl_xor(a, 2); a += __shfl_xor(a, 4); a += __shfl_xor(a, 8);
                    if (kq == 0) HO[((size_t)b * SEQ + c * 32 + tt) * 1024 + h * 128 + vs * 32 + vv] = a;
                }
            }
        }
        __syncthreads();
        if (BOTH(11)) GRID_BAR();
    }
    if (IN(12)) {
        const float* HO = (const float*)(ws + WS_HOF); const bf16* HP = (const bf16*)(ws + WS_HPROJ);
        for (int m = gw; m < M; m += NGW) {
#pragma unroll
            for (int h = 0; h < 8; ++h) {
                const float o0 = HO[(size_t)m * 1024 + h * 128 + lane], o1 = HO[(size_t)m * 1024 + h * 128 + 64 + lane];
                const float rs = 1.f / sqrtf(wave_sum(o0 * o0 + o1 * o1) * (1.f / 128.f) + EPS);
                const float g0 = bf2f(HP[(size_t)m * HG_IN + 3072 + h * 128 + lane]), g1 = bf2f(HP[(size_t)m * HG_IN + 3072 + h * 128 + 64 + lane]);
                bf16* op = (bf16*)(ws + WS_HON) + (size_t)m * 1024 + h * 128;
                op[lane] = (bf16)f2bf(o0 * rs * args.in[13][lane] * (g0 * sigmoid_f(g0)));
                op[64 + lane] = (bf16)f2bf(o1 * rs * args.in[13][64 + lane] * (g1 * sigmoid_f(g1)));
            }
        }
        if (BOTH(12)) GRID_BAR();
    }
    if (IN(13)) {
        pg8::Gemm g{(const bf16*)(ws + WS_HON), (const bf16*)(ws + WS_WHO), M, D, D}; pg8::StaticOrder S; S.init(M, D, G, (int)blockIdx.x);
        pg8::EpiF32Res E{H, H, D, D / 256};
        pg8::gemm_phase<pg8::EpiF32Res, pg8::StaticOrder, true, false>(L + RING_OFF, g, S, E);
        if (BOTH(13)) GRID_BAR();
    }
    if (IN(14)) {
        const float* gn = args.in[3] + D; const float* RT = args.in[18];
        int* rowlist = (int*)(ws + WS_ROWLIST); v4u* tok = (v4u*)(ws + WS_TOK);
        for (int m = gw; m < M; m += NGW) {
            const f32x4* xr = (const f32x4*)(H + (size_t)m * D) + lane; const f32x4* gr = (const f32x4*)gn + lane;
            f32x4 v[4]; float s = 0.f;
#pragma unroll
            for (int j = 0; j < 4; ++j) { v[j] = xr[64 * j]; s += (v[j].x * v[j].x + v[j].y * v[j].y) + (v[j].z * v[j].z + v[j].w * v[j].w); }
            const float rstd = 1.f / sqrtf(wave_sum(s) * (1.f / 1024.f) + EPS);
            float lg[8];
#pragma unroll
            for (int e = 0; e < 8; ++e) lg[e] = 0.f;
            unsigned long long* o8 = (unsigned long long*)((bf16*)(ws + WS_HN3) + (size_t)m * D) + lane;
#pragma unroll
            for (int j = 0; j < 4; ++j) { const f32x4 g = gr[64 * j]; const f32x4 t = (f32x4){v[j].x * rstd * g.x, v[j].y * rstd * g.y, v[j].z * rstd * g.z, v[j].w * rstd * g.w};
                o8[64 * j] = (unsigned long long)pk2(t.x, t.y) | ((unsigned long long)pk2(t.z, t.w) << 32);
                const int k0 = 4 * (lane + 64 * j);
#pragma unroll
                for (int kk = 0; kk < 4; ++kk) { const f32x4 r0 = *(const f32x4*)(RT + (size_t)(k0 + kk) * 8), r1 = *(const f32x4*)(RT + (size_t)(k0 + kk) * 8 + 4); const float tv = t[kk];
                    lg[0] += tv * r0.x; lg[1] += tv * r0.y; lg[2] += tv * r0.z; lg[3] += tv * r0.w; lg[4] += tv * r1.x; lg[5] += tv * r1.y; lg[6] += tv * r1.z; lg[7] += tv * r1.w; } }
#pragma unroll
            for (int e = 0; e < 8; ++e) lg[e] = wave_sum(lg[e]);
            if (lane == 0) {
                int e1 = 0; float v1 = lg[0];
#pragma unroll
                for (int e = 1; e < 8; ++e) if (lg[e] > v1) { v1 = lg[e]; e1 = e; }
                int e2 = (e1 == 0) ? 1 : 0; float v2 = lg[e2];
#pragma unroll
                for (int e = 1; e < 8; ++e) if (e != e1 && lg[e] > v2) { v2 = lg[e]; e2 = e; }
                const float w1 = 1.0f / (1.0f + __expf(v2 - v1)), w2 = 1.0f - w1;
                const unsigned p1 = __hip_atomic_fetch_add((unsigned*)(ctl + CW_CNT + 64 * e1), 1u, RLX_AGENT), p2 = __hip_atomic_fetch_add((unsigned*)(ctl + CW_CNT + 64 * e2), 1u, RLX_AGENT);
                rowlist[e1 * CAP + p1] = m; rowlist[e2 * CAP + p2] = m;
                tok[m] = (v4u){(unsigned)(e1 * CAP) + p1, (unsigned)(e2 * CAP) + p2, __builtin_bit_cast(unsigned, w1), __builtin_bit_cast(unsigned, w2)};
            }
        }
        if (BOTH(14)) GRID_BAR();
    }
    if (IN(15) || IN(16) || IN(17)) {
        if (tid == 0) { volatile LAS int* mt = (volatile LAS int*)(MISC + 16); int acc = 0;
            for (int e = 0; e < 8; ++e) { const int c = (int)__hip_atomic_load((unsigned*)(ctl + CW_CNT + 64 * e), RLX_AGENT); mt[e] = acc; mt[9 + e] = c; acc += (c + 255) >> 8; }
            mt[8] = acc; }
        __syncthreads();
    }
    if (IN(15)) {
        pg8::Gemm g{(const bf16*)(ws + WS_HN3), (const bf16*)(ws + WS_WMGU), M, 2 * FF, D};
        MoeOrder S; S.init((volatile LAS int*)(MISC + 16), 2 * FF / 256, G, (int)blockIdx.x, (const int*)(ws + WS_ROWLIST));
        pg8::EpiSwiGLU E{(bf16*)(ws + WS_MACT), FF, 2 * FF / 256};
        pg8::gemm_phase<pg8::EpiSwiGLU, MoeOrder, true, true>(L + RING_OFF, g, S, E);
        if (BOTH(15)) GRID_BAR();
    }
    if (IN(16)) {
        pg8::Gemm g{(const bf16*)(ws + WS_MACT), (const bf16*)(ws + WS_WMDN), MAXSLOT, D, FF};
        MoeOrder S; S.init((volatile LAS int*)(MISC + 16), D / 256, G, (int)blockIdx.x, (const int*)(ws + WS_ROWLIST));
        pg8::EpiStoreBf16 E{(bf16*)(ws + WS_Y), D, D / 256};
        pg8::gemm_phase<pg8::EpiStoreBf16, MoeOrder, true, false>(L + RING_OFF, g, S, E);
        if (BOTH(16)) GRID_BAR();
    }
    if (IN(17)) {
        volatile LAS int* mt = (volatile LAS int*)(MISC + 16);
        const bf16* Y = (const bf16*)(ws + WS_Y); const v4u* tok = (const v4u*)(ws + WS_TOK);
        for (int m = gw; m < M; m += NGW) {
            const v4u tk = tok[m];
            const int e1 = tk.x / CAP, e2 = tk.y / CAP; const size_t s1 = (size_t)mt[e1] * 256 + (tk.x % CAP), s2 = (size_t)mt[e2] * 256 + (tk.y % CAP);
            const unsigned zb = tk.z, wb = tk.w; const float w1 = __uint_as_float(zb), w2 = __uint_as_float(wb);
            f32x4* xr = (f32x4*)(H + (size_t)m * D) + lane; const f32x4* gr = (const f32x4*)args.in[4] + lane;
            const v2u* y1 = (const v2u*)(Y + s1 * D) + lane; const v2u* y2 = (const v2u*)(Y + s2 * D) + lane;
            f32x4 v[4]; float s = 0.f;
#pragma unroll
            for (int j = 0; j < 4; ++j) { v[j] = xr[64 * j]; const v2u a = y1[64 * j], c = y2[64 * j];
                v[j].x += w1 * bf2f((unsigned short)(a.x & 0xffffu)) + w2 * bf2f((unsigned short)(c.x & 0xffffu)); v[j].y += w1 * bf2f((unsigned short)(a.x >> 16)) + w2 * bf2f((unsigned short)(c.x >> 16));
                v[j].z += w1 * bf2f((unsigned short)(a.y & 0xffffu)) + w2 * bf2f((unsigned short)(c.y & 0xffffu)); v[j].w += w1 * bf2f((unsigned short)(a.y >> 16)) + w2 * bf2f((unsigned short)(c.y >> 16));
                s += (v[j].x * v[j].x + v[j].y * v[j].y) + (v[j].z * v[j].z + v[j].w * v[j].w); }
            const float rstd = 1.f / sqrtf(wave_sum(s) * (1.f / 1024.f) + EPS);
#pragma unroll
            for (int j = 0; j < 4; ++j) { const f32x4 g = gr[64 * j]; xr[64 * j] = (f32x4){v[j].x * rstd * g.x, v[j].y * rstd * g.y, v[j].z * rstd * g.z, v[j].w * rstd * g.w}; }
        }
    }
#undef IN
#undef BOTH
}

extern "C" void kernel_launch(void* const* d_in, const int* in_sizes, int n_in, void* d_out, int out_size, void* d_ws, size_t ws_size, hipStream_t stream) {
    static int grid = 0;
    if (grid == 0) {
        if (n_in != 22 || in_sizes[0] != M * D || out_size != M * D || ws_size < WS_END) { fprintf(stderr, "kernel_launch: unexpected shapes (n_in %d, in0 %d, out %d, ws %zu)\n", n_in, n_in > 0 ? in_sizes[0] : -1, out_size, ws_size); grid = -1; return; }
        int dev = 0, cus = 0, per_cu = 0;
        if (hipGetDevice(&dev) != hipSuccess || hipDeviceGetAttribute(&cus, hipDeviceAttributeMultiprocessorCount, dev) != hipSuccess) { grid = -1; return; }
        if (hipFuncSetAttribute((const void*)fwd_kernel, hipFuncAttributeMaxDynamicSharedMemorySize, LDS_BYTES) != hipSuccess) { fprintf(stderr, "kernel_launch: hipFuncSetAttribute failed\n"); grid = -1; return; }
        if (hipOccupancyMaxActiveBlocksPerMultiprocessor(&per_cu, (const void*)fwd_kernel, NWAVES * 64, LDS_BYTES) != hipSuccess || per_cu < 1) fprintf(stderr, "kernel_launch: occupancy query reports %d\n", per_cu);
        (void)hipGetLastError();
        grid = cus;
    }
    if (grid < 0) return;
    if (hipMemsetAsync((char*)d_ws + WS_CTL, 0, CTL_ZERO_BYTES, stream) != hipSuccess) return;
    Args a{};
    for (int i = 0; i < 22; ++i) a.in[i] = (const float*)d_in[i];
    a.pos = (const int*)d_in[1]; a.out = (float*)d_out; a.ws = (unsigned char*)d_ws;
    static_assert(N_LAUNCHES == 1 || N_LAUNCHES == NPHASE, "MK_N_LAUNCHES: 1 or 18");
    for (int li = 0; li < N_LAUNCHES; ++li) {
        a.ph_lo = (N_LAUNCHES == 1) ? 0 : li; a.ph_hi = (N_LAUNCHES == 1) ? NPHASE : li + 1; a.li = li;
        hipLaunchKernelGGL(fwd_kernel, dim3(grid), dim3(NWAVES * 64), LDS_BYTES, stream, a);
        if (hipPeekAtLastError() != hipSuccess) { fprintf(stderr, "kernel_launch: launch %d failed\n", li); break; }
    }
}
```

```cpp
#include <hip/hip_runtime.h>
#include <cstdio>
#include <cstdint>

#ifndef MK_N_LAUNCHES
#define MK_N_LAUNCHES 1
#endif

namespace pg8 {
#define PG8_LAS __attribute__((address_space(3)))
typedef unsigned short bf16_t;
typedef short bf16x8 __attribute__((ext_vector_type(8)));
typedef float f32x4 __attribute__((ext_vector_type(4)));
typedef unsigned u32x4 __attribute__((ext_vector_type(4)));
constexpr int BM = 256, BK = 64, HALF = 128, HTB = HALF * BK * 2, STAGE_BYTES = 8 * HTB, NXCD = 8, WGM = 8;

__host__ __device__ __forceinline__ int lds_byte(int r, int c) { const int st = (r >> 4) * 2 + (c >> 5), rr = r & 15, cc = c & 31, ob = rr * 64 + cc * 2; return st * 1024 + (ob ^ (((ob >> 9) & 1) << 5)); }
__host__ __device__ __forceinline__ void stage_rc(int b, int& R, int& C) { const int st = b / 1024, sb = b % 1024, swz = sb ^ (((sb >> 9) & 1) << 5); R = (st >> 1) * 16 + swz / 64; C = (st & 1) * 32 + (swz % 64) / 2; }
__host__ __device__ __forceinline__ int perm32(int rho) { const int n = rho >> 4, i = rho & 15; return 8 * (i >> 2) + 4 * n + (i & 3); }

struct Unit { int pm, pn; };
struct Gemm { const bf16_t* A; const bf16_t* Bt; int M, N, K; };

struct StaticOrder {
    int nM, nN, nwg, G, c;
    __host__ __device__ void init(int M, int N, int G_, int c_) { nM = M / BM; nN = N / BM; nwg = nM * nN; G = G_; c = c_; }
    __host__ __device__ bool next(int i, Unit& u) const {
        const long L = (long)i * G + c; if (L >= nwg) return false;
        int wgid = (int)L; { const int q = nwg / NXCD, r = nwg % NXCD, xcd = wgid % NXCD, off = wgid / NXCD; wgid = (xcd < r ? xcd * (q + 1) : r * (q + 1) + (xcd - r) * q) + off; }
        const int nig = WGM * nN, gid = wgid / nig, fm = gid * WGM, gsz = (nM - fm) < WGM ? (nM - fm) : WGM;
        u.pm = fm + ((wgid % nig) % gsz); u.pn = (wgid % nig) / gsz; return true;
    }
    __device__ __forceinline__ void a_ready(const Unit&) const {}
    __device__ __forceinline__ void done(const Unit&) const {}
    __device__ __forceinline__ int arow(const Unit&, int) const { return 0; }
};

__device__ __forceinline__ unsigned cvt_pk_bf16(float lo, float hi) { unsigned r; asm volatile("v_cvt_pk_bf16_f32 %0, %1, %2" : "=v"(r) : "v"(lo), "v"(hi)); return r; }

struct EpiStoreBf16 {
    static constexpr bool PERM = true, AFTER_DRAIN = false;
    bf16_t* O; int ldc; int nN;
    __device__ __forceinline__ void operator()(const f32x4 (&acc)[2][2][4][2], const Unit& u, int wr, int wc, int fr, int fq) const {
        const int pnl = u.pn % nN; const int row0 = u.pm * BM + wr * 64 + fr, col0 = pnl * BM + wc * 32 + 8 * fq;
#pragma unroll
        for (int ai = 0; ai < 2; ++ai)
#pragma unroll
            for (int m = 0; m < 4; ++m) { bf16_t* rowp = O + (size_t)(row0 + ai * HALF + m * 16) * ldc + col0;
#pragma unroll
                for (int bj = 0; bj < 2; ++bj) { const f32x4 v0 = acc[ai][bj][m][0], v1 = acc[ai][bj][m][1];
                    u32x4 w; w.x = cvt_pk_bf16(v0[0], v0[1]); w.y = cvt_pk_bf16(v0[2], v0[3]); w.z = cvt_pk_bf16(v1[0], v1[1]); w.w = cvt_pk_bf16(v1[2], v1[3]);
                    *(u32x4*)(rowp + bj * HALF) = w; } }
    }
};
__device__ __forceinline__ float silu_f(float x) { return x * __builtin_amdgcn_rcpf(1.0f + __builtin_amdgcn_exp2f(-1.4426950408889634f * x)); }
struct EpiSwiGLU {
    static constexpr bool PERM = true, AFTER_DRAIN = false;
    bf16_t* O; int ldc; int nN;
    __device__ __forceinline__ void operator()(const f32x4 (&acc)[2][2][4][2], const Unit& u, int wr, int wc, int fr, int fq) const {
        const int pnl = u.pn % nN; const int row0 = u.pm * BM + wr * 64 + fr, col0 = pnl * HALF + wc * 32 + 8 * fq;
#pragma unroll
        for (int ai = 0; ai < 2; ++ai)
#pragma unroll
            for (int m = 0; m < 4; ++m) { bf16_t* rowp = O + (size_t)(row0 + ai * HALF + m * 16) * ldc + col0;
                const f32x4 g0 = acc[ai][0][m][0], g1 = acc[ai][0][m][1], u0 = acc[ai][1][m][0], u1 = acc[ai][1][m][1];
                u32x4 w; w.x = cvt_pk_bf16(silu_f(g0[0]) * u0[0], silu_f(g0[1]) * u0[1]); w.y = cvt_pk_bf16(silu_f(g0[2]) * u0[2], silu_f(g0[3]) * u0[3]);
                w.z = cvt_pk_bf16(silu_f(g1[0]) * u1[0], silu_f(g1[1]) * u1[1]); w.w = cvt_pk_bf16(silu_f(g1[2]) * u1[2], silu_f(g1[3]) * u1[3]);
                *(u32x4*)rowp = w; }
    }
};
struct EpiF32Res {
    static constexpr bool PERM = false, AFTER_DRAIN = false;
    const float* base; float* out; int ldc; int nN;
    __device__ __forceinline__ void operator()(const f32x4 (&acc)[2][2][4][2], const Unit& u, int wr, int wc, int fr, int fq) const {
        const int pnl = u.pn % nN; const int row0 = u.pm * BM + wr * 64 + fr, col0 = pnl * BM + wc * 32 + 4 * fq;
#pragma unroll
        for (int ai = 0; ai < 2; ++ai)
#pragma unroll
            for (int m = 0; m < 4; ++m) { const size_t off = (size_t)(row0 + ai * HALF + m * 16) * ldc + col0;
#pragma unroll
                for (int bj = 0; bj < 2; ++bj)
#pragma unroll
                    for (int n = 0; n < 2; ++n) { f32x4 v = acc[ai][bj][m][n]; if (base) v += *(const f32x4*)(base + off + bj * HALF + n * 16); *(f32x4*)(out + off + bj * HALF + n * 16) = v; } }
    }
};

template <class Epi, class Sched, bool ALIGN_EPI = true, bool GATHER = false>
__device__ __forceinline__ void gemm_phase(PG8_LAS unsigned char* lds, const Gemm g, const Sched& S, const Epi& E) {
    const int tid = threadIdx.x, wid = __builtin_amdgcn_readfirstlane(tid >> 6), lane = tid & 63, wr = wid >> 2, wc = wid & 3, fr = lane & 15, fq = lane >> 4;
    const int K = g.K, nt = K / BK;
    unsigned voffA[2], voffB[2]; int RA[2], CA[2];
#pragma unroll
    for (int i = 0; i < 2; ++i) { int R, C; stage_rc(tid * 16 + i * 8192, R, C); const int Rb = Epi::PERM ? ((R & ~31) + perm32(R & 31)) : R;
        voffA[i] = (unsigned)(R * K + C) * 2u; voffB[i] = (unsigned)(Rb * K + C) * 2u; RA[i] = R; CA[i] = C; }
    unsigned vAc[2][2], vAn[2][2];
    const size_t kstep = (size_t)(BK * 2);
    const size_t hstep = (size_t)HALF * K * 2;
    const size_t tstep = 2 * hstep;
    const size_t hstepA = GATHER ? (size_t)0 : hstep;
    const unsigned ldsw = (unsigned)wid * 1024u;
    const int aoff = lds_byte(wr * 64 + fr, fq * 8), boff = lds_byte(wc * 32 + fr, fq * 8);
#define PG8_SA(b, h) (((b) * 2 + (h)) * HTB)
#define PG8_SB(b, h) ((4 + (b) * 2 + (h)) * HTB)
#define PG8_STAGE(bufoff, gbase, voff) do { _Pragma("unroll") for (int _i = 0; _i < 2; ++_i) \
        __builtin_amdgcn_global_load_lds((const unsigned*)((const char*)(gbase) + (voff)[_i]), (PG8_LAS unsigned*)(lds + (bufoff) + ldsw + _i * 8192), 16, 0, 0); } while (0)
#define PG8_STAGE_A(bufoff, gbase, h, nx) do { _Pragma("unroll") for (int _i = 0; _i < 2; ++_i) { const unsigned _vo = GATHER ? ((nx) ? vAn[h][_i] : vAc[h][_i]) : voffA[_i]; \
        __builtin_amdgcn_global_load_lds((const unsigned*)((const char*)(gbase) + _vo), (PG8_LAS unsigned*)(lds + (bufoff) + ldsw + _i * 8192), 16, 0, 0); } } while (0)
#define PG8_GATH(dst, un) do { _Pragma("unroll") for (int _h = 0; _h < 2; ++_h) _Pragma("unroll") for (int _i = 0; _i < 2; ++_i) \
        dst[_h][_i] = (unsigned)(S.arow(un, _h * HALF + RA[_i]) * K + CA[_i]) * 2u; } while (0)
#define PG8_LDA(dst, b, h) do { _Pragma("unroll") for (int m = 0; m < 4; ++m) _Pragma("unroll") for (int k = 0; k < 2; ++k) dst[m][k] = *(const PG8_LAS bf16x8*)(lds + PG8_SA(b, h) + aoff + m * 2048 + k * 1024); } while (0)
#define PG8_LDB(dst, b, h) do { _Pragma("unroll") for (int n = 0; n < 2; ++n) _Pragma("unroll") for (int k = 0; k < 2; ++k) dst[n][k] = *(const PG8_LAS bf16x8*)(lds + PG8_SB(b, h) + boff + n * 2048 + k * 1024); } while (0)
#define PG8_MMA(ai, bj, At, Bt) do { __builtin_amdgcn_s_setprio(1); _Pragma("unroll") for (int m = 0; m < 4; ++m) _Pragma("unroll") for (int n = 0; n < 2; ++n) _Pragma("unroll") for (int k = 0; k < 2; ++k) \
        acc[ai][bj][m][n] = __builtin_amdgcn_mfma_f32_16x16x32_bf16(Bt[n][k], At[m][k], acc[ai][bj][m][n], 0, 0, 0); __builtin_amdgcn_s_setprio(0); } while (0)
#define PG8_WAIT_V(n) asm volatile("s_waitcnt vmcnt(" #n ")" ::: "memory")
#define PG8_WAIT_L(n) asm volatile("s_waitcnt lgkmcnt(" #n ")" ::: "memory")
#define PG8_BAR __builtin_amdgcn_s_barrier()
#define PG8_SCHED __builtin_amdgcn_sched_barrier(0)
    Unit cur, nxt; int ui = 0;
    if (!S.next(0, cur)) return;
    f32x4 acc[2][2][4][2];
#pragma unroll
    for (int a = 0; a < 2; ++a)
#pragma unroll
        for (int b = 0; b < 2; ++b)
#pragma unroll
            for (int m = 0; m < 4; ++m)
#pragma unroll
                for (int n = 0; n < 2; ++n) acc[a][b][m][n] = (f32x4){0.f, 0.f, 0.f, 0.f};
    bf16x8 At[4][2], B0[2][2], B1[2][2];
    const char* cA = GATHER ? (const char*)g.A : (const char*)g.A + (size_t)cur.pm * tstep; const char* cB = (const char*)g.Bt + (size_t)cur.pn * tstep;
    if (GATHER) { PG8_GATH(vAc, cur); }
    S.a_ready(cur);
    PG8_STAGE(PG8_SB(0, 0), cB, voffB); PG8_STAGE(PG8_SB(0, 1), cB + hstep, voffB); PG8_STAGE_A(PG8_SA(0, 0), cA, 0, false); PG8_STAGE_A(PG8_SA(0, 1), cA + hstepA, 1, false);
    if (wr == 1) PG8_BAR;
    PG8_WAIT_V(2); PG8_BAR;
    PG8_STAGE(PG8_SB(1, 0), cB + kstep, voffB); PG8_STAGE_A(PG8_SA(1, 0), cA + kstep, 0, false); PG8_STAGE(PG8_SB(1, 1), cB + hstep + kstep, voffB);
    PG8_WAIT_V(6); PG8_BAR;
    for (;;) {
        const bool has_next = S.next(ui + 1, nxt);
        const char* nA = GATHER ? (const char*)g.A : (has_next ? (const char*)g.A + (size_t)nxt.pm * tstep : cA); const char* nB = has_next ? (const char*)g.Bt + (size_t)nxt.pn * tstep : cB;
        if (GATHER) { if (has_next) { PG8_GATH(vAn, nxt); } else {
#pragma unroll
                for (int _h = 0; _h < 2; ++_h)
#pragma unroll
                    for (int _i = 0; _i < 2; ++_i) vAn[_h][_i] = vAc[_h][_i]; } }
        for (int t = 0; t < nt; t += 2) {
            const bool last = (t == nt - 2);
            const char* a1 = cA + (size_t)(t + 1) * kstep;
            const char* a2 = last ? nA : cA + (size_t)(t + 2) * kstep; const char* b2 = last ? nB : cB + (size_t)(t + 2) * kstep;
            const char* a3 = a2 + kstep; const char* b3 = b2 + kstep;
            if (last && has_next) S.a_ready(nxt);
            PG8_LDB(B0, 0, 0); PG8_LDB(B1, 0, 1); PG8_SCHED; PG8_LDA(At, 0, 0); PG8_STAGE_A(PG8_SA(1, 1), a1 + hstepA, 1, false);
            PG8_WAIT_V(8); PG8_WAIT_L(0); PG8_BAR; PG8_MMA(0, 0, At, B0); PG8_MMA(0, 1, At, B1); PG8_BAR; PG8_SCHED;
            PG8_LDA(At, 0, 1); PG8_STAGE(PG8_SB(0, 0), b2, voffB); PG8_STAGE(PG8_SB(0, 1), b2 + hstep, voffB); PG8_STAGE_A(PG8_SA(0, 0), a2, 0, last);
            PG8_WAIT_V(8); PG8_WAIT_L(0); PG8_BAR; PG8_MMA(1, 0, At, B0); PG8_MMA(1, 1, At, B1); PG8_BAR; PG8_SCHED;
            PG8_LDB(B0, 1, 0); PG8_LDB(B1, 1, 1); PG8_SCHED; PG8_LDA(At, 1, 0); PG8_STAGE_A(PG8_SA(0, 1), a2 + hstepA, 1, last);
            PG8_WAIT_V(8); PG8_WAIT_L(0); PG8_BAR; PG8_MMA(0, 0, At, B0); PG8_MMA(0, 1, At, B1); PG8_BAR; PG8_SCHED;
            PG8_LDA(At, 1, 1); PG8_STAGE(PG8_SB(1, 0), b3, voffB); PG8_STAGE(PG8_SB(1, 1), b3 + hstep, voffB); PG8_STAGE_A(PG8_SA(1, 0), a3, 0, last);
            PG8_WAIT_V(8); PG8_WAIT_L(0); PG8_BAR; PG8_MMA(1, 0, At, B0); PG8_MMA(1, 1, At, B1); PG8_BAR; PG8_SCHED;
        }
        if constexpr (ALIGN_EPI) { if (wr == 0) PG8_BAR; }
        E(acc, cur, wr, wc, fr, fq); S.done(cur);
        if (!has_next) break;
#pragma unroll
        for (int a = 0; a < 2; ++a)
#pragma unroll
            for (int b = 0; b < 2; ++b)
#pragma unroll
                for (int m = 0; m < 4; ++m)
#pragma unroll
                    for (int n = 0; n < 2; ++n) acc[a][b][m][n] = (f32x4){0.f, 0.f, 0.f, 0.f};
        cur = nxt; cA = nA; cB = nB; ++ui;
        if (GATHER) {
#pragma unroll
            for (int _h = 0; _h < 2; ++_h)
#pragma unroll
                for (int _i = 0; _i < 2; ++_i) vAc[_h][_i] = vAn[_h][_i]; }
        if constexpr (ALIGN_EPI) { if (wr == 1) PG8_BAR; }
    }
    PG8_WAIT_V(0);
    if constexpr (!ALIGN_EPI) { if (wr == 0) PG8_BAR; }
    PG8_BAR;
#undef PG8_SA
#undef PG8_SB
#undef PG8_STAGE
#undef PG8_STAGE_A
#undef PG8_GATH
#undef PG8_LDA
#undef PG8_LDB
#undef PG8_MMA
#undef PG8_WAIT_V
#undef PG8_WAIT_L
#undef PG8_BAR
#undef PG8_SCHED
}
}

constexpr int NWAVES = 8;
constexpr int N_LAUNCHES = MK_N_LAUNCHES;
constexpr int NPHASE = 18;
constexpr int BATCH = 4, SEQ = 4096, D = 1024, M = BATCH * SEQ;
constexpr int NH = 16, QL = 384, KVL = 256, NOPE = 64, ROPE = 32, VD = 64, MLA_IN = 672, MLA_INP = 768, QW = NH * 96, KVW = NH * 128;
constexpr int HGH = 8, DK = 128, DV = 128, HG_IN = 4096;
constexpr int FF = 3584, NE = 8, CAP = 16384;
constexpr int MAXSLOT = 2 * M + NE * 256;
constexpr float EPS = 1e-6f;

constexpr size_t MiB = 1u << 20;
constexpr size_t WS_CTL = 0, CTL_ZERO_BYTES = 1 * MiB;
constexpr size_t WS_ROWLIST = 1 * MiB;
constexpr size_t WS_TOK = WS_ROWLIST + 512 * 1024;
constexpr size_t WS_COS = 2 * MiB, WS_SIN = 3 * MiB;
constexpr size_t WS_WMLAIN = 4 * MiB;
constexpr size_t WS_WQUP = 6 * MiB;
constexpr size_t WS_WKVUP = 8 * MiB;
constexpr size_t WS_WO0 = 9 * MiB;
constexpr size_t WS_WFGU = 11 * MiB;
constexpr size_t WS_WFDN = 25 * MiB;
constexpr size_t WS_WHIN = 32 * MiB;
constexpr size_t WS_WHO = 40 * MiB;
constexpr size_t WS_WMGU = 42 * MiB;
constexpr size_t WS_WMDN = 154 * MiB;
constexpr size_t WS_ACTS = 210 * MiB;
constexpr size_t WS_HN = WS_ACTS;
constexpr size_t WS_PROJ = WS_ACTS + 32 * MiB;
constexpr size_t WS_CQN = WS_PROJ + 24 * MiB;
constexpr size_t WS_CKVN = WS_CQN + 12 * MiB;
constexpr size_t WS_KR = WS_CKVN + 8 * MiB;
constexpr size_t WS_Q = WS_KR + 1 * MiB;
constexpr size_t WS_KV = WS_Q + 48 * MiB;
constexpr size_t WS_O = WS_KV + 64 * MiB;
constexpr size_t WS_FACT = WS_ACTS + 32 * MiB;
constexpr size_t WS_HPROJ = WS_ACTS + 32 * MiB;
constexpr size_t WS_HOF = WS_HPROJ + 128 * MiB;
constexpr size_t WS_HON = WS_HOF + 64 * MiB;
constexpr size_t WS_HN3 = 4 * MiB;
constexpr size_t WS_MACT = WS_ACTS;
constexpr size_t WS_Y = WS_WMGU;
constexpr size_t WS_END = 472 * MiB;
static_assert(WS_O + (size_t)M * 1024 * 2 <= WS_END && WS_HON + (size_t)M * 1024 * 2 <= WS_END && WS_MACT + (size_t)MAXSLOT * FF * 2 <= WS_END, "d_ws map");
static_assert(WS_HN3 + (size_t)M * 1024 * 2 <= WS_WHO, "hn3 overlay");
constexpr int CW_CNT = 64;
constexpr int CW_BAR = 4096;

constexpr int RING_OFF = 0, RING_BYTES = 131072;
constexpr int LDSCTL_OFF = RING_BYTES, MISC_OFF = LDSCTL_OFF + 320;
constexpr int LDS_BYTES = 147456;

#define GAS __attribute__((address_space(1)))
#define LAS __attribute__((address_space(3)))
typedef unsigned short bf16;
typedef unsigned v4u __attribute__((ext_vector_type(4)));
typedef unsigned v2u __attribute__((ext_vector_type(2)));
typedef float f32x4 __attribute__((ext_vector_type(4)));
typedef GAS unsigned gu32;
#define RLX_AGENT __ATOMIC_RELAXED, __HIP_MEMORY_SCOPE_AGENT
#define LDS_WAIT() asm volatile("s_waitcnt lgkmcnt(0)" ::: "memory")
__device__ __forceinline__ unsigned f2bf(float f) { unsigned u = __builtin_bit_cast(unsigned, f); return (u + 0x7fffu + ((u >> 16) & 1u)) >> 16; }
__device__ __forceinline__ unsigned pk2(float lo, float hi) { return f2bf(lo) | (f2bf(hi) << 16); }
__device__ __forceinline__ float bf2f(unsigned short b) { return __builtin_bit_cast(float, (unsigned)b << 16); }

#define XB_TMO      128
#define XB_XCNT(j)  (256  + 64 * (j))
#define XB_XSUB(j)  (1280 + 64 * (j))
#define XB_XGEN(j)  (2304 + 64 * (j))
#define XB_TOP      3328
#define XB_TOPGEN   3392
#define XCD_BAR_WORDS 3456
#define XB_SPIN_CAP (1u << 24)
__device__ __forceinline__ unsigned xb_ld(unsigned* p)              { return __hip_atomic_load(p, __ATOMIC_RELAXED, __HIP_MEMORY_SCOPE_AGENT); }
__device__ __forceinline__ unsigned xb_add(unsigned* p, unsigned v) { return __hip_atomic_fetch_add(p, v, __ATOMIC_RELAXED, __HIP_MEMORY_SCOPE_AGENT); }
__device__ __forceinline__ unsigned xb_xcc_id() { return (unsigned)__builtin_amdgcn_s_getreg((3 << 11) | 20) & 0xFu; }
#define XB_SPIN(cond, bar) do { unsigned _sp = 0; while (cond) { __builtin_amdgcn_s_sleep(1); \
    if ((++_sp & 255u) == 0u) { if (xb_ld(&(bar)[XB_TMO])) break; if (_sp > XB_SPIN_CAP) { atomicAdd(&(bar)[XB_TMO], 1u); break; } } } } while (0)
struct XcdBarrier { unsigned* bar; unsigned x; volatile LAS unsigned* st; };
__device__ __forceinline__ XcdBarrier xcd_barrier_post(unsigned* bar, volatile LAS unsigned* st) {
    XcdBarrier b; b.bar = bar; b.x = xb_xcc_id(); b.st = st;
    if (threadIdx.x == 0) (void)xb_add(&bar[XB_XCNT(b.x)], 1u);
    return b;
}
__device__ __forceinline__ void xcd_barrier_complete(unsigned* bar, unsigned x, unsigned& nloc, unsigned& nx) {
    const unsigned G = gridDim.x * gridDim.y * gridDim.z;
    unsigned sum, cnt, mine, sp = 0u;
    for (;;) {
        sum = 0u; cnt = 0u; mine = 0u;
#pragma unroll
        for (unsigned j = 0; j < 16; ++j) { const unsigned c = xb_ld(&bar[XB_XCNT(j)]); sum += c; cnt += (c > 0u) ? 1u : 0u; mine = (j == x) ? c : mine; }
        if (sum == G) break;
        __builtin_amdgcn_s_sleep(1);
        if ((++sp & 255u) == 0u) { if (xb_ld(&bar[XB_TMO])) break; if (sp > XB_SPIN_CAP) { atomicAdd(&bar[XB_TMO], 1u); break; } }
    }
    nloc = mine > 0u ? mine : 1u; nx = cnt > 0u ? cnt : 1u;
}
__device__ __forceinline__ void xcd_barrier(const XcdBarrier& b) {
    asm volatile("s_waitcnt vmcnt(0)" ::: "memory");
    __syncthreads();
    if (threadIdx.x == 0) {
        unsigned* bar = b.bar;
        __builtin_amdgcn_s_waitcnt(0);
        unsigned nloc = b.st[0], nx = b.st[1];
        if (nloc == 0u) { xcd_barrier_complete(bar, b.x, nloc, nx); b.st[0] = nloc; b.st[1] = nx; }
        const unsigned old = xb_add(&bar[XB_XSUB(b.x)], 1u);
        const unsigned gen = old / nloc;
        if (old + 1u == (gen + 1u) * nloc) {
            __builtin_amdgcn_fence(__ATOMIC_RELEASE, "agent");
            asm volatile("s_waitcnt vmcnt(0)" ::: "memory");
            const unsigned og = xb_add(&bar[XB_TOP], 1u);
            const unsigned tg = og / nx;
            if (og + 1u == (tg + 1u) * nx) xb_add(&bar[XB_TOPGEN], 1u);
            else XB_SPIN(xb_ld(&bar[XB_TOPGEN]) == tg, bar);
            __builtin_amdgcn_fence(__ATOMIC_ACQUIRE, "agent");
            xb_add(&bar[XB_XGEN(b.x)], 1u);
            asm volatile("s_waitcnt vmcnt(0)" ::: "memory");
        } else {
            XB_SPIN(xb_ld(&bar[XB_XGEN(b.x)]) == gen, bar);
            __builtin_amdgcn_fence(__ATOMIC_ACQUIRE, "agent");
            asm volatile("s_waitcnt vmcnt(0)" ::: "memory");
        }
    }
    __syncthreads();
}

__device__ __forceinline__ float wave_sum(float v) {
#pragma unroll
    for (int o = 1; o < 64; o <<= 1) v += __shfl_xor(v, o);
    return v;
}
__device__ __forceinline__ int dst_row(int n, int mode) { return mode == 0 ? n : (((n >> 7) << 8) + (n & 127) + (mode == 2 ? 128 : 0)); }
__device__ __forceinline__ void tr_item(const float* W, int K, int N, bf16* WT, int mode, LAS float* scr, int item, int lane) {
    const int nblk = N / 32, kb = item / nblk, nb = item % nblk, k0 = 64 * kb, n0 = 32 * nb;
#pragma unroll 8
    for (int i = 0; i < 32; ++i) { const int kk = 2 * i + (lane >> 5); scr[kk * 33 + (lane & 31)] = W[(size_t)(k0 + kk) * N + n0 + (lane & 31)]; }
    LDS_WAIT(); asm volatile("" ::: "memory");
    const int c = lane & 7;
#pragma unroll
    for (int j = 0; j < 4; ++j) { const int n = (lane >> 3) + 8 * j; const LAS float* s = scr + (8 * c) * 33 + n;
        v4u o; o.x = pk2(s[0 * 33], s[1 * 33]); o.y = pk2(s[2 * 33], s[3 * 33]); o.z = pk2(s[4 * 33], s[5 * 33]); o.w = pk2(s[6 * 33], s[7 * 33]);
        *(v4u*)(WT + (size_t)dst_row(n0 + n, mode) * K + k0 + 8 * c) = o; }
    LDS_WAIT(); asm volatile("" ::: "memory");
}
__device__ __forceinline__ void rms_row_to_bf16(const float* xrow, const float* gain, bf16* orow, int lane) {
    const f32x4* xr = (const f32x4*)xrow + lane; const f32x4* gr = (const f32x4*)gain + lane;
    f32x4 v[4]; float s = 0.f;
#pragma unroll
    for (int j = 0; j < 4; ++j) { v[j] = xr[64 * j]; s += (v[j].x * v[j].x + v[j].y * v[j].y) + (v[j].z * v[j].z + v[j].w * v[j].w); }
    const float rstd = 1.f / sqrtf(wave_sum(s) * (1.f / 1024.f) + EPS);
    unsigned long long* o8 = (unsigned long long*)orow + lane;
#pragma unroll
    for (int j = 0; j < 4; ++j) { const f32x4 g = gr[64 * j];
        o8[64 * j] = (unsigned long long)pk2(v[j].x * rstd * g.x, v[j].y * rstd * g.y) | ((unsigned long long)pk2(v[j].z * rstd * g.z, v[j].w * rstd * g.w) << 32); }
}
__device__ __forceinline__ float sigmoid_f(float x) { return 1.0f / (1.0f + __expf(-x)); }

struct MoeOrder {
    pg8::StaticOrder so; int nN; volatile LAS int* mt; const int* rowlist;
    __device__ __forceinline__ void init(volatile LAS int* mt_, int nN_, int G, int c, const int* rl) { mt = mt_; nN = nN_; rowlist = rl; so.init(mt_[8] * 256, nN_ * 256, G, c); }
    __device__ __forceinline__ bool next(int i, pg8::Unit& u) const {
        if (!so.next(i, u)) return false;
        int e = 0;
#pragma unroll
        for (int j = 1; j < 8; ++j) e += (u.pm >= mt[j]) ? 1 : 0;
        u.pn = e * nN + u.pn; return true;
    }
    __device__ __forceinline__ void a_ready(const pg8::Unit&) const {}
    __device__ __forceinline__ void done(const pg8::Unit&) const {}
    __device__ __forceinline__ int arow(const pg8::Unit& u, int r) const { const int e = u.pn / nN; const int lr = (u.pm - mt[e]) * 256 + r; return lr < mt[9 + e] ? rowlist[e * CAP + lr] : 0; }
};


namespace mla_attn {
using bf16x8=__attribute__((ext_vector_type(8)))short;
using s16x4=__attribute__((ext_vector_type(4)))short;
using f32x16=__attribute__((ext_vector_type(16)))float;
using u32x4=__attribute__((ext_vector_type(4)))unsigned;
typedef __attribute__((address_space(3))) const char* lds_cptr;
constexpr int NW=8,QBLK=32,QB=256,KVBLK=64;
constexpr int KSLOT=12288,VSLOT=8192,NSLOT=3;
constexpr int LDS_K=0,LDS_V=NSLOT*KSLOT,LDS_WS=LDS_V+NSLOT*VSLOT,LDS_OST=LDS_WS+NW*64*4,LDS_BYTES_A=LDS_OST+NW*4096;
__device__ __forceinline__ int crow(int r,int hi){return (r&3)+8*(r>>2)+4*hi;}
__device__ __forceinline__ void glds16(const void*gsrc,unsigned lds_dst){unsigned keep;
  asm volatile("s_mov_b32 %0, m0\n\ts_mov_b32 m0, %2\n\ts_nop 0\n\tglobal_load_lds_dwordx4 %1, off\n\ts_mov_b32 m0, %0":"=&s"(keep):"v"(gsrc),"s"(lds_dst):"memory");}
typedef float f32x2_t __attribute__((ext_vector_type(2))); typedef __bf16 bf16x2_t __attribute__((ext_vector_type(2)));
__device__ __forceinline__ unsigned cvtpk_s(float lo,float hi){f32x2_t v={lo,hi};bf16x2_t b=__builtin_convertvector(v,bf16x2_t);return __builtin_bit_cast(unsigned,b);}
#define MLA_WAIT_BAR(N) asm volatile("s_waitcnt vmcnt(" #N ") lgkmcnt(0)\n\ts_barrier":::"memory")
__device__ __forceinline__ void cmask(f32x16&p0,f32x16&p1,int jb,int qrel,int hi){
  const float NEG=-INFINITY; int kb=64*jb+4*hi;
  #pragma unroll
  for(int r=0;r<16;++r){int kv=kb+(r&3)+8*(r>>2); if(kv>qrel)p0[r]=NEG; if(kv+32>qrel)p1[r]=NEG;}
}
__device__ __forceinline__ void qkt6(f32x16&p0,f32x16&p1,lds_cptr kslot,const bf16x8*qr,const f32x16&negm,int r32,int hi){
  lds_cptr kb=kslot+hi*1024+r32*16;
  #pragma unroll
  for(int d0=0;d0<6;++d0){
    const bf16x8 b0=*(const __attribute__((address_space(3))) bf16x8*)(kb+d0*2048);
    const bf16x8 b1=*(const __attribute__((address_space(3))) bf16x8*)(kb+d0*2048+512);
    if(d0==0){p0=__builtin_amdgcn_mfma_f32_32x32x16_bf16(b0,qr[0],negm,0,0,0);p1=__builtin_amdgcn_mfma_f32_32x32x16_bf16(b1,qr[0],negm,0,0,0);}
    else{p0=__builtin_amdgcn_mfma_f32_32x32x16_bf16(b0,qr[d0],p0,0,0,0);p1=__builtin_amdgcn_mfma_f32_32x32x16_bf16(b1,qr[d0],p1,0,0,0);}}
}
__device__ __forceinline__ float rowmax(const f32x16&p0,const f32x16&p1){
  float a=__builtin_fmaxf(__builtin_fmaxf(p0[0],p0[1]),p1[0]),b=__builtin_fmaxf(__builtin_fmaxf(p0[2],p0[3]),p1[1]);a=__builtin_fmaxf(__builtin_fmaxf(a,p1[2]),p1[3]);
  #pragma unroll
  for(int r=4;r<16;r+=4){a=__builtin_fmaxf(__builtin_fmaxf(a,p0[r]),p0[r+1]);b=__builtin_fmaxf(__builtin_fmaxf(b,p0[r+2]),p0[r+3]);a=__builtin_fmaxf(__builtin_fmaxf(a,p1[r]),p1[r+1]);b=__builtin_fmaxf(__builtin_fmaxf(b,p1[r+2]),p1[r+3]);}
  const float m=__builtin_fmaxf(a,b);
  auto rr=__builtin_amdgcn_permlane32_swap(__float_as_uint(m),__float_as_uint(m),false,false);
  return __builtin_fmaxf(__uint_as_float(rr[0]),__uint_as_float(rr[1]));
}
__device__ __forceinline__ void pv(f32x16*o,int vb,bf16x8 pa0,bf16x8 pa1,bf16x8 pa2,bf16x8 pa3){
  #pragma unroll
  for(int d0=0;d0<2;++d0){s16x4 lo[4],hi[4];
    #pragma unroll
    for(int ks=0;ks<4;++ks){
      asm volatile("ds_read_b64_tr_b16 %0,%1 offset:%c2":"=&v"(lo[ks]):"v"(vb),"i"(d0*4096+ks*1024):"memory");
      asm volatile("ds_read_b64_tr_b16 %0,%1 offset:%c2":"=&v"(hi[ks]):"v"(vb),"i"(d0*4096+ks*1024+512):"memory");}
    asm volatile("s_waitcnt lgkmcnt(0)":::"memory");__builtin_amdgcn_sched_barrier(0);
    #define PK(k) (bf16x8){lo[k][0],lo[k][1],lo[k][2],lo[k][3],hi[k][0],hi[k][1],hi[k][2],hi[k][3]}
    o[d0]=__builtin_amdgcn_mfma_f32_32x32x16_bf16(pa0,PK(0),o[d0],0,0,0);
    o[d0]=__builtin_amdgcn_mfma_f32_32x32x16_bf16(pa1,PK(1),o[d0],0,0,0);
    o[d0]=__builtin_amdgcn_mfma_f32_32x32x16_bf16(pa2,PK(2),o[d0],0,0,0);
    o[d0]=__builtin_amdgcn_mfma_f32_32x32x16_bf16(pa3,PK(3),o[d0],0,0,0);
    #undef PK
  }
}
constexpr int QPITCH=1536,KVPITCH=2048,KRPITCH=32,OPITCH=1024,SEQ_=4096;
template<int THRL> __device__ __forceinline__ void attn_unit(int b,int h,int qb,const unsigned short*Q,const unsigned short*KV,const unsigned short*KR,const float*COS,const float*SIN,unsigned short*O,char*shm){
  const int tid=threadIdx.x,lane=tid&63,r32=lane&31,hi=lane>>5; const int wid=__builtin_amdgcn_readfirstlane(tid>>6);
  const long rowbase=(long)b*SEQ_; const int q0=qb*QB;
  const unsigned short*Qw=Q+(rowbase+q0+wid*QBLK)*QPITCH+h*96;
  const unsigned short*Kh=KV+rowbase*KVPITCH+h*128,*Vh=Kh+64,*KRb=KR+rowbase*KRPITCH;
  const unsigned lds0=(unsigned)(uintptr_t)shm;
  float*wsf=(float*)(shm+LDS_WS)+wid*64;
  const unsigned short*ksrc0=Kh+(long)lane*KVPITCH+wid*8;
  const unsigned short*ksrc1=KRb+(long)lane*KRPITCH+(wid&3)*8;
  const unsigned short*vsrc=Vh+(long)(16*(wid&3)+(lane>>2))*KVPITCH+(wid>>2)*32+(lane&3)*8;
  const unsigned kdst0=lds0+LDS_K+wid*1024,kdst1=lds0+LDS_K+(8+(wid&3))*1024,vdst=lds0+LDS_V+wid*1024;
  #define DMA_T(t,sl) do{ glds16(ksrc0+(long)(t)*KVBLK*KVPITCH,(unsigned)__builtin_amdgcn_readfirstlane(kdst0+(sl)*KSLOT)); \
                          glds16(ksrc1+(long)(t)*KVBLK*KRPITCH,(unsigned)__builtin_amdgcn_readfirstlane(kdst1+(sl)*KSLOT)); \
                          glds16(vsrc+(long)(t)*KVBLK*KVPITCH,(unsigned)__builtin_amdgcn_readfirstlane(vdst+(sl)*VSLOT)); }while(0)
  const int vb0=(int)(lds0+LDS_V)+((lane>>4)&1)*32+(lane&3)*8+(4*hi+((lane&15)>>2))*64;
  const lds_cptr shm3=(lds_cptr)(__attribute__((address_space(3))) char*)shm;
  const int NT=(q0+QB)/KVBLK;
  bf16x8 qr[6];
  #pragma unroll
  for(int d0=0;d0<6;++d0)qr[d0]=*reinterpret_cast<const bf16x8*>(&Qw[(long)r32*QPITCH+d0*16+hi*8]);
  {
    const float*cp=COS+(rowbase+q0+wid*QBLK+r32)*16+hi*8,*sp=SIN+(rowbase+q0+wid*QBLK+r32)*16+hi*8;
    float cs[8],sn[8];
    #pragma unroll
    for(int j=0;j<8;++j){cs[j]=cp[j];sn[j]=sp[j];}
    const float sc=0.10206207261596577f*1.4426950408889634f;
    float x1[8],x2[8];
    #pragma unroll
    for(int j=0;j<8;++j){x1[j]=__uint_as_float(((unsigned)(unsigned short)qr[4][j])<<16);x2[j]=__uint_as_float(((unsigned)(unsigned short)qr[5][j])<<16);}
    #pragma unroll
    for(int j=0;j<8;j+=2){
      const unsigned a=cvtpk_s((x1[j]*cs[j]-x2[j]*sn[j])*sc,(x1[j+1]*cs[j+1]-x2[j+1]*sn[j+1])*sc), c=cvtpk_s((x2[j]*cs[j]+x1[j]*sn[j])*sc,(x2[j+1]*cs[j+1]+x1[j+1]*sn[j+1])*sc);
      qr[4][j]=(short)(a&0xffffu);qr[4][j+1]=(short)(a>>16);qr[5][j]=(short)(c&0xffffu);qr[5][j+1]=(short)(c>>16);}
    #pragma unroll
    for(int d0=0;d0<4;++d0)
      #pragma unroll
      for(int j=0;j<8;j+=2){const unsigned a=cvtpk_s(__uint_as_float(((unsigned)(unsigned short)qr[d0][j])<<16)*sc,__uint_as_float(((unsigned)(unsigned short)qr[d0][j+1])<<16)*sc);
        qr[d0][j]=(short)(a&0xffffu);qr[d0][j+1]=(short)(a>>16);}
  }
  asm volatile("s_waitcnt vmcnt(0)":::"memory");
  DMA_T(0,0); DMA_T(1,1);
  float mhat=0.f,l_reg=0.f;f32x16 o[2];o[0]=f32x16{};o[1]=f32x16{};f32x16 negm=f32x16{};
  const int qrel=wid*QBLK+r32;
  int sl=0;
  for(int t=0;t<NT;++t){
    if(t+1<NT){MLA_WAIT_BAR(3);}else{MLA_WAIT_BAR(0);}
    if(t+2<NT){const int s2=(sl==0)?2:sl-1; DMA_T(t+2,s2);}
    f32x16 p0,p1;
    qkt6(p0,p1,shm3+LDS_K+sl*KSLOT,qr,negm,r32,hi);
    if(t>=NT-4)cmask(p0,p1,t-(NT-4),qrel,hi);
    const float rm=rowmax(p0,p1);
    bool resc=false;
    if(t==0){ const float dl=rm; mhat+=dl;
      #pragma unroll
      for(int r=0;r<16;++r){p0[r]-=dl;p1[r]-=dl;}
      #pragma unroll
      for(int r=0;r<16;++r)negm[r]=-mhat;
    } else if(__any(rm>(float)THRL)){ const float dl=__builtin_fmaxf(rm,0.f); mhat+=dl;
      #pragma unroll
      for(int r=0;r<16;++r){p0[r]-=dl;p1[r]-=dl;}
      #pragma unroll
      for(int r=0;r<16;++r)negm[r]=-mhat;
      const float f=__builtin_amdgcn_exp2f(-dl); l_reg*=f; if(hi==0)wsf[r32]=f; resc=true; }
    float sacc=0.f;
    #pragma unroll
    for(int r=0;r<16;++r){p0[r]=__builtin_amdgcn_exp2f(p0[r]);p1[r]=__builtin_amdgcn_exp2f(p1[r]);sacc+=p0[r]+p1[r];}
    l_reg+=sacc;
    if(resc){ asm volatile("s_waitcnt lgkmcnt(0)":::"memory");
      #pragma unroll
      for(int d_=0;d_<2;++d_)
        #pragma unroll
        for(int r=0;r<16;++r)o[d_][r]*=wsf[crow(r,hi)]; }
    u32x4 pw0,pw1,pw2,pw3;
    pw0=(u32x4){cvtpk_s(p0[0],p0[1]),cvtpk_s(p0[2],p0[3]),cvtpk_s(p0[4],p0[5]),cvtpk_s(p0[6],p0[7])};
    pw1=(u32x4){cvtpk_s(p0[8],p0[9]),cvtpk_s(p0[10],p0[11]),cvtpk_s(p0[12],p0[13]),cvtpk_s(p0[14],p0[15])};
    pw2=(u32x4){cvtpk_s(p1[0],p1[1]),cvtpk_s(p1[2],p1[3]),cvtpk_s(p1[4],p1[5]),cvtpk_s(p1[6],p1[7])};
    pw3=(u32x4){cvtpk_s(p1[8],p1[9]),cvtpk_s(p1[10],p1[11]),cvtpk_s(p1[12],p1[13]),cvtpk_s(p1[14],p1[15])};
    pv(o,vb0+sl*VSLOT,__builtin_bit_cast(bf16x8,pw0),__builtin_bit_cast(bf16x8,pw1),__builtin_bit_cast(bf16x8,pw2),__builtin_bit_cast(bf16x8,pw3));
    sl=(sl==2)?0:sl+1;
  }
  {auto rr=__builtin_amdgcn_permlane32_swap(__float_as_uint(l_reg),__float_as_uint(l_reg),false,false);l_reg=__uint_as_float(rr[0])+__uint_as_float(rr[1]);}
  if(hi==0)wsf[32+r32]=l_reg;asm volatile("s_waitcnt lgkmcnt(0)":::"memory");
  float rli[16];
  #pragma unroll
  for(int r=0;r<16;++r)rli[r]=__builtin_amdgcn_rcpf(wsf[32+crow(r,hi)]);
  unsigned short*Ow=O+(rowbase+q0+wid*QBLK)*OPITCH+h*64;
  { unsigned short*stg=(unsigned short*)(shm+LDS_OST)+wid*2048;
    #pragma unroll
    for(int r=0;r<16;++r){const int orow=crow(r,hi);
      #pragma unroll
      for(int d0=0;d0<2;++d0)stg[orow*64+d0*32+r32]=(unsigned short)(cvtpk_s(o[d0][r]*rli[r],0.f)&0xffffu);}
    asm volatile("s_waitcnt lgkmcnt(0)":::"memory");
    #pragma unroll
    for(int i=0;i<4;++i){const int row=i*8+(lane>>3),ch=lane&7; const u32x4 v=*(const u32x4*)(stg+row*64+ch*8); *(u32x4*)(Ow+(long)row*OPITCH+ch*8)=v;} }
  asm volatile("s_waitcnt vmcnt(0) lgkmcnt(0)\n\ts_barrier":::"memory");
  #undef DMA_T
}
}

struct Args { const float* in[22]; const int* pos; float* out; unsigned char* ws; int ph_lo, ph_hi, li, pad; };

__global__ void __launch_bounds__(NWAVES * 64, 2) fwd_kernel(Args args) {
    extern __shared__ __attribute__((aligned(16))) unsigned char lds[];
    LAS unsigned char* L = (LAS unsigned char*)lds;
    volatile LAS unsigned* MISC = (volatile LAS unsigned*)(L + MISC_OFF);
    const int tid = threadIdx.x, lane = tid & 63, wave = __builtin_amdgcn_readfirstlane(tid >> 6);
    const int G = gridDim.x;
    const int gw = blockIdx.x * NWAVES + wave, NGW = G * NWAVES;
    unsigned char* ws = args.ws;
    gu32* ctl = (gu32*)(ws + WS_CTL);
    for (int u = tid; u < (LDS_BYTES - LDSCTL_OFF) / 4; u += NWAVES * 64) ((LAS unsigned*)(L + LDSCTL_OFF))[u] = 0u;
    __syncthreads();
    XcdBarrier bar; bar.bar = (unsigned*)(ctl + CW_BAR); bar.x = 0; bar.st = nullptr;
    if (N_LAUNCHES == 1) bar = xcd_barrier_post((unsigned*)(ctl + CW_BAR), MISC + 8);
#define GRID_BAR() do { if (N_LAUNCHES == 1) xcd_barrier(bar); } while (0)
    const int lo = args.ph_lo, hi = args.ph_hi;
#define IN(k) (lo <= (k) && (k) < hi)
#define BOTH(k) (IN(k) && IN((k) + 1))
    const float* x = args.in[0];
    float* H = args.out;

    if (IN(0)) {
        LAS float* scr = (LAS float*)(L + RING_OFF + wave * 16384);
        constexpr int I_MOE = (1024 / 64) * (3584 / 32);
        constexpr int NITEMS = 16 * 21 + 6 * 48 + 4 * 64 + 16 * 32 + 2 * 1792 + 1792 + 16 * 128 + 16 * 32 + 24 * I_MOE;
        for (int it = gw; it < NITEMS; it += NGW) {
            int r = it;
#define JOB(W, K_, N_, WT, mode) { const int ni = ((K_) / 64) * ((N_) / 32); if (r < ni) { tr_item((W), (K_), (N_), (bf16*)(ws + (WT)), (mode), scr, r, lane); continue; } r -= ni; }
            JOB(args.in[5], 1024, 672, WS_WMLAIN, 0)
            JOB(args.in[7], 384, 1536, WS_WQUP, 0)
            JOB(args.in[9], 256, 2048, WS_WKVUP, 0)
            JOB(args.in[10], 1024, 1024, WS_WO0, 0)
            JOB(args.in[15], 1024, 3584, WS_WFGU, 1)
            JOB(args.in[16], 1024, 3584, WS_WFGU, 2)
            JOB(args.in[17], 3584, 1024, WS_WFDN, 0)
            JOB(args.in[11], 1024, 4096, WS_WHIN, 0)
            JOB(args.in[14], 1024, 1024, WS_WHO, 0)
#undef JOB
            if (r < 8 * I_MOE) { const int e = r / I_MOE; tr_item(args.in[19] + (size_t)e * 1024 * 3584, 1024, 3584, (bf16*)(ws + WS_WMGU) + (size_t)e * 7168 * 1024, 1, scr, r % I_MOE, lane); continue; } r -= 8 * I_MOE;
            if (r < 8 * I_MOE) { const int e = r / I_MOE; tr_item(args.in[20] + (size_t)e * 1024 * 3584, 1024, 3584, (bf16*)(ws + WS_WMGU) + (size_t)e * 7168 * 1024, 2, scr, r % I_MOE, lane); continue; } r -= 8 * I_MOE;
            { const int e = r / I_MOE; tr_item(args.in[21] + (size_t)e * 3584 * 1024, 3584, 1024, (bf16*)(ws + WS_WMDN) + (size_t)e * 1024 * 3584, 0, scr, r % I_MOE, lane); }
        }
        { v4u* z = (v4u*)((bf16*)(ws + WS_WMLAIN) + (size_t)MLA_IN * 1024); const int n16 = (MLA_INP - MLA_IN) * 1024 * 2 / 16;
          for (int i = blockIdx.x * NWAVES * 64 + tid; i < n16; i += G * NWAVES * 64) z[i] = (v4u){0u, 0u, 0u, 0u}; }
        for (int m = gw; m < M; m += NGW) rms_row_to_bf16(x + (size_t)m * D, args.in[2], (bf16*)(ws + WS_HN) + (size_t)m * D, lane);
        if (BOTH(0)) GRID_BAR();
    }
    if (IN(1)) {
        pg8::Gemm g{(const bf16*)(ws + WS_HN), (const bf16*)(ws + WS_WMLAIN), M, MLA_INP, 1024}; pg8::StaticOrder S; S.init(M, MLA_INP, G, (int)blockIdx.x);
        pg8::EpiStoreBf16 E{(bf16*)(ws + WS_PROJ), MLA_INP, MLA_INP / 256};
        pg8::gemm_phase<pg8::EpiStoreBf16, pg8::StaticOrder, true, false>(L + RING_OFF, g, S, E);
        if (BOTH(1)) GRID_BAR();
    }
    if (IN(2)) {
        const bf16* P = (const bf16*)(ws + WS_PROJ);
        for (int m = gw; m < M; m += NGW) {
            const bf16* pr = P + (size_t)m * MLA_INP;
            float cq[6]; float s = 0.f;
#pragma unroll
            for (int j = 0; j < 6; ++j) { cq[j] = bf2f(pr[j * 64 + lane]); s += cq[j] * cq[j]; }
            const float rq = 1.f / sqrtf(wave_sum(s) * (1.f / QL) + EPS);
            bf16* oq = (bf16*)(ws + WS_CQN) + (size_t)m * QL;
#pragma unroll
            for (int j = 0; j < 6; ++j) oq[j * 64 + lane] = (bf16)f2bf(cq[j] * rq * args.in[6][j * 64 + lane]);
            float ck[4]; s = 0.f;
#pragma unroll
            for (int j = 0; j < 4; ++j) { ck[j] = bf2f(pr[QL + j * 64 + lane]); s += ck[j] * ck[j]; }
            const float rk = 1.f / sqrtf(wave_sum(s) * (1.f / KVL) + EPS);
            bf16* ok = (bf16*)(ws + WS_CKVN) + (size_t)m * KVL;
#pragma unroll
            for (int j = 0; j < 4; ++j) ok[j * 64 + lane] = (bf16)f2bf(ck[j] * rk * args.in[8][j * 64 + lane]);
            if (lane < 16) {
                const float invf = exp2f(-(float)lane * (13.287712379549449f / 16.0f));
                const float ang = (float)args.pos[m] * invf;
                const double rev = (double)ang * 0.15915494309189535; const float fr = (float)(rev - rint(rev));
                const float sn = __builtin_amdgcn_sinf(fr), cs = __builtin_amdgcn_cosf(fr);
                ((float*)(ws + WS_COS))[(size_t)m * 16 + lane] = cs; ((float*)(ws + WS_SIN))[(size_t)m * 16 + lane] = sn;
                const float x1 = bf2f(pr[QL + KVL + lane]), x2 = bf2f(pr[QL + KVL + 16 + lane]);
                bf16* okr = (bf16*)(ws + WS_KR) + (size_t)m * 32;
                okr[lane] = (bf16)f2bf(x1 * cs - x2 * sn); okr[16 + lane] = (bf16)f2bf(x2 * cs + x1 * sn);
            }
        }
        if (BOTH(2)) GRID_BAR();
    }
    if (IN(3)) {
        { pg8::Gemm g{(const bf16*)(ws + WS_CQN), (const bf16*)(ws + WS_WQUP), M, QW, QL}; pg8::StaticOrder S; S.init(M, QW, G, (int)blockIdx.x);
          pg8::EpiStoreBf16 E{(bf16*)(ws + WS_Q), QW, QW / 256};
          pg8::gemm_phase<pg8::EpiStoreBf16, pg8::StaticOrder, true, false>(L + RING_OFF, g, S, E); }
        { pg8::Gemm g{(const bf16*)(ws + WS_CKVN), (const bf16*)(ws + WS_WKVUP), M, KVW, KVL}; pg8::StaticOrder S; S.init(M, KVW, G, (int)blockIdx.x);
          pg8::EpiStoreBf16 E{(bf16*)(ws + WS_KV), KVW, KVW / 256};
          pg8::gemm_phase<pg8::EpiStoreBf16, pg8::StaticOrder, true, false>(L + RING_OFF, g, S, E); }
        if (BOTH(3)) GRID_BAR();
    }
    if (IN(4)) {
        const int vcu = (G % 8 == 0) ? ((int)blockIdx.x % 8) * (G / 8) + (int)blockIdx.x / 8 : (int)blockIdx.x;
        for (int v = vcu; v < 256; v += G) {
            const int bh = v >> 2, s4 = v & 3;
#pragma unroll 1
            for (int i = 0; i < 4; ++i) { const int qb = (i == 0) ? s4 : (i == 1) ? 7 - s4 : (i == 2) ? 8 + s4 : 15 - s4;
                mla_attn::attn_unit<8>(bh >> 4, bh & 15, qb, (const bf16*)(ws + WS_Q), (const bf16*)(ws + WS_KV), (const bf16*)(ws + WS_KR), (const float*)(ws + WS_COS), (const float*)(ws + WS_SIN), (bf16*)(ws + WS_O), (char*)lds + RING_OFF); }
        }
        if (BOTH(4)) GRID_BAR();
    }
    if (IN(5)) {
        pg8::Gemm g{(const bf16*)(ws + WS_O), (const bf16*)(ws + WS_WO0), M, D, D}; pg8::StaticOrder S; S.init(M, D, G, (int)blockIdx.x);
        pg8::EpiF32Res E{x, H, D, D / 256};
        pg8::gemm_phase<pg8::EpiF32Res, pg8::StaticOrder, true, false>(L + RING_OFF, g, S, E);
        if (BOTH(5)) GRID_BAR();
    }
    if (IN(6)) {
        for (int m = gw; m < M; m += NGW) rms_row_to_bf16(H + (size_t)m * D, args.in[3], (bf16*)(ws + WS_HN) + (size_t)m * D, lane);
        if (BOTH(6)) GRID_BAR();
    }
    if (IN(7)) {
        pg8::Gemm g{(const bf16*)(ws + WS_HN), (const bf16*)(ws + WS_WFGU), M, 2 * FF, D}; pg8::StaticOrder S; S.init(M, 2 * FF, G, (int)blockIdx.x);
        pg8::EpiSwiGLU E{(bf16*)(ws + WS_FACT), FF, 2 * FF / 256};
        pg8::gemm_phase<pg8::EpiSwiGLU, pg8::StaticOrder, true, false>(L + RING_OFF, g, S, E);
        if (BOTH(7)) GRID_BAR();
    }
    if (IN(8)) {
        pg8::Gemm g{(const bf16*)(ws + WS_FACT), (const bf16*)(ws + WS_WFDN), M, D, FF}; pg8::StaticOrder S; S.init(M, D, G, (int)blockIdx.x);
        pg8::EpiF32Res E{H, H, D, D / 256};
        pg8::gemm_phase<pg8::EpiF32Res, pg8::StaticOrder, true, false>(L + RING_OFF, g, S, E);
        if (BOTH(8)) GRID_BAR();
    }
    if (IN(9)) {
        for (int m = gw; m < M; m += NGW) rms_row_to_bf16(H + (size_t)m * D, args.in[2] + D, (bf16*)(ws + WS_HN) + (size_t)m * D, lane);
        if (BOTH(9)) GRID_BAR();
    }
    if (IN(10)) {
        pg8::Gemm g{(const bf16*)(ws + WS_HN), (const bf16*)(ws + WS_WHIN), M, HG_IN, D}; pg8::StaticOrder S; S.init(M, HG_IN, G, (int)blockIdx.x);
        pg8::EpiStoreBf16 E{(bf16*)(ws + WS_HPROJ), HG_IN, HG_IN / 256};
        pg8::gemm_phase<pg8::EpiStoreBf16, pg8::StaticOrder, true, false>(L + RING_OFF, g, S, E);
        if (BOTH(10)) GRID_BAR();
    }
    if (IN(11)) {
        LAS float* fS = (LAS float*)(L + RING_OFF);
        LAS float* qS = fS + 32 * 128;
        LAS float* vS = qS + 32 * 128;
        const bf16* HP = (const bf16*)(ws + WS_HPROJ); float* HO = (float*)(ws + WS_HOF);
        const int kq = lane & 15, vv = wave * 4 + (lane >> 4);
        for (int uu = blockIdx.x; uu < 128; uu += G) {
            const int b = uu >> 5, h = (uu >> 2) & 7, vs = uu & 3;
            float St[8];
#pragma unroll
            for (int j = 0; j < 8; ++j) St[j] = 0.f;
            for (int c = 0; c < SEQ / 32; ++c) {
                __syncthreads();
                for (int i = tid; i < 32 * 128; i += 512) { const int tt = i >> 7, k = i & 127; const size_t row = (size_t)b * SEQ + c * 32 + tt;
                    const float lbp0 = args.in[12][h * 128 + k], lbp1 = args.in[12][1024 + h * 128 + k]; const float lb = sigmoid_f(lbp1 - lbp0);
                    const float fp = bf2f(HP[row * HG_IN + 1024 + h * 128 + k]);
                    fS[i] = lb + (1.0f - lb) * sigmoid_f(fp);
                    qS[i] = bf2f(HP[row * HG_IN + h * 128 + k]) * 0.08838834764831845f; }
                for (int i = tid; i < 32 * 32; i += 512) { const int tt = i >> 5, v = i & 31; const size_t row = (size_t)b * SEQ + c * 32 + tt;
                    vS[i] = bf2f(HP[row * HG_IN + 2048 + h * 128 + vs * 32 + v]); }
                __syncthreads();
                for (int tt = 0; tt < 32; ++tt) {
                    const f32x4 f0 = *(const LAS f32x4*)(fS + tt * 128 + kq * 8), f1 = *(const LAS f32x4*)(fS + tt * 128 + kq * 8 + 4);
                    const f32x4 q0 = *(const LAS f32x4*)(qS + tt * 128 + kq * 8), q1 = *(const LAS f32x4*)(qS + tt * 128 + kq * 8 + 4);
                    const float vt = vS[tt * 32 + vv];
                    const float fv[8] = {f0.x, f0.y, f0.z, f0.w, f1.x, f1.y, f1.z, f1.w}; const float qv[8] = {q0.x, q0.y, q0.z, q0.w, q1.x, q1.y, q1.z, q1.w};
                    float a = 0.f;
#pragma unroll
                    for (int j = 0; j < 8; ++j) { St[j] = fv[j] * St[j] + (1.0f - fv[j]) * vt; a += St[j] * qv[j]; }
                    a += __shfl_xor(a, 1); a += __shfl_xor(a, 2); a += __shfl_xor(a, 4); a += __shfl_xor(a, 8);
                    if (kq == 0) HO[((size_t)b * SEQ + c * 32 + tt) * 1024 + h * 128 + vs * 32 + vv] = a;
                }
            }
        }
        __syncthreads();
        if (BOTH(11)) GRID_BAR();
    }
    if (IN(12)) {
        const float* HO = (const float*)(ws + WS_HOF); const bf16* HP = (const bf16*)(ws + WS_HPROJ);
        for (int m = gw; m < M; m += NGW) {
#pragma unroll
            for (int h = 0; h < 8; ++h) {
                const float o0 = HO[(size_t)m * 1024 + h * 128 + lane], o1 = HO[(size_t)m * 1024 + h * 128 + 64 + lane];
                const float rs = 1.f / sqrtf(wave_sum(o0 * o0 + o1 * o1) * (1.f / 128.f) + EPS);
                const float g0 = bf2f(HP[(size_t)m * HG_IN + 3072 + h * 128 + lane]), g1 = bf2f(HP[(size_t)m * HG_IN + 3072 + h * 128 + 64 + lane]);
                bf16* op = (bf16*)(ws + WS_HON) + (size_t)m * 1024 + h * 128;
                op[lane] = (bf16)f2bf(o0 * rs * args.in[13][lane] * (g0 * sigmoid_f(g0)));
                op[64 + lane] = (bf16)f2bf(o1 * rs * args.in[13][64 + lane] * (g1 * sigmoid_f(g1)));
            }
        }
        if (BOTH(12)) GRID_BAR();
    }
    if (IN(13)) {
        pg8::Gemm g{(const bf16*)(ws + WS_HON), (const bf16*)(ws + WS_WHO), M, D, D}; pg8::StaticOrder S; S.init(M, D, G, (int)blockIdx.x);
        pg8::EpiF32Res E{H, H, D, D / 256};
        pg8::gemm_phase<pg8::EpiF32Res, pg8::StaticOrder, true, false>(L + RING_OFF, g, S, E);
        if (BOTH(13)) GRID_BAR();
    }
    if (IN(14)) {
        const float* gn = args.in[3] + D; const float* RT = args.in[18];
        int* rowlist = (int*)(ws + WS_ROWLIST); v4u* tok = (v4u*)(ws + WS_TOK);
        for (int m = gw; m < M; m += NGW) {
            const f32x4* xr = (const f32x4*)(H + (size_t)m * D) + lane; const f32x4* gr = (const f32x4*)gn + lane;
            f32x4 v[4]; float s = 0.f;
#pragma unroll
            for (int j = 0; j < 4; ++j) { v[j] = xr[64 * j]; s += (v[j].x * v[j].x + v[j].y * v[j].y) + (v[j].z * v[j].z + v[j].w * v[j].w); }
            const float rstd = 1.f / sqrtf(wave_sum(s) * (1.f / 1024.f) + EPS);
            float lg[8];
#pragma unroll
            for (int e = 0; e < 8; ++e) lg[e] = 0.f;
            unsigned long long* o8 = (unsigned long long*)((bf16*)(ws + WS_HN3) + (size_t)m * D) + lane;
#pragma unroll
            for (int j = 0; j < 4; ++j) { const f32x4 g = gr[64 * j]; const f32x4 t = (f32x4){v[j].x * rstd * g.x, v[j].y * rstd * g.y, v[j].z * rstd * g.z, v[j].w * rstd * g.w};
                o8[64 * j] = (unsigned long long)pk2(t.x, t.y) | ((unsigned long long)pk2(t.z, t.w) << 32);
                const int k0 = 4 * (lane + 64 * j);
#pragma unroll
                for (int kk = 0; kk < 4; ++kk) { const f32x4 r0 = *(const f32x4*)(RT + (size_t)(k0 + kk) * 8), r1 = *(const f32x4*)(RT + (size_t)(k0 + kk) * 8 + 4); const float tv = t[kk];
                    lg[0] += tv * r0.x; lg[1] += tv * r0.y; lg[2] += tv * r0.z; lg[3] += tv * r0.w; lg[4] += tv * r1.x; lg[5] += tv * r1.y; lg[6] += tv * r1.z; lg[7] += tv * r1.w; } }
#pragma unroll
            for (int e = 0; e < 8; ++e) lg[e] = wave_sum(lg[e]);
            if (lane == 0) {
                int e1 = 0; float v1 = lg[0];
#pragma unroll
                for (int e = 1; e < 8; ++e) if (lg[e] > v1) { v1 = lg[e]; e1 = e; }
                int e2 = (e1 == 0) ? 1 : 0; float v2 = lg[e2];
#pragma unroll
                for (int e = 1; e < 8; ++e) if (e != e1 && lg[e] > v2) { v2 = lg[e]; e2 = e; }
                const float w1 = 1.0f / (1.0f + __expf(v2 - v1)), w2 = 1.0f - w1;
                const unsigned p1 = __hip_atomic_fetch_add((unsigned*)(ctl + CW_CNT + 64 * e1), 1u, RLX_AGENT), p2 = __hip_atomic_fetch_add((unsigned*)(ctl + CW_CNT + 64 * e2), 1u, RLX_AGENT);
                rowlist[e1 * CAP + p1] = m; rowlist[e2 * CAP + p2] = m;
                tok[m] = (v4u){(unsigned)(e1 * CAP) + p1, (unsigned)(e2 * CAP) + p2, __builtin_bit_cast(unsigned, w1), __builtin_bit_cast(unsigned, w2)};
            }
        }
        if (BOTH(14)) GRID_BAR();
    }
    if (IN(15) || IN(16) || IN(17)) {
        if (tid == 0) { volatile LAS int* mt = (volatile LAS int*)(MISC + 16); int acc = 0;
            for (int e = 0; e < 8; ++e) { const int c = (int)__hip_atomic_load((unsigned*)(ctl + CW_CNT + 64 * e), RLX_AGENT); mt[e] = acc; mt[9 + e] = c; acc += (c + 255) >> 8; }
            mt[8] = acc; }
        __syncthreads();
    }
    if (IN(15)) {
        pg8::Gemm g{(const bf16*)(ws + WS_HN3), (const bf16*)(ws + WS_WMGU), M, 2 * FF, D};
        MoeOrder S; S.init((volatile LAS int*)(MISC + 16), 2 * FF / 256, G, (int)blockIdx.x, (const int*)(ws + WS_ROWLIST));
        pg8::EpiSwiGLU E{(bf16*)(ws + WS_MACT), FF, 2 * FF / 256};
        pg8::gemm_phase<pg8::EpiSwiGLU, MoeOrder, true, true>(L + RING_OFF, g, S, E);
        if (BOTH(15)) GRID_BAR();
    }
    if (IN(16)) {
        pg8::Gemm g{(const bf16*)(ws + WS_MACT), (const bf16*)(ws + WS_WMDN), MAXSLOT, D, FF};
        MoeOrder S; S.init((volatile LAS int*)(MISC + 16), D / 256, G, (int)blockIdx.x, (const int*)(ws + WS_ROWLIST));
        pg8::EpiStoreBf16 E{(bf16*)(ws + WS_Y), D, D / 256};
        pg8::gemm_phase<pg8::EpiStoreBf16, MoeOrder, true, false>(L + RING_OFF, g, S, E);
        if (BOTH(16)) GRID_BAR();
    }
    if (IN(17)) {
        volatile LAS int* mt = (volatile LAS int*)(MISC + 16);
        const bf16* Y = (const bf16*)(ws + WS_Y); const v4u* tok = (const v4u*)(ws + WS_TOK);
        for (int m = gw; m < M; m += NGW) {
            const v4u tk = tok[m];
            const int e1 = tk.x / CAP, e2 = tk.y / CAP; const size_t s1 = (size_t)mt[e1] * 256 + (tk.x % CAP), s2 = (size_t)mt[e2] * 256 + (tk.y % CAP);
            const unsigned zb = tk.z, wb = tk.w; const float w1 = __uint_as_float(zb), w2 = __uint_as_float(wb);
            f32x4* xr = (f32x4*)(H + (size_t)m * D) + lane; const f32x4* gr = (const f32x4*)args.in[4] + lane;
            const v2u* y1 = (const v2u*)(Y + s1 * D) + lane; const v2u* y2 = (const v2u*)(Y + s2 * D) + lane;
            f32x4 v[4]; float s = 0.f;
#pragma unroll
            for (int j = 0; j < 4; ++j) { v[j] = xr[64 * j]; const v2u a = y1[64 * j], c = y2[64 * j];
                v[j].x += w1 * bf2f((unsigned short)(a.x & 0xffffu)) + w2 * bf2f((unsigned short)(c.x & 0xffffu)); v[j].y += w1 * bf2f((unsigned short)(a.x >> 16)) + w2 * bf2f((unsigned short)(c.x >> 16));
                v[j].z += w1 * bf2f((unsigned short)(a.y & 0xffffu)) + w2 * bf2f((unsigned short)(c.y & 0xffffu)); v[j].w += w1 * bf2f((unsigned short)(a.y >> 16)) + w2 * bf2f((unsigned short)(c.y >> 16));
                s += (v[j].x * v[j].x + v[j].y * v[j].y) + (v[j].z * v[j].z + v[j].w * v[j].w); }
            const float rstd = 1.f / sqrtf(wave_sum(s) * (1.f / 1024.f) + EPS);
#pragma unroll
            for (int j = 0; j < 4; ++j) { const f32x4 g = gr[64 * j]; xr[64 * j] = (f32x4){v[j].x * rstd * g.x, v[j].y * rstd * g.y, v[j].z * rstd * g.z, v[j].w * rstd * g.w}; }
        }
    }
#undef IN
#undef BOTH
}

extern "C" void kernel_launch(void* const* d_in, const int* in_sizes, int n_in, void* d_out, int out_size, void* d_ws, size_t ws_size, hipStream_t stream) {
    static int grid = 0;
    if (grid == 0) {
        if (n_in != 22 || in_sizes[0] != M * D || out_size != M * D || ws_size < WS_END) { fprintf(stderr, "kernel_launch: unexpected shapes (n_in %d, in0 %d, out %d, ws %zu)\n", n_in, n_in > 0 ? in_sizes[0] : -1, out_size, ws_size); grid = -1; return; }
        int dev = 0, cus = 0, per_cu = 0;
        if (hipGetDevice(&dev) != hipSuccess || hipDeviceGetAttribute(&cus, hipDeviceAttributeMultiprocessorCount, dev) != hipSuccess) { grid = -1; return; }
        if (hipFuncSetAttribute((const void*)fwd_kernel, hipFuncAttributeMaxDynamicSharedMemorySize, LDS_BYTES) != hipSuccess) { fprintf(stderr, "kernel_launch: hipFuncSetAttribute failed\n"); grid = -1; return; }
        if (hipOccupancyMaxActiveBlocksPerMultiprocessor(&per_cu, (const void*)fwd_kernel, NWAVES * 64, LDS_BYTES) != hipSuccess || per_cu < 1) fprintf(stderr, "kernel_launch: occupancy query reports %d\n", per_cu);
        (void)hipGetLastError();
        grid = cus;
    }
    if (grid < 0) return;
    if (hipMemsetAsync((char*)d_ws + WS_CTL, 0, CTL_ZERO_BYTES, stream) != hipSuccess) return;
    Args a{};
    for (int i = 0; i < 22; ++i) a.in[i] = (const float*)d_in[i];
    a.pos = (const int*)d_in[1]; a.out = (float*)d_out; a.ws = (unsigned char*)d_ws;
    static_assert(N_LAUNCHES == 1 || N_LAUNCHES == NPHASE, "MK_N_LAUNCHES: 1 or 18");
    for (int li = 0; li < N_LAUNCHES; ++li) {
        a.ph_lo = (N_LAUNCHES == 1) ? 0 : li; a.ph_hi = (N_LAUNCHES == 1) ? NPHASE : li + 1; a.li = li;
        hipLaunchKernelGGL(fwd_kernel, dim3(grid), dim3(NWAVES * 64), LDS_BYTES, stream, a);
        if (hipPeekAtLastError() != hipSuccess) { fprintf(stderr, "kernel_launch: launch %d failed\n", li); break; }
    }
}
```

```cpp
#include <hip/hip_runtime.h>
#include <cstdio>
#include <cstdint>

#ifndef MK_N_LAUNCHES
#define MK_N_LAUNCHES 1
#endif

namespace pg8 {
#define PG8_LAS __attribute__((address_space(3)))
typedef unsigned short bf16_t;
typedef short bf16x8 __attribute__((ext_vector_type(8)));
typedef float f32x4 __attribute__((ext_vector_type(4)));
typedef unsigned u32x4 __attribute__((ext_vector_type(4)));
constexpr int BM = 256, BK = 64, HALF = 128, HTB = HALF * BK * 2, STAGE_BYTES = 8 * HTB, NXCD = 8, WGM = 8;

__host__ __device__ __forceinline__ int lds_byte(int r, int c) { const int st = (r >> 4) * 2 + (c >> 5), rr = r & 15, cc = c & 31, ob = rr * 64 + cc * 2; return st * 1024 + (ob ^ (((ob >> 9) & 1) << 5)); }
__host__ __device__ __forceinline__ void stage_rc(int b, int& R, int& C) { const int st = b / 1024, sb = b % 1024, swz = sb ^ (((sb >> 9) & 1) << 5); R = (st >> 1) * 16 + swz / 64; C = (st & 1) * 32 + (swz % 64) / 2; }
__host__ __device__ __forceinline__ int perm32(int rho) { const int n = rho >> 4, i = rho & 15; return 8 * (i >> 2) + 4 * n + (i & 3); }

struct Unit { int pm, pn; };
struct Gemm { const bf16_t* A; const bf16_t* Bt; int M, N, K; };

struct StaticOrder {
    int nM, nN, nwg, G, c;
    __host__ __device__ void init(int M, int N, int G_, int c_) { nM = M / BM; nN = N / BM; nwg = nM * nN; G = G_; c = c_; }
    __host__ __device__ bool next(int i, Unit& u) const {
        const long L = (long)i * G + c; if (L >= nwg) return false;
        int wgid = (int)L; { const int q = nwg / NXCD, r = nwg % NXCD, xcd = wgid % NXCD, off = wgid / NXCD; wgid = (xcd < r ? xcd * (q + 1) : r * (q + 1) + (xcd - r) * q) + off; }
        const int nig = WGM * nN, gid = wgid / nig, fm = gid * WGM, gsz = (nM - fm) < WGM ? (nM - fm) : WGM;
        u.pm = fm + ((wgid % nig) % gsz); u.pn = (wgid % nig) / gsz; return true;
    }
    __device__ __forceinline__ void a_ready(const Unit&) const {}
    __device__ __forceinline__ void done(const Unit&) const {}
    __device__ __forceinline__ int arow(const Unit&, int) const { return 0; }
};

__device__ __forceinline__ unsigned cvt_pk_bf16(float lo, float hi) { unsigned r; asm volatile("v_cvt_pk_bf16_f32 %0, %1, %2" : "=v"(r) : "v"(lo), "v"(hi)); return r; }

struct EpiStoreBf16 {
    static constexpr bool PERM = true, AFTER_DRAIN = false;
    bf16_t* O; int ldc; int nN;
    __device__ __forceinline__ void operator()(const f32x4 (&acc)[2][2][4][2], const Unit& u, int wr, int wc, int fr, int fq) const {
        const int pnl = u.pn % nN; const int row0 = u.pm * BM + wr * 64 + fr, col0 = pnl * BM + wc * 32 + 8 * fq;
#pragma unroll
        for (int ai = 0; ai < 2; ++ai)
#pragma unroll
            for (int m = 0; m < 4; ++m) { bf16_t* rowp = O + (size_t)(row0 + ai * HALF + m * 16) * ldc + col0;
#pragma unroll
                for (int bj = 0; bj < 2; ++bj) { const f32x4 v0 = acc[ai][bj][m][0], v1 = acc[ai][bj][m][1];
                    u32x4 w; w.x = cvt_pk_bf16(v0[0], v0[1]); w.y = cvt_pk_bf16(v0[2], v0[3]); w.z = cvt_pk_bf16(v1[0], v1[1]); w.w = cvt_pk_bf16(v1[2], v1[3]);
                    *(u32x4*)(rowp + bj * HALF) = w; } }
    }
};
__device__ __forceinline__ float silu_f(float x) { return x * __builtin_amdgcn_rcpf(1.0f + __builtin_amdgcn_exp2f(-1.4426950408889634f * x)); }
struct EpiSwiGLU {
    static constexpr bool PERM = true, AFTER_DRAIN = false;
    bf16_t* O; int ldc; int nN;
    __device__ __forceinline__ void operator()(const f32x4 (&acc)[2][2][4][2], const Unit& u, int wr, int wc, int fr, int fq) const {
        const int pnl = u.pn % nN; const int row0 = u.pm * BM + wr * 64 + fr, col0 = pnl * HALF + wc * 32 + 8 * fq;
#pragma unroll
        for (int ai = 0; ai < 2; ++ai)
#pragma unroll
            for (int m = 0; m < 4; ++m) { bf16_t* rowp = O + (size_t)(row0 + ai * HALF + m * 16) * ldc + col0;
                const f32x4 g0 = acc[ai][0][m][0], g1 = acc[ai][0][m][1], u0 = acc[ai][1][m][0], u1 = acc[ai][1][m][1];
                u32x4 w; w.x = cvt_pk_bf16(silu_f(g0[0]) * u0[0], silu_f(g0[1]) * u0[1]); w.y = cvt_pk_bf16(silu_f(g0[2]) * u0[2], silu_f(g0[3]) * u0[3]);
                w.z = cvt_pk_bf16(silu_f(g1[0]) * u1[0], silu_f(g1[1]) * u1[1]); w.w = cvt_pk_bf16(silu_f(g1[2]) * u1[2], silu_f(g1[3]) * u1[3]);
                *(u32x4*)rowp = w; }
    }
};
struct EpiF32Res {
    static constexpr bool PERM = false, AFTER_DRAIN = false;
    const float* base; float* out; int ldc; int nN;
    __device__ __forceinline__ void operator()(const f32x4 (&acc)[2][2][4][2], const Unit& u, int wr, int wc, int fr, int fq) const {
        const int pnl = u.pn % nN; const int row0 = u.pm * BM + wr * 64 + fr, col0 = pnl * BM + wc * 32 + 4 * fq;
#pragma unroll
        for (int ai = 0; ai < 2; ++ai)
#pragma unroll
            for (int m = 0; m < 4; ++m) { const size_t off = (size_t)(row0 + ai * HALF + m * 16) * ldc + col0;
#pragma unroll
                for (int bj = 0; bj < 2; ++bj)
#pragma unroll
                    for (int n = 0; n < 2; ++n) { f32x4 v = acc[ai][bj][m][n]; if (base) v += *(const f32x4*)(base + off + bj * HALF + n * 16); *(f32x4*)(out + off + bj * HALF + n * 16) = v; } }
    }
};

template <class Epi, class Sched, bool ALIGN_EPI = true, bool GATHER = false>
__device__ __forceinline__ void gemm_phase(PG8_LAS unsigned char* lds, const Gemm g, const Sched& S, const Epi& E) {
    const int tid = threadIdx.x, wid = __builtin_amdgcn_readfirstlane(tid >> 6), lane = tid & 63, wr = wid >> 2, wc = wid & 3, fr = lane & 15, fq = lane >> 4;
    const int K = g.K, nt = K / BK;
    unsigned voffA[2], voffB[2]; int RA[2], CA[2];
#pragma unroll
    for (int i = 0; i < 2; ++i) { int R, C; stage_rc(tid * 16 + i * 8192, R, C); const int Rb = Epi::PERM ? ((R & ~31) + perm32(R & 31)) : R;
        voffA[i] = (unsigned)(R * K + C) * 2u; voffB[i] = (unsigned)(Rb * K + C) * 2u; RA[i] = R; CA[i] = C; }
    unsigned vAc[2][2], vAn[2][2];
    const size_t kstep = (size_t)(BK * 2);
    const size_t hstep = (size_t)HALF * K * 2;
    const size_t tstep = 2 * hstep;
    const size_t hstepA = GATHER ? (size_t)0 : hstep;
    const unsigned ldsw = (unsigned)wid * 1024u;
    const int aoff = lds_byte(wr * 64 + fr, fq * 8), boff = lds_byte(wc * 32 + fr, fq * 8);
#define PG8_SA(b, h) (((b) * 2 + (h)) * HTB)
#define PG8_SB(b, h) ((4 + (b) * 2 + (h)) * HTB)
#define PG8_STAGE(bufoff, gbase, voff) do { _Pragma("unroll") for (int _i = 0; _i < 2; ++_i) \
        __builtin_amdgcn_global_load_lds((const unsigned*)((const char*)(gbase) + (voff)[_i]), (PG8_LAS unsigned*)(lds + (bufoff) + ldsw + _i * 8192), 16, 0, 0); } while (0)
#define PG8_STAGE_A(bufoff, gbase, h, nx) do { _Pragma("unroll") for (int _i = 0; _i < 2; ++_i) { const unsigned _vo = GATHER ? ((nx) ? vAn[h][_i] : vAc[h][_i]) : voffA[_i]; \
        __builtin_amdgcn_global_load_lds((const unsigned*)((const char*)(gbase) + _vo), (PG8_LAS unsigned*)(lds + (bufoff) + ldsw + _i * 8192), 16, 0, 0); } } while (0)
#define PG8_GATH(dst, un) do { _Pragma("unroll") for (int _h = 0; _h < 2; ++_h) _Pragma("unroll") for (int _i = 0; _i < 2; ++_i) \
        dst[_h][_i] = (unsigned)(S.arow(un, _h * HALF + RA[_i]) * K + CA[_i]) * 2u; } while (0)
#define PG8_LDA(dst, b, h) do { _Pragma("unroll") for (int m = 0; m < 4; ++m) _Pragma("unroll") for (int k = 0; k < 2; ++k) dst[m][k] = *(const PG8_LAS bf16x8*)(lds + PG8_SA(b, h) + aoff + m * 2048 + k * 1024); } while (0)
#define PG8_LDB(dst, b, h) do { _Pragma("unroll") for (int n = 0; n < 2; ++n) _Pragma("unroll") for (int k = 0; k < 2; ++k) dst[n][k] = *(const PG8_LAS bf16x8*)(lds + PG8_SB(b, h) + boff + n * 2048 + k * 1024); } while (0)
#define PG8_MMA(ai, bj, At, Bt) do { __builtin_amdgcn_s_setprio(1); _Pragma("unroll") for (int m = 0; m < 4; ++m) _Pragma("unroll") for (int n = 0; n < 2; ++n) _Pragma("unroll") for (int k = 0; k < 2; ++k) \
        acc[ai][bj][m][n] = __builtin_amdgcn_mfma_f32_16x16x32_bf16(Bt[n][k], At[m][k], acc[ai][bj][m][n], 0, 0, 0); __builtin_amdgcn_s_setprio(0); } while (0)
#define PG8_WAIT_V(n) asm volatile("s_waitcnt vmcnt(" #n ")" ::: "memory")
#define PG8_WAIT_L(n) asm volatile("s_waitcnt lgkmcnt(" #n ")" ::: "memory")
#define PG8_BAR __builtin_amdgcn_s_barrier()
#define PG8_SCHED __builtin_amdgcn_sched_barrier(0)
    Unit cur, nxt; int ui = 0;
    if (!S.next(0, cur)) return;
    f32x4 acc[2][2][4][2];
#pragma unroll
    for (int a = 0; a < 2; ++a)
#pragma unroll
        for (int b = 0; b < 2; ++b)
#pragma unroll
            for (int m = 0; m < 4; ++m)
#pragma unroll
                for (int n = 0; n < 2; ++n) acc[a][b][m][n] = (f32x4){0.f, 0.f, 0.f, 0.f};
    bf16x8 At[4][2], B0[2][2], B1[2][2];
    const char* cA = GATHER ? (const char*)g.A : (const char*)g.A + (size_t)cur.pm * tstep; const char* cB = (const char*)g.Bt + (size_t)cur.pn * tstep;
    if (GATHER) { PG8_GATH(vAc, cur); }
    S.a_ready(cur);
    PG8_STAGE(PG8_SB(0, 0), cB, voffB); PG8_STAGE(PG8_SB(0, 1), cB + hstep, voffB); PG8_STAGE_A(PG8_SA(0, 0), cA, 0, false); PG8_STAGE_A(PG8_SA(0, 1), cA + hstepA, 1, false);
    if (wr == 1) PG8_BAR;
    PG8_WAIT_V(2); PG8_BAR;
    PG8_STAGE(PG8_SB(1, 0), cB + kstep, voffB); PG8_STAGE_A(PG8_SA(1, 0), cA + kstep, 0, false); PG8_STAGE(PG8_SB(1, 1), cB + hstep + kstep, voffB);
    PG8_WAIT_V(6); PG8_BAR;
    for (;;) {
        const bool has_next = S.next(ui + 1, nxt);
        const char* nA = GATHER ? (const char*)g.A : (has_next ? (const char*)g.A + (size_t)nxt.pm * tstep : cA); const char* nB = has_next ? (const char*)g.Bt + (size_t)nxt.pn * tstep : cB;
        if (GATHER) { if (has_next) { PG8_GATH(vAn, nxt); } else {
#pragma unroll
                for (int _h = 0; _h < 2; ++_h)
#pragma unroll
                    for (int _i = 0; _i < 2; ++_i) vAn[_h][_i] = vAc[_h][_i]; } }
        for (int t = 0; t < nt; t += 2) {
            const bool last = (t == nt - 2);
            const char* a1 = cA + (size_t)(t + 1) * kstep;
            const char* a2 = last ? nA : cA + (size_t)(t + 2) * kstep; const char* b2 = last ? nB : cB + (size_t)(t + 2) * kstep;
            const char* a3 = a2 + kstep; const char* b3 = b2 + kstep;
            if (last && has_next) S.a_ready(nxt);
            PG8_LDB(B0, 0, 0); PG8_LDB(B1, 0, 1); PG8_SCHED; PG8_LDA(At, 0, 0); PG8_STAGE_A(PG8_SA(1, 1), a1 + hstepA, 1, false);
            PG8_WAIT_V(8); PG8_WAIT_L(0); PG8_BAR; PG8_MMA(0, 0, At, B0); PG8_MMA(0, 1, At, B1); PG8_BAR; PG8_SCHED;
            PG8_LDA(At, 0, 1); PG8_STAGE(PG8_SB(0, 0), b2, voffB); PG8_STAGE(PG8_SB(0, 1), b2 + hstep, voffB); PG8_STAGE_A(PG8_SA(0, 0), a2, 0, last);
            PG8_WAIT_V(8); PG8_WAIT_L(0); PG8_BAR; PG8_MMA(1, 0, At, B0); PG8_MMA(1, 1, At, B1); PG8_BAR; PG8_SCHED;
            PG8_LDB(B0, 1, 0); PG8_LDB(B1, 1, 1); PG8_SCHED; PG8_LDA(At, 1, 0); PG8_STAGE_A(PG8_SA(0, 1), a2 + hstepA, 1, last);
            PG8_WAIT_V(8); PG8_WAIT_L(0); PG8_BAR; PG8_MMA(0, 0, At, B0); PG8_MMA(0, 1, At, B1); PG8_BAR; PG8_SCHED;
            PG8_LDA(At, 1, 1); PG8_STAGE(PG8_SB(1, 0), b3, voffB); PG8_STAGE(PG8_SB(1, 1), b3 + hstep, voffB); PG8_STAGE_A(PG8_SA(1, 0), a3, 0, last);
            PG8_WAIT_V(8); PG8_WAIT_L(0); PG8_BAR; PG8_MMA(1, 0, At, B0); PG8_MMA(1, 1, At, B1); PG8_BAR; PG8_SCHED;
        }
        if constexpr (ALIGN_EPI) { if (wr == 0) PG8_BAR; }
        E(acc, cur, wr, wc, fr, fq); S.done(cur);
        if (!has_next) break;
#pragma unroll
        for (int a = 0; a < 2; ++a)
#pragma unroll
            for (int b = 0; b < 2; ++b)
#pragma unroll
                for (int m = 0; m < 4; ++m)
#pragma unroll
                    for (int n = 0; n < 2; ++n) acc[a][b][m][n] = (f32x4){0.f, 0.f, 0.f, 0.f};
        cur = nxt; cA = nA; cB = nB; ++ui;
        if (GATHER) {
#pragma unroll
            for (int _h = 0; _h < 2; ++_h)
#pragma unroll
                for (int _i = 0; _i < 2; ++_i) vAc[_h][_i] = vAn[_h][_i]; }
        if constexpr (ALIGN_EPI) { if (wr == 1) PG8_BAR; }
    }
    PG8_WAIT_V(0);
    if constexpr (!ALIGN_EPI) { if (wr == 0) PG8_BAR; }
    PG8_BAR;
#undef PG8_SA
#undef PG8_SB
#undef PG8_STAGE
#undef PG8_STAGE_A
#undef PG8_GATH
#undef PG8_LDA
#undef PG8_LDB
#undef PG8_MMA
#undef PG8_WAIT_V
#undef PG8_WAIT_L
#undef PG8_BAR
#undef PG8_SCHED
}
}

constexpr int NWAVES = 8;
constexpr int N_LAUNCHES = MK_N_LAUNCHES;
constexpr int NPHASE = 18;
constexpr int BATCH = 4, SEQ = 4096, D = 1024, M = BATCH * SEQ;
constexpr int NH = 16, QL = 384, KVL = 256, NOPE = 64, ROPE = 32, VD = 64, MLA_IN = 672, MLA_INP = 768, QW = NH * 96, KVW = NH * 128;
constexpr int HGH = 8, DK = 128, DV = 128, HG_IN = 4096;
constexpr int FF = 3584, NE = 8, CAP = 16384;
constexpr int MAXSLOT = 2 * M + NE * 256;
constexpr float EPS = 1e-6f;

constexpr size_t MiB = 1u << 20;
constexpr size_t WS_CTL = 0, CTL_ZERO_BYTES = 1 * MiB;
constexpr size_t WS_ROWLIST = 1 * MiB;
constexpr size_t WS_TOK = WS_ROWLIST + 512 * 1024;
constexpr size_t WS_COS = 2 * MiB, WS_SIN = 3 * MiB;
constexpr size_t WS_WMLAIN = 4 * MiB;
constexpr size_t WS_WQUP = 6 * MiB;
constexpr size_t WS_WKVUP = 8 * MiB;
constexpr size_t WS_WO0 = 9 * MiB;
constexpr size_t WS_WFGU = 11 * MiB;
constexpr size_t WS_WFDN = 25 * MiB;
constexpr size_t WS_WHIN = 32 * MiB;
constexpr size_t WS_WHO = 40 * MiB;
constexpr size_t WS_WMGU = 42 * MiB;
constexpr size_t WS_WMDN = 154 * MiB;
constexpr size_t WS_ACTS = 210 * MiB;
constexpr size_t WS_HN = WS_ACTS;
constexpr size_t WS_PROJ = WS_ACTS + 32 * MiB;
constexpr size_t WS_CQN = WS_PROJ + 24 * MiB;
constexpr size_t WS_CKVN = WS_CQN + 12 * MiB;
constexpr size_t WS_KR = WS_CKVN + 8 * MiB;
constexpr size_t WS_Q = WS_KR + 1 * MiB;
constexpr size_t WS_KV = WS_Q + 48 * MiB;
constexpr size_t WS_O = WS_KV + 64 * MiB;
constexpr size_t WS_FACT = WS_ACTS + 32 * MiB;
constexpr size_t WS_HPROJ = WS_ACTS + 32 * MiB;
constexpr size_t WS_HOF = WS_HPROJ + 128 * MiB;
constexpr size_t WS_HON = WS_HOF + 64 * MiB;
constexpr size_t WS_OL = WS_HOF;
constexpr size_t WS_Q1G = WS_HOF + 32 * MiB;
constexpr size_t WS_SS = WS_HN;
constexpr size_t WS_WN = WS_HN + 16 * MiB;
constexpr size_t WS_DSEG = WS_HN + 17 * MiB;
constexpr size_t WS_HN3 = 4 * MiB;
constexpr size_t WS_MACT = WS_ACTS;
constexpr size_t WS_Y = WS_WMGU;
constexpr size_t WS_END = 472 * MiB;
static_assert(WS_O + (size_t)M * 1024 * 2 <= WS_END && WS_HON + (size_t)M * 1024 * 2 <= WS_END && WS_MACT + (size_t)MAXSLOT * FF * 2 <= WS_END, "d_ws map");
static_assert(WS_HN3 + (size_t)M * 1024 * 2 <= WS_WHO, "hn3 overlay");
constexpr int CW_CNT = 64;
constexpr int CW_BAR = 4096;

constexpr int RING_OFF = 0, RING_BYTES = 131072;
constexpr int LDSCTL_OFF = RING_BYTES, MISC_OFF = LDSCTL_OFF + 320;
constexpr int LDS_BYTES = 147456;

#define GAS __attribute__((address_space(1)))
#define LAS __attribute__((address_space(3)))
typedef unsigned short bf16;
typedef unsigned v4u __attribute__((ext_vector_type(4)));
typedef unsigned v2u __attribute__((ext_vector_type(2)));
typedef float f32x4 __attribute__((ext_vector_type(4)));
typedef GAS unsigned gu32;
#define RLX_AGENT __ATOMIC_RELAXED, __HIP_MEMORY_SCOPE_AGENT
#define LDS_WAIT() asm volatile("s_waitcnt lgkmcnt(0)" ::: "memory")
__device__ __forceinline__ unsigned f2bf(float f) { unsigned u = __builtin_bit_cast(unsigned, f); return (u + 0x7fffu + ((u >> 16) & 1u)) >> 16; }
__device__ __forceinline__ unsigned pk2(float lo, float hi) { return f2bf(lo) | (f2bf(hi) << 16); }
__device__ __forceinline__ float bf2f(unsigned short b) { return __builtin_bit_cast(float, (unsigned)b << 16); }

#define XB_TMO      128
#define XB_XCNT(j)  (256  + 64 * (j))
#define XB_XSUB(j)  (1280 + 64 * (j))
#define XB_XGEN(j)  (2304 + 64 * (j))
#define XB_TOP      3328
#define XB_TOPGEN   3392
#define XCD_BAR_WORDS 3456
#define XB_SPIN_CAP (1u << 24)
__device__ __forceinline__ unsigned xb_ld(unsigned* p)              { return __hip_atomic_load(p, __ATOMIC_RELAXED, __HIP_MEMORY_SCOPE_AGENT); }
__device__ __forceinline__ unsigned xb_add(unsigned* p, unsigned v) { return __hip_atomic_fetch_add(p, v, __ATOMIC_RELAXED, __HIP_MEMORY_SCOPE_AGENT); }
__device__ __forceinline__ unsigned xb_xcc_id() { return (unsigned)__builtin_amdgcn_s_getreg((3 << 11) | 20) & 0xFu; }
#define XB_SPIN(cond, bar) do { unsigned _sp = 0; while (cond) { __builtin_amdgcn_s_sleep(1); \
    if ((++_sp & 255u) == 0u) { if (xb_ld(&(bar)[XB_TMO])) break; if (_sp > XB_SPIN_CAP) { atomicAdd(&(bar)[XB_TMO], 1u); break; } } } } while (0)
struct XcdBarrier { unsigned* bar; unsigned x; volatile LAS unsigned* st; };
__device__ __forceinline__ XcdBarrier xcd_barrier_post(unsigned* bar, volatile LAS unsigned* st) {
    XcdBarrier b; b.bar = bar; b.x = xb_xcc_id(); b.st = st;
    if (threadIdx.x == 0) (void)xb_add(&bar[XB_XCNT(b.x)], 1u);
    return b;
}
__device__ __forceinline__ void xcd_barrier_complete(unsigned* bar, unsigned x, unsigned& nloc, unsigned& nx) {
    const unsigned G = gridDim.x * gridDim.y * gridDim.z;
    unsigned sum, cnt, mine, sp = 0u;
    for (;;) {
        sum = 0u; cnt = 0u; mine = 0u;
#pragma unroll
        for (unsigned j = 0; j < 16; ++j) { const unsigned c = xb_ld(&bar[XB_XCNT(j)]); sum += c; cnt += (c > 0u) ? 1u : 0u; mine = (j == x) ? c : mine; }
        if (sum == G) break;
        __builtin_amdgcn_s_sleep(1);
        if ((++sp & 255u) == 0u) { if (xb_ld(&bar[XB_TMO])) break; if (sp > XB_SPIN_CAP) { atomicAdd(&bar[XB_TMO], 1u); break; } }
    }
    nloc = mine > 0u ? mine : 1u; nx = cnt > 0u ? cnt : 1u;
}
__device__ __forceinline__ void xcd_barrier(const XcdBarrier& b) {
    asm volatile("s_waitcnt vmcnt(0)" ::: "memory");
    __syncthreads();
    if (threadIdx.x == 0) {
        unsigned* bar = b.bar;
        __builtin_amdgcn_s_waitcnt(0);
        unsigned nloc = b.st[0], nx = b.st[1];
        if (nloc == 0u) { xcd_barrier_complete(bar, b.x, nloc, nx); b.st[0] = nloc; b.st[1] = nx; }
        const unsigned old = xb_add(&bar[XB_XSUB(b.x)], 1u);
        const unsigned gen = old / nloc;
        if (old + 1u == (gen + 1u) * nloc) {
            __builtin_amdgcn_fence(__ATOMIC_RELEASE, "agent");
            asm volatile("s_waitcnt vmcnt(0)" ::: "memory");
            const unsigned og = xb_add(&bar[XB_TOP], 1u);
            const unsigned tg = og / nx;
            if (og + 1u == (tg + 1u) * nx) xb_add(&bar[XB_TOPGEN], 1u);
            else XB_SPIN(xb_ld(&bar[XB_TOPGEN]) == tg, bar);
            __builtin_amdgcn_fence(__ATOMIC_ACQUIRE, "agent");
            xb_add(&bar[XB_XGEN(b.x)], 1u);
            asm volatile("s_waitcnt vmcnt(0)" ::: "memory");
        } else {
            XB_SPIN(xb_ld(&bar[XB_XGEN(b.x)]) == gen, bar);
            __builtin_amdgcn_fence(__ATOMIC_ACQUIRE, "agent");
            asm volatile("s_waitcnt vmcnt(0)" ::: "memory");
        }
    }
    __syncthreads();
}

__device__ __forceinline__ float wave_sum(float v) {
#pragma unroll
    for (int o = 1; o < 64; o <<= 1) v += __shfl_xor(v, o);
    return v;
}
__device__ __forceinline__ int dst_row(int n, int mode) { return mode == 0 ? n : (((n >> 7) << 8) + (n & 127) + (mode == 2 ? 128 : 0)); }
__device__ __forceinline__ void tr_item(const float* W, int K, int N, bf16* WT, int mode, LAS float* scr, int item, int lane) {
    const int nblk = N / 32, kb = item / nblk, nb = item % nblk, k0 = 64 * kb, n0 = 32 * nb;
#pragma unroll 8
    for (int i = 0; i < 32; ++i) { const int kk = 2 * i + (lane >> 5); scr[kk * 33 + (lane & 31)] = W[(size_t)(k0 + kk) * N + n0 + (lane & 31)]; }
    LDS_WAIT(); asm volatile("" ::: "memory");
    const int c = lane & 7;
#pragma unroll
    for (int j = 0; j < 4; ++j) { const int n = (lane >> 3) + 8 * j; const LAS float* s = scr + (8 * c) * 33 + n;
        v4u o; o.x = pk2(s[0 * 33], s[1 * 33]); o.y = pk2(s[2 * 33], s[3 * 33]); o.z = pk2(s[4 * 33], s[5 * 33]); o.w = pk2(s[6 * 33], s[7 * 33]);
        *(v4u*)(WT + (size_t)dst_row(n0 + n, mode) * K + k0 + 8 * c) = o; }
    LDS_WAIT(); asm volatile("" ::: "memory");
}
__device__ __forceinline__ void rms_row_to_bf16(const float* xrow, const float* gain, bf16* orow, int lane) {
    const f32x4* xr = (const f32x4*)xrow + lane; const f32x4* gr = (const f32x4*)gain + lane;
    f32x4 v[4]; float s = 0.f;
#pragma unroll
    for (int j = 0; j < 4; ++j) { v[j] = xr[64 * j]; s += (v[j].x * v[j].x + v[j].y * v[j].y) + (v[j].z * v[j].z + v[j].w * v[j].w); }
    const float rstd = 1.f / sqrtf(wave_sum(s) * (1.f / 1024.f) + EPS);
    unsigned long long* o8 = (unsigned long long*)orow + lane;
#pragma unroll
    for (int j = 0; j < 4; ++j) { const f32x4 g = gr[64 * j];
        o8[64 * j] = (unsigned long long)pk2(v[j].x * rstd * g.x, v[j].y * rstd * g.y) | ((unsigned long long)pk2(v[j].z * rstd * g.z, v[j].w * rstd * g.w) << 32); }
}
__device__ __forceinline__ float sigmoid_f(float x) { return 1.0f / (1.0f + __expf(-x)); }

struct MoeOrder {
    pg8::StaticOrder so; int nN; volatile LAS int* mt; const int* rowlist;
    __device__ __forceinline__ void init(volatile LAS int* mt_, int nN_, int G, int c, const int* rl) { mt = mt_; nN = nN_; rowlist = rl; so.init(mt_[8] * 256, nN_ * 256, G, c); }
    __device__ __forceinline__ bool next(int i, pg8::Unit& u) const {
        if (!so.next(i, u)) return false;
        int e = 0;
#pragma unroll
        for (int j = 1; j < 8; ++j) e += (u.pm >= mt[j]) ? 1 : 0;
        u.pn = e * nN + u.pn; return true;
    }
    __device__ __forceinline__ void a_ready(const pg8::Unit&) const {}
    __device__ __forceinline__ void done(const pg8::Unit&) const {}
    __device__ __forceinline__ int arow(const pg8::Unit& u, int r) const { const int e = u.pn / nN; const int lr = (u.pm - mt[e]) * 256 + r; return lr < mt[9 + e] ? rowlist[e * CAP + lr] : 0; }
};


namespace mla_attn {
using bf16x8=__attribute__((ext_vector_type(8)))short;
using s16x4=__attribute__((ext_vector_type(4)))short;
using f32x16=__attribute__((ext_vector_type(16)))float;
using u32x4=__attribute__((ext_vector_type(4)))unsigned;
typedef __attribute__((address_space(3))) const char* lds_cptr;
constexpr int NW=8,QBLK=32,QB=256,KVBLK=64;
constexpr int KSLOT=12288,VSLOT=8192,NSLOT=3;
constexpr int LDS_K=0,LDS_V=NSLOT*KSLOT,LDS_WS=LDS_V+NSLOT*VSLOT,LDS_OST=LDS_WS+NW*64*4,LDS_BYTES_A=LDS_OST+NW*4096;
__device__ __forceinline__ int crow(int r,int hi){return (r&3)+8*(r>>2)+4*hi;}
__device__ __forceinline__ void glds16(const void*gsrc,unsigned lds_dst){unsigned keep;
  asm volatile("s_mov_b32 %0, m0\n\ts_mov_b32 m0, %2\n\ts_nop 0\n\tglobal_load_lds_dwordx4 %1, off\n\ts_mov_b32 m0, %0":"=&s"(keep):"v"(gsrc),"s"(lds_dst):"memory");}
typedef float f32x2_t __attribute__((ext_vector_type(2))); typedef __bf16 bf16x2_t __attribute__((ext_vector_type(2)));
__device__ __forceinline__ unsigned cvtpk_s(float lo,float hi){f32x2_t v={lo,hi};bf16x2_t b=__builtin_convertvector(v,bf16x2_t);return __builtin_bit_cast(unsigned,b);}
#define MLA_WAIT_BAR(N) asm volatile("s_waitcnt vmcnt(" #N ") lgkmcnt(0)\n\ts_barrier":::"memory")
__device__ __forceinline__ void cmask(f32x16&p0,f32x16&p1,int jb,int qrel,int hi){
  const float NEG=-INFINITY; int kb=64*jb+4*hi;
  #pragma unroll
  for(int r=0;r<16;++r){int kv=kb+(r&3)+8*(r>>2); if(kv>qrel)p0[r]=NEG; if(kv+32>qrel)p1[r]=NEG;}
}
__device__ __forceinline__ void qkt6(f32x16&p0,f32x16&p1,lds_cptr kslot,const bf16x8*qr,const f32x16&negm,int r32,int hi){
  lds_cptr kb=kslot+hi*1024+r32*16;
  #pragma unroll
  for(int d0=0;d0<6;++d0){
    const bf16x8 b0=*(const __attribute__((address_space(3))) bf16x8*)(kb+d0*2048);
    const bf16x8 b1=*(const __attribute__((address_space(3))) bf16x8*)(kb+d0*2048+512);
    if(d0==0){p0=__builtin_amdgcn_mfma_f32_32x32x16_bf16(b0,qr[0],negm,0,0,0);p1=__builtin_amdgcn_mfma_f32_32x32x16_bf16(b1,qr[0],negm,0,0,0);}
    else{p0=__builtin_amdgcn_mfma_f32_32x32x16_bf16(b0,qr[d0],p0,0,0,0);p1=__builtin_amdgcn_mfma_f32_32x32x16_bf16(b1,qr[d0],p1,0,0,0);}}
}
__device__ __forceinline__ float rowmax(const f32x16&p0,const f32x16&p1){
  float a=__builtin_fmaxf(__builtin_fmaxf(p0[0],p0[1]),p1[0]),b=__builtin_fmaxf(__builtin_fmaxf(p0[2],p0[3]),p1[1]);a=__builtin_fmaxf(__builtin_fmaxf(a,p1[2]),p1[3]);
  #pragma unroll
  for(int r=4;r<16;r+=4){a=__builtin_fmaxf(__builtin_fmaxf(a,p0[r]),p0[r+1]);b=__builtin_fmaxf(__builtin_fmaxf(b,p0[r+2]),p0[r+3]);a=__builtin_fmaxf(__builtin_fmaxf(a,p1[r]),p1[r+1]);b=__builtin_fmaxf(__builtin_fmaxf(b,p1[r+2]),p1[r+3]);}
  const float m=__builtin_fmaxf(a,b);
  auto rr=__builtin_amdgcn_permlane32_swap(__float_as_uint(m),__float_as_uint(m),false,false);
  return __builtin_fmaxf(__uint_as_float(rr[0]),__uint_as_float(rr[1]));
}
__device__ __forceinline__ void pv(f32x16*o,int vb,bf16x8 pa0,bf16x8 pa1,bf16x8 pa2,bf16x8 pa3){
  #pragma unroll
  for(int d0=0;d0<2;++d0){s16x4 lo[4],hi[4];
    #pragma unroll
    for(int ks=0;ks<4;++ks){
      asm volatile("ds_read_b64_tr_b16 %0,%1 offset:%c2":"=&v"(lo[ks]):"v"(vb),"i"(d0*4096+ks*1024):"memory");
      asm volatile("ds_read_b64_tr_b16 %0,%1 offset:%c2":"=&v"(hi[ks]):"v"(vb),"i"(d0*4096+ks*1024+512):"memory");}
    asm volatile("s_waitcnt lgkmcnt(0)":::"memory");__builtin_amdgcn_sched_barrier(0);
    #define PK(k) (bf16x8){lo[k][0],lo[k][1],lo[k][2],lo[k][3],hi[k][0],hi[k][1],hi[k][2],hi[k][3]}
    o[d0]=__builtin_amdgcn_mfma_f32_32x32x16_bf16(pa0,PK(0),o[d0],0,0,0);
    o[d0]=__builtin_amdgcn_mfma_f32_32x32x16_bf16(pa1,PK(1),o[d0],0,0,0);
    o[d0]=__builtin_amdgcn_mfma_f32_32x32x16_bf16(pa2,PK(2),o[d0],0,0,0);
    o[d0]=__builtin_amdgcn_mfma_f32_32x32x16_bf16(pa3,PK(3),o[d0],0,0,0);
    #undef PK
  }
}
constexpr int QPITCH=1536,KVPITCH=2048,KRPITCH=32,OPITCH=1024,SEQ_=4096;
template<int THRL> __device__ __forceinline__ void attn_unit(int b,int h,int qb,const unsigned short*Q,const unsigned short*KV,const unsigned short*KR,const float*COS,const float*SIN,unsigned short*O,char*shm){
  const int tid=threadIdx.x,lane=tid&63,r32=lane&31,hi=lane>>5; const int wid=__builtin_amdgcn_readfirstlane(tid>>6);
  const long rowbase=(long)b*SEQ_; const int q0=qb*QB;
  const unsigned short*Qw=Q+(rowbase+q0+wid*QBLK)*QPITCH+h*96;
  const unsigned short*Kh=KV+rowbase*KVPITCH+h*128,*Vh=Kh+64,*KRb=KR+rowbase*KRPITCH;
  const unsigned lds0=(unsigned)(uintptr_t)shm;
  float*wsf=(float*)(shm+LDS_WS)+wid*64;
  const unsigned short*ksrc0=Kh+(long)lane*KVPITCH+wid*8;
  const unsigned short*ksrc1=KRb+(long)lane*KRPITCH+(wid&3)*8;
  const unsigned short*vsrc=Vh+(long)(16*(wid&3)+(lane>>2))*KVPITCH+(wid>>2)*32+(lane&3)*8;
  const unsigned kdst0=lds0+LDS_K+wid*1024,kdst1=lds0+LDS_K+(8+(wid&3))*1024,vdst=lds0+LDS_V+wid*1024;
  #define DMA_T(t,sl) do{ glds16(ksrc0+(long)(t)*KVBLK*KVPITCH,(unsigned)__builtin_amdgcn_readfirstlane(kdst0+(sl)*KSLOT)); \
                          glds16(ksrc1+(long)(t)*KVBLK*KRPITCH,(unsigned)__builtin_amdgcn_readfirstlane(kdst1+(sl)*KSLOT)); \
                          glds16(vsrc+(long)(t)*KVBLK*KVPITCH,(unsigned)__builtin_amdgcn_readfirstlane(vdst+(sl)*VSLOT)); }while(0)
  const int vb0=(int)(lds0+LDS_V)+((lane>>4)&1)*32+(lane&3)*8+(4*hi+((lane&15)>>2))*64;
  const lds_cptr shm3=(lds_cptr)(__attribute__((address_space(3))) char*)shm;
  const int NT=(q0+QB)/KVBLK;
  bf16x8 qr[6];
  #pragma unroll
  for(int d0=0;d0<6;++d0)qr[d0]=*reinterpret_cast<const bf16x8*>(&Qw[(long)r32*QPITCH+d0*16+hi*8]);
  {
    const float*cp=COS+(rowbase+q0+wid*QBLK+r32)*16+hi*8,*sp=SIN+(rowbase+q0+wid*QBLK+r32)*16+hi*8;
    float cs[8],sn[8];
    #pragma unroll
    for(int j=0;j<8;++j){cs[j]=cp[j];sn[j]=sp[j];}
    const float sc=0.10206207261596577f*1.4426950408889634f;
    float x1[8],x2[8];
    #pragma unroll
    for(int j=0;j<8;++j){x1[j]=__uint_as_float(((unsigned)(unsigned short)qr[4][j])<<16);x2[j]=__uint_as_float(((unsigned)(unsigned short)qr[5][j])<<16);}
    #pragma unroll
    for(int j=0;j<8;j+=2){
      const unsigned a=cvtpk_s((x1[j]*cs[j]-x2[j]*sn[j])*sc,(x1[j+1]*cs[j+1]-x2[j+1]*sn[j+1])*sc), c=cvtpk_s((x2[j]*cs[j]+x1[j]*sn[j])*sc,(x2[j+1]*cs[j+1]+x1[j+1]*sn[j+1])*sc);
      qr[4][j]=(short)(a&0xffffu);qr[4][j+1]=(short)(a>>16);qr[5][j]=(short)(c&0xffffu);qr[5][j+1]=(short)(c>>16);}
    #pragma unroll
    for(int d0=0;d0<4;++d0)
      #pragma unroll
      for(int j=0;j<8;j+=2){const unsigned a=cvtpk_s(__uint_as_float(((unsigned)(unsigned short)qr[d0][j])<<16)*sc,__uint_as_float(((unsigned)(unsigned short)qr[d0][j+1])<<16)*sc);
        qr[d0][j]=(short)(a&0xffffu);qr[d0][j+1]=(short)(a>>16);}
  }
  asm volatile("s_waitcnt vmcnt(0)":::"memory");
  DMA_T(0,0); DMA_T(1,1);
  float mhat=0.f,l_reg=0.f;f32x16 o[2];o[0]=f32x16{};o[1]=f32x16{};f32x16 negm=f32x16{};
  const int qrel=wid*QBLK+r32;
  int sl=0;
  for(int t=0;t<NT;++t){
    if(t+1<NT){MLA_WAIT_BAR(3);}else{MLA_WAIT_BAR(0);}
    if(t+2<NT){const int s2=(sl==0)?2:sl-1; DMA_T(t+2,s2);}
    f32x16 p0,p1;
    qkt6(p0,p1,shm3+LDS_K+sl*KSLOT,qr,negm,r32,hi);
    if(t>=NT-4)cmask(p0,p1,t-(NT-4),qrel,hi);
    const float rm=rowmax(p0,p1);
    bool resc=false;
    if(t==0){ const float dl=rm; mhat+=dl;
      #pragma unroll
      for(int r=0;r<16;++r){p0[r]-=dl;p1[r]-=dl;}
      #pragma unroll
      for(int r=0;r<16;++r)negm[r]=-mhat;
    } else if(__any(rm>(float)THRL)){ const float dl=__builtin_fmaxf(rm,0.f); mhat+=dl;
      #pragma unroll
      for(int r=0;r<16;++r){p0[r]-=dl;p1[r]-=dl;}
      #pragma unroll
      for(int r=0;r<16;++r)negm[r]=-mhat;
      const float f=__builtin_amdgcn_exp2f(-dl); l_reg*=f; if(hi==0)wsf[r32]=f; resc=true; }
    float sacc=0.f;
    #pragma unroll
    for(int r=0;r<16;++r){p0[r]=__builtin_amdgcn_exp2f(p0[r]);p1[r]=__builtin_amdgcn_exp2f(p1[r]);sacc+=p0[r]+p1[r];}
    l_reg+=sacc;
    if(resc){ asm volatile("s_waitcnt lgkmcnt(0)":::"memory");
      #pragma unroll
      for(int d_=0;d_<2;++d_)
        #pragma unroll
        for(int r=0;r<16;++r)o[d_][r]*=wsf[crow(r,hi)]; }
    u32x4 pw0,pw1,pw2,pw3;
    pw0=(u32x4){cvtpk_s(p0[0],p0[1]),cvtpk_s(p0[2],p0[3]),cvtpk_s(p0[4],p0[5]),cvtpk_s(p0[6],p0[7])};
    pw1=(u32x4){cvtpk_s(p0[8],p0[9]),cvtpk_s(p0[10],p0[11]),cvtpk_s(p0[12],p0[13]),cvtpk_s(p0[14],p0[15])};
    pw2=(u32x4){cvtpk_s(p1[0],p1[1]),cvtpk_s(p1[2],p1[3]),cvtpk_s(p1[4],p1[5]),cvtpk_s(p1[6],p1[7])};
    pw3=(u32x4){cvtpk_s(p1[8],p1[9]),cvtpk_s(p1[10],p1[11]),cvtpk_s(p1[12],p1[13]),cvtpk_s(p1[14],p1[15])};
    pv(o,vb0+sl*VSLOT,__builtin_bit_cast(bf16x8,pw0),__builtin_bit_cast(bf16x8,pw1),__builtin_bit_cast(bf16x8,pw2),__builtin_bit_cast(bf16x8,pw3));
    sl=(sl==2)?0:sl+1;
  }
  {auto rr=__builtin_amdgcn_permlane32_swap(__float_as_uint(l_reg),__float_as_uint(l_reg),false,false);l_reg=__uint_as_float(rr[0])+__uint_as_float(rr[1]);}
  if(hi==0)wsf[32+r32]=l_reg;asm volatile("s_waitcnt lgkmcnt(0)":::"memory");
  float rli[16];
  #pragma unroll
  for(int r=0;r<16;++r)rli[r]=__builtin_amdgcn_rcpf(wsf[32+crow(r,hi)]);
  unsigned short*Ow=O+(rowbase+q0+wid*QBLK)*OPITCH+h*64;
  { unsigned short*stg=(unsigned short*)(shm+LDS_OST)+wid*2048;
    #pragma unroll
    for(int r=0;r<16;++r){const int orow=crow(r,hi);
      #pragma unroll
      for(int d0=0;d0<2;++d0)stg[orow*64+d0*32+r32]=(unsigned short)(cvtpk_s(o[d0][r]*rli[r],0.f)&0xffffu);}
    asm volatile("s_waitcnt lgkmcnt(0)":::"memory");
    #pragma unroll
    for(int i=0;i<4;++i){const int row=i*8+(lane>>3),ch=lane&7; const u32x4 v=*(const u32x4*)(stg+row*64+ch*8); *(u32x4*)(Ow+(long)row*OPITCH+ch*8)=v;} }
  asm volatile("s_waitcnt vmcnt(0) lgkmcnt(0)\n\ts_barrier":::"memory");
  #undef DMA_T
}
}


namespace hg {
typedef float f32x4 __attribute__((ext_vector_type(4)));
typedef short bf16x8 __attribute__((ext_vector_type(8)));
typedef unsigned u32x4 __attribute__((ext_vector_type(4)));
typedef unsigned u32x2 __attribute__((ext_vector_type(2)));
#define HLAS __attribute__((address_space(3)))
constexpr int NSEG = 8, CPS = 64 / NSEG;
constexpr int L_Q = 0, L_F = 16384, L_V = 32768, L_K1T = 49152, L_VT = 67584, L_A = 86016, L_ST = 95232, L_TOT = L_A, L_END = 130048;
constexpr int L_CM = 132096, L_CL = 132608;
constexpr int P144 = 144, P272 = 272;
__device__ __forceinline__ float bf2f_(unsigned short b) { return __uint_as_float((unsigned)b << 16); }
__device__ __forceinline__ unsigned f2bf_(float f) { unsigned u = __float_as_uint(f); return (u + 0x7fffu + ((u >> 16) & 1u)) >> 16; }
__device__ __forceinline__ unsigned pk_(float lo, float hi) { return f2bf_(lo) | (f2bf_(hi) << 16); }
__device__ __forceinline__ int swz(int t, int c) { return t * 256 + ((c ^ (t & 15)) << 4); }
__device__ __forceinline__ int swz_e(int t, int k) { return swz(t, k >> 3) + (k & 7) * 2; }
#define HG_BAR() do { asm volatile("s_waitcnt lgkmcnt(0)" ::: "memory"); __builtin_amdgcn_s_barrier(); asm volatile("" ::: "memory"); } while (0)
#define HG_MFMA(a, b, c) __builtin_amdgcn_mfma_f32_16x16x32_bf16((a), (b), (c), 0, 0, 0)

struct P1Args { const unsigned short* HP; const float* lbp; unsigned short* OL; unsigned short* Q1G; float* WN; float* SS; float* DSEG; };
__device__ __forceinline__ void hg_pass1(HLAS unsigned char* L, const P1Args& a, int G) {
    const int tid = threadIdx.x, lane = tid & 63, w = __builtin_amdgcn_readfirstlane(tid >> 6), r16 = lane & 15, g4 = lane >> 4;
    const int k = tid & 127, tq = tid >> 7;
    for (int u = blockIdx.x; u < 32 * NSEG; u += G) {
        const int bh = u / NSEG, seg = u % NSEG, b = bh >> 3, h = bh & 7;
        const size_t rowseg = (size_t)b * 4096 + (size_t)seg * CPS * 64;
        const float lb = 1.0f / (1.0f + __expf(-(a.lbp[1024 + h * 128 + k] - a.lbp[h * 128 + k])));
        f32x4 S[8];
#pragma unroll
        for (int j = 0; j < 8; ++j) S[j] = (f32x4){0.f, 0.f, 0.f, 0.f};
        float carry = 0.f;
        u32x4 pq[2], pf[2], pv[2];
#define HG_PREFETCH(n_) do { _Pragma("unroll") for (int j = 0; j < 2; ++j) { const int e = tid + 512 * j, t = e >> 4, c = e & 15; \
            const unsigned short* src = a.HP + (rowseg + (size_t)(n_) * 64 + t) * 4096 + h * 128 + 8 * c; \
            pq[j] = *(const u32x4*)src; pf[j] = *(const u32x4*)(src + 1024); pv[j] = *(const u32x4*)(src + 2048); } } while (0)
        HG_PREFETCH(0);
        for (int n = 0; n < CPS; ++n) {
            const size_t row0 = rowseg + (size_t)n * 64;
            HG_BAR();
#pragma unroll
            for (int j = 0; j < 2; ++j) { const int e = tid + 512 * j, t = e >> 4, c = e & 15; const int o = swz(t, c);
                *(HLAS u32x4*)(L + L_Q + o) = pq[j]; *(HLAS u32x4*)(L + L_F + o) = pf[j]; *(HLAS u32x4*)(L + L_V + o) = pv[j]; }
            if (n + 1 < CPS) HG_PREFETCH(n + 1);
            HG_BAR();
            float fv[16], cs[16];
            { float run = 0.f;
#pragma unroll
              for (int i = 0; i < 16; ++i) { const int t = 16 * tq + i; const float x = bf2f_(*(const HLAS unsigned short*)(L + L_F + swz_e(t, k)));
                  const float f = lb + (1.0f - lb) * __builtin_amdgcn_rcpf(1.0f + __expf(-x)); fv[i] = f; run += __logf(f); cs[i] = run; }
              *(HLAS float*)(L + L_TOT + (tq * 128 + k) * 4) = run; }
            HG_BAR();
            { const float t0 = *(const HLAS float*)(L + L_TOT + (0 * 128 + k) * 4), t1 = *(const HLAS float*)(L + L_TOT + (1 * 128 + k) * 4), t2 = *(const HLAS float*)(L + L_TOT + (2 * 128 + k) * 4), t3 = *(const HLAS float*)(L + L_TOT + (3 * 128 + k) * 4);
              const float pre = (tq == 0) ? 0.f : (tq == 1) ? t0 : (tq == 2) ? (t0 + t1) : ((t0 + t1) + t2);
              const float bmid = t0 + t1, blast = (t0 + t1) + (t2 + t3);
              unsigned kt[8], vt[8];
#pragma unroll
              for (int i = 0; i < 16; i += 2) {
                  float q1[2], k1[2];
#pragma unroll
                  for (int d = 0; d < 2; ++d) { const int t = 16 * tq + i + d; const float r = (pre + cs[i + d]) - bmid; const float E1 = __expf(r), iE1 = __builtin_amdgcn_rcpf(E1);
                      const float qs = bf2f_(*(const HLAS unsigned short*)(L + L_Q + swz_e(t, k))) * 0.08838834764831845f;
                      q1[d] = qs * E1; k1[d] = (1.0f - fv[i + d]) * iE1;
                      *(HLAS unsigned short*)(L + L_Q + swz_e(t, k)) = (unsigned short)f2bf_(q1[d]); *(HLAS unsigned short*)(L + L_F + swz_e(t, k)) = (unsigned short)f2bf_(k1[d]); }
                  kt[i >> 1] = pk_(k1[0], k1[1]);
                  vt[i >> 1] = (unsigned)*(const HLAS unsigned short*)(L + L_V + swz_e(16 * tq + i, k)) | ((unsigned)*(const HLAS unsigned short*)(L + L_V + swz_e(16 * tq + i + 1, k)) << 16); }
              *(HLAS u32x4*)(L + L_K1T + k * P144 + tq * 32) = (u32x4){kt[0], kt[1], kt[2], kt[3]}; *(HLAS u32x4*)(L + L_K1T + k * P144 + tq * 32 + 16) = (u32x4){kt[4], kt[5], kt[6], kt[7]};
              *(HLAS u32x4*)(L + L_VT + k * P144 + tq * 32) = (u32x4){vt[0], vt[1], vt[2], vt[3]}; *(HLAS u32x4*)(L + L_VT + k * P144 + tq * 32 + 16) = (u32x4){vt[4], vt[5], vt[6], vt[7]};
              if (tq == 0) { *(HLAS float*)(L + L_CM + k * 4) = __expf(bmid); *(HLAS float*)(L + L_CL + k * 4) = __expf(blast - bmid);
                  a.WN[((size_t)u * CPS + n) * 128 + k] = __expf(bmid + carry); }
              carry += blast; }
            HG_BAR();
            f32x4 cmv, clv;
#pragma unroll
            for (int i = 0; i < 4; ++i) { cmv[i] = *(const HLAS float*)(L + L_CM + (16 * w + 4 * g4 + i) * 4); clv[i] = *(const HLAS float*)(L + L_CL + (16 * w + 4 * g4 + i) * 4); }
#pragma unroll
            for (int j = 0; j < 8; ++j) { S[j] = S[j] * cmv; *(HLAS u32x2*)(L + L_ST + (16 * j + r16) * P272 + (16 * w + 4 * g4) * 2) = (u32x2){pk_(S[j][0], S[j][1]), pk_(S[j][2], S[j][3])}; }
            { const int ct = w >> 1;
#pragma unroll
              for (int q = 0; q < 2; ++q) { const int st = 2 * (w & 1) + q; f32x4 d = (f32x4){0.f, 0.f, 0.f, 0.f};
                  if (st <= ct) {
#pragma unroll
                      for (int ks = 0; ks < 4; ++ks) { const bf16x8 af = *(const HLAS bf16x8*)(L + L_F + swz(16 * st + r16, 4 * ks + g4)), bf = *(const HLAS bf16x8*)(L + L_Q + swz(16 * ct + r16, 4 * ks + g4)); d = HG_MFMA(af, bf, d); }
                      if (st == ct) {
#pragma unroll
                          for (int i = 0; i < 4; ++i) if (4 * g4 + i > r16) d[i] = 0.f; } }
                  *(HLAS u32x2*)(L + L_A + (16 * ct + r16) * P144 + (16 * st + 4 * g4) * 2) = (u32x2){pk_(d[0], d[1]), pk_(d[2], d[3])}; } }
#pragma unroll
            for (int j = 0; j < 2; ++j) { const int e = tid + 512 * j, t = e >> 4, c = e & 15; *(u32x4*)(a.Q1G + (row0 + t) * 1024 + h * 128 + 8 * c) = *(const HLAS u32x4*)(L + L_Q + swz(t, c)); }
            HG_BAR();
#pragma unroll
            for (int ct = 0; ct < 4; ++ct) { f32x4 d = (f32x4){0.f, 0.f, 0.f, 0.f};
#pragma unroll
                for (int ks = 0; ks < 2; ++ks) { if (ks == 1 && ct < 2) continue;
                    const bf16x8 af = *(const HLAS bf16x8*)(L + L_VT + (16 * w + r16) * P144 + (32 * ks + 8 * g4) * 2), bf = *(const HLAS bf16x8*)(L + L_A + (16 * ct + r16) * P144 + (32 * ks + 8 * g4) * 2); d = HG_MFMA(af, bf, d); }
#pragma unroll
                for (int ks = 0; ks < 4; ++ks) { const bf16x8 af = *(const HLAS bf16x8*)(L + L_ST + (16 * w + r16) * P272 + (32 * ks + 8 * g4) * 2), bf = *(const HLAS bf16x8*)(L + L_Q + swz(16 * ct + r16, 4 * ks + g4)); d = HG_MFMA(af, bf, d); }
                *(u32x2*)(a.OL + (row0 + 16 * ct + r16) * 1024 + h * 128 + 16 * w + 4 * g4) = (u32x2){pk_(d[0], d[1]), pk_(d[2], d[3])}; }
#pragma unroll
            for (int j = 0; j < 8; ++j) {
#pragma unroll
                for (int ks = 0; ks < 2; ++ks) { const bf16x8 af = *(const HLAS bf16x8*)(L + L_K1T + (16 * w + r16) * P144 + (32 * ks + 8 * g4) * 2), bf = *(const HLAS bf16x8*)(L + L_VT + (16 * j + r16) * P144 + (32 * ks + 8 * g4) * 2); S[j] = HG_MFMA(af, bf, S[j]); }
                S[j] = S[j] * clv; }
        }
#pragma unroll
        for (int j = 0; j < 8; ++j) *(f32x4*)(a.SS + ((size_t)u * 128 + 16 * j + r16) * 128 + 16 * w + 4 * g4) = S[j];
        if (tq == 0) a.DSEG[(size_t)u * 128 + k] = __expf(carry);
#undef HG_PREFETCH
    }
    HG_BAR();
}

struct P2Args { const unsigned short* HP; const unsigned short* OL; const unsigned short* Q1G; const float* WN; const float* SS; const float* DSEG; const float* gout; unsigned short* HON; };
__device__ __forceinline__ void hg_pass2(HLAS unsigned char* L, const P2Args& a, int G) {
    const int tid = threadIdx.x, lane = tid & 63, w = __builtin_amdgcn_readfirstlane(tid >> 6), r16 = lane & 15, g4 = lane >> 4;
    HLAS float* SSQ = (HLAS float*)(L + L_TOT);
    f32x4 gn;
#pragma unroll
    for (int i = 0; i < 4; ++i) gn[i] = a.gout[16 * w + 4 * g4 + i];
    for (int u = blockIdx.x; u < 32 * NSEG; u += G) {
        const int bh = u / NSEG, seg = u % NSEG, b = bh >> 3, h = bh & 7;
        const size_t rowseg = (size_t)b * 4096 + (size_t)seg * CPS * 64;
        f32x4 Sin[8];
#pragma unroll
        for (int j = 0; j < 8; ++j) Sin[j] = (f32x4){0.f, 0.f, 0.f, 0.f};
        for (int i = 0; i < seg; ++i) { const size_t ui = (size_t)bh * NSEG + i; const f32x4 dv = *(const f32x4*)(a.DSEG + ui * 128 + 16 * w + 4 * g4);
#pragma unroll
            for (int j = 0; j < 8; ++j) Sin[j] = Sin[j] * dv + *(const f32x4*)(a.SS + (ui * 128 + 16 * j + r16) * 128 + 16 * w + 4 * g4); }
        for (int n = 0; n < CPS; ++n) {
            const size_t row0 = rowseg + (size_t)n * 64;
            HG_BAR();
            if (seg > 0) { const f32x4 wn = *(const f32x4*)(a.WN + ((size_t)u * CPS + n) * 128 + 16 * w + 4 * g4);
#pragma unroll
                for (int j = 0; j < 8; ++j) { const f32x4 t = Sin[j] * wn; *(HLAS u32x2*)(L + L_ST + (16 * j + r16) * P272 + (16 * w + 4 * g4) * 2) = (u32x2){pk_(t[0], t[1]), pk_(t[2], t[3])}; } }
            HG_BAR();
            f32x4 o[4];
#pragma unroll
            for (int ct = 0; ct < 4; ++ct) { const size_t row = row0 + 16 * ct + r16; const u32x2 ol = *(const u32x2*)(a.OL + row * 1024 + h * 128 + 16 * w + 4 * g4);
                f32x4 d = (f32x4){bf2f_((unsigned short)(ol.x & 0xffffu)), bf2f_((unsigned short)(ol.x >> 16)), bf2f_((unsigned short)(ol.y & 0xffffu)), bf2f_((unsigned short)(ol.y >> 16))};
                if (seg > 0) {
#pragma unroll
                    for (int ks = 0; ks < 4; ++ks) { const bf16x8 af = *(const HLAS bf16x8*)(L + L_ST + (16 * w + r16) * P272 + (32 * ks + 8 * g4) * 2), bf = *(const bf16x8*)(a.Q1G + row * 1024 + h * 128 + 32 * ks + 8 * g4); d = HG_MFMA(af, bf, d); } }
                o[ct] = d;
                float p = (d[0] * d[0] + d[1] * d[1]) + (d[2] * d[2] + d[3] * d[3]); p += __shfl_xor(p, 16); p += __shfl_xor(p, 32);
                if (g4 == 0) SSQ[w * 64 + 16 * ct + r16] = p; }
            HG_BAR();
#pragma unroll
            for (int ct = 0; ct < 4; ++ct) { float tot = 0.f;
#pragma unroll
                for (int ww = 0; ww < 8; ++ww) tot += SSQ[ww * 64 + 16 * ct + r16];
                const float rs = 1.0f / sqrtf(tot * (1.0f / 128.0f) + 1e-6f);
                const size_t row = row0 + 16 * ct + r16; const u32x2 gg = *(const u32x2*)(a.HP + row * 4096 + 3072 + h * 128 + 16 * w + 4 * g4);
                const float g0 = bf2f_((unsigned short)(gg.x & 0xffffu)), g1 = bf2f_((unsigned short)(gg.x >> 16)), g2 = bf2f_((unsigned short)(gg.y & 0xffffu)), g3 = bf2f_((unsigned short)(gg.y >> 16));
                const float s0 = g0 * __builtin_amdgcn_rcpf(1.0f + __expf(-g0)), s1 = g1 * __builtin_amdgcn_rcpf(1.0f + __expf(-g1)), s2 = g2 * __builtin_amdgcn_rcpf(1.0f + __expf(-g2)), s3 = g3 * __builtin_amdgcn_rcpf(1.0f + __expf(-g3));
                *(u32x2*)(a.HON + row * 1024 + h * 128 + 16 * w + 4 * g4) = (u32x2){pk_(o[ct][0] * rs * gn[0] * s0, o[ct][1] * rs * gn[1] * s1), pk_(o[ct][2] * rs * gn[2] * s2, o[ct][3] * rs * gn[3] * s3)}; }
        }
    }
    HG_BAR();
}
}

struct Args { const float* in[22]; const int* pos; float* out; unsigned char* ws; int ph_lo, ph_hi, li, pad; };

__global__ void __launch_bounds__(NWAVES * 64, 2) fwd_kernel(Args args) {
    extern __shared__ __attribute__((aligned(16))) unsigned char lds[];
    LAS unsigned char* L = (LAS unsigned char*)lds;
    volatile LAS unsigned* MISC = (volatile LAS unsigned*)(L + MISC_OFF);
    const int tid = threadIdx.x, lane = tid & 63, wave = __builtin_amdgcn_readfirstlane(tid >> 6);
    const int G = gridDim.x;
    const int gw = blockIdx.x * NWAVES + wave, NGW = G * NWAVES;
    unsigned char* ws = args.ws;
    gu32* ctl = (gu32*)(ws + WS_CTL);
    for (int u = tid; u < (LDS_BYTES - LDSCTL_OFF) / 4; u += NWAVES * 64) ((LAS unsigned*)(L + LDSCTL_OFF))[u] = 0u;
    __syncthreads();
    XcdBarrier bar; bar.bar = (unsigned*)(ctl + CW_BAR); bar.x = 0; bar.st = nullptr;
    if (N_LAUNCHES == 1) bar = xcd_barrier_post((unsigned*)(ctl + CW_BAR), MISC + 8);
#define GRID_BAR() do { if (N_LAUNCHES == 1) xcd_barrier(bar); } while (0)
    const int lo = args.ph_lo, hi = args.ph_hi;
#define IN(k) (lo <= (k) && (k) < hi)
#define BOTH(k) (IN(k) && IN((k) + 1))
    const float* x = args.in[0];
    float* H = args.out;

    if (IN(0)) {
        LAS float* scr = (LAS float*)(L + RING_OFF + wave * 16384);
        constexpr int I_MOE = (1024 / 64) * (3584 / 32);
        constexpr int NITEMS = 16 * 21 + 6 * 48 + 4 * 64 + 16 * 32 + 2 * 1792 + 1792 + 16 * 128 + 16 * 32 + 24 * I_MOE;
        for (int it = gw; it < NITEMS; it += NGW) {
            int r = it;
#define JOB(W, K_, N_, WT, mode) { const int ni = ((K_) / 64) * ((N_) / 32); if (r < ni) { tr_item((W), (K_), (N_), (bf16*)(ws + (WT)), (mode), scr, r, lane); continue; } r -= ni; }
            JOB(args.in[5], 1024, 672, WS_WMLAIN, 0)
            JOB(args.in[7], 384, 1536, WS_WQUP, 0)
            JOB(args.in[9], 256, 2048, WS_WKVUP, 0)
            JOB(args.in[10], 1024, 1024, WS_WO0, 0)
            JOB(args.in[15], 1024, 3584, WS_WFGU, 1)
            JOB(args.in[16], 1024, 3584, WS_WFGU, 2)
            JOB(args.in[17], 3584, 1024, WS_WFDN, 0)
            JOB(args.in[11], 1024, 4096, WS_WHIN, 0)
            JOB(args.in[14], 1024, 1024, WS_WHO, 0)
#undef JOB
            if (r < 8 * I_MOE) { const int e = r / I_MOE; tr_item(args.in[19] + (size_t)e * 1024 * 3584, 1024, 3584, (bf16*)(ws + WS_WMGU) + (size_t)e * 7168 * 1024, 1, scr, r % I_MOE, lane); continue; } r -= 8 * I_MOE;
            if (r < 8 * I_MOE) { const int e = r / I_MOE; tr_item(args.in[20] + (size_t)e * 1024 * 3584, 1024, 3584, (bf16*)(ws + WS_WMGU) + (size_t)e * 7168 * 1024, 2, scr, r % I_MOE, lane); continue; } r -= 8 * I_MOE;
            { const int e = r / I_MOE; tr_item(args.in[21] + (size_t)e * 3584 * 1024, 3584, 1024, (bf16*)(ws + WS_WMDN) + (size_t)e * 1024 * 3584, 0, scr, r % I_MOE, lane); }
        }
        { v4u* z = (v4u*)((bf16*)(ws + WS_WMLAIN) + (size_t)MLA_IN * 1024); const int n16 = (MLA_INP - MLA_IN) * 1024 * 2 / 16;
          for (int i = blockIdx.x * NWAVES * 64 + tid; i < n16; i += G * NWAVES * 64) z[i] = (v4u){0u, 0u, 0u, 0u}; }
        for (int m = gw; m < M; m += NGW) rms_row_to_bf16(x + (size_t)m * D, args.in[2], (bf16*)(ws + WS_HN) + (size_t)m * D, lane);
        if (BOTH(0)) GRID_BAR();
    }
    if (IN(1)) {
        pg8::Gemm g{(const bf16*)(ws + WS_HN), (const bf16*)(ws + WS_WMLAIN), M, MLA_INP, 1024}; pg8::StaticOrder S; S.init(M, MLA_INP, G, (int)blockIdx.x);
        pg8::EpiStoreBf16 E{(bf16*)(ws + WS_PROJ), MLA_INP, MLA_INP / 256};
        pg8::gemm_phase<pg8::EpiStoreBf16, pg8::StaticOrder, true, false>(L + RING_OFF, g, S, E);
        if (BOTH(1)) GRID_BAR();
    }
    if (IN(2)) {
        const bf16* P = (const bf16*)(ws + WS_PROJ);
        for (int m = gw; m < M; m += NGW) {
            const bf16* pr = P + (size_t)m * MLA_INP;
            float cq[6]; float s = 0.f;
#pragma unroll
            for (int j = 0; j < 6; ++j) { cq[j] = bf2f(pr[j * 64 + lane]); s += cq[j] * cq[j]; }
            const float rq = 1.f / sqrtf(wave_sum(s) * (1.f / QL) + EPS);
            bf16* oq = (bf16*)(ws + WS_CQN) + (size_t)m * QL;
#pragma unroll
            for (int j = 0; j < 6; ++j) oq[j * 64 + lane] = (bf16)f2bf(cq[j] * rq * args.in[6][j * 64 + lane]);
            float ck[4]; s = 0.f;
#pragma unroll
            for (int j = 0; j < 4; ++j) { ck[j] = bf2f(pr[QL + j * 64 + lane]); s += ck[j] * ck[j]; }
            const float rk = 1.f / sqrtf(wave_sum(s) * (1.f / KVL) + EPS);
            bf16* ok = (bf16*)(ws + WS_CKVN) + (size_t)m * KVL;
#pragma unroll
            for (int j = 0; j < 4; ++j) ok[j * 64 + lane] = (bf16)f2bf(ck[j] * rk * args.in[8][j * 64 + lane]);
            if (lane < 16) {
                const float invf = exp2f(-(float)lane * (13.287712379549449f / 16.0f));
                const float ang = (float)args.pos[m] * invf;
                const double rev = (double)ang * 0.15915494309189535; const float fr = (float)(rev - rint(rev));
                const float sn = __builtin_amdgcn_sinf(fr), cs = __builtin_amdgcn_cosf(fr);
                ((float*)(ws + WS_COS))[(size_t)m * 16 + lane] = cs; ((float*)(ws + WS_SIN))[(size_t)m * 16 + lane] = sn;
                const float x1 = bf2f(pr[QL + KVL + lane]), x2 = bf2f(pr[QL + KVL + 16 + lane]);
                bf16* okr = (bf16*)(ws + WS_KR) + (size_t)m * 32;
                okr[lane] = (bf16)f2bf(x1 * cs - x2 * sn); okr[16 + lane] = (bf16)f2bf(x2 * cs + x1 * sn);
            }
        }
        if (BOTH(2)) GRID_BAR();
    }
    if (IN(3)) {
        { pg8::Gemm g{(const bf16*)(ws + WS_CQN), (const bf16*)(ws + WS_WQUP), M, QW, QL}; pg8::StaticOrder S; S.init(M, QW, G, (int)blockIdx.x);
          pg8::EpiStoreBf16 E{(bf16*)(ws + WS_Q), QW, QW / 256};
          pg8::gemm_phase<pg8::EpiStoreBf16, pg8::StaticOrder, true, false>(L + RING_OFF, g, S, E); }
        { pg8::Gemm g{(const bf16*)(ws + WS_CKVN), (const bf16*)(ws + WS_WKVUP), M, KVW, KVL}; pg8::StaticOrder S; S.init(M, KVW, G, (int)blockIdx.x);
          pg8::EpiStoreBf16 E{(bf16*)(ws + WS_KV), KVW, KVW / 256};
          pg8::gemm_phase<pg8::EpiStoreBf16, pg8::StaticOrder, true, false>(L + RING_OFF, g, S, E); }
        if (BOTH(3)) GRID_BAR();
    }
    if (IN(4)) {
        const int vcu = (G % 8 == 0) ? ((int)blockIdx.x % 8) * (G / 8) + (int)blockIdx.x / 8 : (int)blockIdx.x;
        for (int v = vcu; v < 256; v += G) {
            const int bh = v >> 2, s4 = v & 3;
#pragma unroll 1
            for (int i = 0; i < 4; ++i) { const int qb = (i == 0) ? s4 : (i == 1) ? 7 - s4 : (i == 2) ? 8 + s4 : 15 - s4;
                mla_attn::attn_unit<8>(bh >> 4, bh & 15, qb, (const bf16*)(ws + WS_Q), (const bf16*)(ws + WS_KV), (const bf16*)(ws + WS_KR), (const float*)(ws + WS_COS), (const float*)(ws + WS_SIN), (bf16*)(ws + WS_O), (char*)lds + RING_OFF); }
        }
        if (BOTH(4)) GRID_BAR();
    }
    if (IN(5)) {
        pg8::Gemm g{(const bf16*)(ws + WS_O), (const bf16*)(ws + WS_WO0), M, D, D}; pg8::StaticOrder S; S.init(M, D, G, (int)blockIdx.x);
        pg8::EpiF32Res E{x, H, D, D / 256};
        pg8::gemm_phase<pg8::EpiF32Res, pg8::StaticOrder, true, false>(L + RING_OFF, g, S, E);
        if (BOTH(5)) GRID_BAR();
    }
    if (IN(6)) {
        for (int m = gw; m < M; m += NGW) rms_row_to_bf16(H + (size_t)m * D, args.in[3], (bf16*)(ws + WS_HN) + (size_t)m * D, lane);
        if (BOTH(6)) GRID_BAR();
    }
    if (IN(7)) {
        pg8::Gemm g{(const bf16*)(ws + WS_HN), (const bf16*)(ws + WS_WFGU), M, 2 * FF, D}; pg8::StaticOrder S; S.init(M, 2 * FF, G, (int)blockIdx.x);
        pg8::EpiSwiGLU E{(bf16*)(ws + WS_FACT), FF, 2 * FF / 256};
        pg8::gemm_phase<pg8::EpiSwiGLU, pg8::StaticOrder, true, false>(L + RING_OFF, g, S, E);
        if (BOTH(7)) GRID_BAR();
    }
    if (IN(8)) {
        pg8::Gemm g{(const bf16*)(ws + WS_FACT), (const bf16*)(ws + WS_WFDN), M, D, FF}; pg8::StaticOrder S; S.init(M, D, G, (int)blockIdx.x);
        pg8::EpiF32Res E{H, H, D, D / 256};
        pg8::gemm_phase<pg8::EpiF32Res, pg8::StaticOrder, true, false>(L + RING_OFF, g, S, E);
        if (BOTH(8)) GRID_BAR();
    }
    if (IN(9)) {
        for (int m = gw; m < M; m += NGW) rms_row_to_bf16(H + (size_t)m * D, args.in[2] + D, (bf16*)(ws + WS_HN) + (size_t)m * D, lane);
        if (BOTH(9)) GRID_BAR();
    }
    if (IN(10)) {
        pg8::Gemm g{(const bf16*)(ws + WS_HN), (const bf16*)(ws + WS_WHIN), M, HG_IN, D}; pg8::StaticOrder S; S.init(M, HG_IN, G, (int)blockIdx.x);
        pg8::EpiStoreBf16 E{(bf16*)(ws + WS_HPROJ), HG_IN, HG_IN / 256};
        pg8::gemm_phase<pg8::EpiStoreBf16, pg8::StaticOrder, true, false>(L + RING_OFF, g, S, E);
        if (BOTH(10)) GRID_BAR();
    }
    if (IN(11)) {
        hg::P1Args pa{(const bf16*)(ws + WS_HPROJ), args.in[12], (bf16*)(ws + WS_OL), (bf16*)(ws + WS_Q1G), (float*)(ws + WS_WN), (float*)(ws + WS_SS), (float*)(ws + WS_DSEG)};
        hg::hg_pass1(L, pa, G);
        if (BOTH(11)) GRID_BAR();
    }
    if (IN(12)) {
        hg::P2Args pa{(const bf16*)(ws + WS_HPROJ), (const bf16*)(ws + WS_OL), (const bf16*)(ws + WS_Q1G), (const float*)(ws + WS_WN), (const float*)(ws + WS_SS), (const float*)(ws + WS_DSEG), args.in[13], (bf16*)(ws + WS_HON)};
        hg::hg_pass2(L, pa, G);
        if (BOTH(12)) GRID_BAR();
    }
    if (IN(13)) {
        pg8::Gemm g{(const bf16*)(ws + WS_HON), (const bf16*)(ws + WS_WHO), M, D, D}; pg8::StaticOrder S; S.init(M, D, G, (int)blockIdx.x);
        pg8::EpiF32Res E{H, H, D, D / 256};
        pg8::gemm_phase<pg8::EpiF32Res, pg8::StaticOrder, true, false>(L + RING_OFF, g, S, E);
        if (BOTH(13)) GRID_BAR();
    }
    if (IN(14)) {
        const float* gn = args.in[3] + D; const float* RT = args.in[18];
        int* rowlist = (int*)(ws + WS_ROWLIST); v4u* tok = (v4u*)(ws + WS_TOK);
        for (int m = gw; m < M; m += NGW) {
            const f32x4* xr = (const f32x4*)(H + (size_t)m * D) + lane; const f32x4* gr = (const f32x4*)gn + lane;
            f32x4 v[4]; float s = 0.f;
#pragma unroll
            for (int j = 0; j < 4; ++j) { v[j] = xr[64 * j]; s += (v[j].x * v[j].x + v[j].y * v[j].y) + (v[j].z * v[j].z + v[j].w * v[j].w); }
            const float rstd = 1.f / sqrtf(wave_sum(s) * (1.f / 1024.f) + EPS);
            float lg[8];
#pragma unroll
            for (int e = 0; e < 8; ++e) lg[e] = 0.f;
            unsigned long long* o8 = (unsigned long long*)((bf16*)(ws + WS_HN3) + (size_t)m * D) + lane;
#pragma unroll
            for (int j = 0; j < 4; ++j) { const f32x4 g = gr[64 * j]; const f32x4 t = (f32x4){v[j].x * rstd * g.x, v[j].y * rstd * g.y, v[j].z * rstd * g.z, v[j].w * rstd * g.w};
                o8[64 * j] = (unsigned long long)pk2(t.x, t.y) | ((unsigned long long)pk2(t.z, t.w) << 32);
                const int k0 = 4 * (lane + 64 * j);
#pragma unroll
                for (int kk = 0; kk < 4; ++kk) { const f32x4 r0 = *(const f32x4*)(RT + (size_t)(k0 + kk) * 8), r1 = *(const f32x4*)(RT + (size_t)(k0 + kk) * 8 + 4); const float tv = t[kk];
                    lg[0] += tv * r0.x; lg[1] += tv * r0.y; lg[2] += tv * r0.z; lg[3] += tv * r0.w; lg[4] += tv * r1.x; lg[5] += tv * r1.y; lg[6] += tv * r1.z; lg[7] += tv * r1.w; } }
#pragma unroll
            for (int e = 0; e < 8; ++e) lg[e] = wave_sum(lg[e]);
            if (lane == 0) {
                int e1 = 0; float v1 = lg[0];
#pragma unroll
                for (int e = 1; e < 8; ++e) if (lg[e] > v1) { v1 = lg[e]; e1 = e; }
                int e2 = (e1 == 0) ? 1 : 0; float v2 = lg[e2];
#pragma unroll
                for (int e = 1; e < 8; ++e) if (e != e1 && lg[e] > v2) { v2 = lg[e]; e2 = e; }
                const float w1 = 1.0f / (1.0f + __expf(v2 - v1)), w2 = 1.0f - w1;
                const unsigned p1 = __hip_atomic_fetch_add((unsigned*)(ctl + CW_CNT + 64 * e1), 1u, RLX_AGENT), p2 = __hip_atomic_fetch_add((unsigned*)(ctl + CW_CNT + 64 * e2), 1u, RLX_AGENT);
                rowlist[e1 * CAP + p1] = m; rowlist[e2 * CAP + p2] = m;
                tok[m] = (v4u){(unsigned)(e1 * CAP) + p1, (unsigned)(e2 * CAP) + p2, __builtin_bit_cast(unsigned, w1), __builtin_bit_cast(unsigned, w2)};
            }
        }
        if (BOTH(14)) GRID_BAR();
    }
    if (IN(15) || IN(16) || IN(17)) {
        if (tid == 0) { volatile LAS int* mt = (volatile LAS int*)(MISC + 16); int acc = 0;
            for (int e = 0; e < 8; ++e) { const int c = (int)__hip_atomic_load((unsigned*)(ctl + CW_CNT + 64 * e), RLX_AGENT); mt[e] = acc; mt[9 + e] = c; acc += (c + 255) >> 8; }
            mt[8] = acc; }
        __syncthreads();
    }
    if (IN(15)) {
        pg8::Gemm g{(const bf16*)(ws + WS_HN3), (const bf16*)(ws + WS_WMGU), M, 2 * FF, D};
        MoeOrder S; S.init((volatile LAS int*)(MISC + 16), 2 * FF / 256, G, (int)blockIdx.x, (const int*)(ws + WS_ROWLIST));
        pg8::EpiSwiGLU E{(bf16*)(ws + WS_MACT), FF, 2 * FF / 256};
        pg8::gemm_phase<pg8::EpiSwiGLU, MoeOrder, true, true>(L + RING_OFF, g, S, E);
        if (BOTH(15)) GRID_BAR();
    }
    if (IN(16)) {
        pg8::Gemm g{(const bf16*)(ws + WS_MACT), (const bf16*)(ws + WS_WMDN), MAXSLOT, D, FF};
        MoeOrder S; S.init((volatile LAS int*)(MISC + 16), D / 256, G, (int)blockIdx.x, (const int*)(ws + WS_ROWLIST));
        pg8::EpiStoreBf16 E{(bf16*)(ws + WS_Y), D, D / 256};
        pg8::gemm_phase<pg8::EpiStoreBf16, MoeOrder, true, false>(L + RING_OFF, g, S, E);
        if (BOTH(16)) GRID_BAR();
    }
    if (IN(17)) {
        volatile LAS int* mt = (volatile LAS int*)(MISC + 16);
        const bf16* Y = (const bf16*)(ws + WS_Y); const v4u* tok = (const v4u*)(ws + WS_TOK);
        for (int m = gw; m < M; m += NGW) {
            const v4u tk = tok[m];
            const int e1 = tk.x / CAP, e2 = tk.y / CAP; const size_t s1 = (size_t)mt[e1] * 256 + (tk.x % CAP), s2 = (size_t)mt[e2] * 256 + (tk.y % CAP);
            const unsigned zb = tk.z, wb = tk.w; const float w1 = __uint_as_float(zb), w2 = __uint_as_float(wb);
            f32x4* xr = (f32x4*)(H + (size_t)m * D) + lane; const f32x4* gr = (const f32x4*)args.in[4] + lane;
            const v2u* y1 = (const v2u*)(Y + s1 * D) + lane; const v2u* y2 = (const v2u*)(Y + s2 * D) + lane;
            f32x4 v[4]; float s = 0.f;
#pragma unroll
            for (int j = 0; j < 4; ++j) { v[j] = xr[64 * j]; const v2u a = y1[64 * j], c = y2[64 * j];
                v[j].x += w1 * bf2f((unsigned short)(a.x & 0xffffu)) + w2 * bf2f((unsigned short)(c.x & 0xffffu)); v[j].y += w1 * bf2f((unsigned short)(a.x >> 16)) + w2 * bf2f((unsigned short)(c.x >> 16));
                v[j].z += w1 * bf2f((unsigned short)(a.y & 0xffffu)) + w2 * bf2f((unsigned short)(c.y & 0xffffu)); v[j].w += w1 * bf2f((unsigned short)(a.y >> 16)) + w2 * bf2f((unsigned short)(c.y >> 16));
                s += (v[j].x * v[j].x + v[j].y * v[j].y) + (v[j].z * v[j].z + v[j].w * v[j].w); }
            const float rstd = 1.f / sqrtf(wave_sum(s) * (1.f / 1024.f) + EPS);
#pragma unroll
            for (int j = 0; j < 4; ++j) { const f32x4 g = gr[64 * j]; xr[64 * j] = (f32x4){v[j].x * rstd * g.x, v[j].y * rstd * g.y, v[j].z * rstd * g.z, v[j].w * rstd * g.w}; }
        }
    }
#undef IN
#undef BOTH
}

extern "C" void kernel_launch(void* const* d_in, const int* in_sizes, int n_in, void* d_out, int out_size, void* d_ws, size_t ws_size, hipStream_t stream) {
    static int grid = 0;
    if (grid == 0) {
        if (n_in != 22 || in_sizes[0] != M * D || out_size != M * D || ws_size < WS_END) { fprintf(stderr, "kernel_launch: unexpected shapes (n_in %d, in0 %d, out %d, ws %zu)\n", n_in, n_in > 0 ? in_sizes[0] : -1, out_size, ws_size); grid = -1; return; }
        int dev = 0, cus = 0, per_cu = 0;
        if (hipGetDevice(&dev) != hipSuccess || hipDeviceGetAttribute(&cus, hipDeviceAttributeMultiprocessorCount, dev) != hipSuccess) { grid = -1; return; }
        if (hipFuncSetAttribute((const void*)fwd_kernel, hipFuncAttributeMaxDynamicSharedMemorySize, LDS_BYTES) != hipSuccess) { fprintf(stderr, "kernel_launch: hipFuncSetAttribute failed\n"); grid = -1; return; }
        if (hipOccupancyMaxActiveBlocksPerMultiprocessor(&per_cu, (const void*)fwd_kernel, NWAVES * 64, LDS_BYTES) != hipSuccess || per_cu < 1) fprintf(stderr, "kernel_launch: occupancy query reports %d\n", per_cu);
        (void)hipGetLastError();
        grid = cus;
    }
    if (grid < 0) return;
    if (hipMemsetAsync((char*)d_ws + WS_CTL, 0, CTL_ZERO_BYTES, stream) != hipSuccess) return;
    Args a{};
    for (int i = 0; i < 22; ++i) a.in[i] = (const float*)d_in[i];
    a.pos = (const int*)d_in[1]; a.out = (float*)d_out; a.ws = (unsigned char*)d_ws;
    static_assert(N_LAUNCHES == 1 || N_LAUNCHES == NPHASE, "MK_N_LAUNCHES: 1 or 18");
    for (int li = 0; li < N_LAUNCHES; ++li) {
        a.ph_lo = (N_LAUNCHES == 1) ? 0 : li; a.ph_hi = (N_LAUNCHES == 1) ? NPHASE : li + 1; a.li = li;
        hipLaunchKernelGGL(fwd_kernel, dim3(grid), dim3(NWAVES * 64), LDS_BYTES, stream, a);
        if (hipPeekAtLastError() != hipSuccess) { fprintf(stderr, "kernel_launch: launch %d failed\n", li); break; }
    }
}
```

```cpp
#include <hip/hip_runtime.h>
#include <cstdio>
#include <cstdint>

#ifndef MK_N_LAUNCHES
#define MK_N_LAUNCHES 1
#endif

namespace pg8 {
#define PG8_LAS __attribute__((address_space(3)))
typedef unsigned short bf16_t;
typedef short bf16x8 __attribute__((ext_vector_type(8)));
typedef float f32x4 __attribute__((ext_vector_type(4)));
typedef unsigned u32x4 __attribute__((ext_vector_type(4)));
constexpr int BM = 256, BK = 64, HALF = 128, HTB = HALF * BK * 2, STAGE_BYTES = 8 * HTB, NXCD = 8, WGM = 8;

__host__ __device__ __forceinline__ int lds_byte(int r, int c) { const int st = (r >> 4) * 2 + (c >> 5), rr = r & 15, cc = c & 31, ob = rr * 64 + cc * 2; return st * 1024 + (ob ^ (((ob >> 9) & 1) << 5)); }
__host__ __device__ __forceinline__ void stage_rc(int b, int& R, int& C) { const int st = b / 1024, sb = b % 1024, swz = sb ^ (((sb >> 9) & 1) << 5); R = (st >> 1) * 16 + swz / 64; C = (st & 1) * 32 + (swz % 64) / 2; }
__host__ __device__ __forceinline__ int perm32(int rho) { const int n = rho >> 4, i = rho & 15; return 8 * (i >> 2) + 4 * n + (i & 3); }

struct Unit { int pm, pn, kb; };
struct Gemm { const bf16_t* A; const bf16_t* Bt; int M, N, K, ld; };

struct StaticOrder {
    int nM, nN, nwg, G, c;
    __host__ __device__ void init(int M, int N, int G_, int c_) { nM = M / BM; nN = N / BM; nwg = nM * nN; G = G_; c = c_; }
    __host__ __device__ bool next(int i, Unit& u) const {
        const long L = (long)i * G + c; if (L >= nwg) return false;
        int wgid = (int)L; { const int q = nwg / NXCD, r = nwg % NXCD, xcd = wgid % NXCD, off = wgid / NXCD; wgid = (xcd < r ? xcd * (q + 1) : r * (q + 1) + (xcd - r) * q) + off; }
        const int nig = WGM * nN, gid = wgid / nig, fm = gid * WGM, gsz = (nM - fm) < WGM ? (nM - fm) : WGM;
        u.pm = fm + ((wgid % nig) % gsz); u.pn = (wgid % nig) / gsz; u.kb = 0; return true;
    }
    __device__ __forceinline__ void a_ready(const Unit&) const {}
    __device__ __forceinline__ void done(const Unit&) const {}
    __device__ __forceinline__ int arow(const Unit&, int) const { return 0; }
    __device__ __forceinline__ void issue_rows(const Unit&, int, int, int) const {}
    __device__ __forceinline__ int arow_lds(int, int) const { return 0; }
};

__device__ __forceinline__ unsigned cvt_pk_bf16(float lo, float hi) { unsigned r; asm volatile("v_cvt_pk_bf16_f32 %0, %1, %2" : "=v"(r) : "v"(lo), "v"(hi)); return r; }

struct EpiStoreBf16 {
    static constexpr bool PERM = true, AFTER_DRAIN = false;
    bf16_t* O; int ldc; int nN;
    __device__ __forceinline__ void operator()(const f32x4 (&acc)[2][2][4][2], const Unit& u, int wr, int wc, int fr, int fq) const {
        const int pnl = u.pn % nN; const int row0 = u.pm * BM + wr * 64 + fr, col0 = pnl * BM + wc * 32 + 8 * fq;
#pragma unroll
        for (int ai = 0; ai < 2; ++ai)
#pragma unroll
            for (int m = 0; m < 4; ++m) { bf16_t* rowp = O + (size_t)(row0 + ai * HALF + m * 16) * ldc + col0;
#pragma unroll
                for (int bj = 0; bj < 2; ++bj) { const f32x4 v0 = acc[ai][bj][m][0], v1 = acc[ai][bj][m][1];
                    u32x4 w; w.x = cvt_pk_bf16(v0[0], v0[1]); w.y = cvt_pk_bf16(v0[2], v0[3]); w.z = cvt_pk_bf16(v1[0], v1[1]); w.w = cvt_pk_bf16(v1[2], v1[3]);
                    *(u32x4*)(rowp + bj * HALF) = w; } }
    }
};
__device__ __forceinline__ float silu_f(float x) { return x * __builtin_amdgcn_rcpf(1.0f + __builtin_amdgcn_exp2f(-1.4426950408889634f * x)); }
struct EpiSwiGLU {
    static constexpr bool PERM = true, AFTER_DRAIN = false;
    bf16_t* O; int ldc; int nN;
    __device__ __forceinline__ void operator()(const f32x4 (&acc)[2][2][4][2], const Unit& u, int wr, int wc, int fr, int fq) const {
        const int pnl = u.pn % nN; const int row0 = u.pm * BM + wr * 64 + fr, col0 = pnl * HALF + wc * 32 + 8 * fq;
#pragma unroll
        for (int ai = 0; ai < 2; ++ai)
#pragma unroll
            for (int m = 0; m < 4; ++m) { bf16_t* rowp = O + (size_t)(row0 + ai * HALF + m * 16) * ldc + col0;
                const f32x4 g0 = acc[ai][0][m][0], g1 = acc[ai][0][m][1], u0 = acc[ai][1][m][0], u1 = acc[ai][1][m][1];
                u32x4 w; w.x = cvt_pk_bf16(silu_f(g0[0]) * u0[0], silu_f(g0[1]) * u0[1]); w.y = cvt_pk_bf16(silu_f(g0[2]) * u0[2], silu_f(g0[3]) * u0[3]);
                w.z = cvt_pk_bf16(silu_f(g1[0]) * u1[0], silu_f(g1[1]) * u1[1]); w.w = cvt_pk_bf16(silu_f(g1[2]) * u1[2], silu_f(g1[3]) * u1[3]);
                __builtin_nontemporal_store(w, (u32x4*)rowp); }
    }
};
struct EpiPart {
    static constexpr bool PERM = false, AFTER_DRAIN = false;
    float* P0; float* P1; int nN;
    __device__ __forceinline__ void operator()(const f32x4 (&acc)[2][2][4][2], const Unit& u, int wr, int wc, int fr, int fq) const {
        const int pnl = u.pn % nN, ks = u.kb >> 10, tl = u.pm - 128;
        float* base = (tl < 4 ? P0 + (size_t)((tl * 4 + pnl) * 7 + ks) * 65536 : P1 + (size_t)(((tl - 4) * 4 + pnl) * 7 + ks) * 65536) + (wr * 64 + fr) * 256 + wc * 32 + 4 * fq;
#pragma unroll
        for (int ai = 0; ai < 2; ++ai)
#pragma unroll
            for (int m = 0; m < 4; ++m)
#pragma unroll
                for (int bj = 0; bj < 2; ++bj)
#pragma unroll
                    for (int n = 0; n < 2; ++n) *(f32x4*)(base + (ai * HALF + m * 16) * 256 + bj * HALF + n * 16) = acc[ai][bj][m][n];
    }
};
template <bool BASE_F32> struct EpiRes {
    static constexpr bool PERM = false, AFTER_DRAIN = false;
    const void* base; bf16_t* out; int ldb, ldo; int nN;
    __device__ __forceinline__ void operator()(const f32x4 (&acc)[2][2][4][2], const Unit& u, int wr, int wc, int fr, int fq) const {
        typedef unsigned u32x2_ __attribute__((ext_vector_type(2)));
        const int pnl = u.pn % nN; const int row0 = u.pm * BM + wr * 64 + fr, col0 = pnl * BM + wc * 32 + 4 * fq;
#pragma unroll
        for (int ai = 0; ai < 2; ++ai) {
            if constexpr (BASE_F32) {
                f32x4 pre[4][2][2];
#pragma unroll
                for (int m = 0; m < 4; ++m) { const size_t row = (size_t)(row0 + ai * HALF + m * 16);
#pragma unroll
                    for (int bj = 0; bj < 2; ++bj)
#pragma unroll
                        for (int n = 0; n < 2; ++n) pre[m][bj][n] = *(const f32x4*)((const float*)base + row * ldb + col0 + bj * HALF + n * 16); }
                asm volatile("" ::: "memory");
#pragma unroll
                for (int m = 0; m < 4; ++m) { const size_t off = (size_t)(row0 + ai * HALF + m * 16) * ldo + col0;
#pragma unroll
                    for (int bj = 0; bj < 2; ++bj)
#pragma unroll
                        for (int n = 0; n < 2; ++n) { const f32x4 v = acc[ai][bj][m][n] + pre[m][bj][n]; *(u32x2_*)(out + off + bj * HALF + n * 16) = (u32x2_){cvt_pk_bf16(v[0], v[1]), cvt_pk_bf16(v[2], v[3])}; } }
            } else {
                u32x2_ pre[4][2][2];
#pragma unroll
                for (int m = 0; m < 4; ++m) { const size_t row = (size_t)(row0 + ai * HALF + m * 16);
#pragma unroll
                    for (int bj = 0; bj < 2; ++bj)
#pragma unroll
                        for (int n = 0; n < 2; ++n) pre[m][bj][n] = *(const u32x2_*)((const bf16_t*)base + row * ldb + col0 + bj * HALF + n * 16); }
                asm volatile("" ::: "memory");
#pragma unroll
                for (int m = 0; m < 4; ++m) { const size_t off = (size_t)(row0 + ai * HALF + m * 16) * ldo + col0;
#pragma unroll
                    for (int bj = 0; bj < 2; ++bj)
#pragma unroll
                        for (int n = 0; n < 2; ++n) { const u32x2_ b = pre[m][bj][n];
                            const f32x4 v = acc[ai][bj][m][n] + (f32x4){__uint_as_float(b.x << 16), __uint_as_float(b.x & 0xffff0000u), __uint_as_float(b.y << 16), __uint_as_float(b.y & 0xffff0000u)};
                            *(u32x2_*)(out + off + bj * HALF + n * 16) = (u32x2_){cvt_pk_bf16(v[0], v[1]), cvt_pk_bf16(v[2], v[3])}; } }
            }
            asm volatile("" ::: "memory");
        }
    }
};

template <class Epi, class Sched, bool ALIGN_EPI = true, bool GATHER = false>
__device__ __forceinline__ void gemm_phase(PG8_LAS unsigned char* lds, const Gemm g, const Sched& S, const Epi& E) {
    int tid_ = threadIdx.x; asm volatile("" : "+v"(tid_));
    const int tid = tid_, wid = __builtin_amdgcn_readfirstlane(tid >> 6), lane = tid & 63, wr = wid >> 2, wc = wid & 3, fr = lane & 15, fq = lane >> 4;
    const int K = g.ld, nt = g.K / BK;
    unsigned voffA[2], voffB[2]; int RA[2], CA[2];
#pragma unroll
    for (int i = 0; i < 2; ++i) { int R, C; stage_rc(tid * 16 + i * 8192, R, C); const int Rb = Epi::PERM ? ((R & ~31) + perm32(R & 31)) : R;
        voffA[i] = (unsigned)(R * K + C) * 2u; voffB[i] = (unsigned)(Rb * K + C) * 2u; RA[i] = R; CA[i] = C; }
    unsigned vAc[2][2], vAn[2][2];
    const size_t kstep = (size_t)(BK * 2);
    const size_t hstep = (size_t)HALF * K * 2;
    const size_t tstep = 2 * hstep;
    const size_t hstepA = GATHER ? (size_t)0 : hstep;
    const unsigned ldsw = (unsigned)wid * 1024u;
    const int aoff = lds_byte(wr * 64 + fr, fq * 8), boff = lds_byte(wc * 32 + fr, fq * 8);
#define PG8_SA(b, h) (((b) * 2 + (h)) * HTB)
#define PG8_SB(b, h) ((4 + (b) * 2 + (h)) * HTB)
#define PG8_STAGE(bufoff, gbase, voff) do { _Pragma("unroll") for (int _i = 0; _i < 2; ++_i) \
        __builtin_amdgcn_global_load_lds((const unsigned*)((const char*)(gbase) + (voff)[_i]), (PG8_LAS unsigned*)(lds + (bufoff) + ldsw + _i * 8192), 16, 0, 0); } while (0)
#define PG8_STAGE_A(bufoff, gbase, h, nx) do { _Pragma("unroll") for (int _i = 0; _i < 2; ++_i) { const unsigned _vo = GATHER ? ((nx) ? vAn[h][_i] : vAc[h][_i]) : voffA[_i]; \
        __builtin_amdgcn_global_load_lds((const unsigned*)((const char*)(gbase) + _vo), (PG8_LAS unsigned*)(lds + (bufoff) + ldsw + _i * 8192), 16, 0, 0); } } while (0)
#define PG8_GATH(dst, un) do { _Pragma("unroll") for (int _h = 0; _h < 2; ++_h) _Pragma("unroll") for (int _i = 0; _i < 2; ++_i) \
        dst[_h][_i] = (unsigned)(S.arow(un, _h * HALF + RA[_i]) * K + CA[_i]) * 2u; } while (0)
#define PG8_LDA(dst, b, h) do { _Pragma("unroll") for (int m = 0; m < 4; ++m) _Pragma("unroll") for (int k = 0; k < 2; ++k) dst[m][k] = *(const PG8_LAS bf16x8*)(lds + PG8_SA(b, h) + aoff + m * 2048 + k * 1024); } while (0)
#define PG8_LDB(dst, b, h) do { _Pragma("unroll") for (int n = 0; n < 2; ++n) _Pragma("unroll") for (int k = 0; k < 2; ++k) dst[n][k] = *(const PG8_LAS bf16x8*)(lds + PG8_SB(b, h) + boff + n * 2048 + k * 1024); } while (0)
#define PG8_MMA(ai, bj, At, Bt) do { __builtin_amdgcn_s_setprio(1); _Pragma("unroll") for (int m = 0; m < 4; ++m) _Pragma("unroll") for (int n = 0; n < 2; ++n) _Pragma("unroll") for (int k = 0; k < 2; ++k) \
        acc[ai][bj][m][n] = __builtin_amdgcn_mfma_f32_16x16x32_bf16(Bt[n][k], At[m][k], acc[ai][bj][m][n], 0, 0, 0); __builtin_amdgcn_s_setprio(0); } while (0)
#define PG8_WAIT_V(n) asm volatile("s_waitcnt vmcnt(" #n ")" ::: "memory")
#define PG8_WAIT_L(n) asm volatile("s_waitcnt lgkmcnt(" #n ")" ::: "memory")
#define PG8_BAR __builtin_amdgcn_s_barrier()
#define PG8_SCHED __builtin_amdgcn_sched_barrier(0)
    Unit cur, nxt; int ui = 0;
    if (!S.next(0, cur)) return;
    f32x4 acc[2][2][4][2];
#pragma unroll
    for (int a = 0; a < 2; ++a)
#pragma unroll
        for (int b = 0; b < 2; ++b)
#pragma unroll
            for (int m = 0; m < 4; ++m)
#pragma unroll
                for (int n = 0; n < 2; ++n) acc[a][b][m][n] = (f32x4){0.f, 0.f, 0.f, 0.f};
    bf16x8 At[4][2], B0[2][2], B1[2][2];
    const char* cA = GATHER ? (const char*)g.A : (const char*)g.A + (size_t)cur.pm * tstep + cur.kb; const char* cB = (const char*)g.Bt + (size_t)cur.pn * tstep + cur.kb;
    if (GATHER) { PG8_GATH(vAc, cur); }
    S.a_ready(cur);
    PG8_STAGE(PG8_SB(0, 0), cB, voffB); PG8_STAGE(PG8_SB(0, 1), cB + hstep, voffB); PG8_STAGE_A(PG8_SA(0, 0), cA, 0, false); PG8_STAGE_A(PG8_SA(0, 1), cA + hstepA, 1, false);
    if (wr == 1) PG8_BAR;
    PG8_WAIT_V(2); PG8_BAR;
    PG8_STAGE(PG8_SB(1, 0), cB + kstep, voffB); PG8_STAGE_A(PG8_SA(1, 0), cA + kstep, 0, false); PG8_STAGE(PG8_SB(1, 1), cB + hstep + kstep, voffB);
    PG8_WAIT_V(6); PG8_BAR;
    for (;;) {
        const bool has_next = S.next(ui + 1, nxt);
        const char* nA = GATHER ? (const char*)g.A : (has_next ? (const char*)g.A + (size_t)nxt.pm * tstep + nxt.kb : cA); const char* nB = has_next ? (const char*)g.Bt + (size_t)nxt.pn * tstep + nxt.kb : cB;
        if (GATHER) { if (has_next) { S.issue_rows(nxt, ui & 1, wid, lane); } else {
#pragma unroll
                for (int _h = 0; _h < 2; ++_h)
#pragma unroll
                    for (int _i = 0; _i < 2; ++_i) vAn[_h][_i] = vAc[_h][_i]; } }
        for (int t = 0; t < nt; t += 2) {
            const bool last = (t == nt - 2);
            const char* a1 = cA + (size_t)(t + 1) * kstep;
            const char* a2 = last ? nA : cA + (size_t)(t + 2) * kstep; const char* b2 = last ? nB : cB + (size_t)(t + 2) * kstep;
            const char* a3 = a2 + kstep; const char* b3 = b2 + kstep;
            if (last && has_next) S.a_ready(nxt);
            if (GATHER) { if (last && has_next) {
#pragma unroll
                    for (int _h = 0; _h < 2; ++_h)
#pragma unroll
                        for (int _i = 0; _i < 2; ++_i) vAn[_h][_i] = (unsigned)(S.arow_lds(_h * HALF + RA[_i], ui & 1) * K + CA[_i]) * 2u; } }
            PG8_LDB(B0, 0, 0); PG8_LDB(B1, 0, 1); PG8_SCHED; PG8_LDA(At, 0, 0); PG8_STAGE_A(PG8_SA(1, 1), a1 + hstepA, 1, false);
            PG8_WAIT_V(8); PG8_WAIT_L(0); PG8_BAR; PG8_MMA(0, 0, At, B0); PG8_MMA(0, 1, At, B1); PG8_BAR; PG8_SCHED;
            PG8_LDA(At, 0, 1); PG8_STAGE(PG8_SB(0, 0), b2, voffB); PG8_STAGE(PG8_SB(0, 1), b2 + hstep, voffB); PG8_STAGE_A(PG8_SA(0, 0), a2, 0, last);
            PG8_WAIT_V(8); PG8_WAIT_L(0); PG8_BAR; PG8_MMA(1, 0, At, B0); PG8_MMA(1, 1, At, B1); PG8_BAR; PG8_SCHED;
            PG8_LDB(B0, 1, 0); PG8_LDB(B1, 1, 1); PG8_SCHED; PG8_LDA(At, 1, 0); PG8_STAGE_A(PG8_SA(0, 1), a2 + hstepA, 1, last);
            PG8_WAIT_V(8); PG8_WAIT_L(0); PG8_BAR; PG8_MMA(0, 0, At, B0); PG8_MMA(0, 1, At, B1); PG8_BAR; PG8_SCHED;
            PG8_LDA(At, 1, 1); PG8_STAGE(PG8_SB(1, 0), b3, voffB); PG8_STAGE(PG8_SB(1, 1), b3 + hstep, voffB); PG8_STAGE_A(PG8_SA(1, 0), a3, 0, last);
            PG8_WAIT_V(8); PG8_WAIT_L(0); PG8_BAR; PG8_MMA(1, 0, At, B0); PG8_MMA(1, 1, At, B1); PG8_BAR; PG8_SCHED;
        }
        if constexpr (ALIGN_EPI) { if (wr == 0) PG8_BAR; }
        E(acc, cur, wr, wc, fr, fq); S.done(cur);
        if (!has_next) break;
#pragma unroll
        for (int a = 0; a < 2; ++a)
#pragma unroll
            for (int b = 0; b < 2; ++b)
#pragma unroll
                for (int m = 0; m < 4; ++m)
#pragma unroll
                    for (int n = 0; n < 2; ++n) acc[a][b][m][n] = (f32x4){0.f, 0.f, 0.f, 0.f};
        cur = nxt; cA = nA; cB = nB; ++ui;
        if (GATHER) {
#pragma unroll
            for (int _h = 0; _h < 2; ++_h)
#pragma unroll
                for (int _i = 0; _i < 2; ++_i) vAc[_h][_i] = vAn[_h][_i]; }
        if constexpr (ALIGN_EPI) { if (wr == 1) PG8_BAR; }
    }
    PG8_WAIT_V(0);
    if constexpr (!ALIGN_EPI) { if (wr == 0) PG8_BAR; }
    PG8_BAR;
#undef PG8_SA
#undef PG8_SB
#undef PG8_STAGE
#undef PG8_STAGE_A
#undef PG8_GATH
#undef PG8_LDA
#undef PG8_LDB
#undef PG8_MMA
#undef PG8_WAIT_V
#undef PG8_WAIT_L
#undef PG8_BAR
#undef PG8_SCHED
}
}

constexpr int NWAVES = 8;
constexpr int N_LAUNCHES = MK_N_LAUNCHES;
constexpr int NPHASE = 18;
constexpr int BATCH = 4, SEQ = 4096, D = 1024, M = BATCH * SEQ;
constexpr int NH = 16, QL = 384, KVL = 256, NOPE = 64, ROPE = 32, VD = 64, MLA_IN = 672, MLA_INP = 768, QW = NH * 96, KVW = NH * 128;
constexpr int HGH = 8, DK = 128, DV = 128, HG_IN = 4096;
constexpr int FF = 3584, NE = 8, CAP = 16384;
constexpr int MAXSLOT = 2 * M + NE * 256;
constexpr float EPS = 1e-6f;

constexpr size_t MiB = 1u << 20;
constexpr size_t WS_CTL = 0, CTL_ZERO_BYTES = 1 * MiB;
constexpr size_t WS_ROWLIST = 1 * MiB;
constexpr size_t WS_TOK = WS_ROWLIST + 512 * 1024;
constexpr size_t WS_STAMP = WS_TOK + 256 * 1024;
constexpr size_t WS_COS = 2 * MiB, WS_SIN = 3 * MiB;
constexpr size_t WS_WMLAIN = 4 * MiB;
constexpr size_t WS_WQUP = 6 * MiB;
constexpr size_t WS_WKVUP = 8 * MiB;
constexpr size_t WS_WO0 = 9 * MiB;
constexpr size_t WS_WFGU = 11 * MiB;
constexpr size_t WS_WFDN = 25 * MiB;
constexpr size_t WS_WHIN = 32 * MiB;
constexpr size_t WS_WHO = 40 * MiB;
constexpr size_t WS_WMGU = 42 * MiB;
constexpr size_t WS_WMDN = 154 * MiB;
constexpr size_t WS_ACTS = 210 * MiB;
constexpr size_t WS_HN = WS_ACTS;
constexpr size_t WS_PROJ = WS_ACTS + 32 * MiB;
constexpr size_t WS_CQN = WS_PROJ + 24 * MiB;
constexpr size_t WS_CKVN = WS_CQN + 12 * MiB;
constexpr size_t WS_KR = WS_CKVN + 8 * MiB;
constexpr size_t WS_Q = WS_KR + 1 * MiB;
constexpr size_t WS_KV = WS_Q + 48 * MiB;
constexpr size_t WS_O = WS_KV + 64 * MiB;
constexpr size_t WS_FACT = WS_ACTS + 32 * MiB;
constexpr size_t WS_HPROJ = WS_ACTS + 32 * MiB;
constexpr size_t WS_HOF = WS_HPROJ + 128 * MiB;
constexpr size_t WS_HON = WS_HOF + 64 * MiB;
constexpr size_t WS_OL = WS_HOF;
constexpr size_t WS_Q1G = WS_HOF + 32 * MiB;
constexpr size_t WS_SS = WS_HN;
constexpr size_t WS_WN = WS_HN + 16 * MiB;
constexpr size_t WS_DSEG = WS_HN + 17 * MiB;
constexpr size_t WS_HN3 = 4 * MiB;
constexpr size_t WS_MACT = WS_ACTS;
constexpr size_t WS_Y = WS_WMGU;
constexpr size_t WS_PART0 = WS_WMGU + 68 * MiB;
constexpr size_t WS_PART1 = WS_HN3;
constexpr size_t WS_END = 472 * MiB;
static_assert(WS_O + (size_t)M * 1024 * 2 <= WS_END && WS_HON + (size_t)M * 1024 * 2 <= WS_END && WS_MACT + (size_t)MAXSLOT * FF * 2 <= WS_END, "d_ws map");
static_assert(WS_HN3 + (size_t)M * 1024 * 2 <= WS_WHO, "hn3 overlay");
constexpr int CW_CNT = 64;
constexpr int CW_BAR = 4096;

constexpr int RING_OFF = 0, RING_BYTES = 131072;
constexpr int LDSCTL_OFF = RING_BYTES, MISC_OFF = LDSCTL_OFF + 320;
constexpr int ROWBUF_OFF = 133120;
constexpr int LDS_BYTES = 147456;

#define GAS __attribute__((address_space(1)))
#define LAS __attribute__((address_space(3)))
typedef unsigned short bf16;
typedef unsigned v4u __attribute__((ext_vector_type(4)));
typedef unsigned v2u __attribute__((ext_vector_type(2)));
typedef float f32x4 __attribute__((ext_vector_type(4)));
typedef GAS unsigned gu32;
#define RLX_AGENT __ATOMIC_RELAXED, __HIP_MEMORY_SCOPE_AGENT
#define LDS_WAIT() asm volatile("s_waitcnt lgkmcnt(0)" ::: "memory")
__device__ __forceinline__ unsigned f2bf(float f) { unsigned u = __builtin_bit_cast(unsigned, f); return (u + 0x7fffu + ((u >> 16) & 1u)) >> 16; }
__device__ __forceinline__ unsigned pk2(float lo, float hi) { return f2bf(lo) | (f2bf(hi) << 16); }
__device__ __forceinline__ float bf2f(unsigned short b) { return __builtin_bit_cast(float, (unsigned)b << 16); }

#define XB_TMO      128
#define XB_XCNT(j)  (256  + 64 * (j))
#define XB_XSUB(j)  (1280 + 64 * (j))
#define XB_XGEN(j)  (2304 + 64 * (j))
#define XB_TOP      3328
#define XB_TOPGEN   3392
#define XCD_BAR_WORDS 3456
#define XB_SPIN_CAP (1u << 24)
__device__ __forceinline__ unsigned xb_ld(unsigned* p)              { return __hip_atomic_load(p, __ATOMIC_RELAXED, __HIP_MEMORY_SCOPE_AGENT); }
__device__ __forceinline__ unsigned xb_add(unsigned* p, unsigned v) { return __hip_atomic_fetch_add(p, v, __ATOMIC_RELAXED, __HIP_MEMORY_SCOPE_AGENT); }
__device__ __forceinline__ unsigned xb_xcc_id() { return (unsigned)__builtin_amdgcn_s_getreg((3 << 11) | 20) & 0xFu; }
#define XB_SPIN(cond, bar) do { unsigned _sp = 0; while (cond) { __builtin_amdgcn_s_sleep(1); \
    if ((++_sp & 255u) == 0u) { if (xb_ld(&(bar)[XB_TMO])) break; if (_sp > XB_SPIN_CAP) { atomicAdd(&(bar)[XB_TMO], 1u); break; } } } } while (0)
struct XcdBarrier { unsigned* bar; unsigned x; volatile LAS unsigned* st; };
__device__ __forceinline__ XcdBarrier xcd_barrier_post(unsigned* bar, volatile LAS unsigned* st) {
    XcdBarrier b; b.bar = bar; b.x = xb_xcc_id(); b.st = st;
    if (threadIdx.x == 0) (void)xb_add(&bar[XB_XCNT(b.x)], 1u);
    return b;
}
__device__ __forceinline__ void xcd_barrier_complete(unsigned* bar, unsigned x, unsigned& nloc, unsigned& nx) {
    const unsigned G = gridDim.x * gridDim.y * gridDim.z;
    unsigned sum, cnt, mine, sp = 0u;
    for (;;) {
        sum = 0u; cnt = 0u; mine = 0u;
#pragma unroll
        for (unsigned j = 0; j < 16; ++j) { const unsigned c = xb_ld(&bar[XB_XCNT(j)]); sum += c; cnt += (c > 0u) ? 1u : 0u; mine = (j == x) ? c : mine; }
        if (sum == G) break;
        __builtin_amdgcn_s_sleep(1);
        if ((++sp & 255u) == 0u) { if (xb_ld(&bar[XB_TMO])) break; if (sp > XB_SPIN_CAP) { atomicAdd(&bar[XB_TMO], 1u); break; } }
    }
    nloc = mine > 0u ? mine : 1u; nx = cnt > 0u ? cnt : 1u;
}
__device__ __forceinline__ void xcd_barrier(const XcdBarrier& b) {
    asm volatile("s_waitcnt vmcnt(0)" ::: "memory");
    __syncthreads();
    if (threadIdx.x == 0) {
        unsigned* bar = b.bar;
        __builtin_amdgcn_s_waitcnt(0);
        unsigned nloc = b.st[0], nx = b.st[1];
        if (nloc == 0u) { xcd_barrier_complete(bar, b.x, nloc, nx); b.st[0] = nloc; b.st[1] = nx; }
        const unsigned old = xb_add(&bar[XB_XSUB(b.x)], 1u);
        const unsigned gen = old / nloc;
        if (old + 1u == (gen + 1u) * nloc) {
            __builtin_amdgcn_fence(__ATOMIC_RELEASE, "agent");
            asm volatile("s_waitcnt vmcnt(0)" ::: "memory");
            const unsigned og = xb_add(&bar[XB_TOP], 1u);
            const unsigned tg = og / nx;
            if (og + 1u == (tg + 1u) * nx) xb_add(&bar[XB_TOPGEN], 1u);
            else XB_SPIN(xb_ld(&bar[XB_TOPGEN]) == tg, bar);
            __builtin_amdgcn_fence(__ATOMIC_ACQUIRE, "agent");
            xb_add(&bar[XB_XGEN(b.x)], 1u);
            asm volatile("s_waitcnt vmcnt(0)" ::: "memory");
        } else {
            XB_SPIN(xb_ld(&bar[XB_XGEN(b.x)]) == gen, bar);
            __builtin_amdgcn_fence(__ATOMIC_ACQUIRE, "agent");
            asm volatile("s_waitcnt vmcnt(0)" ::: "memory");
        }
    }
    __syncthreads();
}

__device__ __forceinline__ float wave_sum(float v) {
#pragma unroll
    for (int o = 1; o < 64; o <<= 1) v += __shfl_xor(v, o);
    return v;
}
__device__ __forceinline__ int dst_row(int n, int mode) { return mode == 0 ? n : (((n >> 7) << 8) + (n & 127) + (mode == 2 ? 128 : 0)); }
struct TrJob { const float* W; bf16* WT; int K, N, mode, item; };
__device__ __forceinline__ void tr_load(const TrJob& j, float (&v)[32], int lane) {
    const int nblk = j.N / 32, kb = j.item / nblk, nb = j.item % nblk; const float* src = j.W + (size_t)(64 * kb + (lane >> 5)) * j.N + 32 * nb + (lane & 31);
#pragma unroll
    for (int i = 0; i < 32; ++i) v[i] = __builtin_nontemporal_load(src + (size_t)(2 * i) * j.N);
}
__device__ __forceinline__ void tr_finish(const TrJob& j, const float (&v)[32], LAS float* scr, int lane) {
    const int nblk = j.N / 32, kb = j.item / nblk, nb = j.item % nblk, k0 = 64 * kb, n0 = 32 * nb;
#pragma unroll
    for (int i = 0; i < 32; ++i) scr[(2 * i + (lane >> 5)) * 33 + (lane & 31)] = v[i];
    LDS_WAIT(); asm volatile("" ::: "memory");
    const int c = lane & 7;
#pragma unroll
    for (int q = 0; q < 4; ++q) { const int n = (lane >> 3) + 8 * q; const LAS float* sp = scr + (8 * c) * 33 + n;
        v4u o; o.x = pk2(sp[0 * 33], sp[1 * 33]); o.y = pk2(sp[2 * 33], sp[3 * 33]); o.z = pk2(sp[4 * 33], sp[5 * 33]); o.w = pk2(sp[6 * 33], sp[7 * 33]);
        __builtin_nontemporal_store(o, (v4u*)(j.WT + (size_t)dst_row(n0 + n, j.mode) * j.K + k0 + 8 * c)); }
    LDS_WAIT(); asm volatile("" ::: "memory");
}
__device__ __forceinline__ void rms_row_to_bf16(const float* xrow, const float* gain, bf16* orow, int lane) {
    const f32x4* xr = (const f32x4*)xrow + lane; const f32x4* gr = (const f32x4*)gain + lane;
    f32x4 v[4]; float s = 0.f;
#pragma unroll
    for (int j = 0; j < 4; ++j) { v[j] = xr[64 * j]; s += (v[j].x * v[j].x + v[j].y * v[j].y) + (v[j].z * v[j].z + v[j].w * v[j].w); }
    const float rstd = 1.f / sqrtf(wave_sum(s) * (1.f / 1024.f) + EPS);
    unsigned long long* o8 = (unsigned long long*)orow + lane;
#pragma unroll
    for (int j = 0; j < 4; ++j) { const f32x4 g = gr[64 * j];
        o8[64 * j] = (unsigned long long)pk2(v[j].x * rstd * g.x, v[j].y * rstd * g.y) | ((unsigned long long)pk2(v[j].z * rstd * g.z, v[j].w * rstd * g.w) << 32); }
}
__device__ __forceinline__ void rms_rows_to_bf16(const float* X, const float* gain, bf16* O, int gw, int NGW, int Mrows, int lane) {
    f32x4 g[4];
#pragma unroll
    for (int j = 0; j < 4; ++j) g[j] = ((const f32x4*)gain + lane)[64 * j];
    if (gw >= Mrows) return;
    f32x4 vn[4];
#pragma unroll
    for (int j = 0; j < 4; ++j) vn[j] = ((const f32x4*)(X + (size_t)gw * 1024) + lane)[64 * j];
    for (int m = gw; m < Mrows; m += NGW) {
        f32x4 v[4];
#pragma unroll
        for (int j = 0; j < 4; ++j) v[j] = vn[j];
        const int mn = (m + NGW < Mrows) ? m + NGW : m;
#pragma unroll
        for (int j = 0; j < 4; ++j) vn[j] = ((const f32x4*)(X + (size_t)mn * 1024) + lane)[64 * j];
        float s = 0.f;
#pragma unroll
        for (int j = 0; j < 4; ++j) s += (v[j].x * v[j].x + v[j].y * v[j].y) + (v[j].z * v[j].z + v[j].w * v[j].w);
        const float rstd = 1.f / sqrtf(wave_sum(s) * (1.f / 1024.f) + EPS);
        unsigned long long* o8 = (unsigned long long*)(O + (size_t)m * 1024) + lane;
#pragma unroll
        for (int j = 0; j < 4; ++j) o8[64 * j] = (unsigned long long)pk2(v[j].x * rstd * g[j].x, v[j].y * rstd * g[j].y) | ((unsigned long long)pk2(v[j].z * rstd * g[j].z, v[j].w * rstd * g[j].w) << 32);
    }
}
__device__ __forceinline__ f32x4 ld_bf4(const bf16* p) { const v2u b = *(const v2u*)p; return (f32x4){__uint_as_float(b.x << 16), __uint_as_float(b.x & 0xffff0000u), __uint_as_float(b.y << 16), __uint_as_float(b.y & 0xffff0000u)}; }
__device__ __forceinline__ void rms_rows_bf16in(const bf16* X, int pitch, const float* gain, bf16* O, int gw, int NGW, int Mrows, int lane) {
    f32x4 g[4];
#pragma unroll
    for (int j = 0; j < 4; ++j) g[j] = ((const f32x4*)gain + lane)[64 * j];
    if (gw >= Mrows) return;
    f32x4 vn[4];
#pragma unroll
    for (int j = 0; j < 4; ++j) vn[j] = ld_bf4(X + (size_t)gw * pitch + 4 * (lane + 64 * j));
    for (int m = gw; m < Mrows; m += NGW) {
        f32x4 v[4];
#pragma unroll
        for (int j = 0; j < 4; ++j) v[j] = vn[j];
        const int mn = (m + NGW < Mrows) ? m + NGW : m;
#pragma unroll
        for (int j = 0; j < 4; ++j) vn[j] = ld_bf4(X + (size_t)mn * pitch + 4 * (lane + 64 * j));
        float s = 0.f;
#pragma unroll
        for (int j = 0; j < 4; ++j) s += (v[j].x * v[j].x + v[j].y * v[j].y) + (v[j].z * v[j].z + v[j].w * v[j].w);
        const float rstd = 1.f / sqrtf(wave_sum(s) * (1.f / 1024.f) + EPS);
        unsigned long long* o8 = (unsigned long long*)(O + (size_t)m * 1024) + lane;
#pragma unroll
        for (int j = 0; j < 4; ++j) o8[64 * j] = (unsigned long long)pk2(v[j].x * rstd * g[j].x, v[j].y * rstd * g[j].y) | ((unsigned long long)pk2(v[j].z * rstd * g[j].z, v[j].w * rstd * g[j].w) << 32);
    }
}
__device__ __forceinline__ float sigmoid_f(float x) { return 1.0f / (1.0f + __expf(-x)); }

struct MoeOrder {
    pg8::StaticOrder so; int nN; volatile LAS int* mt; const int* rowlist; LAS int* rowbuf;
    __device__ __forceinline__ void init(volatile LAS int* mt_, int nN_, int G, int c, const int* rl, int tmax = 1 << 20) { mt = mt_; nN = nN_; rowlist = rl; rowbuf = (LAS int*)((LAS unsigned char*)mt_ - (MISC_OFF + 64) + ROWBUF_OFF); const int T = mt_[8]; so.init((T < tmax ? T : tmax) * 256, nN_ * 256, G, c); }
    __device__ __forceinline__ bool next(int i, pg8::Unit& u) const {
        if (!so.next(i, u)) return false;
        int e = 0;
#pragma unroll
        for (int j = 1; j < 8; ++j) e += (u.pm >= mt[j]) ? 1 : 0;
        u.pn = e * nN + u.pn; u.kb = 0; return true;
    }
    __device__ __forceinline__ void a_ready(const pg8::Unit&) const {}
    __device__ __forceinline__ void done(const pg8::Unit&) const {}
    __device__ __forceinline__ void issue_rows(const pg8::Unit& u, int par, int wid, int lane) const {
        if (wid < 4) { const int e = u.pn / nN; const int lr = (u.pm - mt[e]) * 256 + wid * 64 + lane, c1 = mt[9 + e] - 1;
            __builtin_amdgcn_global_load_lds((const unsigned*)(rowlist + e * CAP + (lr < c1 ? lr : c1)), (LAS unsigned*)(rowbuf + par * 256 + wid * 64), 4, 0, 0); } }
    __device__ __forceinline__ int arow_lds(int r, int par) const { return rowbuf[par * 256 + r]; }
    __device__ __forceinline__ int arow(const pg8::Unit& u, int r) const { const int e = u.pn / nN; const int lr = (u.pm - mt[e]) * 256 + r, c1 = mt[9 + e] - 1; return rowlist[e * CAP + (lr < c1 ? lr : c1)]; }
};


namespace mla_attn {
using bf16x8=__attribute__((ext_vector_type(8)))short;
using s16x4=__attribute__((ext_vector_type(4)))short;
using f32x16=__attribute__((ext_vector_type(16)))float;
using u32x4=__attribute__((ext_vector_type(4)))unsigned;
typedef __attribute__((address_space(3))) const char* lds_cptr;
constexpr int NW=8,QBLK=32,QB=256,KVBLK=64;
constexpr int KSLOT=12288,VSLOT=8192,NSLOT=3;
constexpr int LDS_K=0,LDS_V=NSLOT*KSLOT,LDS_WS=LDS_V+NSLOT*VSLOT,LDS_OST=LDS_WS+NW*64*4,LDS_BYTES_A=LDS_OST+NW*4096;
__device__ __forceinline__ int crow(int r,int hi){return (r&3)+8*(r>>2)+4*hi;}
__device__ __forceinline__ void glds16(const void*gsrc,unsigned lds_dst){unsigned keep;
  asm volatile("s_mov_b32 %0, m0\n\ts_mov_b32 m0, %2\n\ts_nop 0\n\tglobal_load_lds_dwordx4 %1, off\n\ts_mov_b32 m0, %0":"=&s"(keep):"v"(gsrc),"s"(lds_dst):"memory");}
typedef float f32x2_t __attribute__((ext_vector_type(2))); typedef __bf16 bf16x2_t __attribute__((ext_vector_type(2)));
__device__ __forceinline__ unsigned cvtpk_s(float lo,float hi){f32x2_t v={lo,hi};bf16x2_t b=__builtin_convertvector(v,bf16x2_t);return __builtin_bit_cast(unsigned,b);}
__device__ __forceinline__ void glds16s(const void*sbase,unsigned voff,unsigned lds_dst){unsigned keep;
  asm volatile("s_mov_b32 %0, m0\n\ts_mov_b32 m0, %3\n\ts_nop 0\n\tglobal_load_lds_dwordx4 %1, %2\n\ts_mov_b32 m0, %0":"=&s"(keep):"v"(voff),"s"(sbase),"s"(lds_dst):"memory");}
#define MLA_WAIT_BAR(N) asm volatile("s_waitcnt vmcnt(" #N ") lgkmcnt(0)\n\ts_barrier":::"memory")
__device__ __forceinline__ void cmask(f32x16&p0,f32x16&p1,int jb,int qrel,int hi){
  const float NEG=-INFINITY; int kb=64*jb+4*hi;
  #pragma unroll
  for(int r=0;r<16;++r){int kv=kb+(r&3)+8*(r>>2); if(kv>qrel)p0[r]=NEG; if(kv+32>qrel)p1[r]=NEG;}
}
__device__ __forceinline__ void qkt6(f32x16&p0,f32x16&p1,lds_cptr kslot,const bf16x8*qr,const f32x16&negm,int r32,int hi){
  lds_cptr kb=kslot+hi*1024+r32*16;
  #pragma unroll
  for(int d0=0;d0<6;++d0){
    const bf16x8 b0=*(const __attribute__((address_space(3))) bf16x8*)(kb+d0*2048);
    const bf16x8 b1=*(const __attribute__((address_space(3))) bf16x8*)(kb+d0*2048+512);
    if(d0==0){p0=__builtin_amdgcn_mfma_f32_32x32x16_bf16(b0,qr[0],negm,0,0,0);p1=__builtin_amdgcn_mfma_f32_32x32x16_bf16(b1,qr[0],negm,0,0,0);}
    else{p0=__builtin_amdgcn_mfma_f32_32x32x16_bf16(b0,qr[d0],p0,0,0,0);p1=__builtin_amdgcn_mfma_f32_32x32x16_bf16(b1,qr[d0],p1,0,0,0);}}
}
__device__ __forceinline__ float rowmax(const f32x16&p0,const f32x16&p1){
  float a=__builtin_fmaxf(__builtin_fmaxf(p0[0],p0[1]),p1[0]),b=__builtin_fmaxf(__builtin_fmaxf(p0[2],p0[3]),p1[1]);a=__builtin_fmaxf(__builtin_fmaxf(a,p1[2]),p1[3]);
  #pragma unroll
  for(int r=4;r<16;r+=4){a=__builtin_fmaxf(__builtin_fmaxf(a,p0[r]),p0[r+1]);b=__builtin_fmaxf(__builtin_fmaxf(b,p0[r+2]),p0[r+3]);a=__builtin_fmaxf(__builtin_fmaxf(a,p1[r]),p1[r+1]);b=__builtin_fmaxf(__builtin_fmaxf(b,p1[r+2]),p1[r+3]);}
  const float m=__builtin_fmaxf(a,b);
  auto rr=__builtin_amdgcn_permlane32_swap(__float_as_uint(m),__float_as_uint(m),false,false);
  return __builtin_fmaxf(__uint_as_float(rr[0]),__uint_as_float(rr[1]));
}
__device__ __forceinline__ void pv(f32x16*o,int vb,bf16x8 pa0,bf16x8 pa1,bf16x8 pa2,bf16x8 pa3){
  #pragma unroll
  for(int d0=0;d0<2;++d0){s16x4 lo[4],hi[4];
    #pragma unroll
    for(int ks=0;ks<4;++ks){
      asm volatile("ds_read_b64_tr_b16 %0,%1 offset:%c2":"=&v"(lo[ks]):"v"(vb),"i"(d0*4096+ks*1024):"memory");
      asm volatile("ds_read_b64_tr_b16 %0,%1 offset:%c2":"=&v"(hi[ks]):"v"(vb),"i"(d0*4096+ks*1024+512):"memory");}
    asm volatile("s_waitcnt lgkmcnt(0)":::"memory");__builtin_amdgcn_sched_barrier(0);
    #define PK(k) (bf16x8){lo[k][0],lo[k][1],lo[k][2],lo[k][3],hi[k][0],hi[k][1],hi[k][2],hi[k][3]}
    o[d0]=__builtin_amdgcn_mfma_f32_32x32x16_bf16(pa0,PK(0),o[d0],0,0,0);
    o[d0]=__builtin_amdgcn_mfma_f32_32x32x16_bf16(pa1,PK(1),o[d0],0,0,0);
    o[d0]=__builtin_amdgcn_mfma_f32_32x32x16_bf16(pa2,PK(2),o[d0],0,0,0);
    o[d0]=__builtin_amdgcn_mfma_f32_32x32x16_bf16(pa3,PK(3),o[d0],0,0,0);
    #undef PK
  }
}
constexpr int QPITCH=1536,KVPITCH=2048,KRPITCH=32,OPITCH=1024,SEQ_=4096;
template<int THRL> __device__ __forceinline__ void attn_unit(int b,int h,int qb,const unsigned short*Q,const unsigned short*KV,const unsigned short*KR,const float*COS,const float*SIN,unsigned short*O,char*shm){
  const int tid=threadIdx.x,lane=tid&63,r32=lane&31,hi=lane>>5; const int wid=__builtin_amdgcn_readfirstlane(tid>>6);
  const long rowbase=(long)b*SEQ_; const int q0=qb*QB;
  const unsigned short*Qw=Q+(rowbase+q0+wid*QBLK)*QPITCH+h*96;
  const unsigned short*Kh=KV+rowbase*KVPITCH+h*128,*Vh=Kh+64,*KRb=KR+rowbase*KRPITCH;
  const unsigned lds0=(unsigned)(uintptr_t)shm;
  float*wsf=(float*)(shm+LDS_WS)+wid*64;
  const unsigned short*ksrc0=Kh+(long)lane*KVPITCH+wid*8;
  const unsigned short*ksrc1=KRb+(long)lane*KRPITCH+(wid&3)*8;
  const unsigned short*vsrc=Vh+(long)(16*(wid&3)+(lane>>2))*KVPITCH+(wid>>2)*32+(lane&3)*8;
  const unsigned kdst0=lds0+LDS_K+wid*1024,kdst1=lds0+LDS_K+(8+(wid&3))*1024,vdst=lds0+LDS_V+wid*1024;
  #define DMA_T(t,sl) do{ glds16(ksrc0+(long)(t)*KVBLK*KVPITCH,(unsigned)__builtin_amdgcn_readfirstlane(kdst0+(sl)*KSLOT)); \
                          glds16(ksrc1+(long)(t)*KVBLK*KRPITCH,(unsigned)__builtin_amdgcn_readfirstlane(kdst1+(sl)*KSLOT)); \
                          glds16(vsrc+(long)(t)*KVBLK*KVPITCH,(unsigned)__builtin_amdgcn_readfirstlane(vdst+(sl)*VSLOT)); }while(0)
  const int vb0=(int)(lds0+LDS_V)+((lane>>4)&1)*32+(lane&3)*8+(4*hi+((lane&15)>>2))*64;
  const lds_cptr shm3=(lds_cptr)(__attribute__((address_space(3))) char*)shm;
  const int NT=(q0+QB)/KVBLK;
  bf16x8 qr[6];
  #pragma unroll
  for(int d0=0;d0<6;++d0)qr[d0]=*reinterpret_cast<const bf16x8*>(&Qw[(long)r32*QPITCH+d0*16+hi*8]);
  {
    const float*cp=COS+(rowbase+q0+wid*QBLK+r32)*16+hi*8,*sp=SIN+(rowbase+q0+wid*QBLK+r32)*16+hi*8;
    float cs[8],sn[8];
    #pragma unroll
    for(int j=0;j<8;++j){cs[j]=cp[j];sn[j]=sp[j];}
    const float sc=0.10206207261596577f*1.4426950408889634f;
    float x1[8],x2[8];
    #pragma unroll
    for(int j=0;j<8;++j){x1[j]=__uint_as_float(((unsigned)(unsigned short)qr[4][j])<<16);x2[j]=__uint_as_float(((unsigned)(unsigned short)qr[5][j])<<16);}
    #pragma unroll
    for(int j=0;j<8;j+=2){
      const unsigned a=cvtpk_s((x1[j]*cs[j]-x2[j]*sn[j])*sc,(x1[j+1]*cs[j+1]-x2[j+1]*sn[j+1])*sc), c=cvtpk_s((x2[j]*cs[j]+x1[j]*sn[j])*sc,(x2[j+1]*cs[j+1]+x1[j+1]*sn[j+1])*sc);
      qr[4][j]=(short)(a&0xffffu);qr[4][j+1]=(short)(a>>16);qr[5][j]=(short)(c&0xffffu);qr[5][j+1]=(short)(c>>16);}
    #pragma unroll
    for(int d0=0;d0<4;++d0)
      #pragma unroll
      for(int j=0;j<8;j+=2){const unsigned a=cvtpk_s(__uint_as_float(((unsigned)(unsigned short)qr[d0][j])<<16)*sc,__uint_as_float(((unsigned)(unsigned short)qr[d0][j+1])<<16)*sc);
        qr[d0][j]=(short)(a&0xffffu);qr[d0][j+1]=(short)(a>>16);}
  }
  asm volatile("s_waitcnt vmcnt(0)":::"memory");
  DMA_T(0,0); DMA_T(1,1);
  float mhat=0.f,l_reg=0.f;f32x16 o[2];o[0]=f32x16{};o[1]=f32x16{};f32x16 negm=f32x16{};
  const int qrel=wid*QBLK+r32;
  int sl=0;
  for(int t=0;t<NT;++t){
    if(t+1<NT){MLA_WAIT_BAR(3);}else{MLA_WAIT_BAR(0);}
    if(t+2<NT){const int s2=(sl==0)?2:sl-1; DMA_T(t+2,s2);}
    f32x16 p0,p1;
    qkt6(p0,p1,shm3+LDS_K+sl*KSLOT,qr,negm,r32,hi);
    if(t>=NT-4)cmask(p0,p1,t-(NT-4),qrel,hi);
    const float rm=rowmax(p0,p1);
    bool resc=false;
    if(t==0){ const float dl=rm; mhat+=dl;
      #pragma unroll
      for(int r=0;r<16;++r){p0[r]-=dl;p1[r]-=dl;}
      #pragma unroll
      for(int r=0;r<16;++r)negm[r]=-mhat;
    } else if(__any(rm>(float)THRL)){ const float dl=__builtin_fmaxf(rm,0.f); mhat+=dl;
      #pragma unroll
      for(int r=0;r<16;++r){p0[r]-=dl;p1[r]-=dl;}
      #pragma unroll
      for(int r=0;r<16;++r)negm[r]=-mhat;
      const float f=__builtin_amdgcn_exp2f(-dl); l_reg*=f; if(hi==0)wsf[r32]=f; resc=true; }
    float sacc=0.f;
    #pragma unroll
    for(int r=0;r<16;++r){p0[r]=__builtin_amdgcn_exp2f(p0[r]);p1[r]=__builtin_amdgcn_exp2f(p1[r]);sacc+=p0[r]+p1[r];}
    l_reg+=sacc;
    if(resc){ asm volatile("s_waitcnt lgkmcnt(0)":::"memory");
      #pragma unroll
      for(int d_=0;d_<2;++d_)
        #pragma unroll
        for(int r=0;r<16;++r)o[d_][r]*=wsf[crow(r,hi)]; }
    u32x4 pw0,pw1,pw2,pw3;
    pw0=(u32x4){cvtpk_s(p0[0],p0[1]),cvtpk_s(p0[2],p0[3]),cvtpk_s(p0[4],p0[5]),cvtpk_s(p0[6],p0[7])};
    pw1=(u32x4){cvtpk_s(p0[8],p0[9]),cvtpk_s(p0[10],p0[11]),cvtpk_s(p0[12],p0[13]),cvtpk_s(p0[14],p0[15])};
    pw2=(u32x4){cvtpk_s(p1[0],p1[1]),cvtpk_s(p1[2],p1[3]),cvtpk_s(p1[4],p1[5]),cvtpk_s(p1[6],p1[7])};
    pw3=(u32x4){cvtpk_s(p1[8],p1[9]),cvtpk_s(p1[10],p1[11]),cvtpk_s(p1[12],p1[13]),cvtpk_s(p1[14],p1[15])};
    pv(o,vb0+sl*VSLOT,__builtin_bit_cast(bf16x8,pw0),__builtin_bit_cast(bf16x8,pw1),__builtin_bit_cast(bf16x8,pw2),__builtin_bit_cast(bf16x8,pw3));
    sl=(sl==2)?0:sl+1;
  }
  {auto rr=__builtin_amdgcn_permlane32_swap(__float_as_uint(l_reg),__float_as_uint(l_reg),false,false);l_reg=__uint_as_float(rr[0])+__uint_as_float(rr[1]);}
  if(hi==0)wsf[32+r32]=l_reg;asm volatile("s_waitcnt lgkmcnt(0)":::"memory");
  float rli[16];
  #pragma unroll
  for(int r=0;r<16;++r)rli[r]=__builtin_amdgcn_rcpf(wsf[32+crow(r,hi)]);
  unsigned short*Ow=O+(rowbase+q0+wid*QBLK)*OPITCH+h*64;
  { unsigned short*stg=(unsigned short*)(shm+LDS_OST)+wid*2048;
    #pragma unroll
    for(int r=0;r<16;++r){const int orow=crow(r,hi);
      #pragma unroll
      for(int d0=0;d0<2;++d0)stg[orow*64+d0*32+r32]=(unsigned short)(cvtpk_s(o[d0][r]*rli[r],0.f)&0xffffu);}
    asm volatile("s_waitcnt lgkmcnt(0)":::"memory");
    #pragma unroll
    for(int i=0;i<4;++i){const int row=i*8+(lane>>3),ch=lane&7; const u32x4 v=*(const u32x4*)(stg+row*64+ch*8); *(u32x4*)(Ow+(long)row*OPITCH+ch*8)=v;} }
  asm volatile("s_waitcnt vmcnt(0) lgkmcnt(0)\n\ts_barrier":::"memory");
  #undef DMA_T
}

typedef short v4i16_t __attribute__((ext_vector_type(4)));
__device__ __forceinline__ s16x4 vtr(lds_cptr p){ return __builtin_bit_cast(s16x4,__builtin_amdgcn_ds_read_tr16_b64_v4i16((__attribute__((address_space(3))) v4i16_t*)p)); }
template<int THRL> __device__ __forceinline__ void attn_unit2(int b,int h,int qb,const unsigned short*Q,const unsigned short*KV,const unsigned short*KR,const float*COS,const float*SIN,unsigned short*O,char*shm){
  const int tid=threadIdx.x,lane=tid&63,r32=lane&31,hi=lane>>5; const int wid=__builtin_amdgcn_readfirstlane(tid>>6);
  const long rowbase=(long)b*SEQ_; const int q0=qb*QB;
  const unsigned short*Qw=Q+(rowbase+q0+wid*QBLK)*QPITCH+h*96;
  const unsigned short*Kh=KV+rowbase*KVPITCH+h*128,*Vh=Kh+64,*KRb=KR+rowbase*KRPITCH;
  const unsigned lds0=(unsigned)(uintptr_t)shm;
  float*wsf=(float*)(shm+LDS_WS)+wid*64;
  const unsigned koff0=(unsigned)(lane*KVPITCH+wid*8)*2u, koff1=(unsigned)(lane*KRPITCH+(wid&3)*8)*2u, voffv=(unsigned)((16*(wid&3)+(lane>>2))*KVPITCH+(wid>>2)*32+(lane&3)*8)*2u;
  const unsigned kdst0=lds0+LDS_K+wid*1024,kdst1=lds0+LDS_K+(8+(wid&3))*1024,vdst=lds0+LDS_V+wid*1024;
  #define DMA_K2(t,sl) do{ glds16s(Kh+(long)(t)*KVBLK*KVPITCH,koff0,(unsigned)__builtin_amdgcn_readfirstlane(kdst0+(sl)*KSLOT)); \
                           glds16s(KRb+(long)(t)*KVBLK*KRPITCH,koff1,(unsigned)__builtin_amdgcn_readfirstlane(kdst1+(sl)*KSLOT)); }while(0)
  #define DMA_V2(t,sl) glds16s(Vh+(long)(t)*KVBLK*KVPITCH,voffv,(unsigned)__builtin_amdgcn_readfirstlane(vdst+(sl)*VSLOT))
  const lds_cptr shm3=(lds_cptr)(__attribute__((address_space(3))) char*)shm;
  const lds_cptr vp0=shm3+LDS_V+((lane>>4)&1)*32+(lane&3)*8+(4*hi+((lane&15)>>2))*64;
  const int NT=(q0+QB)/KVBLK;
  DMA_K2(0,0); DMA_V2(0,0); DMA_K2(1,1);
  bf16x8 qr[6];
  #pragma unroll
  for(int d0=0;d0<6;++d0)qr[d0]=*reinterpret_cast<const bf16x8*>(&Qw[(long)r32*QPITCH+d0*16+hi*8]);
  { const float*cp=COS+(rowbase+q0+wid*QBLK+r32)*16+hi*8,*sp=SIN+(rowbase+q0+wid*QBLK+r32)*16+hi*8;
    float cs[8],sn[8];
    #pragma unroll
    for(int j=0;j<8;++j){cs[j]=cp[j];sn[j]=sp[j];}
    const float sc=0.10206207261596577f*1.4426950408889634f;
    float x1[8],x2[8];
    #pragma unroll
    for(int j=0;j<8;++j){x1[j]=__uint_as_float(((unsigned)(unsigned short)qr[4][j])<<16);x2[j]=__uint_as_float(((unsigned)(unsigned short)qr[5][j])<<16);}
    #pragma unroll
    for(int j=0;j<8;j+=2){
      const unsigned a=cvtpk_s((x1[j]*cs[j]-x2[j]*sn[j])*sc,(x1[j+1]*cs[j+1]-x2[j+1]*sn[j+1])*sc), c=cvtpk_s((x2[j]*cs[j]+x1[j]*sn[j])*sc,(x2[j+1]*cs[j+1]+x1[j+1]*sn[j+1])*sc);
      qr[4][j]=(short)(a&0xffffu);qr[4][j+1]=(short)(a>>16);qr[5][j]=(short)(c&0xffffu);qr[5][j+1]=(short)(c>>16);}
    #pragma unroll
    for(int d0=0;d0<4;++d0)
      #pragma unroll
      for(int j=0;j<8;j+=2){const unsigned a=cvtpk_s(__uint_as_float(((unsigned)(unsigned short)qr[d0][j])<<16)*sc,__uint_as_float(((unsigned)(unsigned short)qr[d0][j+1])<<16)*sc);
        qr[d0][j]=(short)(a&0xffffu);qr[d0][j+1]=(short)(a>>16);}
  }
  float mhat=0.f,l_reg=0.f;f32x16 o[2];o[0]=f32x16{};o[1]=f32x16{};f32x16 negm=f32x16{};
  const int qrel=wid*QBLK+r32;
  f32x16 p0,p1;
  MLA_WAIT_BAR(3);
  DMA_K2(2,2); DMA_V2(1,1);
  qkt6(p0,p1,shm3+LDS_K,qr,negm,r32,hi);
  if(NT==4)cmask(p0,p1,0,qrel,hi);
  { const float dl=rowmax(p0,p1); mhat+=dl;
    #pragma unroll
    for(int r=0;r<16;++r){p0[r]=__builtin_amdgcn_exp2f(p0[r]-dl);p1[r]=__builtin_amdgcn_exp2f(p1[r]-dl);}
    #pragma unroll
    for(int r=0;r<16;++r)negm[r]=-mhat; }
  int sk=1,sv=0;
  for(int t=1;t<NT;++t){
    if(t+1<NT){MLA_WAIT_BAR(3);}else{MLA_WAIT_BAR(1);}
    if(t+2<NT){DMA_K2(t+2,(sk==0)?2:sk-1);}
    if(t+1<NT){DMA_V2(t+1,(sv==0)?2:sv-1);}
    f32x16 c0,c1;
    s16x4 vlo[8],vhi[8];
    u32x4 pwa[4];
    float sacc=0.f;
    const lds_cptr vp_=vp0+sv*VSLOT;
    const lds_cptr kbp=shm3+LDS_K+sk*KSLOT+hi*1024+r32*16;
    #define SB_() __builtin_amdgcn_sched_barrier(0)
    #define PINV(x) asm volatile("":"+v"(x))
    #define KF(g) (*(const __attribute__((address_space(3))) bf16x8*)(kbp+((g)>>1)*2048+((g)&1)*512))
    #define PFLAT(i) ((i)<16?p0[(i)&15]:p1[(i)&15])
    #define VRD_(i) do{ vlo[i]=vtr(vp_+(((i)>>2)*4096+((i)&3)*1024)); vhi[i]=vtr(vp_+(((i)>>2)*4096+((i)&3)*1024+512)); }while(0)
    #define FILL(i) do{ if(((i)&3)<2){VRD_(i);} \
        sacc+=(PFLAT(4*(i))+PFLAT(4*(i)+1))+(PFLAT(4*(i)+2)+PFLAT(4*(i)+3)); PINV(sacc); \
        pwa[(i)>>1][2*((i)&1)]=cvtpk_s(PFLAT(4*(i)),PFLAT(4*(i)+1)); pwa[(i)>>1][2*((i)&1)+1]=cvtpk_s(PFLAT(4*(i)+2),PFLAT(4*(i)+3)); PINV(pwa[(i)>>1]); }while(0)
    bf16x8 k0=KF(0),k1=KF(1),k2=KF(2),k3=KF(3);
    SB_();
    c0=__builtin_amdgcn_mfma_f32_32x32x16_bf16(k0,qr[0],negm,0,0,0); k0=KF(4);  FILL(0); SB_();
    c1=__builtin_amdgcn_mfma_f32_32x32x16_bf16(k1,qr[0],negm,0,0,0); k1=KF(5);  FILL(1); SB_();
    c0=__builtin_amdgcn_mfma_f32_32x32x16_bf16(k2,qr[1],c0,0,0,0);   k2=KF(6);  FILL(2); SB_();
    c1=__builtin_amdgcn_mfma_f32_32x32x16_bf16(k3,qr[1],c1,0,0,0);   k3=KF(7);  FILL(3); SB_();
    c0=__builtin_amdgcn_mfma_f32_32x32x16_bf16(k0,qr[2],c0,0,0,0);   k0=KF(8);  FILL(4); SB_();
    c1=__builtin_amdgcn_mfma_f32_32x32x16_bf16(k1,qr[2],c1,0,0,0);   k1=KF(9);  FILL(5); SB_();
    c0=__builtin_amdgcn_mfma_f32_32x32x16_bf16(k2,qr[3],c0,0,0,0);   k2=KF(10); FILL(6); SB_();
    c1=__builtin_amdgcn_mfma_f32_32x32x16_bf16(k3,qr[3],c1,0,0,0);   k3=KF(11); FILL(7); SB_();
    c0=__builtin_amdgcn_mfma_f32_32x32x16_bf16(k0,qr[4],c0,0,0,0);
    c1=__builtin_amdgcn_mfma_f32_32x32x16_bf16(k1,qr[4],c1,0,0,0);
    c0=__builtin_amdgcn_mfma_f32_32x32x16_bf16(k2,qr[5],c0,0,0,0);
    c1=__builtin_amdgcn_mfma_f32_32x32x16_bf16(k3,qr[5],c1,0,0,0);
    SB_();
    l_reg+=sacc;
    if(t>=NT-4)cmask(c0,c1,t-(NT-4),qrel,hi);
    #define VFRG(i) (bf16x8){vlo[i][0],vlo[i][1],vlo[i][2],vlo[i][3],vhi[i][0],vhi[i][1],vhi[i][2],vhi[i][3]}
    #define MX3_(a,b,c) __builtin_fmaxf(__builtin_fmaxf((a),(b)),(c))
    #define EXN(X,B,N) do{ _Pragma("unroll") for(int e_=0;e_<(N);++e_) X[(B)+e_]=__builtin_amdgcn_exp2f(X[(B)+e_]); PINV(X); SB_(); }while(0)
    float ma,mb;
    o[0]=__builtin_amdgcn_mfma_f32_32x32x16_bf16(__builtin_bit_cast(bf16x8,pwa[0]),VFRG(0),o[0],0,0,0);
    ma=MX3_(c0[0],c0[1],c1[0]); mb=MX3_(c0[2],c0[3],c1[1]); ma=MX3_(ma,c1[2],c1[3]);
    ma=MX3_(ma,c0[4],c0[5]); mb=MX3_(mb,c0[6],c0[7]); ma=MX3_(ma,c1[4],c1[5]); mb=MX3_(mb,c1[6],c1[7]); PINV(ma); PINV(mb); VRD_(2); VRD_(6); SB_();
    o[1]=__builtin_amdgcn_mfma_f32_32x32x16_bf16(__builtin_bit_cast(bf16x8,pwa[0]),VFRG(4),o[1],0,0,0);
    ma=MX3_(ma,c0[8],c0[9]); mb=MX3_(mb,c0[10],c0[11]); ma=MX3_(ma,c1[8],c1[9]); mb=MX3_(mb,c1[10],c1[11]);
    ma=MX3_(ma,c0[12],c0[13]); mb=MX3_(mb,c0[14],c0[15]); ma=MX3_(ma,c1[12],c1[13]); mb=MX3_(mb,c1[14],c1[15]);
    float rm=__builtin_fmaxf(ma,mb);
    { auto rr=__builtin_amdgcn_permlane32_swap(__float_as_uint(rm),__float_as_uint(rm),false,false); rm=__builtin_fmaxf(__uint_as_float(rr[0]),__uint_as_float(rr[1])); }
    PINV(rm); VRD_(3); VRD_(7); SB_();
    bool resc=false;
    if(__any(rm>(float)THRL)){ const float dl=__builtin_fmaxf(rm,0.f); mhat+=dl;
      #pragma unroll
      for(int r=0;r<16;++r){c0[r]-=dl;c1[r]-=dl;}
      #pragma unroll
      for(int r=0;r<16;++r)negm[r]=-mhat;
      const float f=__builtin_amdgcn_exp2f(-dl); l_reg*=f; if(hi==0)wsf[r32]=f; resc=true; }
    SB_();
    o[0]=__builtin_amdgcn_mfma_f32_32x32x16_bf16(__builtin_bit_cast(bf16x8,pwa[1]),VFRG(1),o[0],0,0,0); EXN(c0,0,5);
    o[1]=__builtin_amdgcn_mfma_f32_32x32x16_bf16(__builtin_bit_cast(bf16x8,pwa[1]),VFRG(5),o[1],0,0,0); EXN(c0,5,5);
    o[0]=__builtin_amdgcn_mfma_f32_32x32x16_bf16(__builtin_bit_cast(bf16x8,pwa[2]),VFRG(2),o[0],0,0,0); EXN(c0,10,6);
    o[1]=__builtin_amdgcn_mfma_f32_32x32x16_bf16(__builtin_bit_cast(bf16x8,pwa[2]),VFRG(6),o[1],0,0,0); EXN(c1,0,5);
    o[0]=__builtin_amdgcn_mfma_f32_32x32x16_bf16(__builtin_bit_cast(bf16x8,pwa[3]),VFRG(3),o[0],0,0,0); EXN(c1,5,5);
    o[1]=__builtin_amdgcn_mfma_f32_32x32x16_bf16(__builtin_bit_cast(bf16x8,pwa[3]),VFRG(7),o[1],0,0,0); EXN(c1,10,6);
    #undef MX3_
    #undef EXN
    p0=c0; p1=c1;
    #undef KF
    #undef FILL
    #undef VRD_
    if(resc){ asm volatile("s_waitcnt lgkmcnt(0)":::"memory");
      #pragma unroll
      for(int d_=0;d_<2;++d_)
        #pragma unroll
        for(int r=0;r<16;++r)o[d_][r]*=wsf[crow(r,hi)]; }
    sk=(sk==2)?0:sk+1; sv=(sv==2)?0:sv+1;
  }
  MLA_WAIT_BAR(0);
  { s16x4 vlo[8],vhi[8]; const lds_cptr vp_=vp0+sv*VSLOT;
    #pragma unroll
    for(int i=0;i<8;++i){ vlo[i]=vtr(vp_+((i>>2)*4096+(i&3)*1024)); vhi[i]=vtr(vp_+((i>>2)*4096+(i&3)*1024+512)); }
    float sacc=0.f;
    #pragma unroll
    for(int r=0;r<16;++r)sacc+=p0[r]+p1[r];
    l_reg+=sacc;
    u32x4 pw0,pw1,pw2,pw3;
    pw0=(u32x4){cvtpk_s(p0[0],p0[1]),cvtpk_s(p0[2],p0[3]),cvtpk_s(p0[4],p0[5]),cvtpk_s(p0[6],p0[7])};
    pw1=(u32x4){cvtpk_s(p0[8],p0[9]),cvtpk_s(p0[10],p0[11]),cvtpk_s(p0[12],p0[13]),cvtpk_s(p0[14],p0[15])};
    pw2=(u32x4){cvtpk_s(p1[0],p1[1]),cvtpk_s(p1[2],p1[3]),cvtpk_s(p1[4],p1[5]),cvtpk_s(p1[6],p1[7])};
    pw3=(u32x4){cvtpk_s(p1[8],p1[9]),cvtpk_s(p1[10],p1[11]),cvtpk_s(p1[12],p1[13]),cvtpk_s(p1[14],p1[15])};
    o[0]=__builtin_amdgcn_mfma_f32_32x32x16_bf16(__builtin_bit_cast(bf16x8,pw0),VFRG(0),o[0],0,0,0);
    o[1]=__builtin_amdgcn_mfma_f32_32x32x16_bf16(__builtin_bit_cast(bf16x8,pw0),VFRG(4),o[1],0,0,0);
    o[0]=__builtin_amdgcn_mfma_f32_32x32x16_bf16(__builtin_bit_cast(bf16x8,pw1),VFRG(1),o[0],0,0,0);
    o[1]=__builtin_amdgcn_mfma_f32_32x32x16_bf16(__builtin_bit_cast(bf16x8,pw1),VFRG(5),o[1],0,0,0);
    o[0]=__builtin_amdgcn_mfma_f32_32x32x16_bf16(__builtin_bit_cast(bf16x8,pw2),VFRG(2),o[0],0,0,0);
    o[1]=__builtin_amdgcn_mfma_f32_32x32x16_bf16(__builtin_bit_cast(bf16x8,pw2),VFRG(6),o[1],0,0,0);
    o[0]=__builtin_amdgcn_mfma_f32_32x32x16_bf16(__builtin_bit_cast(bf16x8,pw3),VFRG(3),o[0],0,0,0);
    o[1]=__builtin_amdgcn_mfma_f32_32x32x16_bf16(__builtin_bit_cast(bf16x8,pw3),VFRG(7),o[1],0,0,0);
    #undef VFRG
  }
  {auto rr=__builtin_amdgcn_permlane32_swap(__float_as_uint(l_reg),__float_as_uint(l_reg),false,false);l_reg=__uint_as_float(rr[0])+__uint_as_float(rr[1]);}
  if(hi==0)wsf[32+r32]=l_reg;asm volatile("s_waitcnt lgkmcnt(0)":::"memory");
  float rli[16];
  #pragma unroll
  for(int r=0;r<16;++r)rli[r]=__builtin_amdgcn_rcpf(wsf[32+crow(r,hi)]);
  unsigned short*Ow=O+(rowbase+q0+wid*QBLK)*OPITCH+h*64;
  { unsigned short*stg=(unsigned short*)(shm+LDS_OST)+wid*2048;
    #pragma unroll
    for(int r=0;r<16;++r){const int orow=crow(r,hi);
      #pragma unroll
      for(int d0=0;d0<2;++d0)stg[orow*64+d0*32+r32]=(unsigned short)(cvtpk_s(o[d0][r]*rli[r],0.f)&0xffffu);}
    asm volatile("s_waitcnt lgkmcnt(0)":::"memory");
    #pragma unroll
    for(int i=0;i<4;++i){const int row=i*8+(lane>>3),ch=lane&7; const u32x4 v=*(const u32x4*)(stg+row*64+ch*8); *(u32x4*)(Ow+(long)row*OPITCH+ch*8)=v;} }
  asm volatile("s_waitcnt lgkmcnt(0)\n\ts_barrier":::"memory");
  #undef DMA_K2
  #undef DMA_V2
  #undef PFLAT
  #undef SB_
  #undef PINV
}
}


namespace hg {
typedef float f32x4 __attribute__((ext_vector_type(4)));
typedef short bf16x8 __attribute__((ext_vector_type(8)));
typedef unsigned u32x4 __attribute__((ext_vector_type(4)));
typedef unsigned u32x2 __attribute__((ext_vector_type(2)));
#define HLAS __attribute__((address_space(3)))
constexpr int NSEG = 8, CPS = 64 / NSEG;
constexpr int L_Q = 0, L_F = 16384, L_V = 32768, L_K1T = 49152, L_VT = 67584, L_A = 86016, L_ST = 95232, L_TOT = L_A, L_END = 130048;
constexpr int L_CM = 132096, L_CL = 132608;
constexpr int P144 = 144, P272 = 272;
__device__ __forceinline__ float bf2f_(unsigned short b) { return __uint_as_float((unsigned)b << 16); }
__device__ __forceinline__ unsigned f2bf_(float f) { unsigned u = __float_as_uint(f); return (u + 0x7fffu + ((u >> 16) & 1u)) >> 16; }
__device__ __forceinline__ unsigned pk_(float lo, float hi) { return f2bf_(lo) | (f2bf_(hi) << 16); }
__device__ __forceinline__ int swz(int t, int c) { return t * 256 + ((c ^ (t & 15)) << 4); }
__device__ __forceinline__ int swz_e(int t, int k) { return swz(t, k >> 3) + (k & 7) * 2; }
#define HG_BAR() do { asm volatile("s_waitcnt lgkmcnt(0)" ::: "memory"); __builtin_amdgcn_s_barrier(); asm volatile("" ::: "memory"); } while (0)
#define HG_MFMA(a, b, c) __builtin_amdgcn_mfma_f32_16x16x32_bf16((a), (b), (c), 0, 0, 0)

struct P1Args { const unsigned short* HP; const float* lbp; unsigned short* OL; unsigned short* Q1G; float* WN; float* SS; float* DSEG; };
__device__ __forceinline__ void hg_pass1(HLAS unsigned char* L, const P1Args& a, int G) {
    const int tid = threadIdx.x, lane = tid & 63, w = __builtin_amdgcn_readfirstlane(tid >> 6), r16 = lane & 15, g4 = lane >> 4;
    const int k = tid & 127, tq = tid >> 7;
    for (int u = blockIdx.x; u < 32 * NSEG; u += G) {
        const int bh = u / NSEG, seg = u % NSEG, b = bh >> 3, h = bh & 7;
        const size_t rowseg = (size_t)b * 4096 + (size_t)seg * CPS * 64;
        const float lb = 1.0f / (1.0f + __expf(-(a.lbp[1024 + h * 128 + k] - a.lbp[h * 128 + k])));
        f32x4 S[8];
#pragma unroll
        for (int j = 0; j < 8; ++j) S[j] = (f32x4){0.f, 0.f, 0.f, 0.f};
        float carry = 0.f;
        u32x4 pq[2], pf[2], pv[2];
#define HG_PREFETCH(n_) do { _Pragma("unroll") for (int j = 0; j < 2; ++j) { const int e = tid + 512 * j, t = e >> 4, c = e & 15; \
            const unsigned short* src = a.HP + (rowseg + (size_t)(n_) * 64 + t) * 4096 + h * 128 + 8 * c; \
            pq[j] = *(const u32x4*)src; pf[j] = *(const u32x4*)(src + 1024); pv[j] = *(const u32x4*)(src + 2048); } } while (0)
        HG_PREFETCH(0);
        for (int n = 0; n < CPS; ++n) {
            const size_t row0 = rowseg + (size_t)n * 64;
            HG_BAR();
#pragma unroll
            for (int j = 0; j < 2; ++j) { const int e = tid + 512 * j, t = e >> 4, c = e & 15; const int o = swz(t, c);
                *(HLAS u32x4*)(L + L_Q + o) = pq[j]; *(HLAS u32x4*)(L + L_F + o) = pf[j]; *(HLAS u32x4*)(L + L_V + o) = pv[j]; }
            if (n + 1 < CPS) HG_PREFETCH(n + 1);
            HG_BAR();
            float fv[16], cs[16];
            { float run = 0.f;
#pragma unroll
              for (int i = 0; i < 16; ++i) { const int t = 16 * tq + i; const float x = bf2f_(*(const HLAS unsigned short*)(L + L_F + swz_e(t, k)));
                  const float f = lb + (1.0f - lb) * __builtin_amdgcn_rcpf(1.0f + __expf(-x)); fv[i] = f; run += __logf(f); cs[i] = run; }
              *(HLAS float*)(L + L_TOT + (tq * 128 + k) * 4) = run; }
            HG_BAR();
            { const float t0 = *(const HLAS float*)(L + L_TOT + (0 * 128 + k) * 4), t1 = *(const HLAS float*)(L + L_TOT + (1 * 128 + k) * 4), t2 = *(const HLAS float*)(L + L_TOT + (2 * 128 + k) * 4), t3 = *(const HLAS float*)(L + L_TOT + (3 * 128 + k) * 4);
              const float pre = (tq == 0) ? 0.f : (tq == 1) ? t0 : (tq == 2) ? (t0 + t1) : ((t0 + t1) + t2);
              const float bmid = t0 + t1, blast = (t0 + t1) + (t2 + t3);
              unsigned kt[8], vt[8];
#pragma unroll
              for (int i = 0; i < 16; i += 2) {
                  float q1[2], k1[2];
#pragma unroll
                  for (int d = 0; d < 2; ++d) { const int t = 16 * tq + i + d; const float r = (pre + cs[i + d]) - bmid; const float E1 = __expf(r), iE1 = __builtin_amdgcn_rcpf(E1);
                      const float qs = bf2f_(*(const HLAS unsigned short*)(L + L_Q + swz_e(t, k))) * 0.08838834764831845f;
                      q1[d] = qs * E1; k1[d] = (1.0f - fv[i + d]) * iE1;
                      *(HLAS unsigned short*)(L + L_Q + swz_e(t, k)) = (unsigned short)f2bf_(q1[d]); *(HLAS unsigned short*)(L + L_F + swz_e(t, k)) = (unsigned short)f2bf_(k1[d]); }
                  kt[i >> 1] = pk_(k1[0], k1[1]);
                  vt[i >> 1] = (unsigned)*(const HLAS unsigned short*)(L + L_V + swz_e(16 * tq + i, k)) | ((unsigned)*(const HLAS unsigned short*)(L + L_V + swz_e(16 * tq + i + 1, k)) << 16); }
              *(HLAS u32x4*)(L + L_K1T + k * P144 + tq * 32) = (u32x4){kt[0], kt[1], kt[2], kt[3]}; *(HLAS u32x4*)(L + L_K1T + k * P144 + tq * 32 + 16) = (u32x4){kt[4], kt[5], kt[6], kt[7]};
              *(HLAS u32x4*)(L + L_VT + k * P144 + tq * 32) = (u32x4){vt[0], vt[1], vt[2], vt[3]}; *(HLAS u32x4*)(L + L_VT + k * P144 + tq * 32 + 16) = (u32x4){vt[4], vt[5], vt[6], vt[7]};
              if (tq == 0) { *(HLAS float*)(L + L_CM + k * 4) = __expf(bmid); *(HLAS float*)(L + L_CL + k * 4) = __expf(blast - bmid);
                  a.WN[((size_t)u * CPS + n) * 128 + k] = __expf(bmid + carry); }
              carry += blast; }
            HG_BAR();
            f32x4 cmv, clv;
#pragma unroll
            for (int i = 0; i < 4; ++i) { cmv[i] = *(const HLAS float*)(L + L_CM + (16 * w + 4 * g4 + i) * 4); clv[i] = *(const HLAS float*)(L + L_CL + (16 * w + 4 * g4 + i) * 4); }
#pragma unroll
            for (int j = 0; j < 8; ++j) { S[j] = S[j] * cmv; *(HLAS u32x2*)(L + L_ST + (16 * j + r16) * P272 + (16 * w + 4 * g4) * 2) = (u32x2){pk_(S[j][0], S[j][1]), pk_(S[j][2], S[j][3])}; }
            { const int ct = w >> 1;
#pragma unroll
              for (int q = 0; q < 2; ++q) { const int st = 2 * (w & 1) + q; f32x4 d = (f32x4){0.f, 0.f, 0.f, 0.f};
                  if (st <= ct) {
#pragma unroll
                      for (int ks = 0; ks < 4; ++ks) { const bf16x8 af = *(const HLAS bf16x8*)(L + L_F + swz(16 * st + r16, 4 * ks + g4)), bf = *(const HLAS bf16x8*)(L + L_Q + swz(16 * ct + r16, 4 * ks + g4)); d = HG_MFMA(af, bf, d); }
                      if (st == ct) {
#pragma unroll
                          for (int i = 0; i < 4; ++i) if (4 * g4 + i > r16) d[i] = 0.f; } }
                  *(HLAS u32x2*)(L + L_A + (16 * ct + r16) * P144 + (16 * st + 4 * g4) * 2) = (u32x2){pk_(d[0], d[1]), pk_(d[2], d[3])}; } }
#pragma unroll
            for (int j = 0; j < 2; ++j) { const int e = tid + 512 * j, t = e >> 4, c = e & 15; *(u32x4*)(a.Q1G + (row0 + t) * 1024 + h * 128 + 8 * c) = *(const HLAS u32x4*)(L + L_Q + swz(t, c)); }
            HG_BAR();
#pragma unroll
            for (int ct = 0; ct < 4; ++ct) { f32x4 d = (f32x4){0.f, 0.f, 0.f, 0.f};
#pragma unroll
                for (int ks = 0; ks < 2; ++ks) { if (ks == 1 && ct < 2) continue;
                    const bf16x8 af = *(const HLAS bf16x8*)(L + L_VT + (16 * w + r16) * P144 + (32 * ks + 8 * g4) * 2), bf = *(const HLAS bf16x8*)(L + L_A + (16 * ct + r16) * P144 + (32 * ks + 8 * g4) * 2); d = HG_MFMA(af, bf, d); }
#pragma unroll
                for (int ks = 0; ks < 4; ++ks) { const bf16x8 af = *(const HLAS bf16x8*)(L + L_ST + (16 * w + r16) * P272 + (32 * ks + 8 * g4) * 2), bf = *(const HLAS bf16x8*)(L + L_Q + swz(16 * ct + r16, 4 * ks + g4)); d = HG_MFMA(af, bf, d); }
                *(u32x2*)(a.OL + (row0 + 16 * ct + r16) * 1024 + h * 128 + 16 * w + 4 * g4) = (u32x2){pk_(d[0], d[1]), pk_(d[2], d[3])}; }
#pragma unroll
            for (int j = 0; j < 8; ++j) {
#pragma unroll
                for (int ks = 0; ks < 2; ++ks) { const bf16x8 af = *(const HLAS bf16x8*)(L + L_K1T + (16 * w + r16) * P144 + (32 * ks + 8 * g4) * 2), bf = *(const HLAS bf16x8*)(L + L_VT + (16 * j + r16) * P144 + (32 * ks + 8 * g4) * 2); S[j] = HG_MFMA(af, bf, S[j]); }
                S[j] = S[j] * clv; }
        }
#pragma unroll
        for (int j = 0; j < 8; ++j) *(f32x4*)(a.SS + ((size_t)u * 128 + 16 * j + r16) * 128 + 16 * w + 4 * g4) = S[j];
        if (tq == 0) a.DSEG[(size_t)u * 128 + k] = __expf(carry);
#undef HG_PREFETCH
    }
    HG_BAR();
}

struct P2Args { const unsigned short* HP; const unsigned short* OL; const unsigned short* Q1G; const float* WN; const float* SS; const float* DSEG; const float* gout; unsigned short* HON; };
__device__ __forceinline__ void hg_pass2(HLAS unsigned char* L, const P2Args& a, int G) {
    const int tid = threadIdx.x, lane = tid & 63, w = __builtin_amdgcn_readfirstlane(tid >> 6), r16 = lane & 15, g4 = lane >> 4;
    HLAS float* SSQ = (HLAS float*)(L + L_TOT);
    f32x4 gn;
#pragma unroll
    for (int i = 0; i < 4; ++i) gn[i] = a.gout[16 * w + 4 * g4 + i];
    for (int u = blockIdx.x; u < 32 * NSEG; u += G) {
        const int bh = u / NSEG, seg = u % NSEG, b = bh >> 3, h = bh & 7;
        const size_t rowseg = (size_t)b * 4096 + (size_t)seg * CPS * 64;
        const size_t colw = (size_t)h * 128 + 16 * w + 4 * g4;
        u32x2 pol[4], pg[4]; u32x4 pq[2]; f32x4 pwn = (f32x4){0.f, 0.f, 0.f, 0.f};
#define HG2_PREFETCH(n_) do { const size_t r0_ = rowseg + (size_t)(n_) * 64; \
            _Pragma("unroll") for (int ct = 0; ct < 4; ++ct) { const size_t row = r0_ + 16 * ct + r16; pol[ct] = *(const u32x2*)(a.OL + row * 1024 + colw); pg[ct] = *(const u32x2*)(a.HP + row * 4096 + 3072 + colw); } \
            if (seg > 0) { _Pragma("unroll") for (int j = 0; j < 2; ++j) { const int e = tid + 512 * j, t = e >> 4, c = e & 15; pq[j] = *(const u32x4*)(a.Q1G + (r0_ + t) * 1024 + h * 128 + 8 * c); } \
                           pwn = *(const f32x4*)(a.WN + ((size_t)u * CPS + (n_)) * 128 + 16 * w + 4 * g4); } } while (0)
        HG2_PREFETCH(0);
        f32x4 Sin[8];
#pragma unroll
        for (int j = 0; j < 8; ++j) Sin[j] = (f32x4){0.f, 0.f, 0.f, 0.f};
        for (int i = 0; i < seg; ++i) { const size_t ui = (size_t)bh * NSEG + i; const f32x4 dv = *(const f32x4*)(a.DSEG + ui * 128 + 16 * w + 4 * g4);
#pragma unroll
            for (int j = 0; j < 8; ++j) Sin[j] = Sin[j] * dv + *(const f32x4*)(a.SS + (ui * 128 + 16 * j + r16) * 128 + 16 * w + 4 * g4); }
        for (int n = 0; n < CPS; ++n) {
            const size_t row0 = rowseg + (size_t)n * 64;
            HG_BAR();
            u32x2 ol[4], gg[4];
#pragma unroll
            for (int ct = 0; ct < 4; ++ct) { ol[ct] = pol[ct]; gg[ct] = pg[ct]; }
            if (seg > 0) {
#pragma unroll
                for (int j = 0; j < 8; ++j) { const f32x4 t = Sin[j] * pwn; *(HLAS u32x2*)(L + L_ST + (16 * j + r16) * P272 + (16 * w + 4 * g4) * 2) = (u32x2){pk_(t[0], t[1]), pk_(t[2], t[3])}; }
#pragma unroll
                for (int j = 0; j < 2; ++j) { const int e = tid + 512 * j, t = e >> 4, c = e & 15; *(HLAS u32x4*)(L + L_Q + swz(t, c)) = pq[j]; } }
            if (n + 1 < CPS) HG2_PREFETCH(n + 1);
            HG_BAR();
            f32x4 o[4];
#pragma unroll
            for (int ct = 0; ct < 4; ++ct) {
                f32x4 d = (f32x4){bf2f_((unsigned short)(ol[ct].x & 0xffffu)), bf2f_((unsigned short)(ol[ct].x >> 16)), bf2f_((unsigned short)(ol[ct].y & 0xffffu)), bf2f_((unsigned short)(ol[ct].y >> 16))};
                if (seg > 0) {
#pragma unroll
                    for (int ks = 0; ks < 4; ++ks) { const bf16x8 af = *(const HLAS bf16x8*)(L + L_ST + (16 * w + r16) * P272 + (32 * ks + 8 * g4) * 2), bf = *(const HLAS bf16x8*)(L + L_Q + swz(16 * ct + r16, 4 * ks + g4)); d = HG_MFMA(af, bf, d); } }
                o[ct] = d;
                float p = (d[0] * d[0] + d[1] * d[1]) + (d[2] * d[2] + d[3] * d[3]); p += __shfl_xor(p, 16); p += __shfl_xor(p, 32);
                if (g4 == 0) SSQ[w * 64 + 16 * ct + r16] = p; }
            HG_BAR();
#pragma unroll
            for (int ct = 0; ct < 4; ++ct) { float tot = 0.f;
#pragma unroll
                for (int ww = 0; ww < 8; ++ww) tot += SSQ[ww * 64 + 16 * ct + r16];
                const float rs = 1.0f / sqrtf(tot * (1.0f / 128.0f) + 1e-6f);
                const size_t row = row0 + 16 * ct + r16;
                const float g0 = bf2f_((unsigned short)(gg[ct].x & 0xffffu)), g1 = bf2f_((unsigned short)(gg[ct].x >> 16)), g2 = bf2f_((unsigned short)(gg[ct].y & 0xffffu)), g3 = bf2f_((unsigned short)(gg[ct].y >> 16));
                const float s0 = g0 * __builtin_amdgcn_rcpf(1.0f + __expf(-g0)), s1 = g1 * __builtin_amdgcn_rcpf(1.0f + __expf(-g1)), s2 = g2 * __builtin_amdgcn_rcpf(1.0f + __expf(-g2)), s3 = g3 * __builtin_amdgcn_rcpf(1.0f + __expf(-g3));
                *(u32x2*)(a.HON + row * 1024 + colw) = (u32x2){pk_(o[ct][0] * rs * gn[0] * s0, o[ct][1] * rs * gn[1] * s1), pk_(o[ct][2] * rs * gn[2] * s2, o[ct][3] * rs * gn[3] * s3)}; }
        }
#undef HG2_PREFETCH
    }
    HG_BAR();
}
}

struct MoeSplitOrder {
    volatile LAS int* mt; int nN, G, c, nitems;
    __device__ __forceinline__ void init(volatile LAS int* mt_, int nN_, int G_, int c_) { mt = mt_; nN = nN_; G = G_; c = c_; const int T = mt_[8]; nitems = (T > 128 ? T - 128 : 0) * nN_ * 7; }
    __device__ __forceinline__ bool next(int i, pg8::Unit& u) const {
        const int Lx = i * G + c; if (Lx >= nitems) return false;
        const int ks = Lx % 7, r = Lx / 7, pnl = r % nN, tile = 128 + r / nN;
        int e = 0;
#pragma unroll
        for (int j = 1; j < 8; ++j) e += (tile >= mt[j]) ? 1 : 0;
        u.pm = tile; u.pn = e * nN + pnl; u.kb = ks * 1024; return true;
    }
    __device__ __forceinline__ void a_ready(const pg8::Unit&) const {}
    __device__ __forceinline__ void done(const pg8::Unit&) const {}
    __device__ __forceinline__ int arow(const pg8::Unit&, int) const { return 0; }
    __device__ __forceinline__ void issue_rows(const pg8::Unit&, int, int, int) const {}
    __device__ __forceinline__ int arow_lds(int, int) const { return 0; }
};

struct Args { const float* in[22]; const int* pos; float* out; unsigned char* ws; int ph_lo, ph_hi, li, pad; };

__global__ void __launch_bounds__(NWAVES * 64, 2) fwd_kernel(Args args) {
    extern __shared__ __attribute__((aligned(16))) unsigned char lds[];
    LAS unsigned char* L = (LAS unsigned char*)lds;
    volatile LAS unsigned* MISC = (volatile LAS unsigned*)(L + MISC_OFF);
    const int tid = threadIdx.x, lane = tid & 63, wave = __builtin_amdgcn_readfirstlane(tid >> 6);
    const int G = gridDim.x;
    const int gw = blockIdx.x * NWAVES + wave, NGW = G * NWAVES;
    unsigned char* ws = args.ws;
    gu32* ctl = (gu32*)(ws + WS_CTL);
    for (int u = tid; u < (LDS_BYTES - LDSCTL_OFF) / 4; u += NWAVES * 64) ((LAS unsigned*)(L + LDSCTL_OFF))[u] = 0u;
    __syncthreads();
    XcdBarrier bar; bar.bar = (unsigned*)(ctl + CW_BAR); bar.x = 0; bar.st = nullptr;
    if (N_LAUNCHES == 1) bar = xcd_barrier_post((unsigned*)(ctl + CW_BAR) + args.li * XCD_BAR_WORDS, MISC + 8);
#define GRID_BAR() do { if (N_LAUNCHES == 1) xcd_barrier(bar); } while (0)
#if defined(DIAG_STAMP) || defined(AMP_A)
    unsigned long long* const ts_ = (unsigned long long*)(ws + WS_STAMP);
#define STAMP(k) do { if (blockIdx.x == 0 && tid == 0) ts_[(k)] = __builtin_amdgcn_s_memrealtime(); } while (0)
    STAMP(0);
#else
#define STAMP(k) do { } while (0)
#endif
    const int lo = args.ph_lo, hi = args.ph_hi;
#define IN(k) (lo <= (k) && (k) < hi)
#define BOTH(k) (IN(k) && IN((k) + 1))
    const float* x = args.in[0];
    bf16* H = (bf16*)args.out; constexpr int HPITCH = 2048;

    if (IN(0)) {
        LAS float* scr = (LAS float*)(L + RING_OFF + wave * 16384);
        constexpr int I_MOE = (1024 / 64) * (3584 / 32);
        constexpr int NITEMS = 16 * 21 + 6 * 48 + 4 * 64 + 16 * 32 + 2 * 1792 + 1792 + 16 * 128 + 16 * 32 + 24 * I_MOE;
        auto job_of = [&](int it) -> TrJob {
            int r = it; TrJob j;
            if (r < 8 * I_MOE) { const int e = r / I_MOE; j = TrJob{args.in[19] + (size_t)e * 1024 * 3584, (bf16*)(ws + WS_WMGU) + (size_t)e * 7168 * 1024, 1024, 3584, 1, r % I_MOE}; return j; } r -= 8 * I_MOE;
            if (r < 8 * I_MOE) { const int e = r / I_MOE; j = TrJob{args.in[20] + (size_t)e * 1024 * 3584, (bf16*)(ws + WS_WMGU) + (size_t)e * 7168 * 1024, 1024, 3584, 2, r % I_MOE}; return j; } r -= 8 * I_MOE;
            if (r < 8 * I_MOE) { const int e = r / I_MOE; j = TrJob{args.in[21] + (size_t)e * 3584 * 1024, (bf16*)(ws + WS_WMDN) + (size_t)e * 1024 * 3584, 3584, 1024, 0, r % I_MOE}; return j; } r -= 8 * I_MOE;
#define JOB(W, K_, N_, WT, mode) { const int ni = ((K_) / 64) * ((N_) / 32); if (r < ni) { j = TrJob{(W), (bf16*)(ws + (WT)), (K_), (N_), (mode), r}; return j; } r -= ni; }
            JOB(args.in[5], 1024, 672, WS_WMLAIN, 0)
            JOB(args.in[7], 384, 1536, WS_WQUP, 0)
            JOB(args.in[9], 256, 2048, WS_WKVUP, 0)
            JOB(args.in[10], 1024, 1024, WS_WO0, 0)
            JOB(args.in[15], 1024, 3584, WS_WFGU, 1)
            JOB(args.in[16], 1024, 3584, WS_WFGU, 2)
            JOB(args.in[17], 3584, 1024, WS_WFDN, 0)
            JOB(args.in[11], 1024, 4096, WS_WHIN, 0)
#undef JOB
            j = TrJob{args.in[14], (bf16*)(ws + WS_WHO), 1024, 1024, 0, r}; return j; };
        if (gw < NITEMS) {
            TrJob jc = job_of(gw); float vc[32]; tr_load(jc, vc, lane);
            for (int it = gw; it < NITEMS; it += NGW) {
                const bool hn = it + NGW < NITEMS; TrJob jn = jc; float vn[32];
                if (hn) { jn = job_of(it + NGW); tr_load(jn, vn, lane); }
                tr_finish(jc, vc, scr, lane);
                if (hn) { jc = jn;
#pragma unroll
                    for (int i = 0; i < 32; ++i) vc[i] = vn[i]; }
            }
        }
        { v4u* z = (v4u*)((bf16*)(ws + WS_WMLAIN) + (size_t)MLA_IN * 1024); const int n16 = (MLA_INP - MLA_IN) * 1024 * 2 / 16;
          for (int i = blockIdx.x * NWAVES * 64 + tid; i < n16; i += G * NWAVES * 64) z[i] = (v4u){0u, 0u, 0u, 0u}; }
        rms_rows_to_bf16(x, args.in[2], (bf16*)(ws + WS_HN), gw, NGW, M, lane);
        if (BOTH(0)) GRID_BAR(); STAMP(1);
    }
    if (IN(1)) {
        pg8::Gemm g{(const bf16*)(ws + WS_HN), (const bf16*)(ws + WS_WMLAIN), M, MLA_INP, 1024, 1024}; pg8::StaticOrder S; S.init(M, MLA_INP, G, (int)blockIdx.x);
        pg8::EpiStoreBf16 E{(bf16*)(ws + WS_PROJ), MLA_INP, MLA_INP / 256};
        pg8::gemm_phase<pg8::EpiStoreBf16, pg8::StaticOrder, true, false>(L + RING_OFF, g, S, E);
        if (BOTH(1)) GRID_BAR(); STAMP(2);
    }
    if (IN(2)) {
        const bf16* P = (const bf16*)(ws + WS_PROJ);
        for (int m = gw; m < M; m += NGW) {
            const bf16* pr = P + (size_t)m * MLA_INP;
            float cq[6]; float s = 0.f;
#pragma unroll
            for (int j = 0; j < 6; ++j) { cq[j] = bf2f(pr[j * 64 + lane]); s += cq[j] * cq[j]; }
            const float rq = 1.f / sqrtf(wave_sum(s) * (1.f / QL) + EPS);
            bf16* oq = (bf16*)(ws + WS_CQN) + (size_t)m * QL;
#pragma unroll
            for (int j = 0; j < 6; ++j) oq[j * 64 + lane] = (bf16)f2bf(cq[j] * rq * args.in[6][j * 64 + lane]);
            float ck[4]; s = 0.f;
#pragma unroll
            for (int j = 0; j < 4; ++j) { ck[j] = bf2f(pr[QL + j * 64 + lane]); s += ck[j] * ck[j]; }
            const float rk = 1.f / sqrtf(wave_sum(s) * (1.f / KVL) + EPS);
            bf16* ok = (bf16*)(ws + WS_CKVN) + (size_t)m * KVL;
#pragma unroll
            for (int j = 0; j < 4; ++j) ok[j * 64 + lane] = (bf16)f2bf(ck[j] * rk * args.in[8][j * 64 + lane]);
            if (lane < 16) {
                const float invf = exp2f(-(float)lane * (13.287712379549449f / 16.0f));
                const float ang = (float)args.pos[m] * invf;
                const double rev = (double)ang * 0.15915494309189535; const float fr = (float)(rev - rint(rev));
                const float sn = __builtin_amdgcn_sinf(fr), cs = __builtin_amdgcn_cosf(fr);
                ((float*)(ws + WS_COS))[(size_t)m * 16 + lane] = cs; ((float*)(ws + WS_SIN))[(size_t)m * 16 + lane] = sn;
                const float x1 = bf2f(pr[QL + KVL + lane]), x2 = bf2f(pr[QL + KVL + 16 + lane]);
                bf16* okr = (bf16*)(ws + WS_KR) + (size_t)m * 32;
                okr[lane] = (bf16)f2bf(x1 * cs - x2 * sn); okr[16 + lane] = (bf16)f2bf(x2 * cs + x1 * sn);
            }
        }
        if (BOTH(2)) GRID_BAR(); STAMP(3);
    }
    if (IN(3)) {
        { pg8::Gemm g{(const bf16*)(ws + WS_CQN), (const bf16*)(ws + WS_WQUP), M, QW, QL, QL}; pg8::StaticOrder S; S.init(M, QW, G, (int)blockIdx.x);
          pg8::EpiStoreBf16 E{(bf16*)(ws + WS_Q), QW, QW / 256};
          pg8::gemm_phase<pg8::EpiStoreBf16, pg8::StaticOrder, true, false>(L + RING_OFF, g, S, E); }
        { pg8::Gemm g{(const bf16*)(ws + WS_CKVN), (const bf16*)(ws + WS_WKVUP), M, KVW, KVL, KVL}; pg8::StaticOrder S; S.init(M, KVW, G, (int)blockIdx.x);
          pg8::EpiStoreBf16 E{(bf16*)(ws + WS_KV), KVW, KVW / 256};
          pg8::gemm_phase<pg8::EpiStoreBf16, pg8::StaticOrder, true, false>(L + RING_OFF, g, S, E); }
        if (BOTH(3)) GRID_BAR(); STAMP(4);
    }
    if (IN(4)) {
        const int vcu = (G % 8 == 0) ? ((int)blockIdx.x % 8) * (G / 8) + (int)blockIdx.x / 8 : (int)blockIdx.x;
        for (int v = vcu; v < 256; v += G) {
            const int bh = v >> 2, s4 = v & 3;
#pragma unroll 1
            for (int i = 0; i < 4; ++i) { const int qb = (i == 0) ? s4 : (i == 1) ? 7 - s4 : (i == 2) ? 8 + s4 : 15 - s4;
                mla_attn::attn_unit2<8>(bh >> 4, bh & 15, qb, (const bf16*)(ws + WS_Q), (const bf16*)(ws + WS_KV), (const bf16*)(ws + WS_KR), (const float*)(ws + WS_COS), (const float*)(ws + WS_SIN), (bf16*)(ws + WS_O), (char*)lds + RING_OFF); }
        }
        if (BOTH(4)) GRID_BAR(); STAMP(5);
    }
    if (IN(5)) {
        pg8::Gemm g{(const bf16*)(ws + WS_O), (const bf16*)(ws + WS_WO0), M, D, D, D}; pg8::StaticOrder S; S.init(M, D, G, (int)blockIdx.x);
        pg8::EpiRes<true> E{x, H, D, HPITCH, D / 256};
        pg8::gemm_phase<pg8::EpiRes<true>, pg8::StaticOrder, true, false>(L + RING_OFF, g, S, E);
        if (BOTH(5)) GRID_BAR(); STAMP(6);
    }
    if (IN(6)) {
        rms_rows_bf16in(H, HPITCH, args.in[3], (bf16*)(ws + WS_HN), gw, NGW, M, lane);
        if (BOTH(6)) GRID_BAR(); STAMP(7);
    }
    if (IN(7)) {
        pg8::Gemm g{(const bf16*)(ws + WS_HN), (const bf16*)(ws + WS_WFGU), M, 2 * FF, D, D}; pg8::StaticOrder S; S.init(M, 2 * FF, G, (int)blockIdx.x);
        pg8::EpiSwiGLU E{(bf16*)(ws + WS_FACT), FF, 2 * FF / 256};
        pg8::gemm_phase<pg8::EpiSwiGLU, pg8::StaticOrder, true, false>(L + RING_OFF, g, S, E);
        if (BOTH(7)) GRID_BAR(); STAMP(8);
    }
    if (IN(8)) {
        pg8::Gemm g{(const bf16*)(ws + WS_FACT), (const bf16*)(ws + WS_WFDN), M, D, FF, FF}; pg8::StaticOrder S; S.init(M, D, G, (int)blockIdx.x);
        pg8::EpiRes<false> E{H, H, HPITCH, HPITCH, D / 256};
        pg8::gemm_phase<pg8::EpiRes<false>, pg8::StaticOrder, true, false>(L + RING_OFF, g, S, E);
        if (BOTH(8)) GRID_BAR(); STAMP(9);
    }
    if (IN(9)) {
        rms_rows_bf16in(H, HPITCH, args.in[2] + D, (bf16*)(ws + WS_HN), gw, NGW, M, lane);
        if (BOTH(9)) GRID_BAR(); STAMP(10);
    }
    if (IN(10)) {
        pg8::Gemm g{(const bf16*)(ws + WS_HN), (const bf16*)(ws + WS_WHIN), M, HG_IN, D, D}; pg8::StaticOrder S; S.init(M, HG_IN, G, (int)blockIdx.x);
        pg8::EpiStoreBf16 E{(bf16*)(ws + WS_HPROJ), HG_IN, HG_IN / 256};
        pg8::gemm_phase<pg8::EpiStoreBf16, pg8::StaticOrder, true, false>(L + RING_OFF, g, S, E);
        if (BOTH(10)) GRID_BAR(); STAMP(11);
    }
    if (IN(11)) {
        hg::P1Args pa{(const bf16*)(ws + WS_HPROJ), args.in[12], (bf16*)(ws + WS_OL), (bf16*)(ws + WS_Q1G), (float*)(ws + WS_WN), (float*)(ws + WS_SS), (float*)(ws + WS_DSEG)};
        hg::hg_pass1(L, pa, G);
        if (BOTH(11)) GRID_BAR(); STAMP(12);
    }
    if (IN(12)) {
        hg::P2Args pa{(const bf16*)(ws + WS_HPROJ), (const bf16*)(ws + WS_OL), (const bf16*)(ws + WS_Q1G), (const float*)(ws + WS_WN), (const float*)(ws + WS_SS), (const float*)(ws + WS_DSEG), args.in[13], (bf16*)(ws + WS_HON)};
        hg::hg_pass2(L, pa, G);
        if (BOTH(12)) GRID_BAR(); STAMP(13);
    }
    if (IN(13)) {
        pg8::Gemm g{(const bf16*)(ws + WS_HON), (const bf16*)(ws + WS_WHO), M, D, D, D}; pg8::StaticOrder S; S.init(M, D, G, (int)blockIdx.x);
        pg8::EpiRes<false> E{H, H, HPITCH, HPITCH, D / 256};
        pg8::gemm_phase<pg8::EpiRes<false>, pg8::StaticOrder, true, false>(L + RING_OFF, g, S, E);
        if (BOTH(13)) GRID_BAR(); STAMP(14);
    }
    if (IN(14)) {
        const float* gn = args.in[3] + D; const float* RT = args.in[18];
        int* rowlist = (int*)(ws + WS_ROWLIST); v4u* tok = (v4u*)(ws + WS_TOK);
        LAS int* lcnt = (LAS int*)(L + RING_OFF); LAS int* gbase = lcnt + 8; LAS unsigned* rec = (LAS unsigned*)(L + RING_OFF + 64);
        const int niter = (M + NGW - 1) / NGW;
        f32x4 R0[16], R1[16];
#pragma unroll
        for (int j = 0; j < 4; ++j)
#pragma unroll
            for (int kk = 0; kk < 4; ++kk) { const int kx = 4 * (lane + 64 * j) + kk; R0[j * 4 + kk] = *(const f32x4*)(RT + (size_t)kx * 8); R1[j * 4 + kk] = *(const f32x4*)(RT + (size_t)kx * 8 + 4); }
        f32x4 gv[4];
#pragma unroll
        for (int j = 0; j < 4; ++j) gv[j] = ((const f32x4*)gn + lane)[64 * j];
        for (int it0 = 0; it0 < niter; it0 += 16) {
            if (tid < 8) lcnt[tid] = 0;
            __syncthreads();
            const int itn = (niter - it0) < 16 ? (niter - it0) : 16;
            v2u vn[4];
            { const int m0 = it0 * NGW + gw; const bf16* xr = H + (size_t)(m0 < M ? m0 : 0) * HPITCH;
#pragma unroll
              for (int j = 0; j < 4; ++j) vn[j] = *(const v2u*)(xr + 4 * (lane + 64 * j)); }
            for (int it = 0; it < itn; ++it) {
                const int m = (it0 + it) * NGW + gw;
                f32x4 v[4];
#pragma unroll
                for (int j = 0; j < 4; ++j) v[j] = (f32x4){__uint_as_float(vn[j].x << 16), __uint_as_float(vn[j].x & 0xffff0000u), __uint_as_float(vn[j].y << 16), __uint_as_float(vn[j].y & 0xffff0000u)};
                { const int mn = m + NGW; const bf16* xr = H + (size_t)((it + 1 < itn && mn < M) ? mn : 0) * HPITCH;
#pragma unroll
                  for (int j = 0; j < 4; ++j) vn[j] = *(const v2u*)(xr + 4 * (lane + 64 * j)); }
                if (m >= M) continue;
                float s = 0.f;
#pragma unroll
                for (int j = 0; j < 4; ++j) s += (v[j].x * v[j].x + v[j].y * v[j].y) + (v[j].z * v[j].z + v[j].w * v[j].w);
                const float rstd = 1.f / sqrtf(wave_sum(s) * (1.f / 1024.f) + EPS);
                f32x4 la = (f32x4){0.f, 0.f, 0.f, 0.f}, lb4 = (f32x4){0.f, 0.f, 0.f, 0.f};
                unsigned long long* o8 = (unsigned long long*)((bf16*)(ws + WS_HN3) + (size_t)m * D) + lane;
#pragma unroll
                for (int j = 0; j < 4; ++j) { const f32x4 t = (f32x4){v[j].x * rstd * gv[j].x, v[j].y * rstd * gv[j].y, v[j].z * rstd * gv[j].z, v[j].w * rstd * gv[j].w};
                    o8[64 * j] = (unsigned long long)pk2(t.x, t.y) | ((unsigned long long)pk2(t.z, t.w) << 32);
#pragma unroll
                    for (int kk = 0; kk < 4; ++kk) { la += t[kk] * R0[j * 4 + kk]; lb4 += t[kk] * R1[j * 4 + kk]; } }
                float l4[4], l2[2], l1;
                { const bool up = (lane & 1) != 0;
#pragma unroll
                  for (int e = 0; e < 4; ++e) { const float mine = up ? lb4[e] : la[e], give = up ? la[e] : lb4[e]; l4[e] = mine + __shfl_xor(give, 1); } }
                { const bool up = (lane & 2) != 0;
#pragma unroll
                  for (int e = 0; e < 2; ++e) { const float mine = up ? l4[2 + e] : l4[e], give = up ? l4[e] : l4[2 + e]; l2[e] = mine + __shfl_xor(give, 2); } }
                { const bool up = (lane & 4) != 0; const float mine = up ? l2[1] : l2[0], give = up ? l2[0] : l2[1]; l1 = mine + __shfl_xor(give, 4); }
                l1 += __shfl_xor(l1, 8); l1 += __shfl_xor(l1, 16); l1 += __shfl_xor(l1, 32);
                float lg[8];
#pragma unroll
                for (int e = 0; e < 8; ++e) { const int src = ((e >> 2) & 1) | (((e >> 1) & 1) << 1) | ((e & 1) << 2); lg[e] = __shfl(l1, src); }
                if (lane == 0) {
                    int e1 = 0; float v1 = lg[0];
#pragma unroll
                    for (int e = 1; e < 8; ++e) if (lg[e] > v1) { v1 = lg[e]; e1 = e; }
                    int e2 = (e1 == 0) ? 1 : 0; float v2 = lg[e2];
#pragma unroll
                    for (int e = 1; e < 8; ++e) if (e != e1 && lg[e] > v2) { v2 = lg[e]; e2 = e; }
                    const float w1 = 1.0f / (1.0f + __expf(v2 - v1)), w2 = 1.0f - w1;
                    const int r1 = __hip_atomic_fetch_add(lcnt + e1, 1, __ATOMIC_RELAXED, __HIP_MEMORY_SCOPE_WORKGROUP), r2 = __hip_atomic_fetch_add(lcnt + e2, 1, __ATOMIC_RELAXED, __HIP_MEMORY_SCOPE_WORKGROUP);
                    LAS unsigned* rc = rec + (it * NWAVES + wave) * 8;
                    rc[0] = (unsigned)m; rc[1] = (unsigned)e1; rc[2] = (unsigned)e2; rc[3] = (unsigned)r1; rc[4] = (unsigned)r2; rc[5] = __float_as_uint(w1); rc[6] = __float_as_uint(w2);
                }
            }
            __syncthreads();
            if (tid < 8) { const int c = lcnt[tid]; gbase[tid] = c ? (int)__hip_atomic_fetch_add((unsigned*)(ctl + CW_CNT + 64 * tid), (unsigned)c, RLX_AGENT) : 0; }
            __syncthreads();
            for (int i = tid; i < itn * NWAVES; i += NWAVES * 64) {
                const int m = (it0 + i / NWAVES) * NGW + blockIdx.x * NWAVES + (i % NWAVES); if (m >= M) continue;
                const LAS unsigned* rc = rec + i * 8; const int e1 = (int)rc[1], e2 = (int)rc[2]; const unsigned p1 = (unsigned)gbase[e1] + rc[3], p2 = (unsigned)gbase[e2] + rc[4];
                rowlist[e1 * CAP + p1] = m; rowlist[e2 * CAP + p2] = m;
                tok[m] = (v4u){(unsigned)(e1 * CAP) + p1, (unsigned)(e2 * CAP) + p2, rc[5], rc[6]};
            }
            __syncthreads();
        }
        if (BOTH(14)) GRID_BAR(); STAMP(15);
    }
    if (IN(15) || IN(16) || IN(17)) {
        if (tid == 0) { volatile LAS int* mt = (volatile LAS int*)(MISC + 16); int acc = 0;
            for (int e = 0; e < 8; ++e) { const int c = (int)__hip_atomic_load((unsigned*)(ctl + CW_CNT + 64 * e), RLX_AGENT); mt[e] = acc; mt[9 + e] = c; acc += (c + 255) >> 8; }
            mt[8] = acc; }
        __syncthreads();
    }
    if (IN(15)) {
        pg8::Gemm g{(const bf16*)(ws + WS_HN3), (const bf16*)(ws + WS_WMGU), M, 2 * FF, D, D};
        MoeOrder S; S.init((volatile LAS int*)(MISC + 16), 2 * FF / 256, G, (int)blockIdx.x, (const int*)(ws + WS_ROWLIST));
        pg8::EpiSwiGLU E{(bf16*)(ws + WS_MACT), FF, 2 * FF / 256};
        pg8::gemm_phase<pg8::EpiSwiGLU, MoeOrder, true, true>(L + RING_OFF, g, S, E);
        if (BOTH(15)) GRID_BAR(); STAMP(16);
    }
    if (IN(16)) {
        pg8::Gemm g{(const bf16*)(ws + WS_MACT), (const bf16*)(ws + WS_WMDN), MAXSLOT, D, FF, FF};
        MoeOrder S; S.init((volatile LAS int*)(MISC + 16), D / 256, G, (int)blockIdx.x, (const int*)(ws + WS_ROWLIST), 128);
        pg8::EpiStoreBf16 E{(bf16*)(ws + WS_Y), D, D / 256};
        pg8::gemm_phase<pg8::EpiStoreBf16, MoeOrder, true, false>(L + RING_OFF, g, S, E);
        { pg8::Gemm g2{(const bf16*)(ws + WS_MACT), (const bf16*)(ws + WS_WMDN), MAXSLOT, D, 512, FF};
          MoeSplitOrder S2; S2.init((volatile LAS int*)(MISC + 16), D / 256, G, (int)blockIdx.x);
          pg8::EpiPart E2{(float*)(ws + WS_PART0), (float*)(ws + WS_PART1), D / 256};
          pg8::gemm_phase<pg8::EpiPart, MoeSplitOrder, true, false>(L + RING_OFF, g2, S2, E2); }
        if (BOTH(16)) GRID_BAR(); STAMP(17);
    }
    if (IN(17)) {
        volatile LAS int* mt = (volatile LAS int*)(MISC + 16);
        const bf16* Y = (const bf16*)(ws + WS_Y); const v4u* tok = (const v4u*)(ws + WS_TOK);
        f32x4 gfin[4];
#pragma unroll
        for (int j = 0; j < 4; ++j) gfin[j] = ((const f32x4*)args.in[4] + lane)[64 * j];
        if (gw < M) {
#define P17_SLOTS(tk_, s1_, s2_) do { const int e1_ = (tk_).x / CAP, e2_ = (tk_).y / CAP; s1_ = (size_t)mt[e1_] * 256 + ((tk_).x % CAP); s2_ = (size_t)mt[e2_] * 256 + ((tk_).y % CAP); } while (0)
#define P17_LOADROW(m_, s1_, s2_, hv_, ya_, yc_) do { const bf16* xr_ = H + (size_t)(m_) * HPITCH; \
            const v2u* y1_ = (const v2u*)(Y + ((s1_) < 32768 ? (s1_) : (size_t)0) * D) + lane; const v2u* y2_ = (const v2u*)(Y + ((s2_) < 32768 ? (s2_) : (size_t)0) * D) + lane; \
            _Pragma("unroll") for (int j = 0; j < 4; ++j) { hv_[j] = ld_bf4(xr_ + 4 * (lane + 64 * j)); ya_[j] = y1_[64 * j]; yc_[j] = y2_[64 * j]; } } while (0)
            v4u tk = tok[gw]; size_t s1, s2; P17_SLOTS(tk, s1, s2);
            f32x4 hv[4]; v2u ya[4], yc[4]; P17_LOADROW(gw, s1, s2, hv, ya, yc);
            v4u tkn = tok[(gw + NGW < M) ? gw + NGW : gw];
            for (int m = gw; m < M; m += NGW) {
                f32x4 v[4]; v2u a[4], c[4];
#pragma unroll
                for (int j = 0; j < 4; ++j) { v[j] = hv[j]; a[j] = ya[j]; c[j] = yc[j]; }
                const size_t cs1 = s1, cs2 = s2; const unsigned zb = tk.z, wb = tk.w; const float w1 = __uint_as_float(zb), w2 = __uint_as_float(wb);
                const int mn = (m + NGW < M) ? m + NGW : m;
                tk = tkn; P17_SLOTS(tk, s1, s2); P17_LOADROW(mn, s1, s2, hv, ya, yc);
                tkn = tok[(mn + NGW < M) ? mn + NGW : mn];
                float s = 0.f;
#pragma unroll
                for (int j = 0; j < 4; ++j) {
                    f32x4 y1v, y2v;
                    if (cs1 < 32768) y1v = (f32x4){bf2f((unsigned short)(a[j].x & 0xffffu)), bf2f((unsigned short)(a[j].x >> 16)), bf2f((unsigned short)(a[j].y & 0xffffu)), bf2f((unsigned short)(a[j].y >> 16))};
                    else { const int tl = (int)(cs1 >> 8) - 128; const float* pb = (tl < 4 ? (const float*)(ws + WS_PART0) + (size_t)((tl * 4 + j) * 7) * 65536 : (const float*)(ws + WS_PART1) + (size_t)(((tl - 4) * 4 + j) * 7) * 65536) + (cs1 & 255) * 256 + 4 * lane;
                        y1v = *(const f32x4*)pb;
#pragma unroll
                        for (int ks = 1; ks < 7; ++ks) y1v += *(const f32x4*)(pb + (size_t)ks * 65536); }
                    if (cs2 < 32768) y2v = (f32x4){bf2f((unsigned short)(c[j].x & 0xffffu)), bf2f((unsigned short)(c[j].x >> 16)), bf2f((unsigned short)(c[j].y & 0xffffu)), bf2f((unsigned short)(c[j].y >> 16))};
                    else { const int tl = (int)(cs2 >> 8) - 128; const float* pb = (tl < 4 ? (const float*)(ws + WS_PART0) + (size_t)((tl * 4 + j) * 7) * 65536 : (const float*)(ws + WS_PART1) + (size_t)(((tl - 4) * 4 + j) * 7) * 65536) + (cs2 & 255) * 256 + 4 * lane;
                        y2v = *(const f32x4*)pb;
#pragma unroll
                        for (int ks = 1; ks < 7; ++ks) y2v += *(const f32x4*)(pb + (size_t)ks * 65536); }
                    v[j] += w1 * y1v + w2 * y2v;
                    s += (v[j].x * v[j].x + v[j].y * v[j].y) + (v[j].z * v[j].z + v[j].w * v[j].w); }
                const float rstd = 1.f / sqrtf(wave_sum(s) * (1.f / 1024.f) + EPS);
                f32x4* xo = (f32x4*)(args.out + (size_t)m * D) + lane;
#pragma unroll
                for (int j = 0; j < 4; ++j) __builtin_nontemporal_store((f32x4){v[j].x * rstd * gfin[j].x, v[j].y * rstd * gfin[j].y, v[j].z * rstd * gfin[j].z, v[j].w * rstd * gfin[j].w}, xo + 64 * j);
            }
#undef P17_SLOTS
#undef P17_LOADROW
        }
    }
#ifdef AMP_A
    if (blockIdx.x == 0 && tid == 0) { const unsigned long long tend = __builtin_amdgcn_s_memrealtime(); ts_[18] = tend;
        const unsigned long long dt = (ts_[AMP_B] - ts_[AMP_A]) * AMP_K; while (__builtin_amdgcn_s_memrealtime() - tend < dt) __builtin_amdgcn_s_sleep(8); }
#endif
#ifdef DIAG_STAMP
    GRID_BAR(); STAMP(18);
    GRID_BAR();
    { const float da = (float)(ts_[DIAG_A1] - ts_[DIAG_A0]) * 0.001f;
      const float db = (float)(ts_[DIAG_B1] - ts_[DIAG_B0]) * 0.1f;
      for (int m = gw; m < M; m += NGW) { f32x4* xr = (f32x4*)(H + (size_t)m * D) + lane;
          for (int j = 0; j < 4; ++j) xr[64 * j] = (f32x4){da, da, da, da}; }
      __syncthreads();
      if (blockIdx.x == 0 && tid == 0) H[0] = db; }
#endif
#undef IN
#undef BOTH
}

extern "C" void kernel_launch(void* const* d_in, const int* in_sizes, int n_in, void* d_out, int out_size, void* d_ws, size_t ws_size, hipStream_t stream) {
    static int grid = 0;
    if (grid == 0) {
        if (n_in != 22 || in_sizes[0] != M * D || out_size != M * D || ws_size < WS_END) { fprintf(stderr, "kernel_launch: unexpected shapes (n_in %d, in0 %d, out %d, ws %zu)\n", n_in, n_in > 0 ? in_sizes[0] : -1, out_size, ws_size); grid = -1; return; }
        int dev = 0, cus = 0, per_cu = 0;
        if (hipGetDevice(&dev) != hipSuccess || hipDeviceGetAttribute(&cus, hipDeviceAttributeMultiprocessorCount, dev) != hipSuccess) { grid = -1; return; }
        if (hipFuncSetAttribute((const void*)fwd_kernel, hipFuncAttributeMaxDynamicSharedMemorySize, LDS_BYTES) != hipSuccess) { fprintf(stderr, "kernel_launch: hipFuncSetAttribute failed\n"); grid = -1; return; }
        if (hipOccupancyMaxActiveBlocksPerMultiprocessor(&per_cu, (const void*)fwd_kernel, NWAVES * 64, LDS_BYTES) != hipSuccess || per_cu < 1) fprintf(stderr, "kernel_launch: occupancy query reports %d\n", per_cu);
        (void)hipGetLastError();
        grid = cus;
    }
    if (grid < 0) return;
    if (hipMemsetAsync((char*)d_ws + WS_CTL, 0, CTL_ZERO_BYTES, stream) != hipSuccess) return;
    Args a{};
    for (int i = 0; i < 22; ++i) a.in[i] = (const float*)d_in[i];
    a.pos = (const int*)d_in[1]; a.out = (float*)d_out; a.ws = (unsigned char*)d_ws;
    static_assert(N_LAUNCHES == 1 || N_LAUNCHES == NPHASE, "MK_N_LAUNCHES: 1 or 18");
    for (int li = 0; li < N_LAUNCHES; ++li) {
        a.ph_lo = (N_LAUNCHES == 1) ? 0 : li; a.ph_hi = (N_LAUNCHES == 1) ? NPHASE : li + 1; a.li = li;
        hipLaunchKernelGGL(fwd_kernel, dim3(grid), dim3(NWAVES * 64), LDS_BYTES, stream, a);
        if (hipPeekAtLastError() != hipSuccess) { fprintf(stderr, "kernel_launch: launch %d failed\n", li); break; }
    }
#ifdef PROBE_EXTRA
    { const int extra[] = {PROBE_EXTRA}; int li = 1;
      for (int k : extra) { a.ph_lo = k; a.ph_hi = k + 1; a.li = li++; hipLaunchKernelGGL(fwd_kernel, dim3(grid), dim3(NWAVES * 64), LDS_BYTES, stream, a); } }
#endif
}
```

```cpp
#include <hip/hip_runtime.h>
#include <cstdio>
#include <cstdint>

#ifndef MK_N_LAUNCHES
#define MK_N_LAUNCHES 1
#endif

namespace pg8 {
#define PG8_LAS __attribute__((address_space(3)))
typedef unsigned short bf16_t;
typedef short bf16x8 __attribute__((ext_vector_type(8)));
typedef float f32x4 __attribute__((ext_vector_type(4)));
typedef unsigned u32x4 __attribute__((ext_vector_type(4)));
constexpr int BM = 256, BK = 64, HALF = 128, HTB = HALF * BK * 2, STAGE_BYTES = 8 * HTB, NXCD = 8, WGM = 8;

__host__ __device__ __forceinline__ int lds_byte(int r, int c) { const int st = (r >> 4) * 2 + (c >> 5), rr = r & 15, cc = c & 31, ob = rr * 64 + cc * 2; return st * 1024 + (ob ^ (((ob >> 9) & 1) << 5)); }
__host__ __device__ __forceinline__ void stage_rc(int b, int& R, int& C) { const int st = b / 1024, sb = b % 1024, swz = sb ^ (((sb >> 9) & 1) << 5); R = (st >> 1) * 16 + swz / 64; C = (st & 1) * 32 + (swz % 64) / 2; }
__host__ __device__ __forceinline__ int perm32(int rho) { const int n = rho >> 4, i = rho & 15; return 8 * (i >> 2) + 4 * n + (i & 3); }

struct Unit { int pm, pn, kb; };
struct Gemm { const bf16_t* A; const bf16_t* Bt; int M, N, K, ld; };

struct StaticOrder {
    int nM, nN, nwg, G, c;
    __host__ __device__ void init(int M, int N, int G_, int c_) { nM = M / BM; nN = N / BM; nwg = nM * nN; G = G_; c = c_; }
    __host__ __device__ bool next(int i, Unit& u) const {
        const long L = (long)i * G + c; if (L >= nwg) return false;
        int wgid = (int)L; { const int q = nwg / NXCD, r = nwg % NXCD, xcd = wgid % NXCD, off = wgid / NXCD; wgid = (xcd < r ? xcd * (q + 1) : r * (q + 1) + (xcd - r) * q) + off; }
        const int nig = WGM * nN, gid = wgid / nig, fm = gid * WGM, gsz = (nM - fm) < WGM ? (nM - fm) : WGM;
        u.pm = fm + ((wgid % nig) % gsz); u.pn = (wgid % nig) / gsz; u.kb = 0; return true;
    }
    __device__ __forceinline__ void a_ready(const Unit&) const {}
    __device__ __forceinline__ void done(const Unit&) const {}
    __device__ __forceinline__ int arow(const Unit&, int) const { return 0; }
    __device__ __forceinline__ void issue_rows(const Unit&, int, int, int) const {}
    __device__ __forceinline__ int arow_lds(int, int) const { return 0; }
};

__device__ __forceinline__ unsigned cvt_pk_bf16(float lo, float hi) { unsigned r; asm volatile("v_cvt_pk_bf16_f32 %0, %1, %2" : "=v"(r) : "v"(lo), "v"(hi)); return r; }

struct EpiStoreBf16 {
    static constexpr bool PERM = true, AFTER_DRAIN = false;
    bf16_t* O; int ldc; int nN;
    __device__ __forceinline__ void operator()(const f32x4 (&acc)[2][2][4][2], const Unit& u, int wr, int wc, int fr, int fq) const {
        const int pnl = u.pn % nN; const int row0 = u.pm * BM + wr * 64 + fr, col0 = pnl * BM + wc * 32 + 8 * fq;
#pragma unroll
        for (int ai = 0; ai < 2; ++ai)
#pragma unroll
            for (int m = 0; m < 4; ++m) { bf16_t* rowp = O + (size_t)(row0 + ai * HALF + m * 16) * ldc + col0;
#pragma unroll
                for (int bj = 0; bj < 2; ++bj) { const f32x4 v0 = acc[ai][bj][m][0], v1 = acc[ai][bj][m][1];
                    u32x4 w; w.x = cvt_pk_bf16(v0[0], v0[1]); w.y = cvt_pk_bf16(v0[2], v0[3]); w.z = cvt_pk_bf16(v1[0], v1[1]); w.w = cvt_pk_bf16(v1[2], v1[3]);
                    *(u32x4*)(rowp + bj * HALF) = w; } }
    }
};
typedef float f32x2_ __attribute__((ext_vector_type(2)));
__device__ __forceinline__ f32x2_ swiglu_pk(f32x2_ g, f32x2_ u) { const f32x2_ t = g * (-1.4426950408889634f); f32x2_ e; e.x = __builtin_amdgcn_exp2f(t.x); e.y = __builtin_amdgcn_exp2f(t.y);
    const f32x2_ d = e + 1.0f; f32x2_ r; r.x = __builtin_amdgcn_rcpf(d.x); r.y = __builtin_amdgcn_rcpf(d.y); return (g * u) * r; }
__device__ __forceinline__ float silu_f(float x) { return x * __builtin_amdgcn_rcpf(1.0f + __builtin_amdgcn_exp2f(-1.4426950408889634f * x)); }
struct EpiSwiGLU {
    static constexpr bool PERM = true, AFTER_DRAIN = false;
    bf16_t* O; int ldc; int nN;
    __device__ __forceinline__ void operator()(const f32x4 (&acc)[2][2][4][2], const Unit& u, int wr, int wc, int fr, int fq) const {
        const int pnl = u.pn % nN; const int row0 = u.pm * BM + wr * 64 + fr, col0 = pnl * HALF + wc * 32 + 8 * fq;
#pragma unroll
        for (int ai = 0; ai < 2; ++ai)
#pragma unroll
            for (int m = 0; m < 4; ++m) { bf16_t* rowp = O + (size_t)(row0 + ai * HALF + m * 16) * ldc + col0;
                const f32x4 g0 = acc[ai][0][m][0], g1 = acc[ai][0][m][1], u0 = acc[ai][1][m][0], u1 = acc[ai][1][m][1];
                const f32x2_ a0 = swiglu_pk((f32x2_){g0[0], g0[1]}, (f32x2_){u0[0], u0[1]}), a1 = swiglu_pk((f32x2_){g0[2], g0[3]}, (f32x2_){u0[2], u0[3]});
                const f32x2_ a2 = swiglu_pk((f32x2_){g1[0], g1[1]}, (f32x2_){u1[0], u1[1]}), a3 = swiglu_pk((f32x2_){g1[2], g1[3]}, (f32x2_){u1[2], u1[3]});
                u32x4 w; w.x = cvt_pk_bf16(a0.x, a0.y); w.y = cvt_pk_bf16(a1.x, a1.y); w.z = cvt_pk_bf16(a2.x, a2.y); w.w = cvt_pk_bf16(a3.x, a3.y);
                __builtin_nontemporal_store(w, (u32x4*)rowp); }
    }
};
struct EpiPart {
    static constexpr bool PERM = false, AFTER_DRAIN = false;
    float* P0; float* P1; int nN;
    __device__ __forceinline__ void operator()(const f32x4 (&acc)[2][2][4][2], const Unit& u, int wr, int wc, int fr, int fq) const {
        const int pnl = u.pn % nN, ks = u.kb >> 10, tl = u.pm - 128;
        float* base = (tl < 4 ? P0 + (size_t)((tl * 4 + pnl) * 7 + ks) * 65536 : P1 + (size_t)(((tl - 4) * 4 + pnl) * 7 + ks) * 65536) + (wr * 64 + fr) * 256 + wc * 32 + 4 * fq;
#pragma unroll
        for (int ai = 0; ai < 2; ++ai)
#pragma unroll
            for (int m = 0; m < 4; ++m)
#pragma unroll
                for (int bj = 0; bj < 2; ++bj)
#pragma unroll
                    for (int n = 0; n < 2; ++n) *(f32x4*)(base + (ai * HALF + m * 16) * 256 + bj * HALF + n * 16) = acc[ai][bj][m][n];
    }
};
template <bool BASE_F32> struct EpiRes {
    static constexpr bool PERM = false, AFTER_DRAIN = false;
    const void* base; bf16_t* out; int ldb, ldo; int nN;
    __device__ __forceinline__ void operator()(const f32x4 (&acc)[2][2][4][2], const Unit& u, int wr, int wc, int fr, int fq) const {
        typedef unsigned u32x2_ __attribute__((ext_vector_type(2)));
        const int pnl = u.pn % nN; const int row0 = u.pm * BM + wr * 64 + fr, col0 = pnl * BM + wc * 32 + 4 * fq;
#pragma unroll
        for (int ai = 0; ai < 2; ++ai) {
            if constexpr (BASE_F32) {
                f32x4 pre[4][2][2];
#pragma unroll
                for (int m = 0; m < 4; ++m) { const size_t row = (size_t)(row0 + ai * HALF + m * 16);
#pragma unroll
                    for (int bj = 0; bj < 2; ++bj)
#pragma unroll
                        for (int n = 0; n < 2; ++n) pre[m][bj][n] = *(const f32x4*)((const float*)base + row * ldb + col0 + bj * HALF + n * 16); }
                asm volatile("" ::: "memory");
#pragma unroll
                for (int m = 0; m < 4; ++m) { const size_t off = (size_t)(row0 + ai * HALF + m * 16) * ldo + col0;
#pragma unroll
                    for (int bj = 0; bj < 2; ++bj)
#pragma unroll
                        for (int n = 0; n < 2; ++n) { const f32x4 v = acc[ai][bj][m][n] + pre[m][bj][n]; *(u32x2_*)(out + off + bj * HALF + n * 16) = (u32x2_){cvt_pk_bf16(v[0], v[1]), cvt_pk_bf16(v[2], v[3])}; } }
            } else {
                u32x2_ pre[4][2][2];
#pragma unroll
                for (int m = 0; m < 4; ++m) { const size_t row = (size_t)(row0 + ai * HALF + m * 16);
#pragma unroll
                    for (int bj = 0; bj < 2; ++bj)
#pragma unroll
                        for (int n = 0; n < 2; ++n) pre[m][bj][n] = *(const u32x2_*)((const bf16_t*)base + row * ldb + col0 + bj * HALF + n * 16); }
                asm volatile("" ::: "memory");
#pragma unroll
                for (int m = 0; m < 4; ++m) { const size_t off = (size_t)(row0 + ai * HALF + m * 16) * ldo + col0;
#pragma unroll
                    for (int bj = 0; bj < 2; ++bj)
#pragma unroll
                        for (int n = 0; n < 2; ++n) { const u32x2_ b = pre[m][bj][n];
                            const f32x4 v = acc[ai][bj][m][n] + (f32x4){__uint_as_float(b.x << 16), __uint_as_float(b.x & 0xffff0000u), __uint_as_float(b.y << 16), __uint_as_float(b.y & 0xffff0000u)};
                            *(u32x2_*)(out + off + bj * HALF + n * 16) = (u32x2_){cvt_pk_bf16(v[0], v[1]), cvt_pk_bf16(v[2], v[3])}; } }
            }
            asm volatile("" ::: "memory");
        }
    }
};

template <class Epi, class Sched, bool ALIGN_EPI = true, bool GATHER = false>
__device__ __forceinline__ void gemm_phase(PG8_LAS unsigned char* lds, const Gemm g, const Sched& S, const Epi& E) {
    int tid_ = threadIdx.x; asm volatile("" : "+v"(tid_));
    const int tid = tid_, wid = __builtin_amdgcn_readfirstlane(tid >> 6), lane = tid & 63, wr = wid >> 2, wc = wid & 3, fr = lane & 15, fq = lane >> 4;
    const int K = g.ld, nt = g.K / BK;
    unsigned voffA[2], voffB[2]; int RA[2], CA[2];
#pragma unroll
    for (int i = 0; i < 2; ++i) { int R, C; stage_rc(tid * 16 + i * 8192, R, C); const int Rb = Epi::PERM ? ((R & ~31) + perm32(R & 31)) : R;
        voffA[i] = (unsigned)(R * K + C) * 2u; voffB[i] = (unsigned)(Rb * K + C) * 2u; RA[i] = R; CA[i] = C; }
    unsigned vAc[2][2], vAn[2][2];
    const size_t kstep = (size_t)(BK * 2);
    const size_t hstep = (size_t)HALF * K * 2;
    const size_t tstep = 2 * hstep;
    const size_t hstepA = GATHER ? (size_t)0 : hstep;
    const unsigned ldsw = (unsigned)wid * 1024u;
    const int aoff = lds_byte(wr * 64 + fr, fq * 8), boff = lds_byte(wc * 32 + fr, fq * 8);
#define PG8_SA(b, h) (((b) * 2 + (h)) * HTB)
#define PG8_SB(b, h) ((4 + (b) * 2 + (h)) * HTB)
#define PG8_STAGE(bufoff, gbase, voff) do { _Pragma("unroll") for (int _i = 0; _i < 2; ++_i) \
        __builtin_amdgcn_global_load_lds((const unsigned*)((const char*)(gbase) + (voff)[_i]), (PG8_LAS unsigned*)(lds + (bufoff) + ldsw + _i * 8192), 16, 0, 0); } while (0)
#define PG8_STAGE_A(bufoff, gbase, h, nx) do { _Pragma("unroll") for (int _i = 0; _i < 2; ++_i) { const unsigned _vo = GATHER ? ((nx) ? vAn[h][_i] : vAc[h][_i]) : voffA[_i]; \
        __builtin_amdgcn_global_load_lds((const unsigned*)((const char*)(gbase) + _vo), (PG8_LAS unsigned*)(lds + (bufoff) + ldsw + _i * 8192), 16, 0, 0); } } while (0)
#define PG8_GATH(dst, un) do { _Pragma("unroll") for (int _h = 0; _h < 2; ++_h) _Pragma("unroll") for (int _i = 0; _i < 2; ++_i) \
        dst[_h][_i] = (unsigned)(S.arow(un, _h * HALF + RA[_i]) * K + CA[_i]) * 2u; } while (0)
#define PG8_LDA(dst, b, h) do { _Pragma("unroll") for (int m = 0; m < 4; ++m) _Pragma("unroll") for (int k = 0; k < 2; ++k) dst[m][k] = *(const PG8_LAS bf16x8*)(lds + PG8_SA(b, h) + aoff + m * 2048 + k * 1024); } while (0)
#define PG8_LDB(dst, b, h) do { _Pragma("unroll") for (int n = 0; n < 2; ++n) _Pragma("unroll") for (int k = 0; k < 2; ++k) dst[n][k] = *(const PG8_LAS bf16x8*)(lds + PG8_SB(b, h) + boff + n * 2048 + k * 1024); } while (0)
#define PG8_MMA(ai, bj, At, Bt) do { __builtin_amdgcn_s_setprio(1); _Pragma("unroll") for (int m = 0; m < 4; ++m) _Pragma("unroll") for (int n = 0; n < 2; ++n) _Pragma("unroll") for (int k = 0; k < 2; ++k) \
        acc[ai][bj][m][n] = __builtin_amdgcn_mfma_f32_16x16x32_bf16(Bt[n][k], At[m][k], acc[ai][bj][m][n], 0, 0, 0); __builtin_amdgcn_s_setprio(0); } while (0)
#define PG8_WAIT_V(n) asm volatile("s_waitcnt vmcnt(" #n ")" ::: "memory")
#define PG8_WAIT_L(n) asm volatile("s_waitcnt lgkmcnt(" #n ")" ::: "memory")
#define PG8_BAR __builtin_amdgcn_s_barrier()
#define PG8_SCHED __builtin_amdgcn_sched_barrier(0)
    Unit cur, nxt; int ui = 0;
    if (!S.next(0, cur)) return;
    f32x4 acc[2][2][4][2];
#pragma unroll
    for (int a = 0; a < 2; ++a)
#pragma unroll
        for (int b = 0; b < 2; ++b)
#pragma unroll
            for (int m = 0; m < 4; ++m)
#pragma unroll
                for (int n = 0; n < 2; ++n) acc[a][b][m][n] = (f32x4){0.f, 0.f, 0.f, 0.f};
    bf16x8 At[4][2], B0[2][2], B1[2][2];
    const char* cA = GATHER ? (const char*)g.A : (const char*)g.A + (size_t)cur.pm * tstep + cur.kb; const char* cB = (const char*)g.Bt + (size_t)cur.pn * tstep + cur.kb;
    if (GATHER) { PG8_GATH(vAc, cur); }
    S.a_ready(cur);
    PG8_STAGE(PG8_SB(0, 0), cB, voffB); PG8_STAGE(PG8_SB(0, 1), cB + hstep, voffB); PG8_STAGE_A(PG8_SA(0, 0), cA, 0, false); PG8_STAGE_A(PG8_SA(0, 1), cA + hstepA, 1, false);
    if (wr == 1) PG8_BAR;
    PG8_WAIT_V(2); PG8_BAR;
    PG8_STAGE(PG8_SB(1, 0), cB + kstep, voffB); PG8_STAGE_A(PG8_SA(1, 0), cA + kstep, 0, false); PG8_STAGE(PG8_SB(1, 1), cB + hstep + kstep, voffB);
    PG8_WAIT_V(6); PG8_BAR;
    for (;;) {
        const bool has_next = S.next(ui + 1, nxt);
        const char* nA = GATHER ? (const char*)g.A : (has_next ? (const char*)g.A + (size_t)nxt.pm * tstep + nxt.kb : cA); const char* nB = has_next ? (const char*)g.Bt + (size_t)nxt.pn * tstep + nxt.kb : cB;
        if (GATHER) { if (has_next) { S.issue_rows(nxt, ui & 1, wid, lane); } else {
#pragma unroll
                for (int _h = 0; _h < 2; ++_h)
#pragma unroll
                    for (int _i = 0; _i < 2; ++_i) vAn[_h][_i] = vAc[_h][_i]; } }
        for (int t = 0; t < nt; t += 2) {
            const bool last = (t == nt - 2);
            const char* a1 = cA + (size_t)(t + 1) * kstep;
            const char* a2 = last ? nA : cA + (size_t)(t + 2) * kstep; const char* b2 = last ? nB : cB + (size_t)(t + 2) * kstep;
            const char* a3 = a2 + kstep; const char* b3 = b2 + kstep;
            if (last && has_next) S.a_ready(nxt);
            if (GATHER) { if (last && has_next) {
#pragma unroll
                    for (int _h = 0; _h < 2; ++_h)
#pragma unroll
                        for (int _i = 0; _i < 2; ++_i) vAn[_h][_i] = (unsigned)(S.arow_lds(_h * HALF + RA[_i], ui & 1) * K + CA[_i]) * 2u; } }
            PG8_LDB(B0, 0, 0); PG8_LDB(B1, 0, 1); PG8_SCHED; PG8_LDA(At, 0, 0); PG8_STAGE_A(PG8_SA(1, 1), a1 + hstepA, 1, false);
            PG8_WAIT_V(8); PG8_WAIT_L(0); PG8_BAR; PG8_MMA(0, 0, At, B0); PG8_MMA(0, 1, At, B1); PG8_BAR; PG8_SCHED;
            PG8_LDA(At, 0, 1); PG8_STAGE(PG8_SB(0, 0), b2, voffB); PG8_STAGE(PG8_SB(0, 1), b2 + hstep, voffB); PG8_STAGE_A(PG8_SA(0, 0), a2, 0, last);
            PG8_WAIT_V(8); PG8_WAIT_L(0); PG8_BAR; PG8_MMA(1, 0, At, B0); PG8_MMA(1, 1, At, B1); PG8_BAR; PG8_SCHED;
            PG8_LDB(B0, 1, 0); PG8_LDB(B1, 1, 1); PG8_SCHED; PG8_LDA(At, 1, 0); PG8_STAGE_A(PG8_SA(0, 1), a2 + hstepA, 1, last);
            PG8_WAIT_V(8); PG8_WAIT_L(0); PG8_BAR; PG8_MMA(0, 0, At, B0); PG8_MMA(0, 1, At, B1); PG8_BAR; PG8_SCHED;
            PG8_LDA(At, 1, 1); PG8_STAGE(PG8_SB(1, 0), b3, voffB); PG8_STAGE(PG8_SB(1, 1), b3 + hstep, voffB); PG8_STAGE_A(PG8_SA(1, 0), a3, 0, last);
            PG8_WAIT_V(8); PG8_WAIT_L(0); PG8_BAR; PG8_MMA(1, 0, At, B0); PG8_MMA(1, 1, At, B1); PG8_BAR; PG8_SCHED;
        }
        if constexpr (ALIGN_EPI) { if (wr == 0) PG8_BAR; }
        E(acc, cur, wr, wc, fr, fq); S.done(cur);
        if (!has_next) break;
#pragma unroll
        for (int a = 0; a < 2; ++a)
#pragma unroll
            for (int b = 0; b < 2; ++b)
#pragma unroll
                for (int m = 0; m < 4; ++m)
#pragma unroll
                    for (int n = 0; n < 2; ++n) acc[a][b][m][n] = (f32x4){0.f, 0.f, 0.f, 0.f};
        cur = nxt; cA = nA; cB = nB; ++ui;
        if (GATHER) {
#pragma unroll
            for (int _h = 0; _h < 2; ++_h)
#pragma unroll
                for (int _i = 0; _i < 2; ++_i) vAc[_h][_i] = vAn[_h][_i]; }
        if constexpr (ALIGN_EPI) { if (wr == 1) PG8_BAR; }
    }
    PG8_WAIT_V(0);
    if constexpr (!ALIGN_EPI) { if (wr == 0) PG8_BAR; }
    PG8_BAR;
#undef PG8_SA
#undef PG8_SB
#undef PG8_STAGE
#undef PG8_STAGE_A
#undef PG8_GATH
#undef PG8_LDA
#undef PG8_LDB
#undef PG8_MMA
#undef PG8_WAIT_V
#undef PG8_WAIT_L
#undef PG8_BAR
#undef PG8_SCHED
}
}

constexpr int NWAVES = 8;
constexpr int N_LAUNCHES = MK_N_LAUNCHES;
constexpr int NPHASE = 18;
constexpr int BATCH = 4, SEQ = 4096, D = 1024, M = BATCH * SEQ;
constexpr int NH = 16, QL = 384, KVL = 256, NOPE = 64, ROPE = 32, VD = 64, MLA_IN = 672, MLA_INP = 768, QW = NH * 96, KVW = NH * 128;
constexpr int HGH = 8, DK = 128, DV = 128, HG_IN = 4096;
constexpr int FF = 3584, NE = 8, CAP = 16384;
constexpr int MAXSLOT = 2 * M + NE * 256;
constexpr float EPS = 1e-6f;

constexpr size_t MiB = 1u << 20;
constexpr size_t WS_CTL = 0, CTL_ZERO_BYTES = 1 * MiB;
constexpr size_t WS_ROWLIST = 1 * MiB;
constexpr size_t WS_TOK = WS_ROWLIST + 512 * 1024;
constexpr size_t WS_STAMP = WS_TOK + 256 * 1024;
constexpr size_t WS_COS = 2 * MiB, WS_SIN = 3 * MiB;
constexpr size_t WS_WMLAIN = 4 * MiB;
constexpr size_t WS_WQUP = 6 * MiB;
constexpr size_t WS_WKVUP = 8 * MiB;
constexpr size_t WS_WO0 = 9 * MiB;
constexpr size_t WS_WFGU = 11 * MiB;
constexpr size_t WS_WFDN = 25 * MiB;
constexpr size_t WS_WHIN = 32 * MiB;
constexpr size_t WS_WHO = 40 * MiB;
constexpr size_t WS_WMGU = 42 * MiB;
constexpr size_t WS_WMDN = 154 * MiB;
constexpr size_t WS_ACTS = 210 * MiB;
constexpr size_t WS_HN = WS_ACTS;
constexpr size_t WS_PROJ = WS_ACTS + 32 * MiB;
constexpr size_t WS_CQN = WS_PROJ + 24 * MiB;
constexpr size_t WS_CKVN = WS_CQN + 12 * MiB;
constexpr size_t WS_KR = WS_CKVN + 8 * MiB;
constexpr size_t WS_Q = WS_KR + 1 * MiB;
constexpr size_t WS_KV = WS_Q + 48 * MiB;
constexpr size_t WS_O = WS_KV + 64 * MiB;
constexpr size_t WS_FACT = WS_ACTS + 32 * MiB;
constexpr size_t WS_HPROJ = WS_ACTS + 32 * MiB;
constexpr size_t WS_HOF = WS_HPROJ + 128 * MiB;
constexpr size_t WS_HON = WS_HOF + 64 * MiB;
constexpr size_t WS_OL = WS_HOF;
constexpr size_t WS_Q1G = WS_HOF + 32 * MiB;
constexpr size_t WS_SS = WS_HN;
constexpr size_t WS_WN = WS_HN + 16 * MiB;
constexpr size_t WS_DSEG = WS_HN + 17 * MiB;
constexpr size_t WS_HN3 = 4 * MiB;
constexpr size_t WS_MACT = WS_ACTS;
constexpr size_t WS_Y = WS_WMGU;
constexpr size_t WS_PART0 = WS_WMGU + 68 * MiB;
constexpr size_t WS_PART1 = WS_HN3;
constexpr size_t WS_END = 472 * MiB;
static_assert(WS_O + (size_t)M * 1024 * 2 <= WS_END && WS_HON + (size_t)M * 1024 * 2 <= WS_END && WS_MACT + (size_t)MAXSLOT * FF * 2 <= WS_END, "d_ws map");
static_assert(WS_HN3 + (size_t)M * 1024 * 2 <= WS_WHO, "hn3 overlay");
constexpr int CW_CNT = 64;
constexpr int CW_BAR = 4096;

constexpr int RING_OFF = 0, RING_BYTES = 131072;
constexpr int LDSCTL_OFF = RING_BYTES, MISC_OFF = LDSCTL_OFF + 320;
constexpr int ROWBUF_OFF = 133120;
constexpr int LDS_BYTES = 147456;

#define GAS __attribute__((address_space(1)))
#define LAS __attribute__((address_space(3)))
typedef unsigned short bf16;
typedef unsigned v4u __attribute__((ext_vector_type(4)));
typedef unsigned v2u __attribute__((ext_vector_type(2)));
typedef float f32x4 __attribute__((ext_vector_type(4)));
typedef GAS unsigned gu32;
#define RLX_AGENT __ATOMIC_RELAXED, __HIP_MEMORY_SCOPE_AGENT
#define LDS_WAIT() asm volatile("s_waitcnt lgkmcnt(0)" ::: "memory")
__device__ __forceinline__ unsigned f2bf(float f) { unsigned u = __builtin_bit_cast(unsigned, f); return (u + 0x7fffu + ((u >> 16) & 1u)) >> 16; }
__device__ __forceinline__ unsigned pk2(float lo, float hi) { return f2bf(lo) | (f2bf(hi) << 16); }
__device__ __forceinline__ float bf2f(unsigned short b) { return __builtin_bit_cast(float, (unsigned)b << 16); }

#define XB_TMO      128
#define XB_XCNT(j)  (256  + 64 * (j))
#define XB_XSUB(j)  (1280 + 64 * (j))
#define XB_XGEN(j)  (2304 + 64 * (j))
#define XB_TOP      3328
#define XB_TOPGEN   3392
#define XCD_BAR_WORDS 3456
#define XB_SPIN_CAP (1u << 24)
__device__ __forceinline__ unsigned xb_ld(unsigned* p)              { return __hip_atomic_load(p, __ATOMIC_RELAXED, __HIP_MEMORY_SCOPE_AGENT); }
__device__ __forceinline__ unsigned xb_add(unsigned* p, unsigned v) { return __hip_atomic_fetch_add(p, v, __ATOMIC_RELAXED, __HIP_MEMORY_SCOPE_AGENT); }
__device__ __forceinline__ unsigned xb_xcc_id() { return (unsigned)__builtin_amdgcn_s_getreg((3 << 11) | 20) & 0xFu; }
#define XB_SPIN(cond, bar) do { unsigned _sp = 0; while (cond) { __builtin_amdgcn_s_sleep(1); \
    if ((++_sp & 255u) == 0u) { if (xb_ld(&(bar)[XB_TMO])) break; if (_sp > XB_SPIN_CAP) { atomicAdd(&(bar)[XB_TMO], 1u); break; } } } } while (0)
struct XcdBarrier { unsigned* bar; unsigned x; volatile LAS unsigned* st; };
__device__ __forceinline__ XcdBarrier xcd_barrier_post(unsigned* bar, volatile LAS unsigned* st) {
    XcdBarrier b; b.bar = bar; b.x = xb_xcc_id(); b.st = st;
    if (threadIdx.x == 0) (void)xb_add(&bar[XB_XCNT(b.x)], 1u);
    return b;
}
__device__ __forceinline__ void xcd_barrier_complete(unsigned* bar, unsigned x, unsigned& nloc, unsigned& nx) {
    const unsigned G = gridDim.x * gridDim.y * gridDim.z;
    unsigned sum, cnt, mine, sp = 0u;
    for (;;) {
        sum = 0u; cnt = 0u; mine = 0u;
#pragma unroll
        for (unsigned j = 0; j < 16; ++j) { const unsigned c = xb_ld(&bar[XB_XCNT(j)]); sum += c; cnt += (c > 0u) ? 1u : 0u; mine = (j == x) ? c : mine; }
        if (sum == G) break;
        __builtin_amdgcn_s_sleep(1);
        if ((++sp & 255u) == 0u) { if (xb_ld(&bar[XB_TMO])) break; if (sp > XB_SPIN_CAP) { atomicAdd(&bar[XB_TMO], 1u); break; } }
    }
    nloc = mine > 0u ? mine : 1u; nx = cnt > 0u ? cnt : 1u;
}
__device__ __forceinline__ void xcd_barrier(const XcdBarrier& b) {
    asm volatile("s_waitcnt vmcnt(0)" ::: "memory");
    __syncthreads();
    if (threadIdx.x == 0) {
        unsigned* bar = b.bar;
        __builtin_amdgcn_s_waitcnt(0);
        unsigned nloc = b.st[0], nx = b.st[1];
        if (nloc == 0u) { xcd_barrier_complete(bar, b.x, nloc, nx); b.st[0] = nloc; b.st[1] = nx; }
        const unsigned old = xb_add(&bar[XB_XSUB(b.x)], 1u);
        const unsigned gen = old / nloc;
        if (old + 1u == (gen + 1u) * nloc) {
            __builtin_amdgcn_fence(__ATOMIC_RELEASE, "agent");
            asm volatile("s_waitcnt vmcnt(0)" ::: "memory");
            const unsigned og = xb_add(&bar[XB_TOP], 1u);
            const unsigned tg = og / nx;
            if (og + 1u == (tg + 1u) * nx) xb_add(&bar[XB_TOPGEN], 1u);
            else XB_SPIN(xb_ld(&bar[XB_TOPGEN]) == tg, bar);
            __builtin_amdgcn_fence(__ATOMIC_ACQUIRE, "agent");
            xb_add(&bar[XB_XGEN(b.x)], 1u);
            asm volatile("s_waitcnt vmcnt(0)" ::: "memory");
        } else {
            XB_SPIN(xb_ld(&bar[XB_XGEN(b.x)]) == gen, bar);
            __builtin_amdgcn_fence(__ATOMIC_ACQUIRE, "agent");
            asm volatile("s_waitcnt vmcnt(0)" ::: "memory");
        }
    }
    __syncthreads();
}

__device__ __forceinline__ float wave_sum(float v) {
#pragma unroll
    for (int o = 1; o < 64; o <<= 1) v += __shfl_xor(v, o);
    return v;
}
__device__ __forceinline__ int dst_row(int n, int mode) { return mode == 0 ? n : (((n >> 7) << 8) + (n & 127) + (mode == 2 ? 128 : 0)); }
struct TrJob { const float* W; bf16* WT; int K, N, mode, item; };
__device__ __forceinline__ void tr_load(const TrJob& j, float (&v)[32], int lane) {
    const int nblk = j.N / 32, kb = j.item / nblk, nb = j.item % nblk; const float* src = j.W + (size_t)(64 * kb + (lane >> 5)) * j.N + 32 * nb + (lane & 31);
#pragma unroll
    for (int i = 0; i < 32; ++i) v[i] = __builtin_nontemporal_load(src + (size_t)(2 * i) * j.N);
}
__device__ __forceinline__ void tr_finish(const TrJob& j, const float (&v)[32], LAS float* scr, int lane) {
    const int nblk = j.N / 32, kb = j.item / nblk, nb = j.item % nblk, k0 = 64 * kb, n0 = 32 * nb;
#pragma unroll
    for (int i = 0; i < 32; ++i) scr[(2 * i + (lane >> 5)) * 33 + (lane & 31)] = v[i];
    LDS_WAIT(); asm volatile("" ::: "memory");
    const int c = lane & 7;
#pragma unroll
    for (int q = 0; q < 4; ++q) { const int n = (lane >> 3) + 8 * q; const LAS float* sp = scr + (8 * c) * 33 + n;
        v4u o; o.x = pk2(sp[0 * 33], sp[1 * 33]); o.y = pk2(sp[2 * 33], sp[3 * 33]); o.z = pk2(sp[4 * 33], sp[5 * 33]); o.w = pk2(sp[6 * 33], sp[7 * 33]);
        __builtin_nontemporal_store(o, (v4u*)(j.WT + (size_t)dst_row(n0 + n, j.mode) * j.K + k0 + 8 * c)); }
    LDS_WAIT(); asm volatile("" ::: "memory");
}
__device__ __forceinline__ void rms_row_to_bf16(const float* xrow, const float* gain, bf16* orow, int lane) {
    const f32x4* xr = (const f32x4*)xrow + lane; const f32x4* gr = (const f32x4*)gain + lane;
    f32x4 v[4]; float s = 0.f;
#pragma unroll
    for (int j = 0; j < 4; ++j) { v[j] = xr[64 * j]; s += (v[j].x * v[j].x + v[j].y * v[j].y) + (v[j].z * v[j].z + v[j].w * v[j].w); }
    const float rstd = 1.f / sqrtf(wave_sum(s) * (1.f / 1024.f) + EPS);
    unsigned long long* o8 = (unsigned long long*)orow + lane;
#pragma unroll
    for (int j = 0; j < 4; ++j) { const f32x4 g = gr[64 * j];
        o8[64 * j] = (unsigned long long)pk2(v[j].x * rstd * g.x, v[j].y * rstd * g.y) | ((unsigned long long)pk2(v[j].z * rstd * g.z, v[j].w * rstd * g.w) << 32); }
}
__device__ __forceinline__ void rms_rows_to_bf16(const float* X, const float* gain, bf16* O, int gw, int NGW, int Mrows, int lane) {
    f32x4 g[4];
#pragma unroll
    for (int j = 0; j < 4; ++j) g[j] = ((const f32x4*)gain + lane)[64 * j];
    if (gw >= Mrows) return;
    f32x4 vn[4];
#pragma unroll
    for (int j = 0; j < 4; ++j) vn[j] = ((const f32x4*)(X + (size_t)gw * 1024) + lane)[64 * j];
    for (int m = gw; m < Mrows; m += NGW) {
        f32x4 v[4];
#pragma unroll
        for (int j = 0; j < 4; ++j) v[j] = vn[j];
        const int mn = (m + NGW < Mrows) ? m + NGW : m;
#pragma unroll
        for (int j = 0; j < 4; ++j) vn[j] = ((const f32x4*)(X + (size_t)mn * 1024) + lane)[64 * j];
        float s = 0.f;
#pragma unroll
        for (int j = 0; j < 4; ++j) s += (v[j].x * v[j].x + v[j].y * v[j].y) + (v[j].z * v[j].z + v[j].w * v[j].w);
        const float rstd = 1.f / sqrtf(wave_sum(s) * (1.f / 1024.f) + EPS);
        unsigned long long* o8 = (unsigned long long*)(O + (size_t)m * 1024) + lane;
#pragma unroll
        for (int j = 0; j < 4; ++j) o8[64 * j] = (unsigned long long)pk2(v[j].x * rstd * g[j].x, v[j].y * rstd * g[j].y) | ((unsigned long long)pk2(v[j].z * rstd * g[j].z, v[j].w * rstd * g[j].w) << 32);
    }
}
__device__ __forceinline__ f32x4 ld_bf4(const bf16* p) { const v2u b = *(const v2u*)p; return (f32x4){__uint_as_float(b.x << 16), __uint_as_float(b.x & 0xffff0000u), __uint_as_float(b.y << 16), __uint_as_float(b.y & 0xffff0000u)}; }
__device__ __forceinline__ void rms_rows_bf16in(const bf16* X, int pitch, const float* gain, bf16* O, int gw, int NGW, int Mrows, int lane) {
    f32x4 g[4];
#pragma unroll
    for (int j = 0; j < 4; ++j) g[j] = ((const f32x4*)gain + lane)[64 * j];
    if (gw >= Mrows) return;
    f32x4 vn[4];
#pragma unroll
    for (int j = 0; j < 4; ++j) vn[j] = ld_bf4(X + (size_t)gw * pitch + 4 * (lane + 64 * j));
    for (int m = gw; m < Mrows; m += NGW) {
        f32x4 v[4];
#pragma unroll
        for (int j = 0; j < 4; ++j) v[j] = vn[j];
        const int mn = (m + NGW < Mrows) ? m + NGW : m;
#pragma unroll
        for (int j = 0; j < 4; ++j) vn[j] = ld_bf4(X + (size_t)mn * pitch + 4 * (lane + 64 * j));
        float s = 0.f;
#pragma unroll
        for (int j = 0; j < 4; ++j) s += (v[j].x * v[j].x + v[j].y * v[j].y) + (v[j].z * v[j].z + v[j].w * v[j].w);
        const float rstd = 1.f / sqrtf(wave_sum(s) * (1.f / 1024.f) + EPS);
        unsigned long long* o8 = (unsigned long long*)(O + (size_t)m * 1024) + lane;
#pragma unroll
        for (int j = 0; j < 4; ++j) o8[64 * j] = (unsigned long long)pk2(v[j].x * rstd * g[j].x, v[j].y * rstd * g[j].y) | ((unsigned long long)pk2(v[j].z * rstd * g[j].z, v[j].w * rstd * g[j].w) << 32);
    }
}
__device__ __forceinline__ float sigmoid_f(float x) { return 1.0f / (1.0f + __expf(-x)); }

struct MoeOrder {
    pg8::StaticOrder so; int nN; volatile LAS int* mt; const int* rowlist; LAS int* rowbuf;
    __device__ __forceinline__ void init(volatile LAS int* mt_, int nN_, int G, int c, const int* rl, int tmax = 1 << 20) { mt = mt_; nN = nN_; rowlist = rl; rowbuf = (LAS int*)((LAS unsigned char*)mt_ - (MISC_OFF + 64) + ROWBUF_OFF); const int T = mt_[8]; so.init((T < tmax ? T : tmax) * 256, nN_ * 256, G, c); }
    __device__ __forceinline__ bool next(int i, pg8::Unit& u) const {
        if (!so.next(i, u)) return false;
        int e = 0;
#pragma unroll
        for (int j = 1; j < 8; ++j) e += (u.pm >= mt[j]) ? 1 : 0;
        u.pn = e * nN + u.pn; u.kb = 0; return true;
    }
    __device__ __forceinline__ void a_ready(const pg8::Unit&) const {}
    __device__ __forceinline__ void done(const pg8::Unit&) const {}
    __device__ __forceinline__ void issue_rows(const pg8::Unit& u, int par, int wid, int lane) const {
        if (wid < 4) { const int e = u.pn / nN; const int lr = (u.pm - mt[e]) * 256 + wid * 64 + lane, c1 = mt[9 + e] - 1;
            __builtin_amdgcn_global_load_lds((const unsigned*)(rowlist + e * CAP + (lr < c1 ? lr : c1)), (LAS unsigned*)(rowbuf + par * 256 + wid * 64), 4, 0, 0); } }
    __device__ __forceinline__ int arow_lds(int r, int par) const { return rowbuf[par * 256 + r]; }
    __device__ __forceinline__ int arow(const pg8::Unit& u, int r) const { const int e = u.pn / nN; const int lr = (u.pm - mt[e]) * 256 + r, c1 = mt[9 + e] - 1; return rowlist[e * CAP + (lr < c1 ? lr : c1)]; }
};


namespace mla_attn {
using bf16x8=__attribute__((ext_vector_type(8)))short;
using s16x4=__attribute__((ext_vector_type(4)))short;
using f32x16=__attribute__((ext_vector_type(16)))float;
using u32x4=__attribute__((ext_vector_type(4)))unsigned;
typedef __attribute__((address_space(3))) const char* lds_cptr;
constexpr int NW=8,QBLK=32,QB=256,KVBLK=64;
constexpr int KSLOT=12288,VSLOT=8192,NSLOT=3;
constexpr int LDS_K=0,LDS_V=NSLOT*KSLOT,LDS_WS=LDS_V+NSLOT*VSLOT,LDS_OST=LDS_WS+NW*64*4,LDS_BYTES_A=LDS_OST+NW*4096;
__device__ __forceinline__ int crow(int r,int hi){return (r&3)+8*(r>>2)+4*hi;}
__device__ __forceinline__ void glds16(const void*gsrc,unsigned lds_dst){unsigned keep;
  asm volatile("s_mov_b32 %0, m0\n\ts_mov_b32 m0, %2\n\ts_nop 0\n\tglobal_load_lds_dwordx4 %1, off\n\ts_mov_b32 m0, %0":"=&s"(keep):"v"(gsrc),"s"(lds_dst):"memory");}
typedef float f32x2_t __attribute__((ext_vector_type(2))); typedef __bf16 bf16x2_t __attribute__((ext_vector_type(2)));
__device__ __forceinline__ unsigned cvtpk_s(float lo,float hi){f32x2_t v={lo,hi};bf16x2_t b=__builtin_convertvector(v,bf16x2_t);return __builtin_bit_cast(unsigned,b);}
__device__ __forceinline__ void glds16s(const void*sbase,unsigned voff,unsigned lds_dst){unsigned keep;
  asm volatile("s_mov_b32 %0, m0\n\ts_mov_b32 m0, %3\n\ts_nop 0\n\tglobal_load_lds_dwordx4 %1, %2\n\ts_mov_b32 m0, %0":"=&s"(keep):"v"(voff),"s"(sbase),"s"(lds_dst):"memory");}
#define MLA_WAIT_BAR(N) asm volatile("s_waitcnt vmcnt(" #N ") lgkmcnt(0)\n\ts_barrier":::"memory")
__device__ __forceinline__ void cmask(f32x16&p0,f32x16&p1,int jb,int qrel,int hi){
  const float NEG=-INFINITY; int kb=64*jb+4*hi;
  #pragma unroll
  for(int r=0;r<16;++r){int kv=kb+(r&3)+8*(r>>2); if(kv>qrel)p0[r]=NEG; if(kv+32>qrel)p1[r]=NEG;}
}
__device__ __forceinline__ void qkt6(f32x16&p0,f32x16&p1,lds_cptr kslot,const bf16x8*qr,const f32x16&negm,int r32,int hi){
  lds_cptr kb=kslot+hi*1024+r32*16;
  #pragma unroll
  for(int d0=0;d0<6;++d0){
    const bf16x8 b0=*(const __attribute__((address_space(3))) bf16x8*)(kb+d0*2048);
    const bf16x8 b1=*(const __attribute__((address_space(3))) bf16x8*)(kb+d0*2048+512);
    if(d0==0){p0=__builtin_amdgcn_mfma_f32_32x32x16_bf16(b0,qr[0],negm,0,0,0);p1=__builtin_amdgcn_mfma_f32_32x32x16_bf16(b1,qr[0],negm,0,0,0);}
    else{p0=__builtin_amdgcn_mfma_f32_32x32x16_bf16(b0,qr[d0],p0,0,0,0);p1=__builtin_amdgcn_mfma_f32_32x32x16_bf16(b1,qr[d0],p1,0,0,0);}}
}
__device__ __forceinline__ float rowmax(const f32x16&p0,const f32x16&p1){
  float a=__builtin_fmaxf(__builtin_fmaxf(p0[0],p0[1]),p1[0]),b=__builtin_fmaxf(__builtin_fmaxf(p0[2],p0[3]),p1[1]);a=__builtin_fmaxf(__builtin_fmaxf(a,p1[2]),p1[3]);
  #pragma unroll
  for(int r=4;r<16;r+=4){a=__builtin_fmaxf(__builtin_fmaxf(a,p0[r]),p0[r+1]);b=__builtin_fmaxf(__builtin_fmaxf(b,p0[r+2]),p0[r+3]);a=__builtin_fmaxf(__builtin_fmaxf(a,p1[r]),p1[r+1]);b=__builtin_fmaxf(__builtin_fmaxf(b,p1[r+2]),p1[r+3]);}
  const float m=__builtin_fmaxf(a,b);
  auto rr=__builtin_amdgcn_permlane32_swap(__float_as_uint(m),__float_as_uint(m),false,false);
  return __builtin_fmaxf(__uint_as_float(rr[0]),__uint_as_float(rr[1]));
}
__device__ __forceinline__ void pv(f32x16*o,int vb,bf16x8 pa0,bf16x8 pa1,bf16x8 pa2,bf16x8 pa3){
  #pragma unroll
  for(int d0=0;d0<2;++d0){s16x4 lo[4],hi[4];
    #pragma unroll
    for(int ks=0;ks<4;++ks){
      asm volatile("ds_read_b64_tr_b16 %0,%1 offset:%c2":"=&v"(lo[ks]):"v"(vb),"i"(d0*4096+ks*1024):"memory");
      asm volatile("ds_read_b64_tr_b16 %0,%1 offset:%c2":"=&v"(hi[ks]):"v"(vb),"i"(d0*4096+ks*1024+512):"memory");}
    asm volatile("s_waitcnt lgkmcnt(0)":::"memory");__builtin_amdgcn_sched_barrier(0);
    #define PK(k) (bf16x8){lo[k][0],lo[k][1],lo[k][2],lo[k][3],hi[k][0],hi[k][1],hi[k][2],hi[k][3]}
    o[d0]=__builtin_amdgcn_mfma_f32_32x32x16_bf16(pa0,PK(0),o[d0],0,0,0);
    o[d0]=__builtin_amdgcn_mfma_f32_32x32x16_bf16(pa1,PK(1),o[d0],0,0,0);
    o[d0]=__builtin_amdgcn_mfma_f32_32x32x16_bf16(pa2,PK(2),o[d0],0,0,0);
    o[d0]=__builtin_amdgcn_mfma_f32_32x32x16_bf16(pa3,PK(3),o[d0],0,0,0);
    #undef PK
  }
}
constexpr int QPITCH=1536,KVPITCH=2048,KRPITCH=32,OPITCH=1024,SEQ_=4096;
template<int THRL> __device__ __forceinline__ void attn_unit(int b,int h,int qb,const unsigned short*Q,const unsigned short*KV,const unsigned short*KR,const float*COS,const float*SIN,unsigned short*O,char*shm){
  const int tid=threadIdx.x,lane=tid&63,r32=lane&31,hi=lane>>5; const int wid=__builtin_amdgcn_readfirstlane(tid>>6);
  const long rowbase=(long)b*SEQ_; const int q0=qb*QB;
  const unsigned short*Qw=Q+(rowbase+q0+wid*QBLK)*QPITCH+h*96;
  const unsigned short*Kh=KV+rowbase*KVPITCH+h*128,*Vh=Kh+64,*KRb=KR+rowbase*KRPITCH;
  const unsigned lds0=(unsigned)(uintptr_t)shm;
  float*wsf=(float*)(shm+LDS_WS)+wid*64;
  const unsigned short*ksrc0=Kh+(long)lane*KVPITCH+wid*8;
  const unsigned short*ksrc1=KRb+(long)lane*KRPITCH+(wid&3)*8;
  const unsigned short*vsrc=Vh+(long)(16*(wid&3)+(lane>>2))*KVPITCH+(wid>>2)*32+(lane&3)*8;
  const unsigned kdst0=lds0+LDS_K+wid*1024,kdst1=lds0+LDS_K+(8+(wid&3))*1024,vdst=lds0+LDS_V+wid*1024;
  #define DMA_T(t,sl) do{ glds16(ksrc0+(long)(t)*KVBLK*KVPITCH,(unsigned)__builtin_amdgcn_readfirstlane(kdst0+(sl)*KSLOT)); \
                          glds16(ksrc1+(long)(t)*KVBLK*KRPITCH,(unsigned)__builtin_amdgcn_readfirstlane(kdst1+(sl)*KSLOT)); \
                          glds16(vsrc+(long)(t)*KVBLK*KVPITCH,(unsigned)__builtin_amdgcn_readfirstlane(vdst+(sl)*VSLOT)); }while(0)
  const int vb0=(int)(lds0+LDS_V)+((lane>>4)&1)*32+(lane&3)*8+(4*hi+((lane&15)>>2))*64;
  const lds_cptr shm3=(lds_cptr)(__attribute__((address_space(3))) char*)shm;
  const int NT=(q0+QB)/KVBLK;
  bf16x8 qr[6];
  #pragma unroll
  for(int d0=0;d0<6;++d0)qr[d0]=*reinterpret_cast<const bf16x8*>(&Qw[(long)r32*QPITCH+d0*16+hi*8]);
  {
    const float*cp=COS+(rowbase+q0+wid*QBLK+r32)*16+hi*8,*sp=SIN+(rowbase+q0+wid*QBLK+r32)*16+hi*8;
    float cs[8],sn[8];
    #pragma unroll
    for(int j=0;j<8;++j){cs[j]=cp[j];sn[j]=sp[j];}
    const float sc=0.10206207261596577f*1.4426950408889634f;
    float x1[8],x2[8];
    #pragma unroll
    for(int j=0;j<8;++j){x1[j]=__uint_as_float(((unsigned)(unsigned short)qr[4][j])<<16);x2[j]=__uint_as_float(((unsigned)(unsigned short)qr[5][j])<<16);}
    #pragma unroll
    for(int j=0;j<8;j+=2){
      const unsigned a=cvtpk_s((x1[j]*cs[j]-x2[j]*sn[j])*sc,(x1[j+1]*cs[j+1]-x2[j+1]*sn[j+1])*sc), c=cvtpk_s((x2[j]*cs[j]+x1[j]*sn[j])*sc,(x2[j+1]*cs[j+1]+x1[j+1]*sn[j+1])*sc);
      qr[4][j]=(short)(a&0xffffu);qr[4][j+1]=(short)(a>>16);qr[5][j]=(short)(c&0xffffu);qr[5][j+1]=(short)(c>>16);}
    #pragma unroll
    for(int d0=0;d0<4;++d0)
      #pragma unroll
      for(int j=0;j<8;j+=2){const unsigned a=cvtpk_s(__uint_as_float(((unsigned)(unsigned short)qr[d0][j])<<16)*sc,__uint_as_float(((unsigned)(unsigned short)qr[d0][j+1])<<16)*sc);
        qr[d0][j]=(short)(a&0xffffu);qr[d0][j+1]=(short)(a>>16);}
  }
  asm volatile("s_waitcnt vmcnt(0)":::"memory");
  DMA_T(0,0); DMA_T(1,1);
  float mhat=0.f,l_reg=0.f;f32x16 o[2];o[0]=f32x16{};o[1]=f32x16{};f32x16 negm=f32x16{};
  const int qrel=wid*QBLK+r32;
  int sl=0;
  for(int t=0;t<NT;++t){
    if(t+1<NT){MLA_WAIT_BAR(3);}else{MLA_WAIT_BAR(0);}
    if(t+2<NT){const int s2=(sl==0)?2:sl-1; DMA_T(t+2,s2);}
    f32x16 p0,p1;
    qkt6(p0,p1,shm3+LDS_K+sl*KSLOT,qr,negm,r32,hi);
    if(t>=NT-4)cmask(p0,p1,t-(NT-4),qrel,hi);
    const float rm=rowmax(p0,p1);
    bool resc=false;
    if(t==0){ const float dl=rm; mhat+=dl;
      #pragma unroll
      for(int r=0;r<16;++r){p0[r]-=dl;p1[r]-=dl;}
      #pragma unroll
      for(int r=0;r<16;++r)negm[r]=-mhat;
    } else if(__any(rm>(float)THRL)){ const float dl=__builtin_fmaxf(rm,0.f); mhat+=dl;
      #pragma unroll
      for(int r=0;r<16;++r){p0[r]-=dl;p1[r]-=dl;}
      #pragma unroll
      for(int r=0;r<16;++r)negm[r]=-mhat;
      const float f=__builtin_amdgcn_exp2f(-dl); l_reg*=f; if(hi==0)wsf[r32]=f; resc=true; }
    float sacc=0.f;
    #pragma unroll
    for(int r=0;r<16;++r){p0[r]=__builtin_amdgcn_exp2f(p0[r]);p1[r]=__builtin_amdgcn_exp2f(p1[r]);sacc+=p0[r]+p1[r];}
    l_reg+=sacc;
    if(resc){ asm volatile("s_waitcnt lgkmcnt(0)":::"memory");
      #pragma unroll
      for(int d_=0;d_<2;++d_)
        #pragma unroll
        for(int r=0;r<16;++r)o[d_][r]*=wsf[crow(r,hi)]; }
    u32x4 pw0,pw1,pw2,pw3;
    pw0=(u32x4){cvtpk_s(p0[0],p0[1]),cvtpk_s(p0[2],p0[3]),cvtpk_s(p0[4],p0[5]),cvtpk_s(p0[6],p0[7])};
    pw1=(u32x4){cvtpk_s(p0[8],p0[9]),cvtpk_s(p0[10],p0[11]),cvtpk_s(p0[12],p0[13]),cvtpk_s(p0[14],p0[15])};
    pw2=(u32x4){cvtpk_s(p1[0],p1[1]),cvtpk_s(p1[2],p1[3]),cvtpk_s(p1[4],p1[5]),cvtpk_s(p1[6],p1[7])};
    pw3=(u32x4){cvtpk_s(p1[8],p1[9]),cvtpk_s(p1[10],p1[11]),cvtpk_s(p1[12],p1[13]),cvtpk_s(p1[14],p1[15])};
    pv(o,vb0+sl*VSLOT,__builtin_bit_cast(bf16x8,pw0),__builtin_bit_cast(bf16x8,pw1),__builtin_bit_cast(bf16x8,pw2),__builtin_bit_cast(bf16x8,pw3));
    sl=(sl==2)?0:sl+1;
  }
  {auto rr=__builtin_amdgcn_permlane32_swap(__float_as_uint(l_reg),__float_as_uint(l_reg),false,false);l_reg=__uint_as_float(rr[0])+__uint_as_float(rr[1]);}
  if(hi==0)wsf[32+r32]=l_reg;asm volatile("s_waitcnt lgkmcnt(0)":::"memory");
  float rli[16];
  #pragma unroll
  for(int r=0;r<16;++r)rli[r]=__builtin_amdgcn_rcpf(wsf[32+crow(r,hi)]);
  unsigned short*Ow=O+(rowbase+q0+wid*QBLK)*OPITCH+h*64;
  { unsigned short*stg=(unsigned short*)(shm+LDS_OST)+wid*2048;
    #pragma unroll
    for(int r=0;r<16;++r){const int orow=crow(r,hi);
      #pragma unroll
      for(int d0=0;d0<2;++d0)stg[orow*64+d0*32+r32]=(unsigned short)(cvtpk_s(o[d0][r]*rli[r],0.f)&0xffffu);}
    asm volatile("s_waitcnt lgkmcnt(0)":::"memory");
    #pragma unroll
    for(int i=0;i<4;++i){const int row=i*8+(lane>>3),ch=lane&7; const u32x4 v=*(const u32x4*)(stg+row*64+ch*8); *(u32x4*)(Ow+(long)row*OPITCH+ch*8)=v;} }
  asm volatile("s_waitcnt vmcnt(0) lgkmcnt(0)\n\ts_barrier":::"memory");
  #undef DMA_T
}

typedef short v4i16_t __attribute__((ext_vector_type(4)));
__device__ __forceinline__ s16x4 vtr(lds_cptr p){ return __builtin_bit_cast(s16x4,__builtin_amdgcn_ds_read_tr16_b64_v4i16((__attribute__((address_space(3))) v4i16_t*)p)); }
template<int THRL> __device__ __forceinline__ void attn_unit2(int b,int h,int qb,const unsigned short*Q,const unsigned short*KV,const unsigned short*KR,const float*COS,const float*SIN,unsigned short*O,char*shm){
  const int tid=threadIdx.x,lane=tid&63,r32=lane&31,hi=lane>>5; const int wid=__builtin_amdgcn_readfirstlane(tid>>6);
  const long rowbase=(long)b*SEQ_; const int q0=qb*QB;
  const unsigned short*Qw=Q+(rowbase+q0+wid*QBLK)*QPITCH+h*96;
  const unsigned short*Kh=KV+rowbase*KVPITCH+h*128,*Vh=Kh+64,*KRb=KR+rowbase*KRPITCH;
  const unsigned lds0=(unsigned)(uintptr_t)shm;
  float*wsf=(float*)(shm+LDS_WS)+wid*64;
  const unsigned koff0=(unsigned)(lane*KVPITCH+wid*8)*2u, koff1=(unsigned)(lane*KRPITCH+(wid&3)*8)*2u, voffv=(unsigned)((16*(wid&3)+(lane>>2))*KVPITCH+(wid>>2)*32+(lane&3)*8)*2u;
  const unsigned kdst0=lds0+LDS_K+wid*1024,kdst1=lds0+LDS_K+(8+(wid&3))*1024,vdst=lds0+LDS_V+wid*1024;
  #define DMA_K2(t,sl) do{ glds16s(Kh+(long)(t)*KVBLK*KVPITCH,koff0,(unsigned)__builtin_amdgcn_readfirstlane(kdst0+(sl)*KSLOT)); \
                           glds16s(KRb+(long)(t)*KVBLK*KRPITCH,koff1,(unsigned)__builtin_amdgcn_readfirstlane(kdst1+(sl)*KSLOT)); }while(0)
  #define DMA_V2(t,sl) glds16s(Vh+(long)(t)*KVBLK*KVPITCH,voffv,(unsigned)__builtin_amdgcn_readfirstlane(vdst+(sl)*VSLOT))
  const lds_cptr shm3=(lds_cptr)(__attribute__((address_space(3))) char*)shm;
  const lds_cptr vp0=shm3+LDS_V+((lane>>4)&1)*32+(lane&3)*8+(4*hi+((lane&15)>>2))*64;
  const int NT=(q0+QB)/KVBLK;
  DMA_K2(0,0); DMA_V2(0,0); DMA_K2(1,1);
  bf16x8 qr[6];
  #pragma unroll
  for(int d0=0;d0<6;++d0)qr[d0]=*reinterpret_cast<const bf16x8*>(&Qw[(long)r32*QPITCH+d0*16+hi*8]);
  { const float*cp=COS+(rowbase+q0+wid*QBLK+r32)*16+hi*8,*sp=SIN+(rowbase+q0+wid*QBLK+r32)*16+hi*8;
    float cs[8],sn[8];
    #pragma unroll
    for(int j=0;j<8;++j){cs[j]=cp[j];sn[j]=sp[j];}
    const float sc=0.10206207261596577f*1.4426950408889634f;
    float x1[8],x2[8];
    #pragma unroll
    for(int j=0;j<8;++j){x1[j]=__uint_as_float(((unsigned)(unsigned short)qr[4][j])<<16);x2[j]=__uint_as_float(((unsigned)(unsigned short)qr[5][j])<<16);}
    #pragma unroll
    for(int j=0;j<8;j+=2){
      const unsigned a=cvtpk_s((x1[j]*cs[j]-x2[j]*sn[j])*sc,(x1[j+1]*cs[j+1]-x2[j+1]*sn[j+1])*sc), c=cvtpk_s((x2[j]*cs[j]+x1[j]*sn[j])*sc,(x2[j+1]*cs[j+1]+x1[j+1]*sn[j+1])*sc);
      qr[4][j]=(short)(a&0xffffu);qr[4][j+1]=(short)(a>>16);qr[5][j]=(short)(c&0xffffu);qr[5][j+1]=(short)(c>>16);}
    #pragma unroll
    for(int d0=0;d0<4;++d0)
      #pragma unroll
      for(int j=0;j<8;j+=2){const unsigned a=cvtpk_s(__uint_as_float(((unsigned)(unsigned short)qr[d0][j])<<16)*sc,__uint_as_float(((unsigned)(unsigned short)qr[d0][j+1])<<16)*sc);
        qr[d0][j]=(short)(a&0xffffu);qr[d0][j+1]=(short)(a>>16);}
  }
  float mhat=0.f,l_reg=0.f;f32x16 o[2];o[0]=f32x16{};o[1]=f32x16{};f32x16 negm=f32x16{};
  const int qrel=wid*QBLK+r32;
  f32x16 p0,p1;
  MLA_WAIT_BAR(3);
  DMA_K2(2,2); DMA_V2(1,1);
  qkt6(p0,p1,shm3+LDS_K,qr,negm,r32,hi);
  if(NT==4)cmask(p0,p1,0,qrel,hi);
  { const float dl=rowmax(p0,p1); mhat+=dl;
    #pragma unroll
    for(int r=0;r<16;++r){p0[r]=__builtin_amdgcn_exp2f(p0[r]-dl);p1[r]=__builtin_amdgcn_exp2f(p1[r]-dl);}
    #pragma unroll
    for(int r=0;r<16;++r)negm[r]=-mhat; }
  int sk=1,sv=0;
  for(int t=1;t<NT;++t){
    if(t+1<NT){MLA_WAIT_BAR(3);}else{MLA_WAIT_BAR(1);}
    if(t+2<NT){DMA_K2(t+2,(sk==0)?2:sk-1);}
    if(t+1<NT){DMA_V2(t+1,(sv==0)?2:sv-1);}
    f32x16 c0,c1;
    s16x4 vlo[8],vhi[8];
    u32x4 pwa[4];
    float sacc=0.f;
    const lds_cptr vp_=vp0+sv*VSLOT;
    const lds_cptr kbp=shm3+LDS_K+sk*KSLOT+hi*1024+r32*16;
    #define SB_() __builtin_amdgcn_sched_barrier(0)
    #define PINV(x) asm volatile("":"+v"(x))
    #define KF(g) (*(const __attribute__((address_space(3))) bf16x8*)(kbp+((g)>>1)*2048+((g)&1)*512))
    #define PFLAT(i) ((i)<16?p0[(i)&15]:p1[(i)&15])
    #define VRD_(i) do{ vlo[i]=vtr(vp_+(((i)>>2)*4096+((i)&3)*1024)); vhi[i]=vtr(vp_+(((i)>>2)*4096+((i)&3)*1024+512)); }while(0)
    #define FILL(i) do{ if(((i)&3)<2){VRD_(i);} \
        sacc+=(PFLAT(4*(i))+PFLAT(4*(i)+1))+(PFLAT(4*(i)+2)+PFLAT(4*(i)+3)); PINV(sacc); \
        pwa[(i)>>1][2*((i)&1)]=cvtpk_s(PFLAT(4*(i)),PFLAT(4*(i)+1)); pwa[(i)>>1][2*((i)&1)+1]=cvtpk_s(PFLAT(4*(i)+2),PFLAT(4*(i)+3)); PINV(pwa[(i)>>1]); }while(0)
    bf16x8 k0=KF(0),k1=KF(1),k2=KF(2),k3=KF(3);
    SB_();
    c0=__builtin_amdgcn_mfma_f32_32x32x16_bf16(k0,qr[0],negm,0,0,0); k0=KF(4);  FILL(0); SB_();
    c1=__builtin_amdgcn_mfma_f32_32x32x16_bf16(k1,qr[0],negm,0,0,0); k1=KF(5);  FILL(1); SB_();
    c0=__builtin_amdgcn_mfma_f32_32x32x16_bf16(k2,qr[1],c0,0,0,0);   k2=KF(6);  FILL(2); SB_();
    c1=__builtin_amdgcn_mfma_f32_32x32x16_bf16(k3,qr[1],c1,0,0,0);   k3=KF(7);  FILL(3); SB_();
    c0=__builtin_amdgcn_mfma_f32_32x32x16_bf16(k0,qr[2],c0,0,0,0);   k0=KF(8);  FILL(4); SB_();
    c1=__builtin_amdgcn_mfma_f32_32x32x16_bf16(k1,qr[2],c1,0,0,0);   k1=KF(9);  FILL(5); SB_();
    c0=__builtin_amdgcn_mfma_f32_32x32x16_bf16(k2,qr[3],c0,0,0,0);   k2=KF(10); FILL(6); SB_();
    c1=__builtin_amdgcn_mfma_f32_32x32x16_bf16(k3,qr[3],c1,0,0,0);   k3=KF(11); FILL(7); SB_();
    c0=__builtin_amdgcn_mfma_f32_32x32x16_bf16(k0,qr[4],c0,0,0,0);
    c1=__builtin_amdgcn_mfma_f32_32x32x16_bf16(k1,qr[4],c1,0,0,0);
    c0=__builtin_amdgcn_mfma_f32_32x32x16_bf16(k2,qr[5],c0,0,0,0);
    c1=__builtin_amdgcn_mfma_f32_32x32x16_bf16(k3,qr[5],c1,0,0,0);
    SB_();
    l_reg+=sacc;
    if(t>=NT-4)cmask(c0,c1,t-(NT-4),qrel,hi);
    #define VFRG(i) (bf16x8){vlo[i][0],vlo[i][1],vlo[i][2],vlo[i][3],vhi[i][0],vhi[i][1],vhi[i][2],vhi[i][3]}
    #define MX3_(a,b,c) __builtin_fmaxf(__builtin_fmaxf((a),(b)),(c))
    #define EXN(X,B,N) do{ _Pragma("unroll") for(int e_=0;e_<(N);++e_) X[(B)+e_]=__builtin_amdgcn_exp2f(X[(B)+e_]); PINV(X); SB_(); }while(0)
    float ma,mb;
    o[0]=__builtin_amdgcn_mfma_f32_32x32x16_bf16(__builtin_bit_cast(bf16x8,pwa[0]),VFRG(0),o[0],0,0,0);
    ma=MX3_(c0[0],c0[1],c1[0]); mb=MX3_(c0[2],c0[3],c1[1]); ma=MX3_(ma,c1[2],c1[3]);
    ma=MX3_(ma,c0[4],c0[5]); mb=MX3_(mb,c0[6],c0[7]); ma=MX3_(ma,c1[4],c1[5]); mb=MX3_(mb,c1[6],c1[7]); PINV(ma); PINV(mb); VRD_(2); VRD_(6); SB_();
    o[1]=__builtin_amdgcn_mfma_f32_32x32x16_bf16(__builtin_bit_cast(bf16x8,pwa[0]),VFRG(4),o[1],0,0,0);
    ma=MX3_(ma,c0[8],c0[9]); mb=MX3_(mb,c0[10],c0[11]); ma=MX3_(ma,c1[8],c1[9]); mb=MX3_(mb,c1[10],c1[11]);
    ma=MX3_(ma,c0[12],c0[13]); mb=MX3_(mb,c0[14],c0[15]); ma=MX3_(ma,c1[12],c1[13]); mb=MX3_(mb,c1[14],c1[15]);
    float rm=__builtin_fmaxf(ma,mb);
    { auto rr=__builtin_amdgcn_permlane32_swap(__float_as_uint(rm),__float_as_uint(rm),false,false); rm=__builtin_fmaxf(__uint_as_float(rr[0]),__uint_as_float(rr[1])); }
    PINV(rm); VRD_(3); VRD_(7); SB_();
    bool resc=false;
    if(__any(rm>(float)THRL)){ const float dl=__builtin_fmaxf(rm,0.f); mhat+=dl;
      #pragma unroll
      for(int r=0;r<16;++r){c0[r]-=dl;c1[r]-=dl;}
      #pragma unroll
      for(int r=0;r<16;++r)negm[r]=-mhat;
      const float f=__builtin_amdgcn_exp2f(-dl); l_reg*=f; if(hi==0)wsf[r32]=f; resc=true; }
    SB_();
    o[0]=__builtin_amdgcn_mfma_f32_32x32x16_bf16(__builtin_bit_cast(bf16x8,pwa[1]),VFRG(1),o[0],0,0,0); EXN(c0,0,5);
    o[1]=__builtin_amdgcn_mfma_f32_32x32x16_bf16(__builtin_bit_cast(bf16x8,pwa[1]),VFRG(5),o[1],0,0,0); EXN(c0,5,5);
    o[0]=__builtin_amdgcn_mfma_f32_32x32x16_bf16(__builtin_bit_cast(bf16x8,pwa[2]),VFRG(2),o[0],0,0,0); EXN(c0,10,6);
    o[1]=__builtin_amdgcn_mfma_f32_32x32x16_bf16(__builtin_bit_cast(bf16x8,pwa[2]),VFRG(6),o[1],0,0,0); EXN(c1,0,5);
    o[0]=__builtin_amdgcn_mfma_f32_32x32x16_bf16(__builtin_bit_cast(bf16x8,pwa[3]),VFRG(3),o[0],0,0,0); EXN(c1,5,5);
    o[1]=__builtin_amdgcn_mfma_f32_32x32x16_bf16(__builtin_bit_cast(bf16x8,pwa[3]),VFRG(7),o[1],0,0,0); EXN(c1,10,6);
    #undef MX3_
    #undef EXN
    p0=c0; p1=c1;
    #undef KF
    #undef FILL
    #undef VRD_
    if(resc){ asm volatile("s_waitcnt lgkmcnt(0)":::"memory");
      #pragma unroll
      for(int d_=0;d_<2;++d_)
        #pragma unroll
        for(int r=0;r<16;++r)o[d_][r]*=wsf[crow(r,hi)]; }
    sk=(sk==2)?0:sk+1; sv=(sv==2)?0:sv+1;
  }
  MLA_WAIT_BAR(0);
  { s16x4 vlo[8],vhi[8]; const lds_cptr vp_=vp0+sv*VSLOT;
    #pragma unroll
    for(int i=0;i<8;++i){ vlo[i]=vtr(vp_+((i>>2)*4096+(i&3)*1024)); vhi[i]=vtr(vp_+((i>>2)*4096+(i&3)*1024+512)); }
    float sacc=0.f;
    #pragma unroll
    for(int r=0;r<16;++r)sacc+=p0[r]+p1[r];
    l_reg+=sacc;
    u32x4 pw0,pw1,pw2,pw3;
    pw0=(u32x4){cvtpk_s(p0[0],p0[1]),cvtpk_s(p0[2],p0[3]),cvtpk_s(p0[4],p0[5]),cvtpk_s(p0[6],p0[7])};
    pw1=(u32x4){cvtpk_s(p0[8],p0[9]),cvtpk_s(p0[10],p0[11]),cvtpk_s(p0[12],p0[13]),cvtpk_s(p0[14],p0[15])};
    pw2=(u32x4){cvtpk_s(p1[0],p1[1]),cvtpk_s(p1[2],p1[3]),cvtpk_s(p1[4],p1[5]),cvtpk_s(p1[6],p1[7])};
    pw3=(u32x4){cvtpk_s(p1[8],p1[9]),cvtpk_s(p1[10],p1[11]),cvtpk_s(p1[12],p1[13]),cvtpk_s(p1[14],p1[15])};
    o[0]=__builtin_amdgcn_mfma_f32_32x32x16_bf16(__builtin_bit_cast(bf16x8,pw0),VFRG(0),o[0],0,0,0);
    o[1]=__builtin_amdgcn_mfma_f32_32x32x16_bf16(__builtin_bit_cast(bf16x8,pw0),VFRG(4),o[1],0,0,0);
    o[0]=__builtin_amdgcn_mfma_f32_32x32x16_bf16(__builtin_bit_cast(bf16x8,pw1),VFRG(1),o[0],0,0,0);
    o[1]=__builtin_amdgcn_mfma_f32_32x32x16_bf16(__builtin_bit_cast(bf16x8,pw1),VFRG(5),o[1],0,0,0);
    o[0]=__builtin_amdgcn_mfma_f32_32x32x16_bf16(__builtin_bit_cast(bf16x8,pw2),VFRG(2),o[0],0,0,0);
    o[1]=__builtin_amdgcn_mfma_f32_32x32x16_bf16(__builtin_bit_cast(bf16x8,pw2),VFRG(6),o[1],0,0,0);
    o[0]=__builtin_amdgcn_mfma_f32_32x32x16_bf16(__builtin_bit_cast(bf16x8,pw3),VFRG(3),o[0],0,0,0);
    o[1]=__builtin_amdgcn_mfma_f32_32x32x16_bf16(__builtin_bit_cast(bf16x8,pw3),VFRG(7),o[1],0,0,0);
    #undef VFRG
  }
  {auto rr=__builtin_amdgcn_permlane32_swap(__float_as_uint(l_reg),__float_as_uint(l_reg),false,false);l_reg=__uint_as_float(rr[0])+__uint_as_float(rr[1]);}
  if(hi==0)wsf[32+r32]=l_reg;asm volatile("s_waitcnt lgkmcnt(0)":::"memory");
  float rli[16];
  #pragma unroll
  for(int r=0;r<16;++r)rli[r]=__builtin_amdgcn_rcpf(wsf[32+crow(r,hi)]);
  unsigned short*Ow=O+(rowbase+q0+wid*QBLK)*OPITCH+h*64;
  { unsigned short*stg=(unsigned short*)(shm+LDS_OST)+wid*2048;
    #pragma unroll
    for(int r=0;r<16;++r){const int orow=crow(r,hi);
      #pragma unroll
      for(int d0=0;d0<2;++d0)stg[orow*64+d0*32+r32]=(unsigned short)(cvtpk_s(o[d0][r]*rli[r],0.f)&0xffffu);}
    asm volatile("s_waitcnt lgkmcnt(0)":::"memory");
    #pragma unroll
    for(int i=0;i<4;++i){const int row=i*8+(lane>>3),ch=lane&7; const u32x4 v=*(const u32x4*)(stg+row*64+ch*8); *(u32x4*)(Ow+(long)row*OPITCH+ch*8)=v;} }
  asm volatile("s_waitcnt lgkmcnt(0)\n\ts_barrier":::"memory");
  #undef DMA_K2
  #undef DMA_V2
  #undef PFLAT
  #undef SB_
  #undef PINV
}
}


namespace hg {
typedef float f32x4 __attribute__((ext_vector_type(4)));
typedef short bf16x8 __attribute__((ext_vector_type(8)));
typedef unsigned u32x4 __attribute__((ext_vector_type(4)));
typedef unsigned u32x2 __attribute__((ext_vector_type(2)));
#define HLAS __attribute__((address_space(3)))
constexpr int NSEG = 8, CPS = 64 / NSEG;
constexpr int L_Q = 0, L_F = 16384, L_V = 32768, L_K1T = 49152, L_VT = 67584, L_A = 86016, L_ST = 95232, L_TOT = L_A, L_END = 130048;
constexpr int L_CM = 132096, L_CL = 132608;
constexpr int P144 = 144, P272 = 272;
__device__ __forceinline__ float bf2f_(unsigned short b) { return __uint_as_float((unsigned)b << 16); }
__device__ __forceinline__ unsigned f2bf_(float f) { unsigned u = __float_as_uint(f); return (u + 0x7fffu + ((u >> 16) & 1u)) >> 16; }
__device__ __forceinline__ unsigned pk_(float lo, float hi) { return f2bf_(lo) | (f2bf_(hi) << 16); }
__device__ __forceinline__ int swz(int t, int c) { return t * 256 + ((c ^ (t & 15)) << 4); }
__device__ __forceinline__ int swz_e(int t, int k) { return swz(t, k >> 3) + (k & 7) * 2; }
#define HG_BAR() do { asm volatile("s_waitcnt lgkmcnt(0)" ::: "memory"); __builtin_amdgcn_s_barrier(); asm volatile("" ::: "memory"); } while (0)
#define HG_MFMA(a, b, c) __builtin_amdgcn_mfma_f32_16x16x32_bf16((a), (b), (c), 0, 0, 0)

struct P1Args { const unsigned short* HP; const float* lbp; unsigned short* OL; unsigned short* Q1G; float* WN; float* SS; float* DSEG; };
__device__ __forceinline__ void hg_pass1(HLAS unsigned char* L, const P1Args& a, int G) {
    const int tid = threadIdx.x, lane = tid & 63, w = __builtin_amdgcn_readfirstlane(tid >> 6), r16 = lane & 15, g4 = lane >> 4;
    const int k = tid & 127, tq = tid >> 7;
    for (int u = blockIdx.x; u < 32 * NSEG; u += G) {
        const int bh = u / NSEG, seg = u % NSEG, b = bh >> 3, h = bh & 7;
        const size_t rowseg = (size_t)b * 4096 + (size_t)seg * CPS * 64;
        const float lb = 1.0f / (1.0f + __expf(-(a.lbp[1024 + h * 128 + k] - a.lbp[h * 128 + k])));
        f32x4 S[8];
#pragma unroll
        for (int j = 0; j < 8; ++j) S[j] = (f32x4){0.f, 0.f, 0.f, 0.f};
        float carry = 0.f;
        u32x4 pq[2], pf[2], pv[2];
#define HG_PREFETCH(n_) do { _Pragma("unroll") for (int j = 0; j < 2; ++j) { const int e = tid + 512 * j, t = e >> 4, c = e & 15; \
            const unsigned short* src = a.HP + (rowseg + (size_t)(n_) * 64 + t) * 4096 + h * 128 + 8 * c; \
            pq[j] = *(const u32x4*)src; pf[j] = *(const u32x4*)(src + 1024); pv[j] = *(const u32x4*)(src + 2048); } } while (0)
        HG_PREFETCH(0);
        for (int n = 0; n < CPS; ++n) {
            const size_t row0 = rowseg + (size_t)n * 64;
            HG_BAR();
#pragma unroll
            for (int j = 0; j < 2; ++j) { const int e = tid + 512 * j, t = e >> 4, c = e & 15; const int o = swz(t, c);
                *(HLAS u32x4*)(L + L_Q + o) = pq[j]; *(HLAS u32x4*)(L + L_F + o) = pf[j]; *(HLAS u32x4*)(L + L_V + o) = pv[j]; }
            if (n + 1 < CPS) HG_PREFETCH(n + 1);
            HG_BAR();
            float fv[16], cs[16];
            { float run = 0.f;
#pragma unroll
              for (int i = 0; i < 16; ++i) { const int t = 16 * tq + i; const float x = bf2f_(*(const HLAS unsigned short*)(L + L_F + swz_e(t, k)));
                  const float f = lb + (1.0f - lb) * __builtin_amdgcn_rcpf(1.0f + __expf(-x)); fv[i] = f; run += __logf(f); cs[i] = run; }
              *(HLAS float*)(L + L_TOT + (tq * 128 + k) * 4) = run; }
            HG_BAR();
            { const float t0 = *(const HLAS float*)(L + L_TOT + (0 * 128 + k) * 4), t1 = *(const HLAS float*)(L + L_TOT + (1 * 128 + k) * 4), t2 = *(const HLAS float*)(L + L_TOT + (2 * 128 + k) * 4), t3 = *(const HLAS float*)(L + L_TOT + (3 * 128 + k) * 4);
              const float pre = (tq == 0) ? 0.f : (tq == 1) ? t0 : (tq == 2) ? (t0 + t1) : ((t0 + t1) + t2);
              const float bmid = t0 + t1, blast = (t0 + t1) + (t2 + t3);
              unsigned kt[8], vt[8];
#pragma unroll
              for (int i = 0; i < 16; i += 2) {
                  float q1[2], k1[2];
#pragma unroll
                  for (int d = 0; d < 2; ++d) { const int t = 16 * tq + i + d; const float r = (pre + cs[i + d]) - bmid; const float E1 = __expf(r), iE1 = __builtin_amdgcn_rcpf(E1);
                      const float qs = bf2f_(*(const HLAS unsigned short*)(L + L_Q + swz_e(t, k))) * 0.08838834764831845f;
                      q1[d] = qs * E1; k1[d] = (1.0f - fv[i + d]) * iE1;
                      *(HLAS unsigned short*)(L + L_Q + swz_e(t, k)) = (unsigned short)f2bf_(q1[d]); *(HLAS unsigned short*)(L + L_F + swz_e(t, k)) = (unsigned short)f2bf_(k1[d]); }
                  kt[i >> 1] = pk_(k1[0], k1[1]);
                  vt[i >> 1] = (unsigned)*(const HLAS unsigned short*)(L + L_V + swz_e(16 * tq + i, k)) | ((unsigned)*(const HLAS unsigned short*)(L + L_V + swz_e(16 * tq + i + 1, k)) << 16); }
              *(HLAS u32x4*)(L + L_K1T + k * P144 + tq * 32) = (u32x4){kt[0], kt[1], kt[2], kt[3]}; *(HLAS u32x4*)(L + L_K1T + k * P144 + tq * 32 + 16) = (u32x4){kt[4], kt[5], kt[6], kt[7]};
              *(HLAS u32x4*)(L + L_VT + k * P144 + tq * 32) = (u32x4){vt[0], vt[1], vt[2], vt[3]}; *(HLAS u32x4*)(L + L_VT + k * P144 + tq * 32 + 16) = (u32x4){vt[4], vt[5], vt[6], vt[7]};
              if (tq == 0) { *(HLAS float*)(L + L_CM + k * 4) = __expf(bmid); *(HLAS float*)(L + L_CL + k * 4) = __expf(blast - bmid);
                  a.WN[((size_t)u * CPS + n) * 128 + k] = __expf(bmid + carry); }
              carry += blast; }
            HG_BAR();
            f32x4 cmv, clv;
#pragma unroll
            for (int i = 0; i < 4; ++i) { cmv[i] = *(const HLAS float*)(L + L_CM + (16 * w + 4 * g4 + i) * 4); clv[i] = *(const HLAS float*)(L + L_CL + (16 * w + 4 * g4 + i) * 4); }
#pragma unroll
            for (int j = 0; j < 8; ++j) { S[j] = S[j] * cmv; *(HLAS u32x2*)(L + L_ST + (16 * j + r16) * P272 + (16 * w + 4 * g4) * 2) = (u32x2){pk_(S[j][0], S[j][1]), pk_(S[j][2], S[j][3])}; }
            { const int ct = w >> 1;
#pragma unroll
              for (int q = 0; q < 2; ++q) { const int st = 2 * (w & 1) + q; f32x4 d = (f32x4){0.f, 0.f, 0.f, 0.f};
                  if (st <= ct) {
#pragma unroll
                      for (int ks = 0; ks < 4; ++ks) { const bf16x8 af = *(const HLAS bf16x8*)(L + L_F + swz(16 * st + r16, 4 * ks + g4)), bf = *(const HLAS bf16x8*)(L + L_Q + swz(16 * ct + r16, 4 * ks + g4)); d = HG_MFMA(af, bf, d); }
                      if (st == ct) {
#pragma unroll
                          for (int i = 0; i < 4; ++i) if (4 * g4 + i > r16) d[i] = 0.f; } }
                  *(HLAS u32x2*)(L + L_A + (16 * ct + r16) * P144 + (16 * st + 4 * g4) * 2) = (u32x2){pk_(d[0], d[1]), pk_(d[2], d[3])}; } }
#pragma unroll
            for (int j = 0; j < 2; ++j) { const int e = tid + 512 * j, t = e >> 4, c = e & 15; *(u32x4*)(a.Q1G + (row0 + t) * 1024 + h * 128 + 8 * c) = *(const HLAS u32x4*)(L + L_Q + swz(t, c)); }
            HG_BAR();
#pragma unroll
            for (int ct = 0; ct < 4; ++ct) { f32x4 d = (f32x4){0.f, 0.f, 0.f, 0.f};
#pragma unroll
                for (int ks = 0; ks < 2; ++ks) { if (ks == 1 && ct < 2) continue;
                    const bf16x8 af = *(const HLAS bf16x8*)(L + L_VT + (16 * w + r16) * P144 + (32 * ks + 8 * g4) * 2), bf = *(const HLAS bf16x8*)(L + L_A + (16 * ct + r16) * P144 + (32 * ks + 8 * g4) * 2); d = HG_MFMA(af, bf, d); }
#pragma unroll
                for (int ks = 0; ks < 4; ++ks) { const bf16x8 af = *(const HLAS bf16x8*)(L + L_ST + (16 * w + r16) * P272 + (32 * ks + 8 * g4) * 2), bf = *(const HLAS bf16x8*)(L + L_Q + swz(16 * ct + r16, 4 * ks + g4)); d = HG_MFMA(af, bf, d); }
                *(u32x2*)(a.OL + (row0 + 16 * ct + r16) * 1024 + h * 128 + 16 * w + 4 * g4) = (u32x2){pk_(d[0], d[1]), pk_(d[2], d[3])}; }
#pragma unroll
            for (int j = 0; j < 8; ++j) {
#pragma unroll
                for (int ks = 0; ks < 2; ++ks) { const bf16x8 af = *(const HLAS bf16x8*)(L + L_K1T + (16 * w + r16) * P144 + (32 * ks + 8 * g4) * 2), bf = *(const HLAS bf16x8*)(L + L_VT + (16 * j + r16) * P144 + (32 * ks + 8 * g4) * 2); S[j] = HG_MFMA(af, bf, S[j]); }
                S[j] = S[j] * clv; }
        }
#pragma unroll
        for (int j = 0; j < 8; ++j) *(f32x4*)(a.SS + ((size_t)u * 128 + 16 * j + r16) * 128 + 16 * w + 4 * g4) = S[j];
        if (tq == 0) a.DSEG[(size_t)u * 128 + k] = __expf(carry);
#undef HG_PREFETCH
    }
    HG_BAR();
}

struct P2Args { const unsigned short* HP; const unsigned short* OL; const unsigned short* Q1G; const float* WN; const float* SS; const float* DSEG; const float* gout; unsigned short* HON; };
__device__ __forceinline__ void hg_pass2(HLAS unsigned char* L, const P2Args& a, int G) {
    const int tid = threadIdx.x, lane = tid & 63, w = __builtin_amdgcn_readfirstlane(tid >> 6), r16 = lane & 15, g4 = lane >> 4;
    HLAS float* SSQ = (HLAS float*)(L + L_TOT);
    f32x4 gn;
#pragma unroll
    for (int i = 0; i < 4; ++i) gn[i] = a.gout[16 * w + 4 * g4 + i];
    for (int u = blockIdx.x; u < 32 * NSEG; u += G) {
        const int bh = u / NSEG, seg = u % NSEG, b = bh >> 3, h = bh & 7;
        const size_t rowseg = (size_t)b * 4096 + (size_t)seg * CPS * 64;
        const size_t colw = (size_t)h * 128 + 16 * w + 4 * g4;
        u32x2 pol[4], pg[4]; u32x4 pq[2]; f32x4 pwn = (f32x4){0.f, 0.f, 0.f, 0.f};
#define HG2_PREFETCH(n_) do { const size_t r0_ = rowseg + (size_t)(n_) * 64; \
            _Pragma("unroll") for (int ct = 0; ct < 4; ++ct) { const size_t row = r0_ + 16 * ct + r16; pol[ct] = *(const u32x2*)(a.OL + row * 1024 + colw); pg[ct] = *(const u32x2*)(a.HP + row * 4096 + 3072 + colw); } \
            if (seg > 0) { _Pragma("unroll") for (int j = 0; j < 2; ++j) { const int e = tid + 512 * j, t = e >> 4, c = e & 15; pq[j] = *(const u32x4*)(a.Q1G + (r0_ + t) * 1024 + h * 128 + 8 * c); } \
                           pwn = *(const f32x4*)(a.WN + ((size_t)u * CPS + (n_)) * 128 + 16 * w + 4 * g4); } } while (0)
        HG2_PREFETCH(0);
        f32x4 Sin[8];
#pragma unroll
        for (int j = 0; j < 8; ++j) Sin[j] = (f32x4){0.f, 0.f, 0.f, 0.f};
        for (int i = 0; i < seg; ++i) { const size_t ui = (size_t)bh * NSEG + i; const f32x4 dv = *(const f32x4*)(a.DSEG + ui * 128 + 16 * w + 4 * g4);
#pragma unroll
            for (int j = 0; j < 8; ++j) Sin[j] = Sin[j] * dv + *(const f32x4*)(a.SS + (ui * 128 + 16 * j + r16) * 128 + 16 * w + 4 * g4); }
        for (int n = 0; n < CPS; ++n) {
            const size_t row0 = rowseg + (size_t)n * 64;
            HG_BAR();
            u32x2 ol[4], gg[4];
#pragma unroll
            for (int ct = 0; ct < 4; ++ct) { ol[ct] = pol[ct]; gg[ct] = pg[ct]; }
            if (seg > 0) {
#pragma unroll
                for (int j = 0; j < 8; ++j) { const f32x4 t = Sin[j] * pwn; *(HLAS u32x2*)(L + L_ST + (16 * j + r16) * P272 + (16 * w + 4 * g4) * 2) = (u32x2){pk_(t[0], t[1]), pk_(t[2], t[3])}; }
#pragma unroll
                for (int j = 0; j < 2; ++j) { const int e = tid + 512 * j, t = e >> 4, c = e & 15; *(HLAS u32x4*)(L + L_Q + swz(t, c)) = pq[j]; } }
            if (n + 1 < CPS) HG2_PREFETCH(n + 1);
            HG_BAR();
            f32x4 o[4];
#pragma unroll
            for (int ct = 0; ct < 4; ++ct) {
                f32x4 d = (f32x4){bf2f_((unsigned short)(ol[ct].x & 0xffffu)), bf2f_((unsigned short)(ol[ct].x >> 16)), bf2f_((unsigned short)(ol[ct].y & 0xffffu)), bf2f_((unsigned short)(ol[ct].y >> 16))};
                if (seg > 0) {
#pragma unroll
                    for (int ks = 0; ks < 4; ++ks) { const bf16x8 af = *(const HLAS bf16x8*)(L + L_ST + (16 * w + r16) * P272 + (32 * ks + 8 * g4) * 2), bf = *(const HLAS bf16x8*)(L + L_Q + swz(16 * ct + r16, 4 * ks + g4)); d = HG_MFMA(af, bf, d); } }
                o[ct] = d;
                float p = (d[0] * d[0] + d[1] * d[1]) + (d[2] * d[2] + d[3] * d[3]); p += __shfl_xor(p, 16); p += __shfl_xor(p, 32);
                if (g4 == 0) SSQ[w * 64 + 16 * ct + r16] = p; }
            HG_BAR();
#pragma unroll
            for (int ct = 0; ct < 4; ++ct) { float tot = 0.f;
#pragma unroll
                for (int ww = 0; ww < 8; ++ww) tot += SSQ[ww * 64 + 16 * ct + r16];
                const float rs = 1.0f / sqrtf(tot * (1.0f / 128.0f) + 1e-6f);
                const size_t row = row0 + 16 * ct + r16;
                const float g0 = bf2f_((unsigned short)(gg[ct].x & 0xffffu)), g1 = bf2f_((unsigned short)(gg[ct].x >> 16)), g2 = bf2f_((unsigned short)(gg[ct].y & 0xffffu)), g3 = bf2f_((unsigned short)(gg[ct].y >> 16));
                const float s0 = g0 * __builtin_amdgcn_rcpf(1.0f + __expf(-g0)), s1 = g1 * __builtin_amdgcn_rcpf(1.0f + __expf(-g1)), s2 = g2 * __builtin_amdgcn_rcpf(1.0f + __expf(-g2)), s3 = g3 * __builtin_amdgcn_rcpf(1.0f + __expf(-g3));
                *(u32x2*)(a.HON + row * 1024 + colw) = (u32x2){pk_(o[ct][0] * rs * gn[0] * s0, o[ct][1] * rs * gn[1] * s1), pk_(o[ct][2] * rs * gn[2] * s2, o[ct][3] * rs * gn[3] * s3)}; }
        }
#undef HG2_PREFETCH
    }
    HG_BAR();
}
}

struct MoeSplitOrder {
    volatile LAS int* mt; int nN, G, c, nitems;
    __device__ __forceinline__ void init(volatile LAS int* mt_, int nN_, int G_, int c_) { mt = mt_; nN = nN_; G = G_; c = c_; const int T = mt_[8]; nitems = (T > 128 ? T - 128 : 0) * nN_ * 7; }
    __device__ __forceinline__ bool next(int i, pg8::Unit& u) const {
        const int Lx = i * G + c; if (Lx >= nitems) return false;
        const int ks = Lx % 7, r = Lx / 7, pnl = r % nN, tile = 128 + r / nN;
        int e = 0;
#pragma unroll
        for (int j = 1; j < 8; ++j) e += (tile >= mt[j]) ? 1 : 0;
        u.pm = tile; u.pn = e * nN + pnl; u.kb = ks * 1024; return true;
    }
    __device__ __forceinline__ void a_ready(const pg8::Unit&) const {}
    __device__ __forceinline__ void done(const pg8::Unit&) const {}
    __device__ __forceinline__ int arow(const pg8::Unit&, int) const { return 0; }
    __device__ __forceinline__ void issue_rows(const pg8::Unit&, int, int, int) const {}
    __device__ __forceinline__ int arow_lds(int, int) const { return 0; }
};

struct Args { const float* in[22]; const int* pos; float* out; unsigned char* ws; int ph_lo, ph_hi, li, pad; };

__global__ void __launch_bounds__(NWAVES * 64, 2) fwd_kernel(Args args) {
    extern __shared__ __attribute__((aligned(16))) unsigned char lds[];
    LAS unsigned char* L = (LAS unsigned char*)lds;
    volatile LAS unsigned* MISC = (volatile LAS unsigned*)(L + MISC_OFF);
    const int tid = threadIdx.x, lane = tid & 63, wave = __builtin_amdgcn_readfirstlane(tid >> 6);
    const int G = gridDim.x;
    const int gw = blockIdx.x * NWAVES + wave, NGW = G * NWAVES;
    unsigned char* ws = args.ws;
    gu32* ctl = (gu32*)(ws + WS_CTL);
    for (int u = tid; u < (LDS_BYTES - LDSCTL_OFF) / 4; u += NWAVES * 64) ((LAS unsigned*)(L + LDSCTL_OFF))[u] = 0u;
    __syncthreads();
    XcdBarrier bar; bar.bar = (unsigned*)(ctl + CW_BAR); bar.x = 0; bar.st = nullptr;
    if (N_LAUNCHES == 1) bar = xcd_barrier_post((unsigned*)(ctl + CW_BAR) + args.li * XCD_BAR_WORDS, MISC + 8);
#define GRID_BAR() do { if (N_LAUNCHES == 1) xcd_barrier(bar); } while (0)
#if defined(DIAG_STAMP) || defined(AMP_A)
    unsigned long long* const ts_ = (unsigned long long*)(ws + WS_STAMP);
#define STAMP(k) do { if (blockIdx.x == 0 && tid == 0) ts_[(k)] = __builtin_amdgcn_s_memrealtime(); } while (0)
    STAMP(0);
#else
#define STAMP(k) do { } while (0)
#endif
    const int lo = args.ph_lo, hi = args.ph_hi;
#define IN(k) (lo <= (k) && (k) < hi)
#define BOTH(k) (IN(k) && IN((k) + 1))
    const float* x = args.in[0];
    bf16* H = (bf16*)args.out; constexpr int HPITCH = 2048;

    if (IN(0)) {
        LAS float* scr = (LAS float*)(L + RING_OFF + wave * 16384);
        constexpr int I_MOE = (1024 / 64) * (3584 / 32);
        constexpr int NITEMS = 16 * 21 + 6 * 48 + 4 * 64 + 16 * 32 + 2 * 1792 + 1792 + 16 * 128 + 16 * 32 + 24 * I_MOE;
        auto job_of = [&](int it) -> TrJob {
            int r = it; TrJob j;
            if (r < 8 * I_MOE) { const int e = r / I_MOE; j = TrJob{args.in[19] + (size_t)e * 1024 * 3584, (bf16*)(ws + WS_WMGU) + (size_t)e * 7168 * 1024, 1024, 3584, 1, r % I_MOE}; return j; } r -= 8 * I_MOE;
            if (r < 8 * I_MOE) { const int e = r / I_MOE; j = TrJob{args.in[20] + (size_t)e * 1024 * 3584, (bf16*)(ws + WS_WMGU) + (size_t)e * 7168 * 1024, 1024, 3584, 2, r % I_MOE}; return j; } r -= 8 * I_MOE;
            if (r < 8 * I_MOE) { const int e = r / I_MOE; j = TrJob{args.in[21] + (size_t)e * 3584 * 1024, (bf16*)(ws + WS_WMDN) + (size_t)e * 1024 * 3584, 3584, 1024, 0, r % I_MOE}; return j; } r -= 8 * I_MOE;
#define JOB(W, K_, N_, WT, mode) { const int ni = ((K_) / 64) * ((N_) / 32); if (r < ni) { j = TrJob{(W), (bf16*)(ws + (WT)), (K_), (N_), (mode), r}; return j; } r -= ni; }
            JOB(args.in[5], 1024, 672, WS_WMLAIN, 0)
            JOB(args.in[7], 384, 1536, WS_WQUP, 0)
            JOB(args.in[9], 256, 2048, WS_WKVUP, 0)
            JOB(args.in[10], 1024, 1024, WS_WO0, 0)
            JOB(args.in[15], 1024, 3584, WS_WFGU, 1)
            JOB(args.in[16], 1024, 3584, WS_WFGU, 2)
            JOB(args.in[17], 3584, 1024, WS_WFDN, 0)
            JOB(args.in[11], 1024, 4096, WS_WHIN, 0)
#undef JOB
            j = TrJob{args.in[14], (bf16*)(ws + WS_WHO), 1024, 1024, 0, r}; return j; };
        if (gw < NITEMS) {
            TrJob jc = job_of(gw); float vc[32]; tr_load(jc, vc, lane);
            for (int it = gw; it < NITEMS; it += NGW) {
                const bool hn = it + NGW < NITEMS; TrJob jn = jc; float vn[32];
                if (hn) { jn = job_of(it + NGW); tr_load(jn, vn, lane); }
                tr_finish(jc, vc, scr, lane);
                if (hn) { jc = jn;
#pragma unroll
                    for (int i = 0; i < 32; ++i) vc[i] = vn[i]; }
            }
        }
        { v4u* z = (v4u*)((bf16*)(ws + WS_WMLAIN) + (size_t)MLA_IN * 1024); const int n16 = (MLA_INP - MLA_IN) * 1024 * 2 / 16;
          for (int i = blockIdx.x * NWAVES * 64 + tid; i < n16; i += G * NWAVES * 64) z[i] = (v4u){0u, 0u, 0u, 0u}; }
        rms_rows_to_bf16(x, args.in[2], (bf16*)(ws + WS_HN), gw, NGW, M, lane);
        if (BOTH(0)) GRID_BAR(); STAMP(1);
    }
    if (IN(1)) {
        pg8::Gemm g{(const bf16*)(ws + WS_HN), (const bf16*)(ws + WS_WMLAIN), M, MLA_INP, 1024, 1024}; pg8::StaticOrder S; S.init(M, MLA_INP, G, (int)blockIdx.x);
        pg8::EpiStoreBf16 E{(bf16*)(ws + WS_PROJ), MLA_INP, MLA_INP / 256};
        pg8::gemm_phase<pg8::EpiStoreBf16, pg8::StaticOrder, true, false>(L + RING_OFF, g, S, E);
        if (BOTH(1)) GRID_BAR(); STAMP(2);
    }
    if (IN(2)) {
        const bf16* P = (const bf16*)(ws + WS_PROJ);
        for (int m = gw; m < M; m += NGW) {
            const bf16* pr = P + (size_t)m * MLA_INP;
            float cq[6]; float s = 0.f;
#pragma unroll
            for (int j = 0; j < 6; ++j) { cq[j] = bf2f(pr[j * 64 + lane]); s += cq[j] * cq[j]; }
            const float rq = 1.f / sqrtf(wave_sum(s) * (1.f / QL) + EPS);
            bf16* oq = (bf16*)(ws + WS_CQN) + (size_t)m * QL;
#pragma unroll
            for (int j = 0; j < 6; ++j) oq[j * 64 + lane] = (bf16)f2bf(cq[j] * rq * args.in[6][j * 64 + lane]);
            float ck[4]; s = 0.f;
#pragma unroll
            for (int j = 0; j < 4; ++j) { ck[j] = bf2f(pr[QL + j * 64 + lane]); s += ck[j] * ck[j]; }
            const float rk = 1.f / sqrtf(wave_sum(s) * (1.f / KVL) + EPS);
            bf16* ok = (bf16*)(ws + WS_CKVN) + (size_t)m * KVL;
#pragma unroll
            for (int j = 0; j < 4; ++j) ok[j * 64 + lane] = (bf16)f2bf(ck[j] * rk * args.in[8][j * 64 + lane]);
            if (lane < 16) {
                const float invf = exp2f(-(float)lane * (13.287712379549449f / 16.0f));
                const float ang = (float)args.pos[m] * invf;
                const double rev = (double)ang * 0.15915494309189535; const float fr = (float)(rev - rint(rev));
                const float sn = __builtin_amdgcn_sinf(fr), cs = __builtin_amdgcn_cosf(fr);
                ((float*)(ws + WS_COS))[(size_t)m * 16 + lane] = cs; ((float*)(ws + WS_SIN))[(size_t)m * 16 + lane] = sn;
                const float x1 = bf2f(pr[QL + KVL + lane]), x2 = bf2f(pr[QL + KVL + 16 + lane]);
                bf16* okr = (bf16*)(ws + WS_KR) + (size_t)m * 32;
                okr[lane] = (bf16)f2bf(x1 * cs - x2 * sn); okr[16 + lane] = (bf16)f2bf(x2 * cs + x1 * sn);
            }
        }
        if (BOTH(2)) GRID_BAR(); STAMP(3);
    }
    if (IN(3)) {
        { pg8::Gemm g{(const bf16*)(ws + WS_CQN), (const bf16*)(ws + WS_WQUP), M, QW, QL, QL}; pg8::StaticOrder S; S.init(M, QW, G, (int)blockIdx.x);
          pg8::EpiStoreBf16 E{(bf16*)(ws + WS_Q), QW, QW / 256};
          pg8::gemm_phase<pg8::EpiStoreBf16, pg8::StaticOrder, true, false>(L + RING_OFF, g, S, E); }
        { pg8::Gemm g{(const bf16*)(ws + WS_CKVN), (const bf16*)(ws + WS_WKVUP), M, KVW, KVL, KVL}; pg8::StaticOrder S; S.init(M, KVW, G, (int)blockIdx.x);
          pg8::EpiStoreBf16 E{(bf16*)(ws + WS_KV), KVW, KVW / 256};
          pg8::gemm_phase<pg8::EpiStoreBf16, pg8::StaticOrder, true, false>(L + RING_OFF, g, S, E); }
        if (BOTH(3)) GRID_BAR(); STAMP(4);
    }
    if (IN(4)) {
        const int vcu = (G % 8 == 0) ? ((int)blockIdx.x % 8) * (G / 8) + (int)blockIdx.x / 8 : (int)blockIdx.x;
        for (int v = vcu; v < 256; v += G) {
            const int bh = v >> 2, s4 = v & 3;
#pragma unroll 1
            for (int i = 0; i < 4; ++i) { const int qb = (i == 0) ? s4 : (i == 1) ? 7 - s4 : (i == 2) ? 8 + s4 : 15 - s4;
                mla_attn::attn_unit2<8>(bh >> 4, bh & 15, qb, (const bf16*)(ws + WS_Q), (const bf16*)(ws + WS_KV), (const bf16*)(ws + WS_KR), (const float*)(ws + WS_COS), (const float*)(ws + WS_SIN), (bf16*)(ws + WS_O), (char*)lds + RING_OFF); }
        }
        if (BOTH(4)) GRID_BAR(); STAMP(5);
    }
    if (IN(5)) {
        pg8::Gemm g{(const bf16*)(ws + WS_O), (const bf16*)(ws + WS_WO0), M, D, D, D}; pg8::StaticOrder S; S.init(M, D, G, (int)blockIdx.x);
        pg8::EpiRes<true> E{x, H, D, HPITCH, D / 256};
        pg8::gemm_phase<pg8::EpiRes<true>, pg8::StaticOrder, true, false>(L + RING_OFF, g, S, E);
        if (BOTH(5)) GRID_BAR(); STAMP(6);
    }
    if (IN(6)) {
        rms_rows_bf16in(H, HPITCH, args.in[3], (bf16*)(ws + WS_HN), gw, NGW, M, lane);
        if (BOTH(6)) GRID_BAR(); STAMP(7);
    }
    if (IN(7)) {
        pg8::Gemm g{(const bf16*)(ws + WS_HN), (const bf16*)(ws + WS_WFGU), M, 2 * FF, D, D}; pg8::StaticOrder S; S.init(M, 2 * FF, G, (int)blockIdx.x);
        pg8::EpiSwiGLU E{(bf16*)(ws + WS_FACT), FF, 2 * FF / 256};
        pg8::gemm_phase<pg8::EpiSwiGLU, pg8::StaticOrder, true, false>(L + RING_OFF, g, S, E);
        if (BOTH(7)) GRID_BAR(); STAMP(8);
    }
    if (IN(8)) {
        pg8::Gemm g{(const bf16*)(ws + WS_FACT), (const bf16*)(ws + WS_WFDN), M, D, FF, FF}; pg8::StaticOrder S; S.init(M, D, G, (int)blockIdx.x);
        pg8::EpiRes<false> E{H, H, HPITCH, HPITCH, D / 256};
        pg8::gemm_phase<pg8::EpiRes<false>, pg8::StaticOrder, true, false>(L + RING_OFF, g, S, E);
        if (BOTH(8)) GRID_BAR(); STAMP(9);
    }
    if (IN(9)) {
        rms_rows_bf16in(H, HPITCH, args.in[2] + D, (bf16*)(ws + WS_HN), gw, NGW, M, lane);
        if (BOTH(9)) GRID_BAR(); STAMP(10);
    }
    if (IN(10)) {
        pg8::Gemm g{(const bf16*)(ws + WS_HN), (const bf16*)(ws + WS_WHIN), M, HG_IN, D, D}; pg8::StaticOrder S; S.init(M, HG_IN, G, (int)blockIdx.x);
        pg8::EpiStoreBf16 E{(bf16*)(ws + WS_HPROJ), HG_IN, HG_IN / 256};
        pg8::gemm_phase<pg8::EpiStoreBf16, pg8::StaticOrder, true, false>(L + RING_OFF, g, S, E);
        if (BOTH(10)) GRID_BAR(); STAMP(11);
    }
    if (IN(11)) {
        hg::P1Args pa{(const bf16*)(ws + WS_HPROJ), args.in[12], (bf16*)(ws + WS_OL), (bf16*)(ws + WS_Q1G), (float*)(ws + WS_WN), (float*)(ws + WS_SS), (float*)(ws + WS_DSEG)};
        hg::hg_pass1(L, pa, G);
        if (BOTH(11)) GRID_BAR(); STAMP(12);
    }
    if (IN(12)) {
        hg::P2Args pa{(const bf16*)(ws + WS_HPROJ), (const bf16*)(ws + WS_OL), (const bf16*)(ws + WS_Q1G), (const float*)(ws + WS_WN), (const float*)(ws + WS_SS), (const float*)(ws + WS_DSEG), args.in[13], (bf16*)(ws + WS_HON)};
        hg::hg_pass2(L, pa, G);
        if (BOTH(12)) GRID_BAR(); STAMP(13);
    }
    if (IN(13)) {
        pg8::Gemm g{(const bf16*)(ws + WS_HON), (const bf16*)(ws + WS_WHO), M, D, D, D}; pg8::StaticOrder S; S.init(M, D, G, (int)blockIdx.x);
        pg8::EpiRes<false> E{H, H, HPITCH, HPITCH, D / 256};
        pg8::gemm_phase<pg8::EpiRes<false>, pg8::StaticOrder, true, false>(L + RING_OFF, g, S, E);
        if (BOTH(13)) GRID_BAR(); STAMP(14);
    }
    if (IN(14)) {
        const float* gn = args.in[3] + D; const float* RT = args.in[18];
        int* rowlist = (int*)(ws + WS_ROWLIST); v4u* tok = (v4u*)(ws + WS_TOK);
        LAS int* lcnt = (LAS int*)(L + RING_OFF); LAS int* gbase = lcnt + 8; LAS unsigned* rec = (LAS unsigned*)(L + RING_OFF + 64);
        const int niter = (M + NGW - 1) / NGW;
        f32x4 R0[16], R1[16];
#pragma unroll
        for (int j = 0; j < 4; ++j)
#pragma unroll
            for (int kk = 0; kk < 4; ++kk) { const int kx = 4 * (lane + 64 * j) + kk; R0[j * 4 + kk] = *(const f32x4*)(RT + (size_t)kx * 8); R1[j * 4 + kk] = *(const f32x4*)(RT + (size_t)kx * 8 + 4); }
        f32x4 gv[4];
#pragma unroll
        for (int j = 0; j < 4; ++j) gv[j] = ((const f32x4*)gn + lane)[64 * j];
        for (int it0 = 0; it0 < niter; it0 += 16) {
            if (tid < 8) lcnt[tid] = 0;
            __syncthreads();
            const int itn = (niter - it0) < 16 ? (niter - it0) : 16;
            v2u vn[4];
            { const int m0 = it0 * NGW + gw; const bf16* xr = H + (size_t)(m0 < M ? m0 : 0) * HPITCH;
#pragma unroll
              for (int j = 0; j < 4; ++j) vn[j] = *(const v2u*)(xr + 4 * (lane + 64 * j)); }
            for (int it = 0; it < itn; ++it) {
                const int m = (it0 + it) * NGW + gw;
                f32x4 v[4];
#pragma unroll
                for (int j = 0; j < 4; ++j) v[j] = (f32x4){__uint_as_float(vn[j].x << 16), __uint_as_float(vn[j].x & 0xffff0000u), __uint_as_float(vn[j].y << 16), __uint_as_float(vn[j].y & 0xffff0000u)};
                { const int mn = m + NGW; const bf16* xr = H + (size_t)((it + 1 < itn && mn < M) ? mn : 0) * HPITCH;
#pragma unroll
                  for (int j = 0; j < 4; ++j) vn[j] = *(const v2u*)(xr + 4 * (lane + 64 * j)); }
                if (m >= M) continue;
                float s = 0.f;
#pragma unroll
                for (int j = 0; j < 4; ++j) s += (v[j].x * v[j].x + v[j].y * v[j].y) + (v[j].z * v[j].z + v[j].w * v[j].w);
                const float rstd = 1.f / sqrtf(wave_sum(s) * (1.f / 1024.f) + EPS);
                f32x4 la = (f32x4){0.f, 0.f, 0.f, 0.f}, lb4 = (f32x4){0.f, 0.f, 0.f, 0.f};
                unsigned long long* o8 = (unsigned long long*)((bf16*)(ws + WS_HN3) + (size_t)m * D) + lane;
#pragma unroll
                for (int j = 0; j < 4; ++j) { const f32x4 t = (f32x4){v[j].x * rstd * gv[j].x, v[j].y * rstd * gv[j].y, v[j].z * rstd * gv[j].z, v[j].w * rstd * gv[j].w};
                    o8[64 * j] = (unsigned long long)pk2(t.x, t.y) | ((unsigned long long)pk2(t.z, t.w) << 32);
#pragma unroll
                    for (int kk = 0; kk < 4; ++kk) { la += t[kk] * R0[j * 4 + kk]; lb4 += t[kk] * R1[j * 4 + kk]; } }
                float l4[4], l2[2], l1;
                { const bool up = (lane & 1) != 0;
#pragma unroll
                  for (int e = 0; e < 4; ++e) { const float mine = up ? lb4[e] : la[e], give = up ? la[e] : lb4[e]; l4[e] = mine + __shfl_xor(give, 1); } }
                { const bool up = (lane & 2) != 0;
#pragma unroll
                  for (int e = 0; e < 2; ++e) { const float mine = up ? l4[2 + e] : l4[e], give = up ? l4[e] : l4[2 + e]; l2[e] = mine + __shfl_xor(give, 2); } }
                { const bool up = (lane & 4) != 0; const float mine = up ? l2[1] : l2[0], give = up ? l2[0] : l2[1]; l1 = mine + __shfl_xor(give, 4); }
                l1 += __shfl_xor(l1, 8); l1 += __shfl_xor(l1, 16); l1 += __shfl_xor(l1, 32);
                float lg[8];
#pragma unroll
                for (int e = 0; e < 8; ++e) { const int src = ((e >> 2) & 1) | (((e >> 1) & 1) << 1) | ((e & 1) << 2); lg[e] = __shfl(l1, src); }
                if (lane == 0) {
                    int e1 = 0; float v1 = lg[0];
#pragma unroll
                    for (int e = 1; e < 8; ++e) if (lg[e] > v1) { v1 = lg[e]; e1 = e; }
                    int e2 = (e1 == 0) ? 1 : 0; float v2 = lg[e2];
#pragma unroll
                    for (int e = 1; e < 8; ++e) if (e != e1 && lg[e] > v2) { v2 = lg[e]; e2 = e; }
                    const float w1 = 1.0f / (1.0f + __expf(v2 - v1)), w2 = 1.0f - w1;
                    const int r1 = __hip_atomic_fetch_add(lcnt + e1, 1, __ATOMIC_RELAXED, __HIP_MEMORY_SCOPE_WORKGROUP), r2 = __hip_atomic_fetch_add(lcnt + e2, 1, __ATOMIC_RELAXED, __HIP_MEMORY_SCOPE_WORKGROUP);
                    LAS unsigned* rc = rec + (it * NWAVES + wave) * 8;
                    rc[0] = (unsigned)m; rc[1] = (unsigned)e1; rc[2] = (unsigned)e2; rc[3] = (unsigned)r1; rc[4] = (unsigned)r2; rc[5] = __float_as_uint(w1); rc[6] = __float_as_uint(w2);
                }
            }
            __syncthreads();
            if (tid < 8) { const int c = lcnt[tid]; gbase[tid] = c ? (int)__hip_atomic_fetch_add((unsigned*)(ctl + CW_CNT + 64 * tid), (unsigned)c, RLX_AGENT) : 0; }
            __syncthreads();
            for (int i = tid; i < itn * NWAVES; i += NWAVES * 64) {
                const int m = (it0 + i / NWAVES) * NGW + blockIdx.x * NWAVES + (i % NWAVES); if (m >= M) continue;
                const LAS unsigned* rc = rec + i * 8; const int e1 = (int)rc[1], e2 = (int)rc[2]; const unsigned p1 = (unsigned)gbase[e1] + rc[3], p2 = (unsigned)gbase[e2] + rc[4];
                rowlist[e1 * CAP + p1] = m; rowlist[e2 * CAP + p2] = m;
                tok[m] = (v4u){(unsigned)(e1 * CAP) + p1, (unsigned)(e2 * CAP) + p2, rc[5], rc[6]};
            }
            __syncthreads();
        }
        if (BOTH(14)) GRID_BAR(); STAMP(15);
    }
    if (IN(15) || IN(16) || IN(17)) {
        if (tid == 0) { volatile LAS int* mt = (volatile LAS int*)(MISC + 16); int acc = 0;
            for (int e = 0; e < 8; ++e) { const int c = (int)__hip_atomic_load((unsigned*)(ctl + CW_CNT + 64 * e), RLX_AGENT); mt[e] = acc; mt[9 + e] = c; acc += (c + 255) >> 8; }
            mt[8] = acc; }
        __syncthreads();
    }
    if (IN(15)) {
        pg8::Gemm g{(const bf16*)(ws + WS_HN3), (const bf16*)(ws + WS_WMGU), M, 2 * FF, D, D};
        MoeOrder S; S.init((volatile LAS int*)(MISC + 16), 2 * FF / 256, G, (int)blockIdx.x, (const int*)(ws + WS_ROWLIST));
        pg8::EpiSwiGLU E{(bf16*)(ws + WS_MACT), FF, 2 * FF / 256};
        pg8::gemm_phase<pg8::EpiSwiGLU, MoeOrder, true, true>(L + RING_OFF, g, S, E);
        if (BOTH(15)) GRID_BAR(); STAMP(16);
    }
    if (IN(16)) {
        pg8::Gemm g{(const bf16*)(ws + WS_MACT), (const bf16*)(ws + WS_WMDN), MAXSLOT, D, FF, FF};
        MoeOrder S; S.init((volatile LAS int*)(MISC + 16), D / 256, G, (int)blockIdx.x, (const int*)(ws + WS_ROWLIST), 128);
        pg8::EpiStoreBf16 E{(bf16*)(ws + WS_Y), D, D / 256};
        pg8::gemm_phase<pg8::EpiStoreBf16, MoeOrder, true, false>(L + RING_OFF, g, S, E);
        { pg8::Gemm g2{(const bf16*)(ws + WS_MACT), (const bf16*)(ws + WS_WMDN), MAXSLOT, D, 512, FF};
          MoeSplitOrder S2; S2.init((volatile LAS int*)(MISC + 16), D / 256, G, (int)blockIdx.x);
          pg8::EpiPart E2{(float*)(ws + WS_PART0), (float*)(ws + WS_PART1), D / 256};
          pg8::gemm_phase<pg8::EpiPart, MoeSplitOrder, true, false>(L + RING_OFF, g2, S2, E2); }
        if (BOTH(16)) GRID_BAR(); STAMP(17);
    }
    if (IN(17)) {
        volatile LAS int* mt = (volatile LAS int*)(MISC + 16);
        const bf16* Y = (const bf16*)(ws + WS_Y); const v4u* tok = (const v4u*)(ws + WS_TOK);
        f32x4 gfin[4];
#pragma unroll
        for (int j = 0; j < 4; ++j) gfin[j] = ((const f32x4*)args.in[4] + lane)[64 * j];
        if (gw < M) {
#define P17_SLOTS(tk_, s1_, s2_) do { const int e1_ = (tk_).x / CAP, e2_ = (tk_).y / CAP; s1_ = (size_t)mt[e1_] * 256 + ((tk_).x % CAP); s2_ = (size_t)mt[e2_] * 256 + ((tk_).y % CAP); } while (0)
#define P17_LOADROW(m_, s1_, s2_, hv_, ya_, yc_) do { const bf16* xr_ = H + (size_t)(m_) * HPITCH; \
            const v2u* y1_ = (const v2u*)(Y + ((s1_) < 32768 ? (s1_) : (size_t)0) * D) + lane; const v2u* y2_ = (const v2u*)(Y + ((s2_) < 32768 ? (s2_) : (size_t)0) * D) + lane; \
            _Pragma("unroll") for (int j = 0; j < 4; ++j) { hv_[j] = ld_bf4(xr_ + 4 * (lane + 64 * j)); ya_[j] = y1_[64 * j]; yc_[j] = y2_[64 * j]; } } while (0)
            v4u tk = tok[gw]; size_t s1, s2; P17_SLOTS(tk, s1, s2);
            f32x4 hv[4]; v2u ya[4], yc[4]; P17_LOADROW(gw, s1, s2, hv, ya, yc);
            v4u tkn = tok[(gw + NGW < M) ? gw + NGW : gw];
            for (int m = gw; m < M; m += NGW) {
                f32x4 v[4]; v2u a[4], c[4];
#pragma unroll
                for (int j = 0; j < 4; ++j) { v[j] = hv[j]; a[j] = ya[j]; c[j] = yc[j]; }
                const size_t cs1 = s1, cs2 = s2; const unsigned zb = tk.z, wb = tk.w; const float w1 = __uint_as_float(zb), w2 = __uint_as_float(wb);
                const int mn = (m + NGW < M) ? m + NGW : m;
                tk = tkn; P17_SLOTS(tk, s1, s2); P17_LOADROW(mn, s1, s2, hv, ya, yc);
                tkn = tok[(mn + NGW < M) ? mn + NGW : mn];
                float s = 0.f;
#pragma unroll
                for (int j = 0; j < 4; ++j) {
                    f32x4 y1v, y2v;
                    if (cs1 < 32768) y1v = (f32x4){bf2f((unsigned short)(a[j].x & 0xffffu)), bf2f((unsigned short)(a[j].x >> 16)), bf2f((unsigned short)(a[j].y & 0xffffu)), bf2f((unsigned short)(a[j].y >> 16))};
                    else { const int tl = (int)(cs1 >> 8) - 128; const float* pb = (tl < 4 ? (const float*)(ws + WS_PART0) + (size_t)((tl * 4 + j) * 7) * 65536 : (const float*)(ws + WS_PART1) + (size_t)(((tl - 4) * 4 + j) * 7) * 65536) + (cs1 & 255) * 256 + 4 * lane;
                        y1v = *(const f32x4*)pb;
#pragma unroll
                        for (int ks = 1; ks < 7; ++ks) y1v += *(const f32x4*)(pb + (size_t)ks * 65536); }
                    if (cs2 < 32768) y2v = (f32x4){bf2f((unsigned short)(c[j].x & 0xffffu)), bf2f((unsigned short)(c[j].x >> 16)), bf2f((unsigned short)(c[j].y & 0xffffu)), bf2f((unsigned short)(c[j].y >> 16))};
                    else { const int tl = (int)(cs2 >> 8) - 128; const float* pb = (tl < 4 ? (const float*)(ws + WS_PART0) + (size_t)((tl * 4 + j) * 7) * 65536 : (const float*)(ws + WS_PART1) + (size_t)(((tl - 4) * 4 + j) * 7) * 65536) + (cs2 & 255) * 256 + 4 * lane;
                        y2v = *(const f32x4*)pb;
#pragma unroll
                        for (int ks = 1; ks < 7; ++ks) y2v += *(const f32x4*)(pb + (size_t)ks * 65536); }
                    v[j] += w1 * y1v + w2 * y2v;
                    s += (v[j].x * v[j].x + v[j].y * v[j].y) + (v[j].z * v[j].z + v[j].w * v[j].w); }
                const float rstd = 1.f / sqrtf(wave_sum(s) * (1.f / 1024.f) + EPS);
                f32x4* xo = (f32x4*)(args.out + (size_t)m * D) + lane;
#pragma unroll
                for (int j = 0; j < 4; ++j) __builtin_nontemporal_store((f32x4){v[j].x * rstd * gfin[j].x, v[j].y * rstd * gfin[j].y, v[j].z * rstd * gfin[j].z, v[j].w * rstd * gfin[j].w}, xo + 64 * j);
            }
#undef P17_SLOTS
#undef P17_LOADROW
        }
    }
#ifdef AMP_A
    if (blockIdx.x == 0 && tid == 0) { const unsigned long long tend = __builtin_amdgcn_s_memrealtime(); ts_[18] = tend;
        const unsigned long long dt = (ts_[AMP_B] - ts_[AMP_A]) * AMP_K; while (__builtin_amdgcn_s_memrealtime() - tend < dt) __builtin_amdgcn_s_sleep(8); }
#endif
#ifdef DIAG_STAMP
    GRID_BAR(); STAMP(18);
    GRID_BAR();
    { const float da = (float)(ts_[DIAG_A1] - ts_[DIAG_A0]) * 0.001f;
      const float db = (float)(ts_[DIAG_B1] - ts_[DIAG_B0]) * 0.1f;
      for (int m = gw; m < M; m += NGW) { f32x4* xr = (f32x4*)(H + (size_t)m * D) + lane;
          for (int j = 0; j < 4; ++j) xr[64 * j] = (f32x4){da, da, da, da}; }
      __syncthreads();
      if (blockIdx.x == 0 && tid == 0) H[0] = db; }
#endif
#undef IN
#undef BOTH
}

extern "C" void kernel_launch(void* const* d_in, const int* in_sizes, int n_in, void* d_out, int out_size, void* d_ws, size_t ws_size, hipStream_t stream) {
    static int grid = 0;
    if (grid == 0) {
        if (n_in != 22 || in_sizes[0] != M * D || out_size != M * D || ws_size < WS_END) { fprintf(stderr, "kernel_launch: unexpected shapes (n_in %d, in0 %d, out %d, ws %zu)\n", n_in, n_in > 0 ? in_sizes[0] : -1, out_size, ws_size); grid = -1; return; }
        int dev = 0, cus = 0, per_cu = 0;
        if (hipGetDevice(&dev) != hipSuccess || hipDeviceGetAttribute(&cus, hipDeviceAttributeMultiprocessorCount, dev) != hipSuccess) { grid = -1; return; }
        if (hipFuncSetAttribute((const void*)fwd_kernel, hipFuncAttributeMaxDynamicSharedMemorySize, LDS_BYTES) != hipSuccess) { fprintf(stderr, "kernel_launch: hipFuncSetAttribute failed\n"); grid = -1; return; }
        if (hipOccupancyMaxActiveBlocksPerMultiprocessor(&per_cu, (const void*)fwd_kernel, NWAVES * 64, LDS_BYTES) != hipSuccess || per_cu < 1) fprintf(stderr, "kernel_launch: occupancy query reports %d\n", per_cu);
        (void)hipGetLastError();
        grid = cus;
    }
    if (grid < 0) return;
    if (hipMemsetAsync((char*)d_ws + WS_CTL, 0, CTL_ZERO_BYTES, stream) != hipSuccess) return;
    Args a{};
    for (int i = 0; i < 22; ++i) a.in[i] = (const float*)d_in[i];
    a.pos = (const int*)d_in[1]; a.out = (float*)d_out; a.ws = (unsigned char*)d_ws;
    static_assert(N_LAUNCHES == 1 || N_LAUNCHES == NPHASE, "MK_N_LAUNCHES: 1 or 18");
    for (int li = 0; li < N_LAUNCHES; ++li) {
        a.ph_lo = (N_LAUNCHES == 1) ? 0 : li; a.ph_hi = (N_LAUNCHES == 1) ? NPHASE : li + 1; a.li = li;
        hipLaunchKernelGGL(fwd_kernel, dim3(grid), dim3(NWAVES * 64), LDS_BYTES, stream, a);
        if (hipPeekAtLastError() != hipSuccess) { fprintf(stderr, "kernel_launch: launch %d failed\n", li); break; }
    }
#ifdef PROBE_EXTRA
    { const int extra[] = {PROBE_EXTRA}; int li = 1;
      for (int k : extra) { a.ph_lo = k; a.ph_hi = k + 1; a.li = li++; hipLaunchKernelGGL(fwd_kernel, dim3(grid), dim3(NWAVES * 64), LDS_BYTES, stream, a); } }
#endif
}
```

```cpp
#include <hip/hip_runtime.h>
#include <cstdio>
#include <cstdint>

#ifndef MK_N_LAUNCHES
#define MK_N_LAUNCHES 1
#endif

namespace pg8 {
#define PG8_LAS __attribute__((address_space(3)))
typedef unsigned short bf16_t;
typedef short bf16x8 __attribute__((ext_vector_type(8)));
typedef float f32x4 __attribute__((ext_vector_type(4)));
typedef unsigned u32x4 __attribute__((ext_vector_type(4)));
constexpr int BM = 256, BK = 64, HALF = 128, HTB = HALF * BK * 2, STAGE_BYTES = 8 * HTB, NXCD = 8, WGM = 8;

__host__ __device__ __forceinline__ int lds_byte(int r, int c) { const int st = (r >> 4) * 2 + (c >> 5), rr = r & 15, cc = c & 31, ob = rr * 64 + cc * 2; return st * 1024 + (ob ^ (((ob >> 9) & 1) << 5)); }
__host__ __device__ __forceinline__ void stage_rc(int b, int& R, int& C) { const int st = b / 1024, sb = b % 1024, swz = sb ^ (((sb >> 9) & 1) << 5); R = (st >> 1) * 16 + swz / 64; C = (st & 1) * 32 + (swz % 64) / 2; }
__host__ __device__ __forceinline__ int perm32(int rho) { const int n = rho >> 4, i = rho & 15; return 8 * (i >> 2) + 4 * n + (i & 3); }

struct Unit { int pm, pn, kb; };
struct Gemm { const bf16_t* A; const bf16_t* Bt; int M, N, K, ld; int sc_w, sc_a; };

struct StaticOrder {
    int nM, nN, nwg, G, c;
    __host__ __device__ void init(int M, int N, int G_, int c_) { nM = M / BM; nN = N / BM; nwg = nM * nN; G = G_; c = c_; }
    __host__ __device__ bool next(int i, Unit& u) const {
        const long L = (long)i * G + c; if (L >= nwg) return false;
        int wgid = (int)L; { const int q = nwg / NXCD, r = nwg % NXCD, xcd = wgid % NXCD, off = wgid / NXCD; wgid = (xcd < r ? xcd * (q + 1) : r * (q + 1) + (xcd - r) * q) + off; }
        const int nig = WGM * nN, gid = wgid / nig, fm = gid * WGM, gsz = (nM - fm) < WGM ? (nM - fm) : WGM;
        u.pm = fm + ((wgid % nig) % gsz); u.pn = (wgid % nig) / gsz; u.kb = 0; return true;
    }
    __device__ __forceinline__ void a_ready(const Unit&) const {}
    __device__ __forceinline__ void done(const Unit&) const {}
    __device__ __forceinline__ int arow(const Unit&, int) const { return 0; }
    __device__ __forceinline__ void issue_rows(const Unit&, int, int, int) const {}
    __device__ __forceinline__ int arow_lds(int, int) const { return 0; }
};

__device__ __forceinline__ unsigned cvt_pk_bf16(float lo, float hi) { unsigned r; asm volatile("v_cvt_pk_bf16_f32 %0, %1, %2" : "=v"(r) : "v"(lo), "v"(hi)); return r; }

struct EpiStoreBf16 {
    static constexpr bool PERM = true, AFTER_DRAIN = false;
    bf16_t* O; int ldc; int nN;
    __device__ __forceinline__ void operator()(const f32x4 (&acc)[2][2][4][2], const Unit& u, int wr, int wc, int fr, int fq) const {
        const int pnl = u.pn % nN; const int row0 = u.pm * BM + wr * 64 + fr, col0 = pnl * BM + wc * 32 + 8 * fq;
#pragma unroll
        for (int ai = 0; ai < 2; ++ai)
#pragma unroll
            for (int m = 0; m < 4; ++m) { bf16_t* rowp = O + (size_t)(row0 + ai * HALF + m * 16) * ldc + col0;
#pragma unroll
                for (int bj = 0; bj < 2; ++bj) { const f32x4 v0 = acc[ai][bj][m][0], v1 = acc[ai][bj][m][1];
                    u32x4 w; w.x = cvt_pk_bf16(v0[0], v0[1]); w.y = cvt_pk_bf16(v0[2], v0[3]); w.z = cvt_pk_bf16(v1[0], v1[1]); w.w = cvt_pk_bf16(v1[2], v1[3]);
                    *(u32x4*)(rowp + bj * HALF) = w; } }
    }
};
typedef float f32x2_ __attribute__((ext_vector_type(2)));
__device__ __forceinline__ f32x2_ swiglu_pk(f32x2_ g, f32x2_ u) { const f32x2_ t = g * (-1.4426950408889634f); f32x2_ e; e.x = __builtin_amdgcn_exp2f(t.x); e.y = __builtin_amdgcn_exp2f(t.y);
    const f32x2_ d = e + 1.0f; f32x2_ r; r.x = __builtin_amdgcn_rcpf(d.x); r.y = __builtin_amdgcn_rcpf(d.y); return (g * u) * r; }
__device__ __forceinline__ float silu_f(float x) { return x * __builtin_amdgcn_rcpf(1.0f + __builtin_amdgcn_exp2f(-1.4426950408889634f * x)); }
struct EpiSwiGLU {
    static constexpr bool PERM = true, AFTER_DRAIN = false;
    bf16_t* O; int ldc; int nN; bool f8;
    __device__ __forceinline__ void operator()(const f32x4 (&acc)[2][2][4][2], const Unit& u, int wr, int wc, int fr, int fq) const {
        const int pnl = u.pn % nN; const int row0 = u.pm * BM + wr * 64 + fr, col0 = pnl * HALF + wc * 32 + 8 * fq;
#pragma unroll
        for (int ai = 0; ai < 2; ++ai)
#pragma unroll
            for (int m = 0; m < 4; ++m) { bf16_t* rowp = O + (size_t)(row0 + ai * HALF + m * 16) * ldc + col0;
                const f32x4 g0 = acc[ai][0][m][0], g1 = acc[ai][0][m][1], u0 = acc[ai][1][m][0], u1 = acc[ai][1][m][1];
                const f32x2_ a0 = swiglu_pk((f32x2_){g0[0], g0[1]}, (f32x2_){u0[0], u0[1]}), a1 = swiglu_pk((f32x2_){g0[2], g0[3]}, (f32x2_){u0[2], u0[3]});
                const f32x2_ a2 = swiglu_pk((f32x2_){g1[0], g1[1]}, (f32x2_){u1[0], u1[1]}), a3 = swiglu_pk((f32x2_){g1[2], g1[3]}, (f32x2_){u1[2], u1[3]});
                if (f8) { typedef unsigned u32x2_ __attribute__((ext_vector_type(2)));
                    const f32x2_ q0 = __builtin_elementwise_min(__builtin_elementwise_max(a0 * 8.f, (f32x2_){-448.f, -448.f}), (f32x2_){448.f, 448.f}), q1 = __builtin_elementwise_min(__builtin_elementwise_max(a1 * 8.f, (f32x2_){-448.f, -448.f}), (f32x2_){448.f, 448.f});
                    const f32x2_ q2 = __builtin_elementwise_min(__builtin_elementwise_max(a2 * 8.f, (f32x2_){-448.f, -448.f}), (f32x2_){448.f, 448.f}), q3 = __builtin_elementwise_min(__builtin_elementwise_max(a3 * 8.f, (f32x2_){-448.f, -448.f}), (f32x2_){448.f, 448.f});
                    int w0 = __builtin_amdgcn_cvt_pk_fp8_f32(q0.x, q0.y, 0, false); w0 = __builtin_amdgcn_cvt_pk_fp8_f32(q1.x, q1.y, w0, true);
                    int w1 = __builtin_amdgcn_cvt_pk_fp8_f32(q2.x, q2.y, 0, false); w1 = __builtin_amdgcn_cvt_pk_fp8_f32(q3.x, q3.y, w1, true);
                    __builtin_nontemporal_store((u32x2_){(unsigned)w0, (unsigned)w1}, (u32x2_*)((unsigned char*)O + (size_t)(row0 + ai * HALF + m * 16) * ldc + col0)); }
                else { u32x4 w; w.x = cvt_pk_bf16(a0.x, a0.y); w.y = cvt_pk_bf16(a1.x, a1.y); w.z = cvt_pk_bf16(a2.x, a2.y); w.w = cvt_pk_bf16(a3.x, a3.y);
                    __builtin_nontemporal_store(w, (u32x4*)rowp); } }
    }
};
struct EpiPart {
    static constexpr bool PERM = false, AFTER_DRAIN = false;
    float* P0; float* P1; int nN; int kshift;
    __device__ __forceinline__ void operator()(const f32x4 (&acc)[2][2][4][2], const Unit& u, int wr, int wc, int fr, int fq) const {
        const int pnl = u.pn % nN, ks = u.kb >> kshift, tl = u.pm - 128;
        float* base = (tl < 4 ? P0 + (size_t)((tl * 4 + pnl) * 7 + ks) * 65536 : P1 + (size_t)(((tl - 4) * 4 + pnl) * 7 + ks) * 65536) + (wr * 64 + fr) * 256 + wc * 32 + 4 * fq;
#pragma unroll
        for (int ai = 0; ai < 2; ++ai)
#pragma unroll
            for (int m = 0; m < 4; ++m) { float* rp = base + (ai * HALF + m * 16) * 256;
#pragma unroll
                for (int bj = 0; bj < 2; ++bj)
#pragma unroll
                    for (int n = 0; n < 2; ++n) *(f32x4*)(rp + bj * HALF + n * 16) = acc[ai][bj][m][n];
                asm volatile("" ::: "memory"); }
    }
};
template <bool BASE_F32> struct EpiRes {
    static constexpr bool PERM = false, AFTER_DRAIN = false;
    const void* base; bf16_t* out; int ldb, ldo; int nN;
    __device__ __forceinline__ void operator()(const f32x4 (&acc)[2][2][4][2], const Unit& u, int wr, int wc, int fr, int fq) const {
        typedef unsigned u32x2_ __attribute__((ext_vector_type(2)));
        const int pnl = u.pn % nN; const int row0 = u.pm * BM + wr * 64 + fr, col0 = pnl * BM + wc * 32 + 4 * fq;
#pragma unroll
        for (int ai = 0; ai < 2; ++ai) {
            if constexpr (BASE_F32) {
                f32x4 pre[4][2][2];
#pragma unroll
                for (int m = 0; m < 4; ++m) { const size_t row = (size_t)(row0 + ai * HALF + m * 16);
#pragma unroll
                    for (int bj = 0; bj < 2; ++bj)
#pragma unroll
                        for (int n = 0; n < 2; ++n) pre[m][bj][n] = *(const f32x4*)((const float*)base + row * ldb + col0 + bj * HALF + n * 16); }
                asm volatile("" ::: "memory");
#pragma unroll
                for (int m = 0; m < 4; ++m) { const size_t off = (size_t)(row0 + ai * HALF + m * 16) * ldo + col0;
#pragma unroll
                    for (int bj = 0; bj < 2; ++bj)
#pragma unroll
                        for (int n = 0; n < 2; ++n) { const f32x4 v = acc[ai][bj][m][n] + pre[m][bj][n]; *(u32x2_*)(out + off + bj * HALF + n * 16) = (u32x2_){cvt_pk_bf16(v[0], v[1]), cvt_pk_bf16(v[2], v[3])}; } }
            } else {
                u32x2_ pre[4][2][2];
#pragma unroll
                for (int m = 0; m < 4; ++m) { const size_t row = (size_t)(row0 + ai * HALF + m * 16);
#pragma unroll
                    for (int bj = 0; bj < 2; ++bj)
#pragma unroll
                        for (int n = 0; n < 2; ++n) pre[m][bj][n] = *(const u32x2_*)((const bf16_t*)base + row * ldb + col0 + bj * HALF + n * 16); }
                asm volatile("" ::: "memory");
#pragma unroll
                for (int m = 0; m < 4; ++m) { const size_t off = (size_t)(row0 + ai * HALF + m * 16) * ldo + col0;
#pragma unroll
                    for (int bj = 0; bj < 2; ++bj)
#pragma unroll
                        for (int n = 0; n < 2; ++n) { const u32x2_ b = pre[m][bj][n];
                            const f32x4 v = acc[ai][bj][m][n] + (f32x4){__uint_as_float(b.x << 16), __uint_as_float(b.x & 0xffff0000u), __uint_as_float(b.y << 16), __uint_as_float(b.y & 0xffff0000u)};
                            *(u32x2_*)(out + off + bj * HALF + n * 16) = (u32x2_){cvt_pk_bf16(v[0], v[1]), cvt_pk_bf16(v[2], v[3])}; } }
            }
            asm volatile("" ::: "memory");
        }
    }
};

template <class Epi, class Sched, bool ALIGN_EPI = true, bool GATHER = false, bool FP8 = false>
__device__ __forceinline__ void gemm_phase(PG8_LAS unsigned char* lds, const Gemm g, const Sched& S, const Epi& E) {
    int tid_ = threadIdx.x; asm volatile("" : "+v"(tid_));
    const int tid = tid_, wid = __builtin_amdgcn_readfirstlane(tid >> 6), lane = tid & 63, wr = wid >> 2, wc = wid & 3, fr = lane & 15, fq = lane >> 4;
    const int K = g.ld; int nt = g.K / BK; asm volatile("" : "+s"(nt));
    unsigned voffA[2], voffB[2]; int RA[2], CA[2];
#pragma unroll
    for (int i = 0; i < 2; ++i) { int R, C; stage_rc(tid * 16 + i * 8192, R, C); const int Rb = Epi::PERM ? ((R & ~31) + perm32(R & 31)) : R;
        voffA[i] = (unsigned)(R * K + C) * 2u; voffB[i] = (unsigned)(Rb * K + C) * 2u; RA[i] = R; CA[i] = C; }
    unsigned vAc[2][2], vAn[2][2];
    const size_t kstep = (size_t)(BK * 2);
    const size_t hstep = (size_t)HALF * K * 2;
    const size_t tstep = 2 * hstep;
    const size_t hstepA = GATHER ? (size_t)0 : hstep;
    const unsigned ldsw = (unsigned)wid * 1024u;
    const int aoff = lds_byte(wr * 64 + fr, fq * 8), boff = lds_byte(wc * 32 + fr, fq * 8);
    const int aoff8 = lds_byte(wr * 64 + fr, 16 * (fq & 1)) + (fq >> 1) * 1024, boff8 = lds_byte(wc * 32 + fr, 16 * (fq & 1)) + (fq >> 1) * 1024;
    typedef int v8i_ __attribute__((ext_vector_type(8))); typedef int v4i_ __attribute__((ext_vector_type(4)));
    const int scw = g.sc_w, sca = g.sc_a;
#define PG8_SA(b, h) (((b) * 2 + (h)) * HTB)
#define PG8_SB(b, h) ((4 + (b) * 2 + (h)) * HTB)
#define PG8_STAGE(bufoff, gbase, voff) do { _Pragma("unroll") for (int _i = 0; _i < 2; ++_i) \
        __builtin_amdgcn_global_load_lds((const unsigned*)((const char*)(gbase) + (voff)[_i]), (PG8_LAS unsigned*)(lds + (bufoff) + ldsw + _i * 8192), 16, 0, 0); } while (0)
#define PG8_STAGE_A(bufoff, gbase, h, nx) do { _Pragma("unroll") for (int _i = 0; _i < 2; ++_i) { const unsigned _vo = GATHER ? ((nx) ? vAn[h][_i] : vAc[h][_i]) : voffA[_i]; \
        __builtin_amdgcn_global_load_lds((const unsigned*)((const char*)(gbase) + _vo), (PG8_LAS unsigned*)(lds + (bufoff) + ldsw + _i * 8192), 16, 0, 0); } } while (0)
#define PG8_GATH(dst, un) do { _Pragma("unroll") for (int _h = 0; _h < 2; ++_h) _Pragma("unroll") for (int _i = 0; _i < 2; ++_i) \
        dst[_h][_i] = (unsigned)(S.arow(un, _h * HALF + RA[_i]) * K + CA[_i]) * 2u; } while (0)
#define PG8_LD8(dst, idx, off) do { const v4i_ lo_ = *(const PG8_LAS v4i_*)(lds + (off)), hi_ = *(const PG8_LAS v4i_*)(lds + (off) + 16); dst[idx] = (v8i_){lo_[0], lo_[1], lo_[2], lo_[3], hi_[0], hi_[1], hi_[2], hi_[3]}; } while (0)
#define PG8_LDA8(dst, b, h) do { _Pragma("unroll") for (int m = 0; m < 4; ++m) PG8_LD8(dst, m, PG8_SA(b, h) + aoff8 + m * 2048); } while (0)
#define PG8_LDB8(dst, b, h) do { _Pragma("unroll") for (int n = 0; n < 2; ++n) PG8_LD8(dst, n, PG8_SB(b, h) + boff8 + n * 2048); } while (0)
#define PG8_MMA8(ai, bj, At_, Bt_) do { __builtin_amdgcn_s_setprio(1); _Pragma("unroll") for (int m = 0; m < 4; ++m) _Pragma("unroll") for (int n = 0; n < 2; ++n) \
        acc[ai][bj][m][n] = __builtin_amdgcn_mfma_scale_f32_16x16x128_f8f6f4(Bt_[n], At_[m], acc[ai][bj][m][n], 0, 0, 0, scw, 0, sca); \
        _Pragma("unroll") for (int m = 0; m < 4; ++m) _Pragma("unroll") for (int n = 0; n < 2; ++n) asm volatile("" : "+v"(acc[ai][bj][m][n]));     \
        __builtin_amdgcn_s_setprio(0); } while (0)
#define PG8_LDA(dst, b, h) do { _Pragma("unroll") for (int m = 0; m < 4; ++m) _Pragma("unroll") for (int k = 0; k < 2; ++k) dst[m][k] = *(const PG8_LAS bf16x8*)(lds + PG8_SA(b, h) + aoff + m * 2048 + k * 1024); } while (0)
#define PG8_LDB(dst, b, h) do { _Pragma("unroll") for (int n = 0; n < 2; ++n) _Pragma("unroll") for (int k = 0; k < 2; ++k) dst[n][k] = *(const PG8_LAS bf16x8*)(lds + PG8_SB(b, h) + boff + n * 2048 + k * 1024); } while (0)
#define PG8_MMA(ai, bj, At, Bt) do { __builtin_amdgcn_s_setprio(1); _Pragma("unroll") for (int m = 0; m < 4; ++m) _Pragma("unroll") for (int n = 0; n < 2; ++n) _Pragma("unroll") for (int k = 0; k < 2; ++k) \
        acc[ai][bj][m][n] = __builtin_amdgcn_mfma_f32_16x16x32_bf16(Bt[n][k], At[m][k], acc[ai][bj][m][n], 0, 0, 0); __builtin_amdgcn_s_setprio(0); } while (0)
#define PG8_WAIT_V(n) asm volatile("s_waitcnt vmcnt(" #n ")" ::: "memory")
#define PG8_WAIT_L(n) asm volatile("s_waitcnt lgkmcnt(" #n ")" ::: "memory")
#define PG8_BAR __builtin_amdgcn_s_barrier()
#define PG8_SCHED __builtin_amdgcn_sched_barrier(0)
    Unit cur, nxt; int ui = 0;
    if (!S.next(0, cur)) return;
    f32x4 acc[2][2][4][2];
#pragma unroll
    for (int a = 0; a < 2; ++a)
#pragma unroll
        for (int b = 0; b < 2; ++b)
#pragma unroll
            for (int m = 0; m < 4; ++m)
#pragma unroll
                for (int n = 0; n < 2; ++n) acc[a][b][m][n] = (f32x4){0.f, 0.f, 0.f, 0.f};
    bf16x8 At[4][2], B0[2][2], B1[2][2];
    v8i_ At8[4], B08[2], B18[2];
    const char* cA = GATHER ? (const char*)g.A : (const char*)g.A + (size_t)cur.pm * tstep + cur.kb; const char* cB = (const char*)g.Bt + (size_t)cur.pn * tstep + cur.kb;
    if (GATHER) { PG8_GATH(vAc, cur); }
    S.a_ready(cur);
    PG8_STAGE(PG8_SB(0, 0), cB, voffB); PG8_STAGE(PG8_SB(0, 1), cB + hstep, voffB); PG8_STAGE_A(PG8_SA(0, 0), cA, 0, false); PG8_STAGE_A(PG8_SA(0, 1), cA + hstepA, 1, false);
    if (wr == 1) PG8_BAR;
    PG8_WAIT_V(2); PG8_BAR;
    PG8_STAGE(PG8_SB(1, 0), cB + kstep, voffB); PG8_STAGE_A(PG8_SA(1, 0), cA + kstep, 0, false); PG8_STAGE(PG8_SB(1, 1), cB + hstep + kstep, voffB);
    PG8_WAIT_V(6); PG8_BAR;
    for (;;) {
        const bool has_next = S.next(ui + 1, nxt);
        const char* nA = GATHER ? (const char*)g.A : (has_next ? (const char*)g.A + (size_t)nxt.pm * tstep + nxt.kb : cA); const char* nB = has_next ? (const char*)g.Bt + (size_t)nxt.pn * tstep + nxt.kb : cB;
        if (GATHER) { if (has_next) { S.issue_rows(nxt, ui & 1, wid, lane); } else {
#pragma unroll
                for (int _h = 0; _h < 2; ++_h)
#pragma unroll
                    for (int _i = 0; _i < 2; ++_i) vAn[_h][_i] = vAc[_h][_i]; } }
        for (int t = 0; t < nt; t += 2) {
            const bool last = (t == nt - 2);
            const char* a1 = cA + (size_t)(t + 1) * kstep;
            const char* a2 = last ? nA : cA + (size_t)(t + 2) * kstep; const char* b2 = last ? nB : cB + (size_t)(t + 2) * kstep;
            const char* a3 = a2 + kstep; const char* b3 = b2 + kstep;
            if (last && has_next) S.a_ready(nxt);
            if (GATHER) { if (last && has_next) {
#pragma unroll
                    for (int _h = 0; _h < 2; ++_h)
#pragma unroll
                        for (int _i = 0; _i < 2; ++_i) vAn[_h][_i] = (unsigned)(S.arow_lds(_h * HALF + RA[_i], ui & 1) * K + CA[_i]) * 2u; } }
#define PG8_XLDB(b) do { if constexpr (FP8) { PG8_LDB8(B08, b, 0); PG8_LDB8(B18, b, 1); } else { PG8_LDB(B0, b, 0); PG8_LDB(B1, b, 1); } } while (0)
#define PG8_XLDA(b, h) do { if constexpr (FP8) { PG8_LDA8(At8, b, h); } else { PG8_LDA(At, b, h); } } while (0)
#define PG8_XMMA(ai) do { if constexpr (FP8) { PG8_MMA8(ai, 0, At8, B08); PG8_MMA8(ai, 1, At8, B18); } else { PG8_MMA(ai, 0, At, B0); PG8_MMA(ai, 1, At, B1); } } while (0)
            PG8_XLDB(0); PG8_SCHED; PG8_XLDA(0, 0); PG8_STAGE_A(PG8_SA(1, 1), a1 + hstepA, 1, false);
            PG8_WAIT_V(8); PG8_WAIT_L(0); PG8_BAR; PG8_XMMA(0); PG8_BAR; PG8_SCHED;
            PG8_XLDA(0, 1); PG8_STAGE(PG8_SB(0, 0), b2, voffB); PG8_STAGE(PG8_SB(0, 1), b2 + hstep, voffB); PG8_STAGE_A(PG8_SA(0, 0), a2, 0, last);
            PG8_WAIT_V(8); PG8_WAIT_L(0); PG8_BAR; PG8_XMMA(1); PG8_BAR; PG8_SCHED;
            PG8_XLDB(1); PG8_SCHED; PG8_XLDA(1, 0); PG8_STAGE_A(PG8_SA(0, 1), a2 + hstepA, 1, last);
            PG8_WAIT_V(8); PG8_WAIT_L(0); PG8_BAR; PG8_XMMA(0); PG8_BAR; PG8_SCHED;
            PG8_XLDA(1, 1); PG8_STAGE(PG8_SB(1, 0), b3, voffB); PG8_STAGE(PG8_SB(1, 1), b3 + hstep, voffB); PG8_STAGE_A(PG8_SA(1, 0), a3, 0, last);
            PG8_WAIT_V(8); PG8_WAIT_L(0); PG8_BAR; PG8_XMMA(1); PG8_BAR; PG8_SCHED;
        }
        if constexpr (ALIGN_EPI) { if (wr == 0) PG8_BAR; }
        E(acc, cur, wr, wc, fr, fq); S.done(cur);
        if (!has_next) break;
#pragma unroll
        for (int a = 0; a < 2; ++a)
#pragma unroll
            for (int b = 0; b < 2; ++b)
#pragma unroll
                for (int m = 0; m < 4; ++m)
#pragma unroll
                    for (int n = 0; n < 2; ++n) acc[a][b][m][n] = (f32x4){0.f, 0.f, 0.f, 0.f};
        cur = nxt; cA = nA; cB = nB; ++ui;
        if (GATHER) {
#pragma unroll
            for (int _h = 0; _h < 2; ++_h)
#pragma unroll
                for (int _i = 0; _i < 2; ++_i) vAc[_h][_i] = vAn[_h][_i]; }
        if constexpr (ALIGN_EPI) { if (wr == 1) PG8_BAR; }
    }
    PG8_WAIT_V(0);
    if constexpr (!ALIGN_EPI) { if (wr == 0) PG8_BAR; }
    PG8_BAR;
#undef PG8_SA
#undef PG8_SB
#undef PG8_STAGE
#undef PG8_STAGE_A
#undef PG8_GATH
#undef PG8_LDA
#undef PG8_LD8
#undef PG8_LDA8
#undef PG8_LDB8
#undef PG8_MMA8
#undef PG8_XLDB
#undef PG8_XLDA
#undef PG8_XMMA
#undef PG8_LDB
#undef PG8_MMA
#undef PG8_WAIT_V
#undef PG8_WAIT_L
#undef PG8_BAR
#undef PG8_SCHED
}
}

constexpr int NWAVES = 8;
constexpr int N_LAUNCHES = MK_N_LAUNCHES;
constexpr int NPHASE = 18;
constexpr int BATCH = 4, SEQ = 4096, D = 1024, M = BATCH * SEQ;
constexpr int NH = 16, QL = 384, KVL = 256, NOPE = 64, ROPE = 32, VD = 64, MLA_IN = 672, MLA_INP = 768, QW = NH * 96, KVW = NH * 128;
constexpr int HGH = 8, DK = 128, DV = 128, HG_IN = 4096;
constexpr int FF = 3584, NE = 8, CAP = 16384;
constexpr int MAXSLOT = 2 * M + NE * 256;
constexpr float EPS = 1e-6f;

constexpr size_t MiB = 1u << 20;
constexpr size_t WS_CTL = 0, CTL_ZERO_BYTES = 1 * MiB;
constexpr size_t WS_ROWLIST = 1 * MiB;
constexpr size_t WS_TOK = WS_ROWLIST + 512 * 1024;
constexpr size_t WS_STAMP = WS_TOK + 256 * 1024;
constexpr size_t WS_COS = 2 * MiB, WS_SIN = 3 * MiB;
constexpr size_t WS_WMLAIN = 4 * MiB;
constexpr size_t WS_WQUP = 6 * MiB;
constexpr size_t WS_WKVUP = 8 * MiB;
constexpr size_t WS_WO0 = 9 * MiB;
constexpr size_t WS_WFGU = 11 * MiB;
constexpr size_t WS_WFDN = 25 * MiB;
constexpr size_t WS_WHIN = 32 * MiB;
constexpr size_t WS_WHO = 40 * MiB;
constexpr size_t WS_WMGU = 42 * MiB;
constexpr size_t WS_WMDN = 154 * MiB;
constexpr size_t WS_ACTS = 210 * MiB;
constexpr size_t WS_HN = WS_ACTS;
constexpr size_t WS_PROJ = WS_ACTS + 32 * MiB;
constexpr size_t WS_CQN = WS_PROJ + 24 * MiB;
constexpr size_t WS_CKVN = WS_CQN + 12 * MiB;
constexpr size_t WS_KR = WS_CKVN + 8 * MiB;
constexpr size_t WS_Q = WS_KR + 1 * MiB;
constexpr size_t WS_KV = WS_Q + 48 * MiB;
constexpr size_t WS_O = WS_KV + 64 * MiB;
constexpr size_t WS_FACT = WS_ACTS + 32 * MiB;
constexpr size_t WS_HPROJ = WS_ACTS + 32 * MiB;
constexpr size_t WS_HOF = WS_HPROJ + 128 * MiB;
constexpr size_t WS_HON = WS_HOF + 64 * MiB;
constexpr size_t WS_OL = WS_HOF;
constexpr size_t WS_Q1G = WS_HOF + 32 * MiB;
constexpr size_t WS_SS = WS_HN;
constexpr size_t WS_WN = WS_HN + 16 * MiB;
constexpr size_t WS_DSEG = WS_HN + 17 * MiB;
constexpr size_t WS_HN3 = 4 * MiB;
constexpr size_t WS_MACT = WS_ACTS;
constexpr size_t WS_Y = WS_WMGU;
constexpr size_t WS_PART0 = WS_WMGU + 68 * MiB;
constexpr size_t WS_PART1 = WS_HN3;
constexpr size_t WS_END = 472 * MiB;
static_assert(WS_O + (size_t)M * 1024 * 2 <= WS_END && WS_HON + (size_t)M * 1024 * 2 <= WS_END && WS_MACT + (size_t)MAXSLOT * FF * 2 <= WS_END, "d_ws map");
static_assert(WS_HN3 + (size_t)M * 1024 * 2 <= WS_WHO, "hn3 overlay");
constexpr int CW_CNT = 64;
constexpr int CW_BAR = 4096;

constexpr int RING_OFF = 0, RING_BYTES = 131072;
constexpr int LDSCTL_OFF = RING_BYTES, MISC_OFF = LDSCTL_OFF + 320;
constexpr int ROWBUF_OFF = 133120;
constexpr int LDS_BYTES = 147456;

#define GAS __attribute__((address_space(1)))
#define LAS __attribute__((address_space(3)))
typedef unsigned short bf16;
typedef unsigned v4u __attribute__((ext_vector_type(4)));
typedef unsigned v2u __attribute__((ext_vector_type(2)));
typedef float f32x4 __attribute__((ext_vector_type(4)));
typedef GAS unsigned gu32;
#define RLX_AGENT __ATOMIC_RELAXED, __HIP_MEMORY_SCOPE_AGENT
#define LDS_WAIT() asm volatile("s_waitcnt lgkmcnt(0)" ::: "memory")
__device__ __forceinline__ unsigned f2bf(float f) { unsigned u = __builtin_bit_cast(unsigned, f); return (u + 0x7fffu + ((u >> 16) & 1u)) >> 16; }
__device__ __forceinline__ unsigned pk2(float lo, float hi) { return f2bf(lo) | (f2bf(hi) << 16); }
__device__ __forceinline__ float bf2f(unsigned short b) { return __builtin_bit_cast(float, (unsigned)b << 16); }

#define XB_TMO      128
#define XB_XCNT(j)  (256  + 64 * (j))
#define XB_XSUB(j)  (1280 + 64 * (j))
#define XB_XGEN(j)  (2304 + 64 * (j))
#define XB_TOP      3328
#define XB_TOPGEN   3392
#define XCD_BAR_WORDS 3456
#define XB_SPIN_CAP (1u << 24)
__device__ __forceinline__ unsigned xb_ld(unsigned* p)              { return __hip_atomic_load(p, __ATOMIC_RELAXED, __HIP_MEMORY_SCOPE_AGENT); }
__device__ __forceinline__ unsigned xb_add(unsigned* p, unsigned v) { return __hip_atomic_fetch_add(p, v, __ATOMIC_RELAXED, __HIP_MEMORY_SCOPE_AGENT); }
__device__ __forceinline__ unsigned xb_xcc_id() { return (unsigned)__builtin_amdgcn_s_getreg((3 << 11) | 20) & 0xFu; }
#define XB_SPIN(cond, bar) do { unsigned _sp = 0; while (cond) { __builtin_amdgcn_s_sleep(1); \
    if ((++_sp & 255u) == 0u) { if (xb_ld(&(bar)[XB_TMO])) break; if (_sp > XB_SPIN_CAP) { atomicAdd(&(bar)[XB_TMO], 1u); break; } } } } while (0)
struct XcdBarrier { unsigned* bar; unsigned x; volatile LAS unsigned* st; };
__device__ __forceinline__ XcdBarrier xcd_barrier_post(unsigned* bar, volatile LAS unsigned* st) {
    XcdBarrier b; b.bar = bar; b.x = xb_xcc_id(); b.st = st;
    if (threadIdx.x == 0) (void)xb_add(&bar[XB_XCNT(b.x)], 1u);
    return b;
}
__device__ __forceinline__ void xcd_barrier_complete(unsigned* bar, unsigned x, unsigned& nloc, unsigned& nx) {
    const unsigned G = gridDim.x * gridDim.y * gridDim.z;
    unsigned sum, cnt, mine, sp = 0u;
    for (;;) {
        sum = 0u; cnt = 0u; mine = 0u;
#pragma unroll
        for (unsigned j = 0; j < 16; ++j) { const unsigned c = xb_ld(&bar[XB_XCNT(j)]); sum += c; cnt += (c > 0u) ? 1u : 0u; mine = (j == x) ? c : mine; }
        if (sum == G) break;
        __builtin_amdgcn_s_sleep(1);
        if ((++sp & 255u) == 0u) { if (xb_ld(&bar[XB_TMO])) break; if (sp > XB_SPIN_CAP) { atomicAdd(&bar[XB_TMO], 1u); break; } }
    }
    nloc = mine > 0u ? mine : 1u; nx = cnt > 0u ? cnt : 1u;
}
__device__ __forceinline__ void xcd_barrier(const XcdBarrier& b) {
    asm volatile("s_waitcnt vmcnt(0)" ::: "memory");
    __syncthreads();
    if (threadIdx.x == 0) {
        unsigned* bar = b.bar;
        __builtin_amdgcn_s_waitcnt(0);
        unsigned nloc = b.st[0], nx = b.st[1];
        if (nloc == 0u) { xcd_barrier_complete(bar, b.x, nloc, nx); b.st[0] = nloc; b.st[1] = nx; }
        const unsigned old = xb_add(&bar[XB_XSUB(b.x)], 1u);
        const unsigned gen = old / nloc;
        if (old + 1u == (gen + 1u) * nloc) {
            __builtin_amdgcn_fence(__ATOMIC_RELEASE, "agent");
            asm volatile("s_waitcnt vmcnt(0)" ::: "memory");
            const unsigned og = xb_add(&bar[XB_TOP], 1u);
            const unsigned tg = og / nx;
            if (og + 1u == (tg + 1u) * nx) xb_add(&bar[XB_TOPGEN], 1u);
            else XB_SPIN(xb_ld(&bar[XB_TOPGEN]) == tg, bar);
            __builtin_amdgcn_fence(__ATOMIC_ACQUIRE, "agent");
            xb_add(&bar[XB_XGEN(b.x)], 1u);
            asm volatile("s_waitcnt vmcnt(0)" ::: "memory");
        } else {
            XB_SPIN(xb_ld(&bar[XB_XGEN(b.x)]) == gen, bar);
            __builtin_amdgcn_fence(__ATOMIC_ACQUIRE, "agent");
            asm volatile("s_waitcnt vmcnt(0)" ::: "memory");
        }
    }
    __syncthreads();
}

__device__ __forceinline__ float wave_sum(float v) {
#pragma unroll
    for (int o = 1; o < 64; o <<= 1) v += __shfl_xor(v, o);
    return v;
}
__device__ __forceinline__ int dst_row(int n, int mode) { return mode == 0 ? n : (((n >> 7) << 8) + (n & 127) + (mode == 2 ? 128 : 0)); }
__device__ __forceinline__ unsigned pk_fp8x4(float a, float b, float c, float d, float sc) {
    a = __builtin_amdgcn_fmed3f(a * sc, -448.f, 448.f); b = __builtin_amdgcn_fmed3f(b * sc, -448.f, 448.f); c = __builtin_amdgcn_fmed3f(c * sc, -448.f, 448.f); d = __builtin_amdgcn_fmed3f(d * sc, -448.f, 448.f);
    int w = __builtin_amdgcn_cvt_pk_fp8_f32(a, b, 0, false); w = __builtin_amdgcn_cvt_pk_fp8_f32(c, d, w, true); return (unsigned)w; }
struct TrJob { const float* W; bf16* WT; int K, N, mode, item; };
__device__ __forceinline__ void tr_load(const TrJob& j, float (&v)[32], int lane) {
    const int nblk = j.N / 32, kb = j.item / nblk, nb = j.item % nblk; const float* src = j.W + (size_t)(64 * kb + (lane >> 5)) * j.N + 32 * nb + (lane & 31);
#pragma unroll
    for (int i = 0; i < 32; ++i) v[i] = __builtin_nontemporal_load(src + (size_t)(2 * i) * j.N);
}
__device__ __forceinline__ void tr_finish(const TrJob& j, const float (&v)[32], LAS float* scr, int lane) {
    const int nblk = j.N / 32, kb = j.item / nblk, nb = j.item % nblk, k0 = 64 * kb, n0 = 32 * nb;
#pragma unroll
    for (int i = 0; i < 32; ++i) scr[(2 * i + (lane >> 5)) * 33 + (lane & 31)] = v[i];
    LDS_WAIT(); asm volatile("" ::: "memory");
    const int c = lane & 7;
#pragma unroll
    for (int q = 0; q < 4; ++q) { const int n = (lane >> 3) + 8 * q; const LAS float* sp = scr + (8 * c) * 33 + n;
        if (j.mode & 32) { v2u o8; o8.x = pk_fp8x4(sp[0 * 33], sp[1 * 33], sp[2 * 33], sp[3 * 33], 512.f); o8.y = pk_fp8x4(sp[4 * 33], sp[5 * 33], sp[6 * 33], sp[7 * 33], 512.f);
            __builtin_nontemporal_store(o8, (v2u*)((unsigned char*)j.WT + (size_t)dst_row(n0 + n, j.mode & 3) * j.K + k0 + 8 * c)); }
        else { v4u o; o.x = pk2(sp[0 * 33], sp[1 * 33]); o.y = pk2(sp[2 * 33], sp[3 * 33]); o.z = pk2(sp[4 * 33], sp[5 * 33]); o.w = pk2(sp[6 * 33], sp[7 * 33]);
            __builtin_nontemporal_store(o, (v4u*)(j.WT + (size_t)dst_row(n0 + n, j.mode) * j.K + k0 + 8 * c)); } }
    LDS_WAIT(); asm volatile("" ::: "memory");
}
__device__ __forceinline__ void rms_row_to_bf16(const float* xrow, const float* gain, bf16* orow, int lane) {
    const f32x4* xr = (const f32x4*)xrow + lane; const f32x4* gr = (const f32x4*)gain + lane;
    f32x4 v[4]; float s = 0.f;
#pragma unroll
    for (int j = 0; j < 4; ++j) { v[j] = xr[64 * j]; s += (v[j].x * v[j].x + v[j].y * v[j].y) + (v[j].z * v[j].z + v[j].w * v[j].w); }
    const float rstd = 1.f / sqrtf(wave_sum(s) * (1.f / 1024.f) + EPS);
    unsigned long long* o8 = (unsigned long long*)orow + lane;
#pragma unroll
    for (int j = 0; j < 4; ++j) { const f32x4 g = gr[64 * j];
        o8[64 * j] = (unsigned long long)pk2(v[j].x * rstd * g.x, v[j].y * rstd * g.y) | ((unsigned long long)pk2(v[j].z * rstd * g.z, v[j].w * rstd * g.w) << 32); }
}
__device__ __forceinline__ void rms_rows_to_bf16(const float* X, const float* gain, bf16* O, int gw, int NGW, int Mrows, int lane) {
    f32x4 g[4];
#pragma unroll
    for (int j = 0; j < 4; ++j) g[j] = ((const f32x4*)gain + lane)[64 * j];
    if (gw >= Mrows) return;
    f32x4 vn[4];
#pragma unroll
    for (int j = 0; j < 4; ++j) vn[j] = ((const f32x4*)(X + (size_t)gw * 1024) + lane)[64 * j];
    for (int m = gw; m < Mrows; m += NGW) {
        f32x4 v[4];
#pragma unroll
        for (int j = 0; j < 4; ++j) v[j] = vn[j];
        const int mn = (m + NGW < Mrows) ? m + NGW : m;
#pragma unroll
        for (int j = 0; j < 4; ++j) vn[j] = ((const f32x4*)(X + (size_t)mn * 1024) + lane)[64 * j];
        float s = 0.f;
#pragma unroll
        for (int j = 0; j < 4; ++j) s += (v[j].x * v[j].x + v[j].y * v[j].y) + (v[j].z * v[j].z + v[j].w * v[j].w);
        const float rstd = 1.f / sqrtf(wave_sum(s) * (1.f / 1024.f) + EPS);
        unsigned long long* o8 = (unsigned long long*)(O + (size_t)m * 1024) + lane;
#pragma unroll
        for (int j = 0; j < 4; ++j) o8[64 * j] = (unsigned long long)pk2(v[j].x * rstd * g[j].x, v[j].y * rstd * g[j].y) | ((unsigned long long)pk2(v[j].z * rstd * g[j].z, v[j].w * rstd * g[j].w) << 32);
    }
}
__device__ __forceinline__ f32x4 ld_bf4(const bf16* p) { const v2u b = *(const v2u*)p; return (f32x4){__uint_as_float(b.x << 16), __uint_as_float(b.x & 0xffff0000u), __uint_as_float(b.y << 16), __uint_as_float(b.y & 0xffff0000u)}; }
__device__ __forceinline__ void rms_rows_bf16in(const bf16* X, int pitch, const float* gain, bf16* O, int gw, int NGW, int Mrows, int lane) {
    f32x4 g[4];
#pragma unroll
    for (int j = 0; j < 4; ++j) g[j] = ((const f32x4*)gain + lane)[64 * j];
    if (gw >= Mrows) return;
    f32x4 vn[4];
#pragma unroll
    for (int j = 0; j < 4; ++j) vn[j] = ld_bf4(X + (size_t)gw * pitch + 4 * (lane + 64 * j));
    for (int m = gw; m < Mrows; m += NGW) {
        f32x4 v[4];
#pragma unroll
        for (int j = 0; j < 4; ++j) v[j] = vn[j];
        const int mn = (m + NGW < Mrows) ? m + NGW : m;
#pragma unroll
        for (int j = 0; j < 4; ++j) vn[j] = ld_bf4(X + (size_t)mn * pitch + 4 * (lane + 64 * j));
        float s = 0.f;
#pragma unroll
        for (int j = 0; j < 4; ++j) s += (v[j].x * v[j].x + v[j].y * v[j].y) + (v[j].z * v[j].z + v[j].w * v[j].w);
        const float rstd = 1.f / sqrtf(wave_sum(s) * (1.f / 1024.f) + EPS);
        unsigned long long* o8 = (unsigned long long*)(O + (size_t)m * 1024) + lane;
#pragma unroll
        for (int j = 0; j < 4; ++j) o8[64 * j] = (unsigned long long)pk2(v[j].x * rstd * g[j].x, v[j].y * rstd * g[j].y) | ((unsigned long long)pk2(v[j].z * rstd * g[j].z, v[j].w * rstd * g[j].w) << 32);
    }
}
__device__ __forceinline__ float sigmoid_f(float x) { return 1.0f / (1.0f + __expf(-x)); }

struct MoeOrder {
    pg8::StaticOrder so; int nN; volatile LAS int* mt; const int* rowlist; LAS int* rowbuf;
    __device__ __forceinline__ void init(volatile LAS int* mt_, int nN_, int G, int c, const int* rl, int tmax = 1 << 20) { mt = mt_; nN = nN_; rowlist = rl; rowbuf = (LAS int*)((LAS unsigned char*)mt_ - (MISC_OFF + 64) + ROWBUF_OFF); const int T = mt_[8]; so.init((T < tmax ? T : tmax) * 256, nN_ * 256, G, c); }
    __device__ __forceinline__ bool next(int i, pg8::Unit& u) const {
        if (!so.next(i, u)) return false;
        int e = 0;
#pragma unroll
        for (int j = 1; j < 8; ++j) e += (u.pm >= mt[j]) ? 1 : 0;
        u.pn = e * nN + u.pn; u.kb = 0; return true;
    }
    __device__ __forceinline__ void a_ready(const pg8::Unit&) const {}
    __device__ __forceinline__ void done(const pg8::Unit&) const {}
    __device__ __forceinline__ void issue_rows(const pg8::Unit& u, int par, int wid, int lane) const {
        if (wid < 4) { const int e = u.pn / nN; const int lr = (u.pm - mt[e]) * 256 + wid * 64 + lane, c1 = mt[9 + e] - 1;
            __builtin_amdgcn_global_load_lds((const unsigned*)(rowlist + e * CAP + (lr < c1 ? lr : c1)), (LAS unsigned*)(rowbuf + par * 256 + wid * 64), 4, 0, 0); } }
    __device__ __forceinline__ int arow_lds(int r, int par) const { return rowbuf[par * 256 + r]; }
    __device__ __forceinline__ int arow(const pg8::Unit& u, int r) const { const int e = u.pn / nN; const int lr = (u.pm - mt[e]) * 256 + r, c1 = mt[9 + e] - 1; return rowlist[e * CAP + (lr < c1 ? lr : c1)]; }
};


namespace mla_attn {
using bf16x8=__attribute__((ext_vector_type(8)))short;
using s16x4=__attribute__((ext_vector_type(4)))short;
using f32x16=__attribute__((ext_vector_type(16)))float;
using u32x4=__attribute__((ext_vector_type(4)))unsigned;
typedef __attribute__((address_space(3))) const char* lds_cptr;
constexpr int NW=8,QBLK=32,QB=256,KVBLK=64;
constexpr int KSLOT=12288,VSLOT=8192,NSLOT=3;
constexpr int LDS_K=0,LDS_V=NSLOT*KSLOT,LDS_WS=LDS_V+NSLOT*VSLOT,LDS_OST=LDS_WS+NW*64*4,LDS_BYTES_A=LDS_OST+NW*4096;
__device__ __forceinline__ int crow(int r,int hi){return (r&3)+8*(r>>2)+4*hi;}
__device__ __forceinline__ void glds16(const void*gsrc,unsigned lds_dst){unsigned keep;
  asm volatile("s_mov_b32 %0, m0\n\ts_mov_b32 m0, %2\n\ts_nop 0\n\tglobal_load_lds_dwordx4 %1, off\n\ts_mov_b32 m0, %0":"=&s"(keep):"v"(gsrc),"s"(lds_dst):"memory");}
typedef float f32x2_t __attribute__((ext_vector_type(2))); typedef __bf16 bf16x2_t __attribute__((ext_vector_type(2)));
__device__ __forceinline__ unsigned cvtpk_s(float lo,float hi){f32x2_t v={lo,hi};bf16x2_t b=__builtin_convertvector(v,bf16x2_t);return __builtin_bit_cast(unsigned,b);}
__device__ __forceinline__ void glds16s(const void*sbase,unsigned voff,unsigned lds_dst){unsigned keep;
  asm volatile("s_mov_b32 %0, m0\n\ts_mov_b32 m0, %3\n\ts_nop 0\n\tglobal_load_lds_dwordx4 %1, %2\n\ts_mov_b32 m0, %0":"=&s"(keep):"v"(voff),"s"(sbase),"s"(lds_dst):"memory");}
#define MLA_WAIT_BAR(N) asm volatile("s_waitcnt vmcnt(" #N ") lgkmcnt(0)\n\ts_barrier":::"memory")
__device__ __forceinline__ void cmask(f32x16&p0,f32x16&p1,int jb,int qrel,int hi){
  const float NEG=-INFINITY; int kb=64*jb+4*hi;
  #pragma unroll
  for(int r=0;r<16;++r){int kv=kb+(r&3)+8*(r>>2); if(kv>qrel)p0[r]=NEG; if(kv+32>qrel)p1[r]=NEG;}
}
__device__ __forceinline__ void qkt6(f32x16&p0,f32x16&p1,lds_cptr kslot,const bf16x8*qr,const f32x16&negm,int r32,int hi){
  lds_cptr kb=kslot+hi*1024+r32*16;
  #pragma unroll
  for(int d0=0;d0<6;++d0){
    const bf16x8 b0=*(const __attribute__((address_space(3))) bf16x8*)(kb+d0*2048);
    const bf16x8 b1=*(const __attribute__((address_space(3))) bf16x8*)(kb+d0*2048+512);
    if(d0==0){p0=__builtin_amdgcn_mfma_f32_32x32x16_bf16(b0,qr[0],negm,0,0,0);p1=__builtin_amdgcn_mfma_f32_32x32x16_bf16(b1,qr[0],negm,0,0,0);}
    else{p0=__builtin_amdgcn_mfma_f32_32x32x16_bf16(b0,qr[d0],p0,0,0,0);p1=__builtin_amdgcn_mfma_f32_32x32x16_bf16(b1,qr[d0],p1,0,0,0);}}
}
__device__ __forceinline__ float rowmax(const f32x16&p0,const f32x16&p1){
  float a=__builtin_fmaxf(__builtin_fmaxf(p0[0],p0[1]),p1[0]),b=__builtin_fmaxf(__builtin_fmaxf(p0[2],p0[3]),p1[1]);a=__builtin_fmaxf(__builtin_fmaxf(a,p1[2]),p1[3]);
  #pragma unroll
  for(int r=4;r<16;r+=4){a=__builtin_fmaxf(__builtin_fmaxf(a,p0[r]),p0[r+1]);b=__builtin_fmaxf(__builtin_fmaxf(b,p0[r+2]),p0[r+3]);a=__builtin_fmaxf(__builtin_fmaxf(a,p1[r]),p1[r+1]);b=__builtin_fmaxf(__builtin_fmaxf(b,p1[r+2]),p1[r+3]);}
  const float m=__builtin_fmaxf(a,b);
  auto rr=__builtin_amdgcn_permlane32_swap(__float_as_uint(m),__float_as_uint(m),false,false);
  return __builtin_fmaxf(__uint_as_float(rr[0]),__uint_as_float(rr[1]));
}
__device__ __forceinline__ void pv(f32x16*o,int vb,bf16x8 pa0,bf16x8 pa1,bf16x8 pa2,bf16x8 pa3){
  #pragma unroll
  for(int d0=0;d0<2;++d0){s16x4 lo[4],hi[4];
    #pragma unroll
    for(int ks=0;ks<4;++ks){
      asm volatile("ds_read_b64_tr_b16 %0,%1 offset:%c2":"=&v"(lo[ks]):"v"(vb),"i"(d0*4096+ks*1024):"memory");
      asm volatile("ds_read_b64_tr_b16 %0,%1 offset:%c2":"=&v"(hi[ks]):"v"(vb),"i"(d0*4096+ks*1024+512):"memory");}
    asm volatile("s_waitcnt lgkmcnt(0)":::"memory");__builtin_amdgcn_sched_barrier(0);
    #define PK(k) (bf16x8){lo[k][0],lo[k][1],lo[k][2],lo[k][3],hi[k][0],hi[k][1],hi[k][2],hi[k][3]}
    o[d0]=__builtin_amdgcn_mfma_f32_32x32x16_bf16(pa0,PK(0),o[d0],0,0,0);
    o[d0]=__builtin_amdgcn_mfma_f32_32x32x16_bf16(pa1,PK(1),o[d0],0,0,0);
    o[d0]=__builtin_amdgcn_mfma_f32_32x32x16_bf16(pa2,PK(2),o[d0],0,0,0);
    o[d0]=__builtin_amdgcn_mfma_f32_32x32x16_bf16(pa3,PK(3),o[d0],0,0,0);
    #undef PK
  }
}
constexpr int QPITCH=1536,KVPITCH=2048,KRPITCH=32,OPITCH=1024,SEQ_=4096;
template<int THRL> __device__ __forceinline__ void attn_unit(int b,int h,int qb,const unsigned short*Q,const unsigned short*KV,const unsigned short*KR,const float*COS,const float*SIN,unsigned short*O,char*shm){
  const int tid=threadIdx.x,lane=tid&63,r32=lane&31,hi=lane>>5; const int wid=__builtin_amdgcn_readfirstlane(tid>>6);
  const long rowbase=(long)b*SEQ_; const int q0=qb*QB;
  const unsigned short*Qw=Q+(rowbase+q0+wid*QBLK)*QPITCH+h*96;
  const unsigned short*Kh=KV+rowbase*KVPITCH+h*128,*Vh=Kh+64,*KRb=KR+rowbase*KRPITCH;
  const unsigned lds0=(unsigned)(uintptr_t)shm;
  float*wsf=(float*)(shm+LDS_WS)+wid*64;
  const unsigned short*ksrc0=Kh+(long)lane*KVPITCH+wid*8;
  const unsigned short*ksrc1=KRb+(long)lane*KRPITCH+(wid&3)*8;
  const unsigned short*vsrc=Vh+(long)(16*(wid&3)+(lane>>2))*KVPITCH+(wid>>2)*32+(lane&3)*8;
  const unsigned kdst0=lds0+LDS_K+wid*1024,kdst1=lds0+LDS_K+(8+(wid&3))*1024,vdst=lds0+LDS_V+wid*1024;
  #define DMA_T(t,sl) do{ glds16(ksrc0+(long)(t)*KVBLK*KVPITCH,(unsigned)__builtin_amdgcn_readfirstlane(kdst0+(sl)*KSLOT)); \
                          glds16(ksrc1+(long)(t)*KVBLK*KRPITCH,(unsigned)__builtin_amdgcn_readfirstlane(kdst1+(sl)*KSLOT)); \
                          glds16(vsrc+(long)(t)*KVBLK*KVPITCH,(unsigned)__builtin_amdgcn_readfirstlane(vdst+(sl)*VSLOT)); }while(0)
  const int vb0=(int)(lds0+LDS_V)+((lane>>4)&1)*32+(lane&3)*8+(4*hi+((lane&15)>>2))*64;
  const lds_cptr shm3=(lds_cptr)(__attribute__((address_space(3))) char*)shm;
  const int NT=(q0+QB)/KVBLK;
  bf16x8 qr[6];
  #pragma unroll
  for(int d0=0;d0<6;++d0)qr[d0]=*reinterpret_cast<const bf16x8*>(&Qw[(long)r32*QPITCH+d0*16+hi*8]);
  {
    const float*cp=COS+(rowbase+q0+wid*QBLK+r32)*16+hi*8,*sp=SIN+(rowbase+q0+wid*QBLK+r32)*16+hi*8;
    float cs[8],sn[8];
    #pragma unroll
    for(int j=0;j<8;++j){cs[j]=cp[j];sn[j]=sp[j];}
    const float sc=0.10206207261596577f*1.4426950408889634f;
    float x1[8],x2[8];
    #pragma unroll
    for(int j=0;j<8;++j){x1[j]=__uint_as_float(((unsigned)(unsigned short)qr[4][j])<<16);x2[j]=__uint_as_float(((unsigned)(unsigned short)qr[5][j])<<16);}
    #pragma unroll
    for(int j=0;j<8;j+=2){
      const unsigned a=cvtpk_s((x1[j]*cs[j]-x2[j]*sn[j])*sc,(x1[j+1]*cs[j+1]-x2[j+1]*sn[j+1])*sc), c=cvtpk_s((x2[j]*cs[j]+x1[j]*sn[j])*sc,(x2[j+1]*cs[j+1]+x1[j+1]*sn[j+1])*sc);
      qr[4][j]=(short)(a&0xffffu);qr[4][j+1]=(short)(a>>16);qr[5][j]=(short)(c&0xffffu);qr[5][j+1]=(short)(c>>16);}
    #pragma unroll
    for(int d0=0;d0<4;++d0)
      #pragma unroll
      for(int j=0;j<8;j+=2){const unsigned a=cvtpk_s(__uint_as_float(((unsigned)(unsigned short)qr[d0][j])<<16)*sc,__uint_as_float(((unsigned)(unsigned short)qr[d0][j+1])<<16)*sc);
        qr[d0][j]=(short)(a&0xffffu);qr[d0][j+1]=(short)(a>>16);}
  }
  asm volatile("s_waitcnt vmcnt(0)":::"memory");
  DMA_T(0,0); DMA_T(1,1);
  float mhat=0.f,l_reg=0.f;f32x16 o[2];o[0]=f32x16{};o[1]=f32x16{};f32x16 negm=f32x16{};
  const int qrel=wid*QBLK+r32;
  int sl=0;
  for(int t=0;t<NT;++t){
    if(t+1<NT){MLA_WAIT_BAR(3);}else{MLA_WAIT_BAR(0);}
    if(t+2<NT){const int s2=(sl==0)?2:sl-1; DMA_T(t+2,s2);}
    f32x16 p0,p1;
    qkt6(p0,p1,shm3+LDS_K+sl*KSLOT,qr,negm,r32,hi);
    if(t>=NT-4)cmask(p0,p1,t-(NT-4),qrel,hi);
    const float rm=rowmax(p0,p1);
    bool resc=false;
    if(t==0){ const float dl=rm; mhat+=dl;
      #pragma unroll
      for(int r=0;r<16;++r){p0[r]-=dl;p1[r]-=dl;}
      #pragma unroll
      for(int r=0;r<16;++r)negm[r]=-mhat;
    } else if(__any(rm>(float)THRL)){ const float dl=__builtin_fmaxf(rm,0.f); mhat+=dl;
      #pragma unroll
      for(int r=0;r<16;++r){p0[r]-=dl;p1[r]-=dl;}
      #pragma unroll
      for(int r=0;r<16;++r)negm[r]=-mhat;
      const float f=__builtin_amdgcn_exp2f(-dl); l_reg*=f; if(hi==0)wsf[r32]=f; resc=true; }
    float sacc=0.f;
    #pragma unroll
    for(int r=0;r<16;++r){p0[r]=__builtin_amdgcn_exp2f(p0[r]);p1[r]=__builtin_amdgcn_exp2f(p1[r]);sacc+=p0[r]+p1[r];}
    l_reg+=sacc;
    if(resc){ asm volatile("s_waitcnt lgkmcnt(0)":::"memory");
      #pragma unroll
      for(int d_=0;d_<2;++d_)
        #pragma unroll
        for(int r=0;r<16;++r)o[d_][r]*=wsf[crow(r,hi)]; }
    u32x4 pw0,pw1,pw2,pw3;
    pw0=(u32x4){cvtpk_s(p0[0],p0[1]),cvtpk_s(p0[2],p0[3]),cvtpk_s(p0[4],p0[5]),cvtpk_s(p0[6],p0[7])};
    pw1=(u32x4){cvtpk_s(p0[8],p0[9]),cvtpk_s(p0[10],p0[11]),cvtpk_s(p0[12],p0[13]),cvtpk_s(p0[14],p0[15])};
    pw2=(u32x4){cvtpk_s(p1[0],p1[1]),cvtpk_s(p1[2],p1[3]),cvtpk_s(p1[4],p1[5]),cvtpk_s(p1[6],p1[7])};
    pw3=(u32x4){cvtpk_s(p1[8],p1[9]),cvtpk_s(p1[10],p1[11]),cvtpk_s(p1[12],p1[13]),cvtpk_s(p1[14],p1[15])};
    pv(o,vb0+sl*VSLOT,__builtin_bit_cast(bf16x8,pw0),__builtin_bit_cast(bf16x8,pw1),__builtin_bit_cast(bf16x8,pw2),__builtin_bit_cast(bf16x8,pw3));
    sl=(sl==2)?0:sl+1;
  }
  {auto rr=__builtin_amdgcn_permlane32_swap(__float_as_uint(l_reg),__float_as_uint(l_reg),false,false);l_reg=__uint_as_float(rr[0])+__uint_as_float(rr[1]);}
  if(hi==0)wsf[32+r32]=l_reg;asm volatile("s_waitcnt lgkmcnt(0)":::"memory");
  float rli[16];
  #pragma unroll
  for(int r=0;r<16;++r)rli[r]=__builtin_amdgcn_rcpf(wsf[32+crow(r,hi)]);
  unsigned short*Ow=O+(rowbase+q0+wid*QBLK)*OPITCH+h*64;
  { unsigned short*stg=(unsigned short*)(shm+LDS_OST)+wid*2048;
    #pragma unroll
    for(int r=0;r<16;++r){const int orow=crow(r,hi);
      #pragma unroll
      for(int d0=0;d0<2;++d0)stg[orow*64+d0*32+r32]=(unsigned short)(cvtpk_s(o[d0][r]*rli[r],0.f)&0xffffu);}
    asm volatile("s_waitcnt lgkmcnt(0)":::"memory");
    #pragma unroll
    for(int i=0;i<4;++i){const int row=i*8+(lane>>3),ch=lane&7; const u32x4 v=*(const u32x4*)(stg+row*64+ch*8); *(u32x4*)(Ow+(long)row*OPITCH+ch*8)=v;} }
  asm volatile("s_waitcnt vmcnt(0) lgkmcnt(0)\n\ts_barrier":::"memory");
  #undef DMA_T
}

typedef short v4i16_t __attribute__((ext_vector_type(4)));
__device__ __forceinline__ s16x4 vtr(lds_cptr p){ return __builtin_bit_cast(s16x4,__builtin_amdgcn_ds_read_tr16_b64_v4i16((__attribute__((address_space(3))) v4i16_t*)p)); }
template<int THRL> __device__ __forceinline__ void attn_unit2(int b,int h,int qb,const unsigned short*Q,const unsigned short*KV,const unsigned short*KR,const float*COS,const float*SIN,unsigned short*O,char*shm){
  const int tid=threadIdx.x,lane=tid&63,r32=lane&31,hi=lane>>5; const int wid=__builtin_amdgcn_readfirstlane(tid>>6);
  const long rowbase=(long)b*SEQ_; const int q0=qb*QB;
  const unsigned short*Qw=Q+(rowbase+q0+wid*QBLK)*QPITCH+h*96;
  const unsigned short*Kh=KV+rowbase*KVPITCH+h*128,*Vh=Kh+64,*KRb=KR+rowbase*KRPITCH;
  const unsigned lds0=(unsigned)(uintptr_t)shm;
  float*wsf=(float*)(shm+LDS_WS)+wid*64;
  const unsigned koff0=(unsigned)(lane*KVPITCH+wid*8)*2u, koff1=(unsigned)(lane*KRPITCH+(wid&3)*8)*2u, voffv=(unsigned)((16*(wid&3)+(lane>>2))*KVPITCH+(wid>>2)*32+(lane&3)*8)*2u;
  const unsigned kdst0=lds0+LDS_K+wid*1024,kdst1=lds0+LDS_K+(8+(wid&3))*1024,vdst=lds0+LDS_V+wid*1024;
  #define DMA_K2(t,sl) do{ glds16s(Kh+(long)(t)*KVBLK*KVPITCH,koff0,(unsigned)__builtin_amdgcn_readfirstlane(kdst0+(sl)*KSLOT)); \
                           glds16s(KRb+(long)(t)*KVBLK*KRPITCH,koff1,(unsigned)__builtin_amdgcn_readfirstlane(kdst1+(sl)*KSLOT)); }while(0)
  #define DMA_V2(t,sl) glds16s(Vh+(long)(t)*KVBLK*KVPITCH,voffv,(unsigned)__builtin_amdgcn_readfirstlane(vdst+(sl)*VSLOT))
  const lds_cptr shm3=(lds_cptr)(__attribute__((address_space(3))) char*)shm;
  const lds_cptr vp0=shm3+LDS_V+((lane>>4)&1)*32+(lane&3)*8+(4*hi+((lane&15)>>2))*64;
  const int NT=(q0+QB)/KVBLK;
  DMA_K2(0,0); DMA_V2(0,0); DMA_K2(1,1);
  bf16x8 qr[6];
  #pragma unroll
  for(int d0=0;d0<6;++d0)qr[d0]=*reinterpret_cast<const bf16x8*>(&Qw[(long)r32*QPITCH+d0*16+hi*8]);
  { const float*cp=COS+(rowbase+q0+wid*QBLK+r32)*16+hi*8,*sp=SIN+(rowbase+q0+wid*QBLK+r32)*16+hi*8;
    float cs[8],sn[8];
    #pragma unroll
    for(int j=0;j<8;++j){cs[j]=cp[j];sn[j]=sp[j];}
    const float sc=0.10206207261596577f*1.4426950408889634f;
    float x1[8],x2[8];
    #pragma unroll
    for(int j=0;j<8;++j){x1[j]=__uint_as_float(((unsigned)(unsigned short)qr[4][j])<<16);x2[j]=__uint_as_float(((unsigned)(unsigned short)qr[5][j])<<16);}
    #pragma unroll
    for(int j=0;j<8;j+=2){
      const unsigned a=cvtpk_s((x1[j]*cs[j]-x2[j]*sn[j])*sc,(x1[j+1]*cs[j+1]-x2[j+1]*sn[j+1])*sc), c=cvtpk_s((x2[j]*cs[j]+x1[j]*sn[j])*sc,(x2[j+1]*cs[j+1]+x1[j+1]*sn[j+1])*sc);
      qr[4][j]=(short)(a&0xffffu);qr[4][j+1]=(short)(a>>16);qr[5][j]=(short)(c&0xffffu);qr[5][j+1]=(short)(c>>16);}
    #pragma unroll
    for(int d0=0;d0<4;++d0)
      #pragma unroll
      for(int j=0;j<8;j+=2){const unsigned a=cvtpk_s(__uint_as_float(((unsigned)(unsigned short)qr[d0][j])<<16)*sc,__uint_as_float(((unsigned)(unsigned short)qr[d0][j+1])<<16)*sc);
        qr[d0][j]=(short)(a&0xffffu);qr[d0][j+1]=(short)(a>>16);}
  }
  float mhat=0.f,l_reg=0.f;f32x16 o[2];o[0]=f32x16{};o[1]=f32x16{};f32x16 negm=f32x16{};
  const int qrel=wid*QBLK+r32;
  f32x16 p0,p1;
  MLA_WAIT_BAR(3);
  DMA_K2(2,2); DMA_V2(1,1);
  qkt6(p0,p1,shm3+LDS_K,qr,negm,r32,hi);
  if(NT==4)cmask(p0,p1,0,qrel,hi);
  { const float dl=rowmax(p0,p1); mhat+=dl;
    #pragma unroll
    for(int r=0;r<16;++r){p0[r]=__builtin_amdgcn_exp2f(p0[r]-dl);p1[r]=__builtin_amdgcn_exp2f(p1[r]-dl);}
    #pragma unroll
    for(int r=0;r<16;++r)negm[r]=-mhat; }
  int sk=1,sv=0;
  for(int t=1;t<NT;++t){
    if(t+1<NT){MLA_WAIT_BAR(3);}else{MLA_WAIT_BAR(1);}
    if(t+2<NT){DMA_K2(t+2,(sk==0)?2:sk-1);}
    if(t+1<NT){DMA_V2(t+1,(sv==0)?2:sv-1);}
    f32x16 c0,c1;
    s16x4 vlo[8],vhi[8];
    u32x4 pwa[4];
    float sacc=0.f;
    const lds_cptr vp_=vp0+sv*VSLOT;
    const lds_cptr kbp=shm3+LDS_K+sk*KSLOT+hi*1024+r32*16;
    #define SB_() __builtin_amdgcn_sched_barrier(0)
    #define PINV(x) asm volatile("":"+v"(x))
    #define KF(g) (*(const __attribute__((address_space(3))) bf16x8*)(kbp+((g)>>1)*2048+((g)&1)*512))
    #define PFLAT(i) ((i)<16?p0[(i)&15]:p1[(i)&15])
    #define VRD_(i) do{ vlo[i]=vtr(vp_+(((i)>>2)*4096+((i)&3)*1024)); vhi[i]=vtr(vp_+(((i)>>2)*4096+((i)&3)*1024+512)); }while(0)
    #define FILL(i) do{ if(((i)&3)<2){VRD_(i);} \
        sacc+=(PFLAT(4*(i))+PFLAT(4*(i)+1))+(PFLAT(4*(i)+2)+PFLAT(4*(i)+3)); PINV(sacc); \
        pwa[(i)>>1][2*((i)&1)]=cvtpk_s(PFLAT(4*(i)),PFLAT(4*(i)+1)); pwa[(i)>>1][2*((i)&1)+1]=cvtpk_s(PFLAT(4*(i)+2),PFLAT(4*(i)+3)); PINV(pwa[(i)>>1]); }while(0)
    bf16x8 k0=KF(0),k1=KF(1),k2=KF(2),k3=KF(3);
    SB_();
    c0=__builtin_amdgcn_mfma_f32_32x32x16_bf16(k0,qr[0],negm,0,0,0); k0=KF(4);  FILL(0); SB_();
    c1=__builtin_amdgcn_mfma_f32_32x32x16_bf16(k1,qr[0],negm,0,0,0); k1=KF(5);  FILL(1); SB_();
    c0=__builtin_amdgcn_mfma_f32_32x32x16_bf16(k2,qr[1],c0,0,0,0);   k2=KF(6);  FILL(2); SB_();
    c1=__builtin_amdgcn_mfma_f32_32x32x16_bf16(k3,qr[1],c1,0,0,0);   k3=KF(7);  FILL(3); SB_();
    c0=__builtin_amdgcn_mfma_f32_32x32x16_bf16(k0,qr[2],c0,0,0,0);   k0=KF(8);  FILL(4); SB_();
    c1=__builtin_amdgcn_mfma_f32_32x32x16_bf16(k1,qr[2],c1,0,0,0);   k1=KF(9);  FILL(5); SB_();
    c0=__builtin_amdgcn_mfma_f32_32x32x16_bf16(k2,qr[3],c0,0,0,0);   k2=KF(10); FILL(6); SB_();
    c1=__builtin_amdgcn_mfma_f32_32x32x16_bf16(k3,qr[3],c1,0,0,0);   k3=KF(11); FILL(7); SB_();
    c0=__builtin_amdgcn_mfma_f32_32x32x16_bf16(k0,qr[4],c0,0,0,0);
    c1=__builtin_amdgcn_mfma_f32_32x32x16_bf16(k1,qr[4],c1,0,0,0);
    c0=__builtin_amdgcn_mfma_f32_32x32x16_bf16(k2,qr[5],c0,0,0,0);
    c1=__builtin_amdgcn_mfma_f32_32x32x16_bf16(k3,qr[5],c1,0,0,0);
    SB_();
    l_reg+=sacc;
    if(t>=NT-4)cmask(c0,c1,t-(NT-4),qrel,hi);
    #define VFRG(i) (bf16x8){vlo[i][0],vlo[i][1],vlo[i][2],vlo[i][3],vhi[i][0],vhi[i][1],vhi[i][2],vhi[i][3]}
    #define MX3_(a,b,c) __builtin_fmaxf(__builtin_fmaxf((a),(b)),(c))
    #define EXN(X,B,N) do{ _Pragma("unroll") for(int e_=0;e_<(N);++e_) X[(B)+e_]=__builtin_amdgcn_exp2f(X[(B)+e_]); PINV(X); SB_(); }while(0)
    float ma,mb;
    o[0]=__builtin_amdgcn_mfma_f32_32x32x16_bf16(__builtin_bit_cast(bf16x8,pwa[0]),VFRG(0),o[0],0,0,0);
    ma=MX3_(c0[0],c0[1],c1[0]); mb=MX3_(c0[2],c0[3],c1[1]); ma=MX3_(ma,c1[2],c1[3]);
    ma=MX3_(ma,c0[4],c0[5]); mb=MX3_(mb,c0[6],c0[7]); ma=MX3_(ma,c1[4],c1[5]); mb=MX3_(mb,c1[6],c1[7]); PINV(ma); PINV(mb); VRD_(2); VRD_(6); SB_();
    o[1]=__builtin_amdgcn_mfma_f32_32x32x16_bf16(__builtin_bit_cast(bf16x8,pwa[0]),VFRG(4),o[1],0,0,0);
    ma=MX3_(ma,c0[8],c0[9]); mb=MX3_(mb,c0[10],c0[11]); ma=MX3_(ma,c1[8],c1[9]); mb=MX3_(mb,c1[10],c1[11]);
    ma=MX3_(ma,c0[12],c0[13]); mb=MX3_(mb,c0[14],c0[15]); ma=MX3_(ma,c1[12],c1[13]); mb=MX3_(mb,c1[14],c1[15]);
    float rm=__builtin_fmaxf(ma,mb);
    { auto rr=__builtin_amdgcn_permlane32_swap(__float_as_uint(rm),__float_as_uint(rm),false,false); rm=__builtin_fmaxf(__uint_as_float(rr[0]),__uint_as_float(rr[1])); }
    PINV(rm); VRD_(3); VRD_(7); SB_();
    bool resc=false;
    if(__any(rm>(float)THRL)){ const float dl=__builtin_fmaxf(rm,0.f); mhat+=dl;
      #pragma unroll
      for(int r=0;r<16;++r){c0[r]-=dl;c1[r]-=dl;}
      #pragma unroll
      for(int r=0;r<16;++r)negm[r]=-mhat;
      const float f=__builtin_amdgcn_exp2f(-dl); l_reg*=f; if(hi==0)wsf[r32]=f; resc=true; }
    SB_();
    o[0]=__builtin_amdgcn_mfma_f32_32x32x16_bf16(__builtin_bit_cast(bf16x8,pwa[1]),VFRG(1),o[0],0,0,0); EXN(c0,0,5);
    o[1]=__builtin_amdgcn_mfma_f32_32x32x16_bf16(__builtin_bit_cast(bf16x8,pwa[1]),VFRG(5),o[1],0,0,0); EXN(c0,5,5);
    o[0]=__builtin_amdgcn_mfma_f32_32x32x16_bf16(__builtin_bit_cast(bf16x8,pwa[2]),VFRG(2),o[0],0,0,0); EXN(c0,10,6);
    o[1]=__builtin_amdgcn_mfma_f32_32x32x16_bf16(__builtin_bit_cast(bf16x8,pwa[2]),VFRG(6),o[1],0,0,0); EXN(c1,0,5);
    o[0]=__builtin_amdgcn_mfma_f32_32x32x16_bf16(__builtin_bit_cast(bf16x8,pwa[3]),VFRG(3),o[0],0,0,0); EXN(c1,5,5);
    o[1]=__builtin_amdgcn_mfma_f32_32x32x16_bf16(__builtin_bit_cast(bf16x8,pwa[3]),VFRG(7),o[1],0,0,0); EXN(c1,10,6);
    #undef MX3_
    #undef EXN
    p0=c0; p1=c1;
    #undef KF
    #undef FILL
    #undef VRD_
    if(resc){ asm volatile("s_waitcnt lgkmcnt(0)":::"memory");
      #pragma unroll
      for(int d_=0;d_<2;++d_)
        #pragma unroll
        for(int r=0;r<16;++r)o[d_][r]*=wsf[crow(r,hi)]; }
    sk=(sk==2)?0:sk+1; sv=(sv==2)?0:sv+1;
  }
  MLA_WAIT_BAR(0);
  { s16x4 vlo[8],vhi[8]; const lds_cptr vp_=vp0+sv*VSLOT;
    #pragma unroll
    for(int i=0;i<8;++i){ vlo[i]=vtr(vp_+((i>>2)*4096+(i&3)*1024)); vhi[i]=vtr(vp_+((i>>2)*4096+(i&3)*1024+512)); }
    float sacc=0.f;
    #pragma unroll
    for(int r=0;r<16;++r)sacc+=p0[r]+p1[r];
    l_reg+=sacc;
    u32x4 pw0,pw1,pw2,pw3;
    pw0=(u32x4){cvtpk_s(p0[0],p0[1]),cvtpk_s(p0[2],p0[3]),cvtpk_s(p0[4],p0[5]),cvtpk_s(p0[6],p0[7])};
    pw1=(u32x4){cvtpk_s(p0[8],p0[9]),cvtpk_s(p0[10],p0[11]),cvtpk_s(p0[12],p0[13]),cvtpk_s(p0[14],p0[15])};
    pw2=(u32x4){cvtpk_s(p1[0],p1[1]),cvtpk_s(p1[2],p1[3]),cvtpk_s(p1[4],p1[5]),cvtpk_s(p1[6],p1[7])};
    pw3=(u32x4){cvtpk_s(p1[8],p1[9]),cvtpk_s(p1[10],p1[11]),cvtpk_s(p1[12],p1[13]),cvtpk_s(p1[14],p1[15])};
    o[0]=__builtin_amdgcn_mfma_f32_32x32x16_bf16(__builtin_bit_cast(bf16x8,pw0),VFRG(0),o[0],0,0,0);
    o[1]=__builtin_amdgcn_mfma_f32_32x32x16_bf16(__builtin_bit_cast(bf16x8,pw0),VFRG(4),o[1],0,0,0);
    o[0]=__builtin_amdgcn_mfma_f32_32x32x16_bf16(__builtin_bit_cast(bf16x8,pw1),VFRG(1),o[0],0,0,0);
    o[1]=__builtin_amdgcn_mfma_f32_32x32x16_bf16(__builtin_bit_cast(bf16x8,pw1),VFRG(5),o[1],0,0,0);
    o[0]=__builtin_amdgcn_mfma_f32_32x32x16_bf16(__builtin_bit_cast(bf16x8,pw2),VFRG(2),o[0],0,0,0);
    o[1]=__builtin_amdgcn_mfma_f32_32x32x16_bf16(__builtin_bit_cast(bf16x8,pw2),VFRG(6),o[1],0,0,0);
    o[0]=__builtin_amdgcn_mfma_f32_32x32x16_bf16(__builtin_bit_cast(bf16x8,pw3),VFRG(3),o[0],0,0,0);
    o[1]=__builtin_amdgcn_mfma_f32_32x32x16_bf16(__builtin_bit_cast(bf16x8,pw3),VFRG(7),o[1],0,0,0);
    #undef VFRG
  }
  {auto rr=__builtin_amdgcn_permlane32_swap(__float_as_uint(l_reg),__float_as_uint(l_reg),false,false);l_reg=__uint_as_float(rr[0])+__uint_as_float(rr[1]);}
  if(hi==0)wsf[32+r32]=l_reg;asm volatile("s_waitcnt lgkmcnt(0)":::"memory");
  float rli[16];
  #pragma unroll
  for(int r=0;r<16;++r)rli[r]=__builtin_amdgcn_rcpf(wsf[32+crow(r,hi)]);
  unsigned short*Ow=O+(rowbase+q0+wid*QBLK)*OPITCH+h*64;
  { unsigned short*stg=(unsigned short*)(shm+LDS_OST)+wid*2048;
    #pragma unroll
    for(int r=0;r<16;++r){const int orow=crow(r,hi);
      #pragma unroll
      for(int d0=0;d0<2;++d0)stg[orow*64+d0*32+r32]=(unsigned short)(cvtpk_s(o[d0][r]*rli[r],0.f)&0xffffu);}
    asm volatile("s_waitcnt lgkmcnt(0)":::"memory");
    #pragma unroll
    for(int i=0;i<4;++i){const int row=i*8+(lane>>3),ch=lane&7; const u32x4 v=*(const u32x4*)(stg+row*64+ch*8); *(u32x4*)(Ow+(long)row*OPITCH+ch*8)=v;} }
  asm volatile("s_waitcnt lgkmcnt(0)\n\ts_barrier":::"memory");
  #undef DMA_K2
  #undef DMA_V2
  #undef PFLAT
  #undef SB_
  #undef PINV
}
}


namespace hg {
typedef float f32x4 __attribute__((ext_vector_type(4)));
typedef short bf16x8 __attribute__((ext_vector_type(8)));
typedef unsigned u32x4 __attribute__((ext_vector_type(4)));
typedef unsigned u32x2 __attribute__((ext_vector_type(2)));
#define HLAS __attribute__((address_space(3)))
constexpr int NSEG = 8, CPS = 64 / NSEG;
constexpr int L_Q = 0, L_F = 16384, L_V = 32768, L_K1T = 49152, L_VT = 67584, L_A = 86016, L_ST = 95232, L_TOT = L_A, L_END = 130048;
constexpr int L_CM = 132096, L_CL = 132608;
constexpr int P144 = 144, P272 = 272;
__device__ __forceinline__ float bf2f_(unsigned short b) { return __uint_as_float((unsigned)b << 16); }
__device__ __forceinline__ unsigned f2bf_(float f) { unsigned u = __float_as_uint(f); return (u + 0x7fffu + ((u >> 16) & 1u)) >> 16; }
__device__ __forceinline__ unsigned pk_(float lo, float hi) { return f2bf_(lo) | (f2bf_(hi) << 16); }
__device__ __forceinline__ int swz(int t, int c) { return t * 256 + ((c ^ (t & 15)) << 4); }
__device__ __forceinline__ int swz_e(int t, int k) { return swz(t, k >> 3) + (k & 7) * 2; }
#define HG_BAR() do { asm volatile("s_waitcnt lgkmcnt(0)" ::: "memory"); __builtin_amdgcn_s_barrier(); asm volatile("" ::: "memory"); } while (0)
#define HG_MFMA(a, b, c) __builtin_amdgcn_mfma_f32_16x16x32_bf16((a), (b), (c), 0, 0, 0)

struct P1Args { const unsigned short* HP; const float* lbp; unsigned short* OL; unsigned short* Q1G; float* WN; float* SS; float* DSEG; };
__device__ __forceinline__ void hg_pass1(HLAS unsigned char* L, const P1Args& a, int G) {
    const int tid = threadIdx.x, lane = tid & 63, w = __builtin_amdgcn_readfirstlane(tid >> 6), r16 = lane & 15, g4 = lane >> 4;
    const int k = tid & 127, tq = tid >> 7;
    for (int u = blockIdx.x; u < 32 * NSEG; u += G) {
        const int bh = u / NSEG, seg = u % NSEG, b = bh >> 3, h = bh & 7;
        const size_t rowseg = (size_t)b * 4096 + (size_t)seg * CPS * 64;
        const float lb = 1.0f / (1.0f + __expf(-(a.lbp[1024 + h * 128 + k] - a.lbp[h * 128 + k])));
        f32x4 S[8];
#pragma unroll
        for (int j = 0; j < 8; ++j) S[j] = (f32x4){0.f, 0.f, 0.f, 0.f};
        float carry = 0.f;
        u32x4 pq[2], pf[2], pv[2];
#define HG_PREFETCH(n_) do { _Pragma("unroll") for (int j = 0; j < 2; ++j) { const int e = tid + 512 * j, t = e >> 4, c = e & 15; \
            const unsigned short* src = a.HP + (rowseg + (size_t)(n_) * 64 + t) * 4096 + h * 128 + 8 * c; \
            pq[j] = *(const u32x4*)src; pf[j] = *(const u32x4*)(src + 1024); pv[j] = *(const u32x4*)(src + 2048); } } while (0)
        HG_PREFETCH(0);
        for (int n = 0; n < CPS; ++n) {
            const size_t row0 = rowseg + (size_t)n * 64;
            HG_BAR();
#pragma unroll
            for (int j = 0; j < 2; ++j) { const int e = tid + 512 * j, t = e >> 4, c = e & 15; const int o = swz(t, c);
                *(HLAS u32x4*)(L + L_Q + o) = pq[j]; *(HLAS u32x4*)(L + L_F + o) = pf[j]; *(HLAS u32x4*)(L + L_V + o) = pv[j]; }
            if (n + 1 < CPS) HG_PREFETCH(n + 1);
            HG_BAR();
            float fv[16], cs[16];
            { float run = 0.f;
#pragma unroll
              for (int i = 0; i < 16; ++i) { const int t = 16 * tq + i; const float x = bf2f_(*(const HLAS unsigned short*)(L + L_F + swz_e(t, k)));
                  const float f = lb + (1.0f - lb) * __builtin_amdgcn_rcpf(1.0f + __expf(-x)); fv[i] = f; run += __logf(f); cs[i] = run; }
              *(HLAS float*)(L + L_TOT + (tq * 128 + k) * 4) = run; }
            HG_BAR();
            { const float t0 = *(const HLAS float*)(L + L_TOT + (0 * 128 + k) * 4), t1 = *(const HLAS float*)(L + L_TOT + (1 * 128 + k) * 4), t2 = *(const HLAS float*)(L + L_TOT + (2 * 128 + k) * 4), t3 = *(const HLAS float*)(L + L_TOT + (3 * 128 + k) * 4);
              const float pre = (tq == 0) ? 0.f : (tq == 1) ? t0 : (tq == 2) ? (t0 + t1) : ((t0 + t1) + t2);
              const float bmid = t0 + t1, blast = (t0 + t1) + (t2 + t3);
              unsigned kt[8], vt[8];
#pragma unroll
              for (int i = 0; i < 16; i += 2) {
                  float q1[2], k1[2];
#pragma unroll
                  for (int d = 0; d < 2; ++d) { const int t = 16 * tq + i + d; const float r = (pre + cs[i + d]) - bmid; const float E1 = __expf(r), iE1 = __builtin_amdgcn_rcpf(E1);
                      const float qs = bf2f_(*(const HLAS unsigned short*)(L + L_Q + swz_e(t, k))) * 0.08838834764831845f;
                      q1[d] = qs * E1; k1[d] = (1.0f - fv[i + d]) * iE1;
                      *(HLAS unsigned short*)(L + L_Q + swz_e(t, k)) = (unsigned short)f2bf_(q1[d]); *(HLAS unsigned short*)(L + L_F + swz_e(t, k)) = (unsigned short)f2bf_(k1[d]); }
                  kt[i >> 1] = pk_(k1[0], k1[1]);
                  vt[i >> 1] = (unsigned)*(const HLAS unsigned short*)(L + L_V + swz_e(16 * tq + i, k)) | ((unsigned)*(const HLAS unsigned short*)(L + L_V + swz_e(16 * tq + i + 1, k)) << 16); }
              *(HLAS u32x4*)(L + L_K1T + k * P144 + tq * 32) = (u32x4){kt[0], kt[1], kt[2], kt[3]}; *(HLAS u32x4*)(L + L_K1T + k * P144 + tq * 32 + 16) = (u32x4){kt[4], kt[5], kt[6], kt[7]};
              *(HLAS u32x4*)(L + L_VT + k * P144 + tq * 32) = (u32x4){vt[0], vt[1], vt[2], vt[3]}; *(HLAS u32x4*)(L + L_VT + k * P144 + tq * 32 + 16) = (u32x4){vt[4], vt[5], vt[6], vt[7]};
              if (tq == 0) { *(HLAS float*)(L + L_CM + k * 4) = __expf(bmid); *(HLAS float*)(L + L_CL + k * 4) = __expf(blast - bmid);
                  a.WN[((size_t)u * CPS + n) * 128 + k] = __expf(bmid + carry); }
              carry += blast; }
            HG_BAR();
            f32x4 cmv, clv;
#pragma unroll
            for (int i = 0; i < 4; ++i) { cmv[i] = *(const HLAS float*)(L + L_CM + (16 * w + 4 * g4 + i) * 4); clv[i] = *(const HLAS float*)(L + L_CL + (16 * w + 4 * g4 + i) * 4); }
#pragma unroll
            for (int j = 0; j < 8; ++j) { S[j] = S[j] * cmv; *(HLAS u32x2*)(L + L_ST + (16 * j + r16) * P272 + (16 * w + 4 * g4) * 2) = (u32x2){pk_(S[j][0], S[j][1]), pk_(S[j][2], S[j][3])}; }
            { const int ct = w >> 1;
#pragma unroll
              for (int q = 0; q < 2; ++q) { const int st = 2 * (w & 1) + q; f32x4 d = (f32x4){0.f, 0.f, 0.f, 0.f};
                  if (st <= ct) {
#pragma unroll
                      for (int ks = 0; ks < 4; ++ks) { const bf16x8 af = *(const HLAS bf16x8*)(L + L_F + swz(16 * st + r16, 4 * ks + g4)), bf = *(const HLAS bf16x8*)(L + L_Q + swz(16 * ct + r16, 4 * ks + g4)); d = HG_MFMA(af, bf, d); }
                      if (st == ct) {
#pragma unroll
                          for (int i = 0; i < 4; ++i) if (4 * g4 + i > r16) d[i] = 0.f; } }
                  *(HLAS u32x2*)(L + L_A + (16 * ct + r16) * P144 + (16 * st + 4 * g4) * 2) = (u32x2){pk_(d[0], d[1]), pk_(d[2], d[3])}; } }
#pragma unroll
            for (int j = 0; j < 2; ++j) { const int e = tid + 512 * j, t = e >> 4, c = e & 15; *(u32x4*)(a.Q1G + (row0 + t) * 1024 + h * 128 + 8 * c) = *(const HLAS u32x4*)(L + L_Q + swz(t, c)); }
            HG_BAR();
#pragma unroll
            for (int ct = 0; ct < 4; ++ct) { f32x4 d = (f32x4){0.f, 0.f, 0.f, 0.f};
#pragma unroll
                for (int ks = 0; ks < 2; ++ks) { if (ks == 1 && ct < 2) continue;
                    const bf16x8 af = *(const HLAS bf16x8*)(L + L_VT + (16 * w + r16) * P144 + (32 * ks + 8 * g4) * 2), bf = *(const HLAS bf16x8*)(L + L_A + (16 * ct + r16) * P144 + (32 * ks + 8 * g4) * 2); d = HG_MFMA(af, bf, d); }
#pragma unroll
                for (int ks = 0; ks < 4; ++ks) { const bf16x8 af = *(const HLAS bf16x8*)(L + L_ST + (16 * w + r16) * P272 + (32 * ks + 8 * g4) * 2), bf = *(const HLAS bf16x8*)(L + L_Q + swz(16 * ct + r16, 4 * ks + g4)); d = HG_MFMA(af, bf, d); }
                *(u32x2*)(a.OL + (row0 + 16 * ct + r16) * 1024 + h * 128 + 16 * w + 4 * g4) = (u32x2){pk_(d[0], d[1]), pk_(d[2], d[3])}; }
#pragma unroll
            for (int j = 0; j < 8; ++j) {
#pragma unroll
                for (int ks = 0; ks < 2; ++ks) { const bf16x8 af = *(const HLAS bf16x8*)(L + L_K1T + (16 * w + r16) * P144 + (32 * ks + 8 * g4) * 2), bf = *(const HLAS bf16x8*)(L + L_VT + (16 * j + r16) * P144 + (32 * ks + 8 * g4) * 2); S[j] = HG_MFMA(af, bf, S[j]); }
                S[j] = S[j] * clv; }
        }
#pragma unroll
        for (int j = 0; j < 8; ++j) *(f32x4*)(a.SS + ((size_t)u * 128 + 16 * j + r16) * 128 + 16 * w + 4 * g4) = S[j];
        if (tq == 0) a.DSEG[(size_t)u * 128 + k] = __expf(carry);
#undef HG_PREFETCH
    }
    HG_BAR();
}

struct P2Args { const unsigned short* HP; const unsigned short* OL; const unsigned short* Q1G; const float* WN; const float* SS; const float* DSEG; const float* gout; unsigned short* HON; };
__device__ __forceinline__ void hg_pass2(HLAS unsigned char* L, const P2Args& a, int G) {
    const int tid = threadIdx.x, lane = tid & 63, w = __builtin_amdgcn_readfirstlane(tid >> 6), r16 = lane & 15, g4 = lane >> 4;
    HLAS float* SSQ = (HLAS float*)(L + L_TOT);
    f32x4 gn;
#pragma unroll
    for (int i = 0; i < 4; ++i) gn[i] = a.gout[16 * w + 4 * g4 + i];
    for (int u = blockIdx.x; u < 32 * NSEG; u += G) {
        const int bh = u / NSEG, seg = u % NSEG, b = bh >> 3, h = bh & 7;
        const size_t rowseg = (size_t)b * 4096 + (size_t)seg * CPS * 64;
        const size_t colw = (size_t)h * 128 + 16 * w + 4 * g4;
        u32x2 pol[4], pg[4]; u32x4 pq[2]; f32x4 pwn = (f32x4){0.f, 0.f, 0.f, 0.f};
#define HG2_PREFETCH(n_) do { const size_t r0_ = rowseg + (size_t)(n_) * 64; \
            _Pragma("unroll") for (int ct = 0; ct < 4; ++ct) { const size_t row = r0_ + 16 * ct + r16; pol[ct] = *(const u32x2*)(a.OL + row * 1024 + colw); pg[ct] = *(const u32x2*)(a.HP + row * 4096 + 3072 + colw); } \
            if (seg > 0) { _Pragma("unroll") for (int j = 0; j < 2; ++j) { const int e = tid + 512 * j, t = e >> 4, c = e & 15; pq[j] = *(const u32x4*)(a.Q1G + (r0_ + t) * 1024 + h * 128 + 8 * c); } \
                           pwn = *(const f32x4*)(a.WN + ((size_t)u * CPS + (n_)) * 128 + 16 * w + 4 * g4); } } while (0)
        HG2_PREFETCH(0);
        f32x4 Sin[8];
#pragma unroll
        for (int j = 0; j < 8; ++j) Sin[j] = (f32x4){0.f, 0.f, 0.f, 0.f};
        for (int i = 0; i < seg; ++i) { const size_t ui = (size_t)bh * NSEG + i; const f32x4 dv = *(const f32x4*)(a.DSEG + ui * 128 + 16 * w + 4 * g4);
#pragma unroll
            for (int j = 0; j < 8; ++j) Sin[j] = Sin[j] * dv + *(const f32x4*)(a.SS + (ui * 128 + 16 * j + r16) * 128 + 16 * w + 4 * g4); }
        for (int n = 0; n < CPS; ++n) {
            const size_t row0 = rowseg + (size_t)n * 64;
            HG_BAR();
            u32x2 ol[4], gg[4];
#pragma unroll
            for (int ct = 0; ct < 4; ++ct) { ol[ct] = pol[ct]; gg[ct] = pg[ct]; }
            if (seg > 0) {
#pragma unroll
                for (int j = 0; j < 8; ++j) { const f32x4 t = Sin[j] * pwn; *(HLAS u32x2*)(L + L_ST + (16 * j + r16) * P272 + (16 * w + 4 * g4) * 2) = (u32x2){pk_(t[0], t[1]), pk_(t[2], t[3])}; }
#pragma unroll
                for (int j = 0; j < 2; ++j) { const int e = tid + 512 * j, t = e >> 4, c = e & 15; *(HLAS u32x4*)(L + L_Q + swz(t, c)) = pq[j]; } }
            if (n + 1 < CPS) HG2_PREFETCH(n + 1);
            HG_BAR();
            f32x4 o[4];
#pragma unroll
            for (int ct = 0; ct < 4; ++ct) {
                f32x4 d = (f32x4){bf2f_((unsigned short)(ol[ct].x & 0xffffu)), bf2f_((unsigned short)(ol[ct].x >> 16)), bf2f_((unsigned short)(ol[ct].y & 0xffffu)), bf2f_((unsigned short)(ol[ct].y >> 16))};
                if (seg > 0) {
#pragma unroll
                    for (int ks = 0; ks < 4; ++ks) { const bf16x8 af = *(const HLAS bf16x8*)(L + L_ST + (16 * w + r16) * P272 + (32 * ks + 8 * g4) * 2), bf = *(const HLAS bf16x8*)(L + L_Q + swz(16 * ct + r16, 4 * ks + g4)); d = HG_MFMA(af, bf, d); } }
                o[ct] = d;
                float p = (d[0] * d[0] + d[1] * d[1]) + (d[2] * d[2] + d[3] * d[3]); p += __shfl_xor(p, 16); p += __shfl_xor(p, 32);
                if (g4 == 0) SSQ[w * 64 + 16 * ct + r16] = p; }
            HG_BAR();
#pragma unroll
            for (int ct = 0; ct < 4; ++ct) { float tot = 0.f;
#pragma unroll
                for (int ww = 0; ww < 8; ++ww) tot += SSQ[ww * 64 + 16 * ct + r16];
                const float rs = 1.0f / sqrtf(tot * (1.0f / 128.0f) + 1e-6f);
                const size_t row = row0 + 16 * ct + r16;
                const float g0 = bf2f_((unsigned short)(gg[ct].x & 0xffffu)), g1 = bf2f_((unsigned short)(gg[ct].x >> 16)), g2 = bf2f_((unsigned short)(gg[ct].y & 0xffffu)), g3 = bf2f_((unsigned short)(gg[ct].y >> 16));
                const float s0 = g0 * __builtin_amdgcn_rcpf(1.0f + __expf(-g0)), s1 = g1 * __builtin_amdgcn_rcpf(1.0f + __expf(-g1)), s2 = g2 * __builtin_amdgcn_rcpf(1.0f + __expf(-g2)), s3 = g3 * __builtin_amdgcn_rcpf(1.0f + __expf(-g3));
                *(u32x2*)(a.HON + row * 1024 + colw) = (u32x2){pk_(o[ct][0] * rs * gn[0] * s0, o[ct][1] * rs * gn[1] * s1), pk_(o[ct][2] * rs * gn[2] * s2, o[ct][3] * rs * gn[3] * s3)}; }
        }
#undef HG2_PREFETCH
    }
    HG_BAR();
}
}

struct MoeSplitOrder {
    volatile LAS int* mt; int nN, G, c, nitems, kbytes;
    __device__ __forceinline__ void init(volatile LAS int* mt_, int nN_, int G_, int c_, int kbytes_) { mt = mt_; nN = nN_; G = G_; c = c_; kbytes = kbytes_; const int T = mt_[8]; nitems = (T > 128 ? T - 128 : 0) * nN_ * 7; }
    __device__ __forceinline__ bool next(int i, pg8::Unit& u) const {
        const int Lx = i * G + c; if (Lx >= nitems) return false;
        const int ks = Lx % 7, r = Lx / 7, pnl = r % nN, tile = 128 + r / nN;
        int e = 0;
#pragma unroll
        for (int j = 1; j < 8; ++j) e += (tile >= mt[j]) ? 1 : 0;
        u.pm = tile; u.pn = e * nN + pnl; u.kb = ks * kbytes; return true;
    }
    __device__ __forceinline__ void a_ready(const pg8::Unit&) const {}
    __device__ __forceinline__ void done(const pg8::Unit&) const {}
    __device__ __forceinline__ int arow(const pg8::Unit&, int) const { return 0; }
    __device__ __forceinline__ void issue_rows(const pg8::Unit&, int, int, int) const {}
    __device__ __forceinline__ int arow_lds(int, int) const { return 0; }
};

struct Args { const float* in[22]; const int* pos; float* out; unsigned char* ws; int ph_lo, ph_hi, li, pad; };

__global__ void __launch_bounds__(NWAVES * 64, 2) fwd_kernel(Args args) {
    extern __shared__ __attribute__((aligned(16))) unsigned char lds[];
    LAS unsigned char* L = (LAS unsigned char*)lds;
    volatile LAS unsigned* MISC = (volatile LAS unsigned*)(L + MISC_OFF);
    const int tid = threadIdx.x, lane = tid & 63, wave = __builtin_amdgcn_readfirstlane(tid >> 6);
    const int G = gridDim.x;
    const int gw = blockIdx.x * NWAVES + wave, NGW = G * NWAVES;
    unsigned char* ws = args.ws;
    gu32* ctl = (gu32*)(ws + WS_CTL);
    for (int u = tid; u < (LDS_BYTES - LDSCTL_OFF) / 4; u += NWAVES * 64) ((LAS unsigned*)(L + LDSCTL_OFF))[u] = 0u;
    __syncthreads();
    XcdBarrier bar; bar.bar = (unsigned*)(ctl + CW_BAR); bar.x = 0; bar.st = nullptr;
    if (N_LAUNCHES == 1) bar = xcd_barrier_post((unsigned*)(ctl + CW_BAR) + args.li * XCD_BAR_WORDS, MISC + 8);
#define GRID_BAR() do { if (N_LAUNCHES == 1) xcd_barrier(bar); } while (0)
#if defined(DIAG_STAMP) || defined(AMP_A)
    unsigned long long* const ts_ = (unsigned long long*)(ws + WS_STAMP);
#define STAMP(k) do { if (blockIdx.x == 0 && tid == 0) ts_[(k)] = __builtin_amdgcn_s_memrealtime(); } while (0)
    STAMP(0);
#else
#define STAMP(k) do { } while (0)
#endif
    const int lo = args.ph_lo, hi = args.ph_hi;
#define IN(k) (lo <= (k) && (k) < hi)
#define BOTH(k) (IN(k) && IN((k) + 1))
    const float* x = args.in[0];
    bf16* H = (bf16*)args.out; constexpr int HPITCH = 2048;

    if (IN(0)) {
        LAS float* scr = (LAS float*)(L + RING_OFF + wave * 16384);
        constexpr int I_MOE = (1024 / 64) * (3584 / 32);
        constexpr int NITEMS = 16 * 21 + 6 * 48 + 4 * 64 + 16 * 32 + 2 * 1792 + 1792 + 16 * 128 + 16 * 32 + 24 * I_MOE;
        auto job_of = [&](int it) -> TrJob {
            int r = it; TrJob j;
            if (r < 8 * I_MOE) { const int e = r / I_MOE; j = TrJob{args.in[19] + (size_t)e * 1024 * 3584, (bf16*)(ws + WS_WMGU + (size_t)e * 7168 * 1024), 1024, 3584, 1 | 32, r % I_MOE}; return j; } r -= 8 * I_MOE;
            if (r < 8 * I_MOE) { const int e = r / I_MOE; j = TrJob{args.in[20] + (size_t)e * 1024 * 3584, (bf16*)(ws + WS_WMGU + (size_t)e * 7168 * 1024), 1024, 3584, 2 | 32, r % I_MOE}; return j; } r -= 8 * I_MOE;
            if (r < 8 * I_MOE) { const int e = r / I_MOE; j = TrJob{args.in[21] + (size_t)e * 3584 * 1024, (bf16*)(ws + WS_WMDN + (size_t)e * 1024 * 3584), 3584, 1024, 0 | 32, r % I_MOE}; return j; } r -= 8 * I_MOE;
#define JOB(W, K_, N_, WT, mode) { const int ni = ((K_) / 64) * ((N_) / 32); if (r < ni) { j = TrJob{(W), (bf16*)(ws + (WT)), (K_), (N_), (mode), r}; return j; } r -= ni; }
            JOB(args.in[5], 1024, 672, WS_WMLAIN, 0)
            JOB(args.in[7], 384, 1536, WS_WQUP, 0)
            JOB(args.in[9], 256, 2048, WS_WKVUP, 0)
            JOB(args.in[10], 1024, 1024, WS_WO0, 0)
            JOB(args.in[15], 1024, 3584, WS_WFGU, 1)
            JOB(args.in[16], 1024, 3584, WS_WFGU, 2)
            JOB(args.in[17], 3584, 1024, WS_WFDN, 0)
            JOB(args.in[11], 1024, 4096, WS_WHIN, 0)
#undef JOB
            j = TrJob{args.in[14], (bf16*)(ws + WS_WHO), 1024, 1024, 0, r}; return j; };
        if (gw < NITEMS) {
            TrJob jc = job_of(gw); float vc[32]; tr_load(jc, vc, lane);
            for (int it = gw; it < NITEMS; it += NGW) {
                const bool hn = it + NGW < NITEMS; TrJob jn = jc; float vn[32];
                if (hn) { jn = job_of(it + NGW); tr_load(jn, vn, lane); }
                tr_finish(jc, vc, scr, lane);
                if (hn) { jc = jn;
#pragma unroll
                    for (int i = 0; i < 32; ++i) vc[i] = vn[i]; }
            }
        }
        { v4u* z = (v4u*)((bf16*)(ws + WS_WMLAIN) + (size_t)MLA_IN * 1024); const int n16 = (MLA_INP - MLA_IN) * 1024 * 2 / 16;
          for (int i = blockIdx.x * NWAVES * 64 + tid; i < n16; i += G * NWAVES * 64) z[i] = (v4u){0u, 0u, 0u, 0u}; }
        rms_rows_to_bf16(x, args.in[2], (bf16*)(ws + WS_HN), gw, NGW, M, lane);
        if (BOTH(0)) GRID_BAR(); STAMP(1);
    }
    if (IN(1)) {
        pg8::Gemm g{(const bf16*)(ws + WS_HN), (const bf16*)(ws + WS_WMLAIN), M, MLA_INP, 1024, 1024, 0, 0}; pg8::StaticOrder S; S.init(M, MLA_INP, G, (int)blockIdx.x);
        pg8::EpiStoreBf16 E{(bf16*)(ws + WS_PROJ), MLA_INP, MLA_INP / 256};
        pg8::gemm_phase<pg8::EpiStoreBf16, pg8::StaticOrder, true, false>(L + RING_OFF, g, S, E);
        if (BOTH(1)) GRID_BAR(); STAMP(2);
    }
    if (IN(2)) {
        const bf16* P = (const bf16*)(ws + WS_PROJ);
        for (int m = gw; m < M; m += NGW) {
            const bf16* pr = P + (size_t)m * MLA_INP;
            float cq[6]; float s = 0.f;
#pragma unroll
            for (int j = 0; j < 6; ++j) { cq[j] = bf2f(pr[j * 64 + lane]); s += cq[j] * cq[j]; }
            const float rq = 1.f / sqrtf(wave_sum(s) * (1.f / QL) + EPS);
            bf16* oq = (bf16*)(ws + WS_CQN) + (size_t)m * QL;
#pragma unroll
            for (int j = 0; j < 6; ++j) oq[j * 64 + lane] = (bf16)f2bf(cq[j] * rq * args.in[6][j * 64 + lane]);
            float ck[4]; s = 0.f;
#pragma unroll
            for (int j = 0; j < 4; ++j) { ck[j] = bf2f(pr[QL + j * 64 + lane]); s += ck[j] * ck[j]; }
            const float rk = 1.f / sqrtf(wave_sum(s) * (1.f / KVL) + EPS);
            bf16* ok = (bf16*)(ws + WS_CKVN) + (size_t)m * KVL;
#pragma unroll
            for (int j = 0; j < 4; ++j) ok[j * 64 + lane] = (bf16)f2bf(ck[j] * rk * args.in[8][j * 64 + lane]);
            if (lane < 16) {
                const float invf = exp2f(-(float)lane * (13.287712379549449f / 16.0f));
                const float ang = (float)args.pos[m] * invf;
                const double rev = (double)ang * 0.15915494309189535; const float fr = (float)(rev - rint(rev));
                const float sn = __builtin_amdgcn_sinf(fr), cs = __builtin_amdgcn_cosf(fr);
                ((float*)(ws + WS_COS))[(size_t)m * 16 + lane] = cs; ((float*)(ws + WS_SIN))[(size_t)m * 16 + lane] = sn;
                const float x1 = bf2f(pr[QL + KVL + lane]), x2 = bf2f(pr[QL + KVL + 16 + lane]);
                bf16* okr = (bf16*)(ws + WS_KR) + (size_t)m * 32;
                okr[lane] = (bf16)f2bf(x1 * cs - x2 * sn); okr[16 + lane] = (bf16)f2bf(x2 * cs + x1 * sn);
            }
        }
        if (BOTH(2)) GRID_BAR(); STAMP(3);
    }
    if (IN(3)) {
        { pg8::Gemm g{(const bf16*)(ws + WS_CQN), (const bf16*)(ws + WS_WQUP), M, QW, QL, QL, 0, 0}; pg8::StaticOrder S; S.init(M, QW, G, (int)blockIdx.x);
          pg8::EpiStoreBf16 E{(bf16*)(ws + WS_Q), QW, QW / 256};
          pg8::gemm_phase<pg8::EpiStoreBf16, pg8::StaticOrder, true, false>(L + RING_OFF, g, S, E); }
        { pg8::Gemm g{(const bf16*)(ws + WS_CKVN), (const bf16*)(ws + WS_WKVUP), M, KVW, KVL, KVL, 0, 0}; pg8::StaticOrder S; S.init(M, KVW, G, (int)blockIdx.x);
          pg8::EpiStoreBf16 E{(bf16*)(ws + WS_KV), KVW, KVW / 256};
          pg8::gemm_phase<pg8::EpiStoreBf16, pg8::StaticOrder, true, false>(L + RING_OFF, g, S, E); }
        if (BOTH(3)) GRID_BAR(); STAMP(4);
    }
    if (IN(4)) {
        const int vcu = (G % 8 == 0) ? ((int)blockIdx.x % 8) * (G / 8) + (int)blockIdx.x / 8 : (int)blockIdx.x;
        for (int v = vcu; v < 256; v += G) {
            const int bh = v >> 2, s4 = v & 3;
#pragma unroll 1
            for (int i = 0; i < 4; ++i) { const int qb = (i == 0) ? s4 : (i == 1) ? 7 - s4 : (i == 2) ? 8 + s4 : 15 - s4;
                mla_attn::attn_unit2<8>(bh >> 4, bh & 15, qb, (const bf16*)(ws + WS_Q), (const bf16*)(ws + WS_KV), (const bf16*)(ws + WS_KR), (const float*)(ws + WS_COS), (const float*)(ws + WS_SIN), (bf16*)(ws + WS_O), (char*)lds + RING_OFF); }
        }
        if (BOTH(4)) GRID_BAR(); STAMP(5);
    }
    if (IN(5)) {
        pg8::Gemm g{(const bf16*)(ws + WS_O), (const bf16*)(ws + WS_WO0), M, D, D, D, 0, 0}; pg8::StaticOrder S; S.init(M, D, G, (int)blockIdx.x);
        pg8::EpiRes<true> E{x, H, D, HPITCH, D / 256};
        pg8::gemm_phase<pg8::EpiRes<true>, pg8::StaticOrder, true, false>(L + RING_OFF, g, S, E);
        if (BOTH(5)) GRID_BAR(); STAMP(6);
    }
    if (IN(6)) {
        rms_rows_bf16in(H, HPITCH, args.in[3], (bf16*)(ws + WS_HN), gw, NGW, M, lane);
        if (BOTH(6)) GRID_BAR(); STAMP(7);
    }
    if (IN(7)) {
        pg8::Gemm g{(const bf16*)(ws + WS_HN), (const bf16*)(ws + WS_WFGU), M, 2 * FF, D, D, 0, 0}; pg8::StaticOrder S; S.init(M, 2 * FF, G, (int)blockIdx.x);
        pg8::EpiSwiGLU E{(bf16*)(ws + WS_FACT), FF, 2 * FF / 256, false};
        pg8::gemm_phase<pg8::EpiSwiGLU, pg8::StaticOrder, true, false>(L + RING_OFF, g, S, E);
        if (BOTH(7)) GRID_BAR(); STAMP(8);
    }
    if (IN(8)) {
        pg8::Gemm g{(const bf16*)(ws + WS_FACT), (const bf16*)(ws + WS_WFDN), M, D, FF, FF, 0, 0}; pg8::StaticOrder S; S.init(M, D, G, (int)blockIdx.x);
        pg8::EpiRes<false> E{H, H, HPITCH, HPITCH, D / 256};
        pg8::gemm_phase<pg8::EpiRes<false>, pg8::StaticOrder, true, false>(L + RING_OFF, g, S, E);
        if (BOTH(8)) GRID_BAR(); STAMP(9);
    }
    if (IN(9)) {
        rms_rows_bf16in(H, HPITCH, args.in[2] + D, (bf16*)(ws + WS_HN), gw, NGW, M, lane);
        if (BOTH(9)) GRID_BAR(); STAMP(10);
    }
    if (IN(10)) {
        pg8::Gemm g{(const bf16*)(ws + WS_HN), (const bf16*)(ws + WS_WHIN), M, HG_IN, D, D, 0, 0}; pg8::StaticOrder S; S.init(M, HG_IN, G, (int)blockIdx.x);
        pg8::EpiStoreBf16 E{(bf16*)(ws + WS_HPROJ), HG_IN, HG_IN / 256};
        pg8::gemm_phase<pg8::EpiStoreBf16, pg8::StaticOrder, true, false>(L + RING_OFF, g, S, E);
        if (BOTH(10)) GRID_BAR(); STAMP(11);
    }
    if (IN(11)) {
        hg::P1Args pa{(const bf16*)(ws + WS_HPROJ), args.in[12], (bf16*)(ws + WS_OL), (bf16*)(ws + WS_Q1G), (float*)(ws + WS_WN), (float*)(ws + WS_SS), (float*)(ws + WS_DSEG)};
        hg::hg_pass1(L, pa, G);
        if (BOTH(11)) GRID_BAR(); STAMP(12);
    }
    if (IN(12)) {
        hg::P2Args pa{(const bf16*)(ws + WS_HPROJ), (const bf16*)(ws + WS_OL), (const bf16*)(ws + WS_Q1G), (const float*)(ws + WS_WN), (const float*)(ws + WS_SS), (const float*)(ws + WS_DSEG), args.in[13], (bf16*)(ws + WS_HON)};
        hg::hg_pass2(L, pa, G);
        if (BOTH(12)) GRID_BAR(); STAMP(13);
    }
    if (IN(13)) {
        pg8::Gemm g{(const bf16*)(ws + WS_HON), (const bf16*)(ws + WS_WHO), M, D, D, D, 0, 0}; pg8::StaticOrder S; S.init(M, D, G, (int)blockIdx.x);
        pg8::EpiRes<false> E{H, H, HPITCH, HPITCH, D / 256};
        pg8::gemm_phase<pg8::EpiRes<false>, pg8::StaticOrder, true, false>(L + RING_OFF, g, S, E);
        if (BOTH(13)) GRID_BAR(); STAMP(14);
    }
    if (IN(14)) {
        const float* gn = args.in[3] + D; const float* RT = args.in[18];
        int* rowlist = (int*)(ws + WS_ROWLIST); v4u* tok = (v4u*)(ws + WS_TOK);
        LAS int* lcnt = (LAS int*)(L + RING_OFF); LAS int* gbase = lcnt + 8; LAS unsigned* rec = (LAS unsigned*)(L + RING_OFF + 64);
        const int niter = (M + NGW - 1) / NGW;
        f32x4 R0[16], R1[16];
#pragma unroll
        for (int j = 0; j < 4; ++j)
#pragma unroll
            for (int kk = 0; kk < 4; ++kk) { const int kx = 4 * (lane + 64 * j) + kk; R0[j * 4 + kk] = *(const f32x4*)(RT + (size_t)kx * 8); R1[j * 4 + kk] = *(const f32x4*)(RT + (size_t)kx * 8 + 4); }
        f32x4 gv[4];
#pragma unroll
        for (int j = 0; j < 4; ++j) gv[j] = ((const f32x4*)gn + lane)[64 * j];
        for (int it0 = 0; it0 < niter; it0 += 16) {
            if (tid < 8) lcnt[tid] = 0;
            __syncthreads();
            const int itn = (niter - it0) < 16 ? (niter - it0) : 16;
            v2u vn[4];
            { const int m0 = it0 * NGW + gw; const bf16* xr = H + (size_t)(m0 < M ? m0 : 0) * HPITCH;
#pragma unroll
              for (int j = 0; j < 4; ++j) vn[j] = *(const v2u*)(xr + 4 * (lane + 64 * j)); }
            for (int it = 0; it < itn; ++it) {
                const int m = (it0 + it) * NGW + gw;
                f32x4 v[4];
#pragma unroll
                for (int j = 0; j < 4; ++j) v[j] = (f32x4){__uint_as_float(vn[j].x << 16), __uint_as_float(vn[j].x & 0xffff0000u), __uint_as_float(vn[j].y << 16), __uint_as_float(vn[j].y & 0xffff0000u)};
                { const int mn = m + NGW; const bf16* xr = H + (size_t)((it + 1 < itn && mn < M) ? mn : 0) * HPITCH;
#pragma unroll
                  for (int j = 0; j < 4; ++j) vn[j] = *(const v2u*)(xr + 4 * (lane + 64 * j)); }
                if (m >= M) continue;
                float s = 0.f;
#pragma unroll
                for (int j = 0; j < 4; ++j) s += (v[j].x * v[j].x + v[j].y * v[j].y) + (v[j].z * v[j].z + v[j].w * v[j].w);
                const float rstd = 1.f / sqrtf(wave_sum(s) * (1.f / 1024.f) + EPS);
                f32x4 la = (f32x4){0.f, 0.f, 0.f, 0.f}, lb4 = (f32x4){0.f, 0.f, 0.f, 0.f};
                unsigned* o8 = (unsigned*)(ws + WS_HN3 + (size_t)m * D) + lane;
#pragma unroll
                for (int j = 0; j < 4; ++j) { const f32x4 t = (f32x4){v[j].x * rstd * gv[j].x, v[j].y * rstd * gv[j].y, v[j].z * rstd * gv[j].z, v[j].w * rstd * gv[j].w};
                    o8[64 * j] = pk_fp8x4(t.x, t.y, t.z, t.w, 16.f);
#pragma unroll
                    for (int kk = 0; kk < 4; ++kk) { la += t[kk] * R0[j * 4 + kk]; lb4 += t[kk] * R1[j * 4 + kk]; } }
                float l4[4], l2[2], l1;
                { const bool up = (lane & 1) != 0;
#pragma unroll
                  for (int e = 0; e < 4; ++e) { const float mine = up ? lb4[e] : la[e], give = up ? la[e] : lb4[e]; l4[e] = mine + __shfl_xor(give, 1); } }
                { const bool up = (lane & 2) != 0;
#pragma unroll
                  for (int e = 0; e < 2; ++e) { const float mine = up ? l4[2 + e] : l4[e], give = up ? l4[e] : l4[2 + e]; l2[e] = mine + __shfl_xor(give, 2); } }
                { const bool up = (lane & 4) != 0; const float mine = up ? l2[1] : l2[0], give = up ? l2[0] : l2[1]; l1 = mine + __shfl_xor(give, 4); }
                l1 += __shfl_xor(l1, 8); l1 += __shfl_xor(l1, 16); l1 += __shfl_xor(l1, 32);
                float lg[8];
#pragma unroll
                for (int e = 0; e < 8; ++e) { const int src = ((e >> 2) & 1) | (((e >> 1) & 1) << 1) | ((e & 1) << 2); lg[e] = __shfl(l1, src); }
                if (lane == 0) {
                    int e1 = 0; float v1 = lg[0];
#pragma unroll
                    for (int e = 1; e < 8; ++e) if (lg[e] > v1) { v1 = lg[e]; e1 = e; }
                    int e2 = (e1 == 0) ? 1 : 0; float v2 = lg[e2];
#pragma unroll
                    for (int e = 1; e < 8; ++e) if (e != e1 && lg[e] > v2) { v2 = lg[e]; e2 = e; }
                    const float w1 = 1.0f / (1.0f + __expf(v2 - v1)), w2 = 1.0f - w1;
                    const int r1 = __hip_atomic_fetch_add(lcnt + e1, 1, __ATOMIC_RELAXED, __HIP_MEMORY_SCOPE_WORKGROUP), r2 = __hip_atomic_fetch_add(lcnt + e2, 1, __ATOMIC_RELAXED, __HIP_MEMORY_SCOPE_WORKGROUP);
                    LAS unsigned* rc = rec + (it * NWAVES + wave) * 8;
                    rc[0] = (unsigned)m; rc[1] = (unsigned)e1; rc[2] = (unsigned)e2; rc[3] = (unsigned)r1; rc[4] = (unsigned)r2; rc[5] = __float_as_uint(w1); rc[6] = __float_as_uint(w2);
                }
            }
            __syncthreads();
            if (tid < 8) { const int c = lcnt[tid]; gbase[tid] = c ? (int)__hip_atomic_fetch_add((unsigned*)(ctl + CW_CNT + 64 * tid), (unsigned)c, RLX_AGENT) : 0; }
            __syncthreads();
            for (int i = tid; i < itn * NWAVES; i += NWAVES * 64) {
                const int m = (it0 + i / NWAVES) * NGW + blockIdx.x * NWAVES + (i % NWAVES); if (m >= M) continue;
                const LAS unsigned* rc = rec + i * 8; const int e1 = (int)rc[1], e2 = (int)rc[2]; const unsigned p1 = (unsigned)gbase[e1] + rc[3], p2 = (unsigned)gbase[e2] + rc[4];
                rowlist[e1 * CAP + p1] = m; rowlist[e2 * CAP + p2] = m;
                tok[m] = (v4u){(unsigned)(e1 * CAP) + p1, (unsigned)(e2 * CAP) + p2, rc[5], rc[6]};
            }
            __syncthreads();
        }
        if (BOTH(14)) GRID_BAR(); STAMP(15);
    }
    if (IN(15) || IN(16) || IN(17)) {
        if (tid == 0) { volatile LAS int* mt = (volatile LAS int*)(MISC + 16); int acc = 0;
            for (int e = 0; e < 8; ++e) { const int c = (int)__hip_atomic_load((unsigned*)(ctl + CW_CNT + 64 * e), RLX_AGENT); mt[e] = acc; mt[9 + e] = c; acc += (c + 255) >> 8; }
            mt[8] = acc; }
        __syncthreads();
    }
    if (IN(15)) {
        pg8::Gemm g{(const bf16*)(ws + WS_HN3), (const bf16*)(ws + WS_WMGU), M, 2 * FF, D / 2, D / 2, 0x76767676, 0x7B7B7B7B};
        MoeOrder S; S.init((volatile LAS int*)(MISC + 16), 2 * FF / 256, G, (int)blockIdx.x, (const int*)(ws + WS_ROWLIST));
        pg8::EpiSwiGLU E{(bf16*)(ws + WS_MACT), FF, 2 * FF / 256, true};
        pg8::gemm_phase<pg8::EpiSwiGLU, MoeOrder, true, true, true>(L + RING_OFF, g, S, E);
        if (BOTH(15)) GRID_BAR(); STAMP(16);
    }
    if (IN(16)) {
        pg8::Gemm g{(const bf16*)(ws + WS_MACT), (const bf16*)(ws + WS_WMDN), MAXSLOT, D, FF / 2, FF / 2, 0x76767676, 0x7C7C7C7C};
        MoeOrder S; S.init((volatile LAS int*)(MISC + 16), D / 256, G, (int)blockIdx.x, (const int*)(ws + WS_ROWLIST), 128);
        pg8::EpiStoreBf16 E{(bf16*)(ws + WS_Y), D, D / 256};
        pg8::gemm_phase<pg8::EpiStoreBf16, MoeOrder, true, false, true>(L + RING_OFF, g, S, E);
        { pg8::Gemm g2{(const bf16*)(ws + WS_MACT), (const bf16*)(ws + WS_WMDN), MAXSLOT, D, 256, FF / 2, 0x76767676, 0x7C7C7C7C};
          MoeSplitOrder S2; S2.init((volatile LAS int*)(MISC + 16), D / 256, G, (int)blockIdx.x, 512);
          pg8::EpiPart E2{(float*)(ws + WS_PART0), (float*)(ws + WS_PART1), D / 256, 9};
          pg8::gemm_phase<pg8::EpiPart, MoeSplitOrder, true, false, true>(L + RING_OFF, g2, S2, E2); }
        if (BOTH(16)) GRID_BAR(); STAMP(17);
    }
    if (IN(17)) {
        volatile LAS int* mt = (volatile LAS int*)(MISC + 16);
        const bf16* Y = (const bf16*)(ws + WS_Y); const v4u* tok = (const v4u*)(ws + WS_TOK);
        f32x4 gfin[4];
#pragma unroll
        for (int j = 0; j < 4; ++j) gfin[j] = ((const f32x4*)args.in[4] + lane)[64 * j];
        if (gw < M) {
#define P17_SLOTS(tk_, s1_, s2_) do { const int e1_ = (tk_).x / CAP, e2_ = (tk_).y / CAP; s1_ = (size_t)mt[e1_] * 256 + ((tk_).x % CAP); s2_ = (size_t)mt[e2_] * 256 + ((tk_).y % CAP); } while (0)
#define P17_LOADROW(m_, s1_, s2_, hv_, ya_, yc_) do { const bf16* xr_ = H + (size_t)(m_) * HPITCH; \
            const v2u* y1_ = (const v2u*)(Y + ((s1_) < 32768 ? (s1_) : (size_t)0) * D) + lane; const v2u* y2_ = (const v2u*)(Y + ((s2_) < 32768 ? (s2_) : (size_t)0) * D) + lane; \
            _Pragma("unroll") for (int j = 0; j < 4; ++j) { hv_[j] = ld_bf4(xr_ + 4 * (lane + 64 * j)); ya_[j] = y1_[64 * j]; yc_[j] = y2_[64 * j]; } } while (0)
            v4u tk = tok[gw]; size_t s1, s2; P17_SLOTS(tk, s1, s2);
            f32x4 hv[4]; v2u ya[4], yc[4]; P17_LOADROW(gw, s1, s2, hv, ya, yc);
            v4u tkn = tok[(gw + NGW < M) ? gw + NGW : gw];
            for (int m = gw; m < M; m += NGW) {
                f32x4 v[4]; v2u a[4], c[4];
#pragma unroll
                for (int j = 0; j < 4; ++j) { v[j] = hv[j]; a[j] = ya[j]; c[j] = yc[j]; }
                const size_t cs1 = s1, cs2 = s2; const unsigned zb = tk.z, wb = tk.w; const float w1 = __uint_as_float(zb), w2 = __uint_as_float(wb);
                const int mn = (m + NGW < M) ? m + NGW : m;
                tk = tkn; P17_SLOTS(tk, s1, s2); P17_LOADROW(mn, s1, s2, hv, ya, yc);
                tkn = tok[(mn + NGW < M) ? mn + NGW : mn];
                float s = 0.f;
#pragma unroll
                for (int j = 0; j < 4; ++j) {
                    f32x4 y1v, y2v;
                    if (cs1 < 32768) y1v = (f32x4){bf2f((unsigned short)(a[j].x & 0xffffu)), bf2f((unsigned short)(a[j].x >> 16)), bf2f((unsigned short)(a[j].y & 0xffffu)), bf2f((unsigned short)(a[j].y >> 16))};
                    else { const int tl = (int)(cs1 >> 8) - 128; const float* pb = (tl < 4 ? (const float*)(ws + WS_PART0) + (size_t)((tl * 4 + j) * 7) * 65536 : (const float*)(ws + WS_PART1) + (size_t)(((tl - 4) * 4 + j) * 7) * 65536) + (cs1 & 255) * 256 + 4 * lane;
                        y1v = *(const f32x4*)pb;
#pragma unroll
                        for (int ks = 1; ks < 7; ++ks) y1v += *(const f32x4*)(pb + (size_t)ks * 65536); }
                    if (cs2 < 32768) y2v = (f32x4){bf2f((unsigned short)(c[j].x & 0xffffu)), bf2f((unsigned short)(c[j].x >> 16)), bf2f((unsigned short)(c[j].y & 0xffffu)), bf2f((unsigned short)(c[j].y >> 16))};
                    else { const int tl = (int)(cs2 >> 8) - 128; const float* pb = (tl < 4 ? (const float*)(ws + WS_PART0) + (size_t)((tl * 4 + j) * 7) * 65536 : (const float*)(ws + WS_PART1) + (size_t)(((tl - 4) * 4 + j) * 7) * 65536) + (cs2 & 255) * 256 + 4 * lane;
                        y2v = *(const f32x4*)pb;
#pragma unroll
                        for (int ks = 1; ks < 7; ++ks) y2v += *(const f32x4*)(pb + (size_t)ks * 65536); }
                    v[j] += w1 * y1v + w2 * y2v;
                    s += (v[j].x * v[j].x + v[j].y * v[j].y) + (v[j].z * v[j].z + v[j].w * v[j].w); }
                const float rstd = 1.f / sqrtf(wave_sum(s) * (1.f / 1024.f) + EPS);
                f32x4* xo = (f32x4*)(args.out + (size_t)m * D) + lane;
#pragma unroll
                for (int j = 0; j < 4; ++j) __builtin_nontemporal_store((f32x4){v[j].x * rstd * gfin[j].x, v[j].y * rstd * gfin[j].y, v[j].z * rstd * gfin[j].z, v[j].w * rstd * gfin[j].w}, xo + 64 * j);
            }
#undef P17_SLOTS
#undef P17_LOADROW
        }
    }
#ifdef AMP_A
    if (blockIdx.x == 0 && tid == 0) { const unsigned long long tend = __builtin_amdgcn_s_memrealtime(); ts_[18] = tend;
        const unsigned long long dt = (ts_[AMP_B] - ts_[AMP_A]) * AMP_K; while (__builtin_amdgcn_s_memrealtime() - tend < dt) __builtin_amdgcn_s_sleep(8); }
#endif
#ifdef DIAG_STAMP
    GRID_BAR(); STAMP(18);
    GRID_BAR();
    { const float da = (float)(ts_[DIAG_A1] - ts_[DIAG_A0]) * 0.001f;
      const float db = (float)(ts_[DIAG_B1] - ts_[DIAG_B0]) * 0.1f;
      for (int m = gw; m < M; m += NGW) { f32x4* xr = (f32x4*)(H + (size_t)m * D) + lane;
          for (int j = 0; j < 4; ++j) xr[64 * j] = (f32x4){da, da, da, da}; }
      __syncthreads();
      if (blockIdx.x == 0 && tid == 0) H[0] = db; }
#endif
#undef IN
#undef BOTH
}

extern "C" void kernel_launch(void* const* d_in, const int* in_sizes, int n_in, void* d_out, int out_size, void* d_ws, size_t ws_size, hipStream_t stream) {
    static int grid = 0;
    if (grid == 0) {
        if (n_in != 22 || in_sizes[0] != M * D || out_size != M * D || ws_size < WS_END) { fprintf(stderr, "kernel_launch: unexpected shapes (n_in %d, in0 %d, out %d, ws %zu)\n", n_in, n_in > 0 ? in_sizes[0] : -1, out_size, ws_size); grid = -1; return; }
        int dev = 0, cus = 0, per_cu = 0;
        if (hipGetDevice(&dev) != hipSuccess || hipDeviceGetAttribute(&cus, hipDeviceAttributeMultiprocessorCount, dev) != hipSuccess) { grid = -1; return; }
        if (hipFuncSetAttribute((const void*)fwd_kernel, hipFuncAttributeMaxDynamicSharedMemorySize, LDS_BYTES) != hipSuccess) { fprintf(stderr, "kernel_launch: hipFuncSetAttribute failed\n"); grid = -1; return; }
        if (hipOccupancyMaxActiveBlocksPerMultiprocessor(&per_cu, (const void*)fwd_kernel, NWAVES * 64, LDS_BYTES) != hipSuccess || per_cu < 1) fprintf(stderr, "kernel_launch: occupancy query reports %d\n", per_cu);
        (void)hipGetLastError();
        grid = cus;
    }
    if (grid < 0) return;
    if (hipMemsetAsync((char*)d_ws + WS_CTL, 0, CTL_ZERO_BYTES, stream) != hipSuccess) return;
    Args a{};
    for (int i = 0; i < 22; ++i) a.in[i] = (const float*)d_in[i];
    a.pos = (const int*)d_in[1]; a.out = (float*)d_out; a.ws = (unsigned char*)d_ws;
    static_assert(N_LAUNCHES == 1 || N_LAUNCHES == NPHASE, "MK_N_LAUNCHES: 1 or 18");
    for (int li = 0; li < N_LAUNCHES; ++li) {
        a.ph_lo = (N_LAUNCHES == 1) ? 0 : li; a.ph_hi = (N_LAUNCHES == 1) ? NPHASE : li + 1; a.li = li;
        hipLaunchKernelGGL(fwd_kernel, dim3(grid), dim3(NWAVES * 64), LDS_BYTES, stream, a);
        if (hipPeekAtLastError() != hipSuccess) { fprintf(stderr, "kernel_launch: launch %d failed\n", li); break; }
    }
#ifdef PROBE_EXTRA
    { const int extra[] = {PROBE_EXTRA}; int li = 1;
      for (int k : extra) { a.ph_lo = k; a.ph_hi = k + 1; a.li = li++; hipLaunchKernelGGL(fwd_kernel, dim3(grid), dim3(NWAVES * 64), LDS_BYTES, stream, a); } }
#endif
}
```

```cpp
#include <hip/hip_runtime.h>
#include <cstdio>
#include <cstdint>

#ifndef MK_N_LAUNCHES
#define MK_N_LAUNCHES 1
#endif

namespace pg8 {
#define PG8_LAS __attribute__((address_space(3)))
typedef unsigned short bf16_t;
typedef short bf16x8 __attribute__((ext_vector_type(8)));
typedef float f32x4 __attribute__((ext_vector_type(4)));
typedef unsigned u32x4 __attribute__((ext_vector_type(4)));
constexpr int BM = 256, BK = 64, HALF = 128, HTB = HALF * BK * 2, STAGE_BYTES = 8 * HTB, NXCD = 8, WGM = 8;

__host__ __device__ __forceinline__ int lds_byte(int r, int c) { const int st = (r >> 4) * 2 + (c >> 5), rr = r & 15, cc = c & 31, ob = rr * 64 + cc * 2; return st * 1024 + (ob ^ (((ob >> 9) & 1) << 5)); }
__host__ __device__ __forceinline__ void stage_rc(int b, int& R, int& C) { const int st = b / 1024, sb = b % 1024, swz = sb ^ (((sb >> 9) & 1) << 5); R = (st >> 1) * 16 + swz / 64; C = (st & 1) * 32 + (swz % 64) / 2; }
__host__ __device__ __forceinline__ int perm32(int rho) { const int n = rho >> 4, i = rho & 15; return 8 * (i >> 2) + 4 * n + (i & 3); }

struct Unit { int pm, pn, kb; };
struct Gemm { const bf16_t* A; const bf16_t* Bt; int M, N, K, ld; int sc_w, sc_a; int lda = 0; };

struct StaticOrder {
    int nM, nN, nwg, G, c;
    __host__ __device__ void init(int M, int N, int G_, int c_) { nM = M / BM; nN = N / BM; nwg = nM * nN; G = G_; c = c_; }
    __host__ __device__ bool next(int i, Unit& u) const {
        const long L = (long)i * G + c; if (L >= nwg) return false;
        int wgid = (int)L; { const int q = nwg / NXCD, r = nwg % NXCD, xcd = wgid % NXCD, off = wgid / NXCD; wgid = (xcd < r ? xcd * (q + 1) : r * (q + 1) + (xcd - r) * q) + off; }
        const int nig = WGM * nN, gid = wgid / nig, fm = gid * WGM, gsz = (nM - fm) < WGM ? (nM - fm) : WGM;
        u.pm = fm + ((wgid % nig) % gsz); u.pn = (wgid % nig) / gsz; u.kb = 0; return true;
    }
    __device__ __forceinline__ void a_ready(const Unit&) const {}
    __device__ __forceinline__ void done(const Unit&) const {}
    __device__ __forceinline__ int arow(const Unit&, int) const { return 0; }
    __device__ __forceinline__ void issue_rows(const Unit&, int, int, int) const {}
    __device__ __forceinline__ int arow_lds(int, int) const { return 0; }
};

__device__ __forceinline__ unsigned cvt_pk_bf16(float lo, float hi) { unsigned r; asm volatile("v_cvt_pk_bf16_f32 %0, %1, %2" : "=v"(r) : "v"(lo), "v"(hi)); return r; }

__device__ __forceinline__ void st_wt16(void* p, u32x4 v) { asm volatile("global_store_dwordx4 %0, %1, off sc1\n\ts_nop 1" :: "v"(p), "v"(v) : "memory"); }
typedef unsigned u32x2w __attribute__((ext_vector_type(2)));
__device__ __forceinline__ void st_wt8(void* p, u32x2w v) { asm volatile("global_store_dwordx2 %0, %1, off sc1\n\ts_nop 1" :: "v"(p), "v"(v) : "memory"); }
__device__ __forceinline__ void st_wt4(void* p, unsigned v) { asm volatile("global_store_dword %0, %1, off sc1" :: "v"(p), "v"(v) : "memory"); }
__device__ __forceinline__ void st_wt16f(void* p, f32x4 v) { asm volatile("global_store_dwordx4 %0, %1, off sc1\n\ts_nop 1" :: "v"(p), "v"(v) : "memory"); }
struct EpiStoreBf16 {
    static constexpr bool PERM = true, AFTER_DRAIN = false;
    bf16_t* O; int ldc; int nN; const float* ssq4 = nullptr; int sq_pitch = 4, sq_mask = 0xF; float sq_inv = 1.0f / 1024.0f;
    PG8_LAS float* lssq = nullptr;
    mutable int ub = 0;
    __device__ __forceinline__ void prefetch(const Unit& u, int ui, int wid, int lane) const {
        if (ssq4 && lssq && wid < sq_pitch) __builtin_amdgcn_global_load_lds((const unsigned*)((const char*)(ssq4 + (size_t)u.pm * BM * sq_pitch) + wid * 1024 + lane * 16), (PG8_LAS unsigned*)((PG8_LAS char*)lssq + (ui & 1) * 8192 + wid * 1024), 16, 0, 0); }
    float* sq_out = nullptr; PG8_LAS float* lpart = nullptr;
    __device__ __forceinline__ void operator()(const f32x4 (&acc)[2][2][4][2], const Unit& u, int wr, int wc, int fr, int fq) const {
        const int pnl = u.pn % nN; const int row0 = u.pm * BM + wr * 64 + fr, col0 = pnl * BM + wc * 32 + 8 * fq;
        float rs[2][4];
#pragma unroll
        for (int ai = 0; ai < 2; ++ai)
#pragma unroll
            for (int m = 0; m < 4; ++m) rs[ai][m] = 1.0f;
        if (ssq4) {
            if (sq_pitch == 4) { f32x4 q[2][4];
#pragma unroll
                for (int ai = 0; ai < 2; ++ai)
#pragma unroll
                    for (int m = 0; m < 4; ++m) q[ai][m] = lssq ? *(const PG8_LAS f32x4*)(lssq + ub * 2048 + (wr * 64 + fr + ai * HALF + m * 16) * 4) : *(const f32x4*)(ssq4 + (size_t)(row0 + ai * HALF + m * 16) * 4);
#pragma unroll
                for (int ai = 0; ai < 2; ++ai)
#pragma unroll
                    for (int m = 0; m < 4; ++m) rs[ai][m] = __builtin_amdgcn_rsqf(((q[ai][m][0] + q[ai][m][1]) + (q[ai][m][2] + q[ai][m][3])) * sq_inv + 1e-6f); }
            else { f32x4 qa[2][4], qb[2][4];
#pragma unroll
                for (int ai = 0; ai < 2; ++ai)
#pragma unroll
                    for (int m = 0; m < 4; ++m) { if (lssq) { const PG8_LAS float* lp = lssq + ub * 2048 + (wr * 64 + fr + ai * HALF + m * 16) * 8; qa[ai][m] = *(const PG8_LAS f32x4*)lp; qb[ai][m] = *(const PG8_LAS f32x4*)(lp + 4); }
                        else { const float* sp = ssq4 + (size_t)(row0 + ai * HALF + m * 16) * 8; qa[ai][m] = *(const f32x4*)sp; qb[ai][m] = *(const f32x4*)(sp + 4); } }
#pragma unroll
                for (int ai = 0; ai < 2; ++ai)
#pragma unroll
                    for (int m = 0; m < 4; ++m) { float t = 0.f;
#pragma unroll
                        for (int i = 0; i < 4; ++i) { t += (sq_mask >> i & 1) ? qa[ai][m][i] : 0.f; }
#pragma unroll
                        for (int i = 0; i < 4; ++i) { t += (sq_mask >> (4 + i) & 1) ? qb[ai][m][i] : 0.f; }
                        rs[ai][m] = __builtin_amdgcn_rsqf(t * sq_inv + 1e-6f); } } }
        float pb[2][4][2];
#pragma unroll
        for (int ai = 0; ai < 2; ++ai)
#pragma unroll
            for (int m = 0; m < 4; ++m) { bf16_t* rowp = O + (size_t)(row0 + ai * HALF + m * 16) * ldc + col0;
#pragma unroll
                for (int bj = 0; bj < 2; ++bj) { const f32x4 v0 = acc[ai][bj][m][0] * rs[ai][m], v1 = acc[ai][bj][m][1] * rs[ai][m];
                    if (sq_out) pb[ai][m][bj] = ((v0[0] * v0[0] + v0[1] * v0[1]) + (v0[2] * v0[2] + v0[3] * v0[3])) + ((v1[0] * v1[0] + v1[1] * v1[1]) + (v1[2] * v1[2] + v1[3] * v1[3]));
                    u32x4 w; w.x = cvt_pk_bf16(v0[0], v0[1]); w.y = cvt_pk_bf16(v0[2], v0[3]); w.z = cvt_pk_bf16(v1[0], v1[1]); w.w = cvt_pk_bf16(v1[2], v1[3]);
                    st_wt16(rowp + bj * HALF, w); } }
        if (sq_out) {
#pragma unroll
            for (int ai = 0; ai < 2; ++ai)
#pragma unroll
                for (int m = 0; m < 4; ++m)
#pragma unroll
                    for (int bj = 0; bj < 2; ++bj) { float p = pb[ai][m][bj]; p += __shfl_xor(p, 16); p += __shfl_xor(p, 32);
                        if (fq == 0) lpart[(bj * 4 + wc) * 256 + wr * 64 + fr + ai * HALF + m * 16] = p; }
            asm volatile("s_waitcnt lgkmcnt(0)" ::: "memory"); __builtin_amdgcn_s_barrier(); asm volatile("" ::: "memory");
            const int t = threadIdx.x, r = t & 255, hb = t >> 8;
            sq_out[((size_t)u.pm * BM + r) * 8 + 2 * pnl + hb] = (lpart[(hb * 4 + 0) * 256 + r] + lpart[(hb * 4 + 1) * 256 + r]) + (lpart[(hb * 4 + 2) * 256 + r] + lpart[(hb * 4 + 3) * 256 + r]);
        }
    }
};
typedef float f32x2_ __attribute__((ext_vector_type(2)));
__device__ __forceinline__ f32x2_ swiglu_pk(f32x2_ g, f32x2_ u) { const f32x2_ t = g * (-1.4426950408889634f); f32x2_ e; e.x = __builtin_amdgcn_exp2f(t.x); e.y = __builtin_amdgcn_exp2f(t.y);
    const f32x2_ d = e + 1.0f; f32x2_ r; r.x = __builtin_amdgcn_rcpf(d.x); r.y = __builtin_amdgcn_rcpf(d.y); return (g * u) * r; }
__device__ __forceinline__ float silu_f(float x) { return x * __builtin_amdgcn_rcpf(1.0f + __builtin_amdgcn_exp2f(-1.4426950408889634f * x)); }
__device__ __forceinline__ f32x2_ swiglu_pk_s(f32x2_ g, f32x2_ u, float c1, float c2) { const f32x2_ t = g * c1; f32x2_ e; e.x = __builtin_amdgcn_exp2f(t.x); e.y = __builtin_amdgcn_exp2f(t.y);
    const f32x2_ d = e + 1.0f; f32x2_ r; r.x = __builtin_amdgcn_rcpf(d.x); r.y = __builtin_amdgcn_rcpf(d.y); return ((g * c2) * u) * r; }
struct EpiSwiGLU {
    static constexpr bool PERM = true, AFTER_DRAIN = false;
    bf16_t* O; int ldc; int nN; bool f8;
    const float* ssq4 = nullptr;
    PG8_LAS float* lssq = nullptr;
    mutable int ub = 0;
    __device__ __forceinline__ void prefetch(const Unit& u, int ui, int wid, int lane) const {
        if (ssq4 && lssq && wid < 4) __builtin_amdgcn_global_load_lds((const unsigned*)((const char*)(ssq4 + (size_t)u.pm * BM * 4) + wid * 1024 + lane * 16), (PG8_LAS unsigned*)((PG8_LAS char*)lssq + (ui & 1) * 8192 + wid * 1024), 16, 0, 0); }
    __device__ __forceinline__ void operator()(const f32x4 (&acc)[2][2][4][2], const Unit& u, int wr, int wc, int fr, int fq) const {
        const int pnl = u.pn % nN; const int row0 = u.pm * BM + wr * 64 + fr, col0 = pnl * HALF + wc * 32 + 8 * fq;
        float rs[2][4];
        if (ssq4) { f32x4 q[2][4];
#pragma unroll
            for (int ai = 0; ai < 2; ++ai)
#pragma unroll
                for (int m = 0; m < 4; ++m) q[ai][m] = lssq ? *(const PG8_LAS f32x4*)(lssq + ub * 2048 + (wr * 64 + fr + ai * HALF + m * 16) * 4) : *(const f32x4*)(ssq4 + (size_t)(row0 + ai * HALF + m * 16) * 4);
#pragma unroll
            for (int ai = 0; ai < 2; ++ai)
#pragma unroll
                for (int m = 0; m < 4; ++m) rs[ai][m] = __builtin_amdgcn_rsqf(((q[ai][m][0] + q[ai][m][1]) + (q[ai][m][2] + q[ai][m][3])) * (1.0f / 1024.0f) + 1e-6f); }
#pragma unroll
        for (int ai = 0; ai < 2; ++ai)
#pragma unroll
            for (int m = 0; m < 4; ++m) { bf16_t* rowp = O + (size_t)(row0 + ai * HALF + m * 16) * ldc + col0;
                const f32x4 g0 = acc[ai][0][m][0], g1 = acc[ai][0][m][1], u0 = acc[ai][1][m][0], u1 = acc[ai][1][m][1];
                f32x2_ a0, a1, a2, a3;
                if (ssq4) { const float c1 = -1.4426950408889634f * rs[ai][m], c2 = rs[ai][m] * rs[ai][m];
                    a0 = swiglu_pk_s((f32x2_){g0[0], g0[1]}, (f32x2_){u0[0], u0[1]}, c1, c2); a1 = swiglu_pk_s((f32x2_){g0[2], g0[3]}, (f32x2_){u0[2], u0[3]}, c1, c2);
                    a2 = swiglu_pk_s((f32x2_){g1[0], g1[1]}, (f32x2_){u1[0], u1[1]}, c1, c2); a3 = swiglu_pk_s((f32x2_){g1[2], g1[3]}, (f32x2_){u1[2], u1[3]}, c1, c2); }
                else {
                    a0 = swiglu_pk((f32x2_){g0[0], g0[1]}, (f32x2_){u0[0], u0[1]}); a1 = swiglu_pk((f32x2_){g0[2], g0[3]}, (f32x2_){u0[2], u0[3]});
                    a2 = swiglu_pk((f32x2_){g1[0], g1[1]}, (f32x2_){u1[0], u1[1]}); a3 = swiglu_pk((f32x2_){g1[2], g1[3]}, (f32x2_){u1[2], u1[3]}); }
                if (f8) { typedef unsigned u32x2_ __attribute__((ext_vector_type(2)));
                    const f32x2_ q0 = __builtin_elementwise_min(__builtin_elementwise_max(a0 * 8.f, (f32x2_){-448.f, -448.f}), (f32x2_){448.f, 448.f}), q1 = __builtin_elementwise_min(__builtin_elementwise_max(a1 * 8.f, (f32x2_){-448.f, -448.f}), (f32x2_){448.f, 448.f});
                    const f32x2_ q2 = __builtin_elementwise_min(__builtin_elementwise_max(a2 * 8.f, (f32x2_){-448.f, -448.f}), (f32x2_){448.f, 448.f}), q3 = __builtin_elementwise_min(__builtin_elementwise_max(a3 * 8.f, (f32x2_){-448.f, -448.f}), (f32x2_){448.f, 448.f});
                    int w0 = __builtin_amdgcn_cvt_pk_fp8_f32(q0.x, q0.y, 0, false); w0 = __builtin_amdgcn_cvt_pk_fp8_f32(q1.x, q1.y, w0, true);
                    int w1 = __builtin_amdgcn_cvt_pk_fp8_f32(q2.x, q2.y, 0, false); w1 = __builtin_amdgcn_cvt_pk_fp8_f32(q3.x, q3.y, w1, true);
                    __builtin_nontemporal_store((u32x2_){(unsigned)w0, (unsigned)w1}, (u32x2_*)((unsigned char*)O + (size_t)(row0 + ai * HALF + m * 16) * ldc + col0)); }
                else { u32x4 w; w.x = cvt_pk_bf16(a0.x, a0.y); w.y = cvt_pk_bf16(a1.x, a1.y); w.z = cvt_pk_bf16(a2.x, a2.y); w.w = cvt_pk_bf16(a3.x, a3.y);
                    st_wt16(rowp, w); } }
    }
};
struct EpiPart {
    static constexpr bool PERM = false, AFTER_DRAIN = false;
    float* P0; float* P1; int nN; int kshift;
    mutable int ub = 0;
    __device__ __forceinline__ void prefetch(const Unit&, int, int, int) const {}
    __device__ __forceinline__ void operator()(const f32x4 (&acc)[2][2][4][2], const Unit& u, int wr, int wc, int fr, int fq) const {
        const int pnl = u.pn % nN, ks = u.kb >> kshift, tl = u.pm - 128;
        float* base = (tl < 4 ? P0 + (size_t)((tl * 4 + pnl) * 7 + ks) * 65536 : P1 + (size_t)(((tl - 4) * 4 + pnl) * 7 + ks) * 65536) + (wr * 64 + fr) * 256 + wc * 32 + 4 * fq;
#pragma unroll
        for (int ai = 0; ai < 2; ++ai)
#pragma unroll
            for (int m = 0; m < 4; ++m) { float* rp = base + (ai * HALF + m * 16) * 256;
#pragma unroll
                for (int bj = 0; bj < 2; ++bj)
#pragma unroll
                    for (int n = 0; n < 2; ++n) st_wt16f(rp + bj * HALF + n * 16, acc[ai][bj][m][n]);
                asm volatile("" ::: "memory"); }
    }
};
template <bool BASE_F32> struct EpiRes {
    static constexpr bool PERM = true, AFTER_DRAIN = false;
    const void* base; bf16_t* out; int ldb, ldo; int nN;
    float* ssq4 = nullptr; PG8_LAS float* lpart = nullptr;
    mutable int ub = 0;
    __device__ __forceinline__ void prefetch(const Unit&, int, int, int) const {}
    __device__ __forceinline__ void operator()(const f32x4 (&acc)[2][2][4][2], const Unit& u, int wr, int wc, int fr, int fq) const {
        const int pnl = u.pn % nN; const int row0 = u.pm * BM + wr * 64 + fr, col0 = pnl * BM + wc * 32 + 8 * fq;
        float ps[2][4];
#pragma unroll
        for (int ai = 0; ai < 2; ++ai)
#pragma unroll
            for (int m = 0; m < 4; ++m) ps[ai][m] = 0.f;
#pragma unroll
        for (int ai = 0; ai < 2; ++ai) {
            if constexpr (BASE_F32) {
                f32x4 pre[4][2][2];
#pragma unroll
                for (int m = 0; m < 4; ++m) { const size_t row = (size_t)(row0 + ai * HALF + m * 16);
#pragma unroll
                    for (int bj = 0; bj < 2; ++bj)
#pragma unroll
                        for (int n = 0; n < 2; ++n) pre[m][bj][n] = *(const f32x4*)((const float*)base + row * ldb + col0 + bj * HALF + n * 4); }
                asm volatile("" ::: "memory");
#pragma unroll
                for (int m = 0; m < 4; ++m) { const size_t off = (size_t)(row0 + ai * HALF + m * 16) * ldo + col0;
#pragma unroll
                    for (int bj = 0; bj < 2; ++bj) { const f32x4 v0 = acc[ai][bj][m][0] + pre[m][bj][0], v1 = acc[ai][bj][m][1] + pre[m][bj][1];
                        st_wt16(out + off + bj * HALF, (u32x4){cvt_pk_bf16(v0[0], v0[1]), cvt_pk_bf16(v0[2], v0[3]), cvt_pk_bf16(v1[0], v1[1]), cvt_pk_bf16(v1[2], v1[3])});
                        ps[ai][m] += ((v0[0] * v0[0] + v0[1] * v0[1]) + (v0[2] * v0[2] + v0[3] * v0[3])) + ((v1[0] * v1[0] + v1[1] * v1[1]) + (v1[2] * v1[2] + v1[3] * v1[3])); } }
            } else {
                u32x4 pre[4][2];
#pragma unroll
                for (int m = 0; m < 4; ++m) { const size_t row = (size_t)(row0 + ai * HALF + m * 16);
#pragma unroll
                    for (int bj = 0; bj < 2; ++bj) pre[m][bj] = *(const u32x4*)((const bf16_t*)base + row * ldb + col0 + bj * HALF); }
                asm volatile("" ::: "memory");
#pragma unroll
                for (int m = 0; m < 4; ++m) { const size_t off = (size_t)(row0 + ai * HALF + m * 16) * ldo + col0;
#pragma unroll
                    for (int bj = 0; bj < 2; ++bj) { const u32x4 b = pre[m][bj];
                        const f32x4 v0 = acc[ai][bj][m][0] + (f32x4){__uint_as_float(b.x << 16), __uint_as_float(b.x & 0xffff0000u), __uint_as_float(b.y << 16), __uint_as_float(b.y & 0xffff0000u)};
                        const f32x4 v1 = acc[ai][bj][m][1] + (f32x4){__uint_as_float(b.z << 16), __uint_as_float(b.z & 0xffff0000u), __uint_as_float(b.w << 16), __uint_as_float(b.w & 0xffff0000u)};
                        st_wt16(out + off + bj * HALF, (u32x4){cvt_pk_bf16(v0[0], v0[1]), cvt_pk_bf16(v0[2], v0[3]), cvt_pk_bf16(v1[0], v1[1]), cvt_pk_bf16(v1[2], v1[3])});
                        ps[ai][m] += ((v0[0] * v0[0] + v0[1] * v0[1]) + (v0[2] * v0[2] + v0[3] * v0[3])) + ((v1[0] * v1[0] + v1[1] * v1[1]) + (v1[2] * v1[2] + v1[3] * v1[3])); } }
            }
            asm volatile("" ::: "memory");
        }
        if (ssq4) {
#pragma unroll
            for (int ai = 0; ai < 2; ++ai)
#pragma unroll
                for (int m = 0; m < 4; ++m) { float p = ps[ai][m]; p += __shfl_xor(p, 16); p += __shfl_xor(p, 32);
                    if (fq == 0) lpart[wc * 256 + wr * 64 + fr + ai * HALF + m * 16] = p; }
            asm volatile("s_waitcnt lgkmcnt(0)" ::: "memory"); __builtin_amdgcn_s_barrier(); asm volatile("" ::: "memory");
            const int t = threadIdx.x;
            if (t < 256) ssq4[((size_t)u.pm * BM + t) * 4 + pnl] = (lpart[t] + lpart[256 + t]) + (lpart[512 + t] + lpart[768 + t]);
        }
    }
};

template <class Epi, class Sched, bool ALIGN_EPI = true, bool GATHER = false, bool FP8 = false>
__device__ __forceinline__ void gemm_phase(PG8_LAS unsigned char* lds, const Gemm g, const Sched& S, const Epi& E) {
    int tid_ = threadIdx.x; asm volatile("" : "+v"(tid_));
    const int tid = tid_, wid = __builtin_amdgcn_readfirstlane(tid >> 6), lane = tid & 63, wr = wid >> 2, wc = wid & 3, fr = lane & 15, fq = lane >> 4;
    const int K = g.ld, KA = g.lda ? g.lda : g.ld; int nt = g.K / BK; asm volatile("" : "+s"(nt));
    unsigned voffA[2], voffB[2]; int RA[2], CA[2];
#pragma unroll
    for (int i = 0; i < 2; ++i) { int R, C; stage_rc(tid * 16 + i * 8192, R, C); const int Rb = Epi::PERM ? ((R & ~31) + perm32(R & 31)) : R;
        voffA[i] = (unsigned)(R * KA + C) * 2u; voffB[i] = (unsigned)(Rb * K + C) * 2u; RA[i] = R; CA[i] = C; }
    unsigned vAc[2][2], vAn[2][2];
    const size_t kstep = (size_t)(BK * 2);
    const size_t hstep = (size_t)HALF * K * 2;
    const size_t tstep = 2 * hstep;
    const size_t hstepA = GATHER ? (size_t)0 : (size_t)HALF * KA * 2, tstepA = (size_t)2 * HALF * KA * 2;
    const unsigned ldsw = (unsigned)wid * 1024u;
    const int aoff = lds_byte(wr * 64 + fr, fq * 8), boff = lds_byte(wc * 32 + fr, fq * 8);
    const int aoff8 = lds_byte(wr * 64 + fr, 16 * (fq & 1)) + (fq >> 1) * 1024, boff8 = lds_byte(wc * 32 + fr, 16 * (fq & 1)) + (fq >> 1) * 1024;
    typedef int v8i_ __attribute__((ext_vector_type(8))); typedef int v4i_ __attribute__((ext_vector_type(4)));
    const int scw = g.sc_w, sca = g.sc_a;
#define PG8_SA(b, h) (((b) * 2 + (h)) * HTB)
#define PG8_SB(b, h) ((4 + (b) * 2 + (h)) * HTB)
#define PG8_STAGE(bufoff, gbase, voff) do { _Pragma("unroll") for (int _i = 0; _i < 2; ++_i) \
        __builtin_amdgcn_global_load_lds((const unsigned*)((const char*)(gbase) + (voff)[_i]), (PG8_LAS unsigned*)(lds + (bufoff) + ldsw + _i * 8192), 16, 0, 0); } while (0)
#define PG8_STAGE_A(bufoff, gbase, h, nx) do { _Pragma("unroll") for (int _i = 0; _i < 2; ++_i) { const unsigned _vo = GATHER ? ((nx) ? vAn[h][_i] : vAc[h][_i]) : voffA[_i]; \
        __builtin_amdgcn_global_load_lds((const unsigned*)((const char*)(gbase) + _vo), (PG8_LAS unsigned*)(lds + (bufoff) + ldsw + _i * 8192), 16, 0, 0); } } while (0)
#define PG8_GATH(dst, un) do { _Pragma("unroll") for (int _h = 0; _h < 2; ++_h) _Pragma("unroll") for (int _i = 0; _i < 2; ++_i) \
        dst[_h][_i] = (unsigned)(S.arow(un, _h * HALF + RA[_i]) * KA + CA[_i]) * 2u; } while (0)
#define PG8_LD8(dst, idx, off) do { const v4i_ lo_ = *(const PG8_LAS v4i_*)(lds + (off)), hi_ = *(const PG8_LAS v4i_*)(lds + (off) + 16); dst[idx] = (v8i_){lo_[0], lo_[1], lo_[2], lo_[3], hi_[0], hi_[1], hi_[2], hi_[3]}; } while (0)
#define PG8_LDA8(dst, b, h) do { _Pragma("unroll") for (int m = 0; m < 4; ++m) PG8_LD8(dst, m, PG8_SA(b, h) + aoff8 + m * 2048); } while (0)
#define PG8_LDB8(dst, b, h) do { _Pragma("unroll") for (int n = 0; n < 2; ++n) PG8_LD8(dst, n, PG8_SB(b, h) + boff8 + n * 2048); } while (0)
#define PG8_MMA8(ai, bj, At_, Bt_) do { __builtin_amdgcn_s_setprio(1); _Pragma("unroll") for (int m = 0; m < 4; ++m) _Pragma("unroll") for (int n = 0; n < 2; ++n) \
        acc[ai][bj][m][n] = __builtin_amdgcn_mfma_scale_f32_16x16x128_f8f6f4(Bt_[n], At_[m], acc[ai][bj][m][n], 0, 0, 0, scw, 0, sca); \
        _Pragma("unroll") for (int m = 0; m < 4; ++m) _Pragma("unroll") for (int n = 0; n < 2; ++n) asm volatile("" : "+v"(acc[ai][bj][m][n]));     \
        __builtin_amdgcn_s_setprio(0); } while (0)
#define PG8_LDA(dst, b, h) do { _Pragma("unroll") for (int m = 0; m < 4; ++m) _Pragma("unroll") for (int k = 0; k < 2; ++k) dst[m][k] = *(const PG8_LAS bf16x8*)(lds + PG8_SA(b, h) + aoff + m * 2048 + k * 1024); } while (0)
#define PG8_LDB(dst, b, h) do { _Pragma("unroll") for (int n = 0; n < 2; ++n) _Pragma("unroll") for (int k = 0; k < 2; ++k) dst[n][k] = *(const PG8_LAS bf16x8*)(lds + PG8_SB(b, h) + boff + n * 2048 + k * 1024); } while (0)
#define PG8_MMA(ai, bj, At, Bt) do { __builtin_amdgcn_s_setprio(1); _Pragma("unroll") for (int m = 0; m < 4; ++m) _Pragma("unroll") for (int n = 0; n < 2; ++n) _Pragma("unroll") for (int k = 0; k < 2; ++k) \
        acc[ai][bj][m][n] = __builtin_amdgcn_mfma_f32_16x16x32_bf16(Bt[n][k], At[m][k], acc[ai][bj][m][n], 0, 0, 0); __builtin_amdgcn_s_setprio(0); } while (0)
#define PG8_WAIT_V(n) asm volatile("s_waitcnt vmcnt(" #n ")" ::: "memory")
#define PG8_WAIT_L(n) asm volatile("s_waitcnt lgkmcnt(" #n ")" ::: "memory")
#define PG8_BAR __builtin_amdgcn_s_barrier()
#define PG8_SCHED __builtin_amdgcn_sched_barrier(0)
    Unit cur, nxt; int ui = 0;
    if (!S.next(0, cur)) return;
    f32x4 acc[2][2][4][2];
#pragma unroll
    for (int a = 0; a < 2; ++a)
#pragma unroll
        for (int b = 0; b < 2; ++b)
#pragma unroll
            for (int m = 0; m < 4; ++m)
#pragma unroll
                for (int n = 0; n < 2; ++n) acc[a][b][m][n] = (f32x4){0.f, 0.f, 0.f, 0.f};
    bf16x8 At[4][2], B0[2][2], B1[2][2];
    v8i_ At8[4], B08[2], B18[2];
    const char* cA = GATHER ? (const char*)g.A : (const char*)g.A + (size_t)cur.pm * tstepA + cur.kb; const char* cB = (const char*)g.Bt + (size_t)cur.pn * tstep + cur.kb;
    if (GATHER) { PG8_GATH(vAc, cur); }
    S.a_ready(cur);
    PG8_STAGE(PG8_SB(0, 0), cB, voffB); PG8_STAGE(PG8_SB(0, 1), cB + hstep, voffB); PG8_STAGE_A(PG8_SA(0, 0), cA, 0, false); PG8_STAGE_A(PG8_SA(0, 1), cA + hstepA, 1, false);
    if (wr == 1) PG8_BAR;
    PG8_WAIT_V(2); PG8_BAR;
    PG8_STAGE(PG8_SB(1, 0), cB + kstep, voffB); PG8_STAGE_A(PG8_SA(1, 0), cA + kstep, 0, false); PG8_STAGE(PG8_SB(1, 1), cB + hstep + kstep, voffB);
    PG8_WAIT_V(6); PG8_BAR;
    for (;;) {
        const bool has_next = S.next(ui + 1, nxt);
        const char* nA = GATHER ? (const char*)g.A : (has_next ? (const char*)g.A + (size_t)nxt.pm * tstepA + nxt.kb : cA); const char* nB = has_next ? (const char*)g.Bt + (size_t)nxt.pn * tstep + nxt.kb : cB;
        if (GATHER) { if (has_next) { S.issue_rows(nxt, ui & 1, wid, lane); } else {
#pragma unroll
                for (int _h = 0; _h < 2; ++_h)
#pragma unroll
                    for (int _i = 0; _i < 2; ++_i) vAn[_h][_i] = vAc[_h][_i]; } }
        E.prefetch(cur, ui, wid, lane);
        for (int t = 0; t < nt; t += 2) {
            const bool last = (t == nt - 2);
            const char* a1 = cA + (size_t)(t + 1) * kstep;
            const char* a2 = last ? nA : cA + (size_t)(t + 2) * kstep; const char* b2 = last ? nB : cB + (size_t)(t + 2) * kstep;
            const char* a3 = a2 + kstep; const char* b3 = b2 + kstep;
            if (last && has_next) S.a_ready(nxt);
            if (GATHER) { if (last && has_next) {
#pragma unroll
                    for (int _h = 0; _h < 2; ++_h)
#pragma unroll
                        for (int _i = 0; _i < 2; ++_i) vAn[_h][_i] = (unsigned)(S.arow_lds(_h * HALF + RA[_i], ui & 1) * KA + CA[_i]) * 2u; } }
#define PG8_XLDB(b) do { if constexpr (FP8) { PG8_LDB8(B08, b, 0); PG8_LDB8(B18, b, 1); } else { PG8_LDB(B0, b, 0); PG8_LDB(B1, b, 1); } } while (0)
#define PG8_XLDA(b, h) do { if constexpr (FP8) { PG8_LDA8(At8, b, h); } else { PG8_LDA(At, b, h); } } while (0)
#define PG8_XMMA(ai) do { if constexpr (FP8) { PG8_MMA8(ai, 0, At8, B08); PG8_MMA8(ai, 1, At8, B18); } else { PG8_MMA(ai, 0, At, B0); PG8_MMA(ai, 1, At, B1); } } while (0)
            PG8_XLDB(0); PG8_SCHED; PG8_XLDA(0, 0); PG8_STAGE_A(PG8_SA(1, 1), a1 + hstepA, 1, false);
            PG8_WAIT_V(8); PG8_WAIT_L(0); PG8_BAR; PG8_XMMA(0); PG8_BAR; PG8_SCHED;
            PG8_XLDA(0, 1); PG8_STAGE(PG8_SB(0, 0), b2, voffB); PG8_STAGE(PG8_SB(0, 1), b2 + hstep, voffB); PG8_STAGE_A(PG8_SA(0, 0), a2, 0, last);
            PG8_WAIT_V(8); PG8_WAIT_L(0); PG8_BAR; PG8_XMMA(1); PG8_BAR; PG8_SCHED;
            PG8_XLDB(1); PG8_SCHED; PG8_XLDA(1, 0); PG8_STAGE_A(PG8_SA(0, 1), a2 + hstepA, 1, last);
            PG8_WAIT_V(8); PG8_WAIT_L(0); PG8_BAR; PG8_XMMA(0); PG8_BAR; PG8_SCHED;
            PG8_XLDA(1, 1); PG8_STAGE(PG8_SB(1, 0), b3, voffB); PG8_STAGE(PG8_SB(1, 1), b3 + hstep, voffB); PG8_STAGE_A(PG8_SA(1, 0), a3, 0, last);
            PG8_WAIT_V(8); PG8_WAIT_L(0); PG8_BAR; PG8_XMMA(1); PG8_BAR; PG8_SCHED;
        }
        if constexpr (ALIGN_EPI) { if (wr == 0) PG8_BAR; }
        E.ub = ui & 1; E(acc, cur, wr, wc, fr, fq); S.done(cur);
        if (!has_next) break;
#pragma unroll
        for (int a = 0; a < 2; ++a)
#pragma unroll
            for (int b = 0; b < 2; ++b)
#pragma unroll
                for (int m = 0; m < 4; ++m)
#pragma unroll
                    for (int n = 0; n < 2; ++n) acc[a][b][m][n] = (f32x4){0.f, 0.f, 0.f, 0.f};
        cur = nxt; cA = nA; cB = nB; ++ui;
        if (GATHER) {
#pragma unroll
            for (int _h = 0; _h < 2; ++_h)
#pragma unroll
                for (int _i = 0; _i < 2; ++_i) vAc[_h][_i] = vAn[_h][_i]; }
        if constexpr (ALIGN_EPI) { if (wr == 1) PG8_BAR; }
    }
    PG8_WAIT_V(0);
    if constexpr (!ALIGN_EPI) { if (wr == 0) PG8_BAR; }
    PG8_BAR;
#undef PG8_SA
#undef PG8_SB
#undef PG8_STAGE
#undef PG8_STAGE_A
#undef PG8_GATH
#undef PG8_LDA
#undef PG8_LD8
#undef PG8_LDA8
#undef PG8_LDB8
#undef PG8_MMA8
#undef PG8_XLDB
#undef PG8_XLDA
#undef PG8_XMMA
#undef PG8_LDB
#undef PG8_MMA
#undef PG8_WAIT_V
#undef PG8_WAIT_L
#undef PG8_BAR
#undef PG8_SCHED
}
}

constexpr int NWAVES = 8;
constexpr int N_LAUNCHES = MK_N_LAUNCHES;
constexpr int NPHASE = 18;
constexpr int BATCH = 4, SEQ = 4096, D = 1024, M = BATCH * SEQ;
constexpr int NH = 16, QL = 384, KVL = 256, NOPE = 64, ROPE = 32, VD = 64, MLA_IN = 672, MLA_INP = 768, QW = NH * 96, KVW = NH * 128;
constexpr int HGH = 8, DK = 128, DV = 128, HG_IN = 4096;
constexpr int FF = 3584, NE = 8, CAP = 16384;
constexpr int MAXSLOT = 2 * M + NE * 256;
constexpr float EPS = 1e-6f;

constexpr size_t MiB = 1u << 20;
#if defined(PROBE_EXTRA) || defined(AMP_A) || defined(DIAG_STAMP)
constexpr size_t WS_CTL = 0, CTL_ZERO_BYTES = 1 * MiB;
#else
constexpr size_t WS_CTL = 0, CTL_ZERO_BYTES = 32 * 1024;
#endif
constexpr size_t WS_SSQ = 512 * 1024;
constexpr size_t WS_ROWLIST = 1 * MiB;
constexpr size_t WS_TOK = WS_ROWLIST + 512 * 1024;
constexpr size_t WS_STAMP = WS_TOK + 256 * 1024;
constexpr size_t WS_COS = 2 * MiB, WS_SIN = 3 * MiB;
constexpr size_t WS_WMLAIN = 4 * MiB;
constexpr size_t WS_WQUP = 6 * MiB;
constexpr size_t WS_WKVUP = 8 * MiB;
constexpr size_t WS_WO0 = 9 * MiB;
constexpr size_t WS_WFGU = 11 * MiB;
constexpr size_t WS_WFDN = 25 * MiB;
constexpr size_t WS_WHIN = 32 * MiB;
constexpr size_t WS_WHO = 40 * MiB;
constexpr size_t WS_WMGU = 42 * MiB;
constexpr size_t WS_WMDN = 154 * MiB;
constexpr size_t WS_ACTS = 210 * MiB;
constexpr size_t WS_HN = WS_ACTS;
constexpr size_t WS_PROJ = WS_ACTS + 32 * MiB;
constexpr size_t WS_CQN = WS_PROJ + 24 * MiB;
constexpr size_t WS_CKVN = WS_CQN + 12 * MiB;
constexpr size_t WS_SSQ8 = WS_CQN;
constexpr size_t WS_KR = WS_CKVN + 8 * MiB;
constexpr size_t WS_Q = WS_KR + 1 * MiB;
constexpr size_t WS_KV = WS_Q + 48 * MiB;
constexpr size_t WS_O = WS_KV + 64 * MiB;
constexpr size_t WS_FACT = WS_ACTS + 32 * MiB;
constexpr size_t WS_HPROJ = WS_ACTS + 32 * MiB;
constexpr size_t WS_HOF = WS_HPROJ + 128 * MiB;
constexpr size_t WS_HON = WS_HOF + 64 * MiB;
constexpr size_t WS_OL = WS_HOF;
constexpr size_t WS_Q1G = WS_HOF + 32 * MiB;
constexpr size_t WS_SS = WS_HN;
constexpr size_t WS_WN = WS_HN + 16 * MiB;
constexpr size_t WS_DSEG = WS_HN + 17 * MiB;
constexpr size_t WS_HN3 = 4 * MiB;
constexpr size_t WS_MACT = WS_ACTS;
constexpr size_t WS_Y = WS_WMGU;
constexpr size_t WS_PART0 = WS_WMGU + 68 * MiB;
constexpr size_t WS_PART1 = WS_HN3;
constexpr size_t WS_END = 472 * MiB;
static_assert(WS_O + (size_t)M * 1024 * 2 <= WS_END && WS_HON + (size_t)M * 1024 * 2 <= WS_END && WS_MACT + (size_t)MAXSLOT * FF * 2 <= WS_END, "d_ws map");
static_assert(WS_HN3 + (size_t)M * 1024 * 2 <= WS_WHO, "hn3 overlay");
constexpr int CW_CNT = 64;
constexpr int CW_BAR = 4096;

constexpr int RING_OFF = 0, RING_BYTES = 131072;
constexpr int LDSCTL_OFF = RING_BYTES, MISC_OFF = LDSCTL_OFF + 320;
constexpr int ROWBUF_OFF = 133120;
constexpr int SSQ_LDS_OFF = 139264;
constexpr int LDS_BYTES = 163840;

#define GAS __attribute__((address_space(1)))
#define LAS __attribute__((address_space(3)))
typedef unsigned short bf16;
typedef unsigned v4u __attribute__((ext_vector_type(4)));
typedef unsigned v2u __attribute__((ext_vector_type(2)));
typedef float f32x4 __attribute__((ext_vector_type(4)));
typedef GAS unsigned gu32;
#define RLX_AGENT __ATOMIC_RELAXED, __HIP_MEMORY_SCOPE_AGENT
#define LDS_WAIT() asm volatile("s_waitcnt lgkmcnt(0)" ::: "memory")
typedef float f32x2c_t __attribute__((ext_vector_type(2))); typedef __bf16 bf16x2c_t __attribute__((ext_vector_type(2)));
__device__ __forceinline__ unsigned pk2(float lo, float hi) { f32x2c_t v = {lo, hi}; bf16x2c_t b = __builtin_convertvector(v, bf16x2c_t); return __builtin_bit_cast(unsigned, b); }
__device__ __forceinline__ unsigned f2bf(float f) { return pk2(f, 0.f) & 0xffffu; }
__device__ __forceinline__ float bf2f(unsigned short b) { return __builtin_bit_cast(float, (unsigned)b << 16); }

#define XB_TMO      128
#define XB_XCNT(j)  (256  + 64 * (j))
#define XB_XSUB(j)  (1280 + 64 * (j))
#define XB_XGEN(j)  (2304 + 64 * (j))
#define XB_TOP      3328
#define XB_TOPGEN   3392
#define XCD_BAR_WORDS 3456
#define XB_SPIN_CAP (1u << 24)
__device__ __forceinline__ unsigned xb_ld(unsigned* p)              { return __hip_atomic_load(p, __ATOMIC_RELAXED, __HIP_MEMORY_SCOPE_AGENT); }
__device__ __forceinline__ unsigned xb_add(unsigned* p, unsigned v) { return __hip_atomic_fetch_add(p, v, __ATOMIC_RELAXED, __HIP_MEMORY_SCOPE_AGENT); }
__device__ __forceinline__ unsigned xb_xcc_id() { return (unsigned)__builtin_amdgcn_s_getreg((3 << 11) | 20) & 0xFu; }
#define XB_SPIN(cond, bar) do { unsigned _sp = 0; while (cond) { __builtin_amdgcn_s_sleep(1); \
    if ((++_sp & 255u) == 0u) { if (xb_ld(&(bar)[XB_TMO])) break; if (_sp > XB_SPIN_CAP) { atomicAdd(&(bar)[XB_TMO], 1u); break; } } } } while (0)
struct XcdBarrier { unsigned* bar; unsigned x; volatile LAS unsigned* st; };
__device__ __forceinline__ XcdBarrier xcd_barrier_post(unsigned* bar, volatile LAS unsigned* st) {
    XcdBarrier b; b.bar = bar; b.x = xb_xcc_id(); b.st = st;
    if (threadIdx.x == 0) (void)xb_add(&bar[XB_XCNT(b.x)], 1u);
    return b;
}
__device__ __forceinline__ void xcd_barrier_complete(unsigned* bar, unsigned x, unsigned& nloc, unsigned& nx) {
    const unsigned G = gridDim.x * gridDim.y * gridDim.z;
    unsigned sum, cnt, mine, sp = 0u;
    for (;;) {
        sum = 0u; cnt = 0u; mine = 0u;
#pragma unroll
        for (unsigned j = 0; j < 16; ++j) { const unsigned c = xb_ld(&bar[XB_XCNT(j)]); sum += c; cnt += (c > 0u) ? 1u : 0u; mine = (j == x) ? c : mine; }
        if (sum == G) break;
        __builtin_amdgcn_s_sleep(1);
        if ((++sp & 255u) == 0u) { if (xb_ld(&bar[XB_TMO])) break; if (sp > XB_SPIN_CAP) { atomicAdd(&bar[XB_TMO], 1u); break; } }
    }
    nloc = mine > 0u ? mine : 1u; nx = cnt > 0u ? cnt : 1u;
}
__device__ __forceinline__ void xcd_barrier(const XcdBarrier& b) {
    asm volatile("s_waitcnt vmcnt(0)" ::: "memory");
    __syncthreads();
    if (threadIdx.x == 0) {
        unsigned* bar = b.bar;
        __builtin_amdgcn_s_waitcnt(0);
        unsigned nloc = b.st[0], nx = b.st[1];
        if (nloc == 0u) { xcd_barrier_complete(bar, b.x, nloc, nx); b.st[0] = nloc; b.st[1] = nx; }
        const unsigned old = xb_add(&bar[XB_XSUB(b.x)], 1u);
        const unsigned gen = old / nloc;
        if (old + 1u == (gen + 1u) * nloc) {
            __builtin_amdgcn_fence(__ATOMIC_RELEASE, "agent");
            asm volatile("s_waitcnt vmcnt(0)" ::: "memory");
            const unsigned og = xb_add(&bar[XB_TOP], 1u);
            const unsigned tg = og / nx;
            if (og + 1u == (tg + 1u) * nx) xb_add(&bar[XB_TOPGEN], 1u);
            else XB_SPIN(xb_ld(&bar[XB_TOPGEN]) == tg, bar);
            __builtin_amdgcn_fence(__ATOMIC_ACQUIRE, "agent");
            xb_add(&bar[XB_XGEN(b.x)], 1u);
            asm volatile("s_waitcnt vmcnt(0)" ::: "memory");
        } else {
            XB_SPIN(xb_ld(&bar[XB_XGEN(b.x)]) == gen, bar);
            __builtin_amdgcn_fence(__ATOMIC_ACQUIRE, "agent");
            asm volatile("s_waitcnt vmcnt(0)" ::: "memory");
        }
    }
    __syncthreads();
}

template <int CTRL> __device__ __forceinline__ float dpp_mov(float v) { return __int_as_float(__builtin_amdgcn_update_dpp(0, __float_as_int(v), CTRL, 0xF, 0xF, true)); }
__device__ __forceinline__ float lane_x1(float v) { return dpp_mov<0xB1>(v); }
__device__ __forceinline__ float lane_x2(float v) { return dpp_mov<0x4E>(v); }
__device__ __forceinline__ float lane_m8(float v) { return dpp_mov<0x141>(v); }
__device__ __forceinline__ float lane_m16(float v) { return dpp_mov<0x140>(v); }
__device__ __forceinline__ float lane_x8(float v) { return dpp_mov<0x128>(v); }
__device__ __forceinline__ float sum_x16(float v) { const auto r = __builtin_amdgcn_permlane16_swap(__float_as_uint(v), __float_as_uint(v), false, false); return __uint_as_float(r[0]) + __uint_as_float(r[1]); }
__device__ __forceinline__ float sum_x32(float v) { const auto r = __builtin_amdgcn_permlane32_swap(__float_as_uint(v), __float_as_uint(v), false, false); return __uint_as_float(r[0]) + __uint_as_float(r[1]); }
__device__ __forceinline__ float wave_sum(float v) {
    v += lane_x1(v); v += lane_x2(v); v += lane_m8(v); v += lane_m16(v);
    return sum_x32(sum_x16(v));
}
__device__ __forceinline__ int dst_row(int n, int mode) { return mode == 0 ? n : (((n >> 7) << 8) + (n & 127) + (mode == 2 ? 128 : 0)); }
__device__ __forceinline__ unsigned pk_fp8x4(float a, float b, float c, float d, float sc) {
    a = __builtin_amdgcn_fmed3f(a * sc, -448.f, 448.f); b = __builtin_amdgcn_fmed3f(b * sc, -448.f, 448.f); c = __builtin_amdgcn_fmed3f(c * sc, -448.f, 448.f); d = __builtin_amdgcn_fmed3f(d * sc, -448.f, 448.f);
    int w = __builtin_amdgcn_cvt_pk_fp8_f32(a, b, 0, false); w = __builtin_amdgcn_cvt_pk_fp8_f32(c, d, w, true); return (unsigned)w; }
struct TrJob { const float* W; bf16* WT; int K, N, mode, item; const float* gain = nullptr; };
__device__ __forceinline__ void tr_load(const TrJob& j, float (&v)[32], int lane) {
    const int nblk = j.N / 32, kb = j.item / nblk, nb = j.item % nblk; const float* src = j.W + (size_t)(64 * kb + (lane >> 3)) * j.N + 32 * nb + 4 * (lane & 7);
#pragma unroll
    for (int i = 0; i < 8; ++i) { const f32x4 t = __builtin_nontemporal_load((const f32x4*)(src + (size_t)(8 * i) * j.N));
        v[4 * i] = t[0]; v[4 * i + 1] = t[1]; v[4 * i + 2] = t[2]; v[4 * i + 3] = t[3]; }
}
__device__ __forceinline__ void tr_finish(const TrJob& j, const float (&v)[32], LAS float* scr, int lane) {
    const int nblk = j.N / 32, kb = j.item / nblk, nb = j.item % nblk, k0 = 64 * kb, n0 = 32 * nb;
#pragma unroll
    for (int i = 0; i < 8; ++i)
#pragma unroll
        for (int jj = 0; jj < 4; ++jj) scr[(8 * i + (lane >> 3)) * 33 + 4 * (lane & 7) + jj] = v[4 * i + jj];
    LDS_WAIT(); asm volatile("" ::: "memory");
    const int c = lane & 7;
#pragma unroll
    for (int q = 0; q < 4; ++q) { const int n = (lane >> 3) + 8 * q; const LAS float* sp = scr + (8 * c) * 33 + n;
        if (j.mode & 32) { v2u o8; o8.x = pk_fp8x4(sp[0 * 33], sp[1 * 33], sp[2 * 33], sp[3 * 33], 512.f); o8.y = pk_fp8x4(sp[4 * 33], sp[5 * 33], sp[6 * 33], sp[7 * 33], 512.f);
            __builtin_nontemporal_store(o8, (v2u*)((unsigned char*)j.WT + (size_t)dst_row(n0 + n, j.mode & 3) * j.K + k0 + 8 * c)); }
        else { f32x4 ga = (f32x4){1.f, 1.f, 1.f, 1.f}, gb = ga;
            if (j.gain) { ga = *(const f32x4*)(j.gain + k0 + 8 * c); gb = *(const f32x4*)(j.gain + k0 + 8 * c + 4); }
            v4u o; o.x = pk2(sp[0 * 33] * ga[0], sp[1 * 33] * ga[1]); o.y = pk2(sp[2 * 33] * ga[2], sp[3 * 33] * ga[3]); o.z = pk2(sp[4 * 33] * gb[0], sp[5 * 33] * gb[1]); o.w = pk2(sp[6 * 33] * gb[2], sp[7 * 33] * gb[3]);
            __builtin_nontemporal_store(o, (v4u*)(j.WT + (size_t)dst_row(n0 + n, j.mode) * j.K + k0 + 8 * c)); } }
    LDS_WAIT(); asm volatile("" ::: "memory");
}
__device__ __forceinline__ void rms_row_to_bf16(const float* xrow, const float* gain, bf16* orow, int lane) {
    const f32x4* xr = (const f32x4*)xrow + lane; const f32x4* gr = (const f32x4*)gain + lane;
    f32x4 v[4]; float s = 0.f;
#pragma unroll
    for (int j = 0; j < 4; ++j) { v[j] = xr[64 * j]; s += (v[j].x * v[j].x + v[j].y * v[j].y) + (v[j].z * v[j].z + v[j].w * v[j].w); }
    const float rstd = 1.f / sqrtf(wave_sum(s) * (1.f / 1024.f) + EPS);
    unsigned long long* o8 = (unsigned long long*)orow + lane;
#pragma unroll
    for (int j = 0; j < 4; ++j) { const f32x4 g = gr[64 * j];
        o8[64 * j] = (unsigned long long)pk2(v[j].x * rstd * g.x, v[j].y * rstd * g.y) | ((unsigned long long)pk2(v[j].z * rstd * g.z, v[j].w * rstd * g.w) << 32); }
}
struct MoeW { const float* wg; const float* wu; const float* wd; unsigned char* gu8; unsigned char* dn8; };
__device__ __forceinline__ int moe_bg_items(int G) { return (G <= 256) ? G * NWAVES * 8 : 0; }
__device__ __forceinline__ TrJob moe_job(const MoeW& w, int r) {
    constexpr int IM = 1792; const int mtx = r / (8 * IM), e = (r / IM) & 7, it = r % IM;
    if (mtx == 0) return TrJob{w.wg + (size_t)e * 1024 * 3584, (bf16*)(w.gu8 + (size_t)e * 7168 * 1024), 1024, 3584, 1 | 32, it};
    if (mtx == 1) return TrJob{w.wu + (size_t)e * 1024 * 3584, (bf16*)(w.gu8 + (size_t)e * 7168 * 1024), 1024, 3584, 2 | 32, it};
    return TrJob{w.wd + (size_t)e * 3584 * 1024, (bf16*)(w.dn8 + (size_t)e * 1024 * 3584), 3584, 1024, 0 | 32, it};
}
__device__ __forceinline__ void rms_rows_to_bf16(const float* X, const float* gain, bf16* O, int gw, int NGW, int Mrows, int lane, bool f8 = false) {
    f32x4 g[4];
#pragma unroll
    for (int j = 0; j < 4; ++j) g[j] = ((const f32x4*)gain + lane)[64 * j];
    if (gw >= Mrows) return;
    f32x4 vn[4], vn2[4], vn3[4];
#define RMS_LOAD(dst, m_) do { const int mq_ = ((m_) < Mrows) ? (m_) : gw; _Pragma("unroll") for (int j = 0; j < 4; ++j) dst[j] = __builtin_nontemporal_load((const f32x4*)(X + (size_t)mq_ * 1024) + lane + 64 * j); } while (0)
    RMS_LOAD(vn, gw); RMS_LOAD(vn2, gw + NGW); RMS_LOAD(vn3, gw + 2 * NGW);
    for (int m = gw; m < Mrows; m += NGW) {
        f32x4 v[4];
#pragma unroll
        for (int j = 0; j < 4; ++j) { v[j] = vn[j]; vn[j] = vn2[j]; vn2[j] = vn3[j]; }
        RMS_LOAD(vn3, m + 3 * NGW);
        float s = 0.f;
#pragma unroll
        for (int j = 0; j < 4; ++j) s += (v[j].x * v[j].x + v[j].y * v[j].y) + (v[j].z * v[j].z + v[j].w * v[j].w);
        const float rstd = 1.f / sqrtf(wave_sum(s) * (1.f / 1024.f) + EPS);
        if (f8) { unsigned* o4 = (unsigned*)((unsigned char*)O + (size_t)m * 1024) + lane;
#pragma unroll
            for (int j = 0; j < 4; ++j) pg8::st_wt4(o4 + 64 * j, pk_fp8x4(v[j].x * rstd * g[j].x, v[j].y * rstd * g[j].y, v[j].z * rstd * g[j].z, v[j].w * rstd * g[j].w, 16.f)); }
        else { unsigned long long* o8 = (unsigned long long*)(O + (size_t)m * 1024) + lane;
#pragma unroll
            for (int j = 0; j < 4; ++j) o8[64 * j] = (unsigned long long)pk2(v[j].x * rstd * g[j].x, v[j].y * rstd * g[j].y) | ((unsigned long long)pk2(v[j].z * rstd * g[j].z, v[j].w * rstd * g[j].w) << 32); }
    }
}
__device__ __forceinline__ f32x4 ld_bf4(const bf16* p) { const v2u b = *(const v2u*)p; return (f32x4){__uint_as_float(b.x << 16), __uint_as_float(b.x & 0xffff0000u), __uint_as_float(b.y << 16), __uint_as_float(b.y & 0xffff0000u)}; }
__device__ __forceinline__ void rms_rows_bf16in(const bf16* X, int pitch, const float* gain, bf16* O, int gw, int NGW, int Mrows, int lane) {
    f32x4 g[4];
#pragma unroll
    for (int j = 0; j < 4; ++j) g[j] = ((const f32x4*)gain + lane)[64 * j];
    if (gw >= Mrows) return;
    f32x4 vn[4];
#pragma unroll
    for (int j = 0; j < 4; ++j) vn[j] = ld_bf4(X + (size_t)gw * pitch + 4 * (lane + 64 * j));
    for (int m = gw; m < Mrows; m += NGW) {
        f32x4 v[4];
#pragma unroll
        for (int j = 0; j < 4; ++j) v[j] = vn[j];
        const int mn = (m + NGW < Mrows) ? m + NGW : m;
#pragma unroll
        for (int j = 0; j < 4; ++j) vn[j] = ld_bf4(X + (size_t)mn * pitch + 4 * (lane + 64 * j));
        float s = 0.f;
#pragma unroll
        for (int j = 0; j < 4; ++j) s += (v[j].x * v[j].x + v[j].y * v[j].y) + (v[j].z * v[j].z + v[j].w * v[j].w);
        const float rstd = 1.f / sqrtf(wave_sum(s) * (1.f / 1024.f) + EPS);
        unsigned long long* o8 = (unsigned long long*)(O + (size_t)m * 1024) + lane;
#pragma unroll
        for (int j = 0; j < 4; ++j) o8[64 * j] = (unsigned long long)pk2(v[j].x * rstd * g[j].x, v[j].y * rstd * g[j].y) | ((unsigned long long)pk2(v[j].z * rstd * g[j].z, v[j].w * rstd * g[j].w) << 32);
    }
}
__device__ __forceinline__ float sigmoid_f(float x) { return 1.0f / (1.0f + __expf(-x)); }

struct MoeOrder {
    pg8::StaticOrder so; int nN; volatile LAS int* mt; const int* rowlist; LAS int* rowbuf;
    __device__ __forceinline__ void init(volatile LAS int* mt_, int nN_, int G, int c, const int* rl, int tmax = 1 << 20) { mt = mt_; nN = nN_; rowlist = rl; rowbuf = (LAS int*)((LAS unsigned char*)mt_ - (MISC_OFF + 64) + ROWBUF_OFF); const int T = mt_[8]; so.init((T < tmax ? T : tmax) * 256, nN_ * 256, G, c); }
    __device__ __forceinline__ bool next(int i, pg8::Unit& u) const {
        if (!so.next(i, u)) return false;
        int e = 0;
#pragma unroll
        for (int j = 1; j < 8; ++j) e += (u.pm >= mt[j]) ? 1 : 0;
        u.pn = e * nN + u.pn; u.kb = 0; return true;
    }
    __device__ __forceinline__ void a_ready(const pg8::Unit&) const {}
    __device__ __forceinline__ void done(const pg8::Unit&) const {}
    __device__ __forceinline__ void issue_rows(const pg8::Unit& u, int par, int wid, int lane) const {
        if (wid < 4) { const int e = u.pn / nN; const int lr = (u.pm - mt[e]) * 256 + wid * 64 + lane, c1 = mt[9 + e] - 1;
            __builtin_amdgcn_global_load_lds((const unsigned*)(rowlist + e * CAP + (lr < c1 ? lr : c1)), (LAS unsigned*)(rowbuf + par * 256 + wid * 64), 4, 0, 0); } }
    __device__ __forceinline__ int arow_lds(int r, int par) const { return rowbuf[par * 256 + r]; }
    __device__ __forceinline__ int arow(const pg8::Unit& u, int r) const { const int e = u.pn / nN; const int lr = (u.pm - mt[e]) * 256 + r, c1 = mt[9 + e] - 1; return rowlist[e * CAP + (lr < c1 ? lr : c1)]; }
};


namespace mla_attn {
using bf16x8=__attribute__((ext_vector_type(8)))short;
using s16x4=__attribute__((ext_vector_type(4)))short;
using f32x16=__attribute__((ext_vector_type(16)))float;
using u32x4=__attribute__((ext_vector_type(4)))unsigned;
typedef __attribute__((address_space(3))) const char* lds_cptr;
constexpr int NW=8,QBLK=32,QB=256,KVBLK=64;
constexpr int KSLOT=12288,VSLOT=8192,NSLOT=3;
constexpr int LDS_K=0,LDS_V=NSLOT*KSLOT,LDS_WS=LDS_V+NSLOT*VSLOT,LDS_OST=LDS_WS+NW*64*4,LDS_BYTES_A=LDS_OST+NW*4096;
__device__ __forceinline__ int crow(int r,int hi){return (r&3)+8*(r>>2)+4*hi;}
__device__ __forceinline__ void glds16(const void*gsrc,unsigned lds_dst){unsigned keep;
  asm volatile("s_mov_b32 %0, m0\n\ts_mov_b32 m0, %2\n\ts_nop 0\n\tglobal_load_lds_dwordx4 %1, off\n\ts_mov_b32 m0, %0":"=&s"(keep):"v"(gsrc),"s"(lds_dst):"memory");}
typedef float f32x2_t __attribute__((ext_vector_type(2))); typedef __bf16 bf16x2_t __attribute__((ext_vector_type(2)));
__device__ __forceinline__ unsigned cvtpk_s(float lo,float hi){f32x2_t v={lo,hi};bf16x2_t b=__builtin_convertvector(v,bf16x2_t);return __builtin_bit_cast(unsigned,b);}
__device__ __forceinline__ void glds16s(const void*sbase,unsigned voff,unsigned lds_dst){unsigned keep;
  asm volatile("s_mov_b32 %0, m0\n\ts_mov_b32 m0, %3\n\ts_nop 0\n\tglobal_load_lds_dwordx4 %1, %2\n\ts_mov_b32 m0, %0":"=&s"(keep):"v"(voff),"s"(sbase),"s"(lds_dst):"memory");}
#define MLA_WAIT_BAR(N) asm volatile("s_waitcnt vmcnt(" #N ") lgkmcnt(0)\n\ts_barrier":::"memory")
__device__ __forceinline__ void cmask(f32x16&p0,f32x16&p1,int jb,int qrel,int hi){
  const float NEG=-INFINITY; int kb=64*jb+4*hi;
  #pragma unroll
  for(int r=0;r<16;++r){int kv=kb+(r&3)+8*(r>>2); if(kv>qrel)p0[r]=NEG; if(kv+32>qrel)p1[r]=NEG;}
}
__device__ __forceinline__ void qkt6(f32x16&p0,f32x16&p1,lds_cptr kslot,const bf16x8*qr,const f32x16&negm,int r32,int hi){
  lds_cptr kb=kslot+hi*1024+r32*16;
  #pragma unroll
  for(int d0=0;d0<6;++d0){
    const bf16x8 b0=*(const __attribute__((address_space(3))) bf16x8*)(kb+d0*2048);
    const bf16x8 b1=*(const __attribute__((address_space(3))) bf16x8*)(kb+d0*2048+512);
    if(d0==0){p0=__builtin_amdgcn_mfma_f32_32x32x16_bf16(b0,qr[0],negm,0,0,0);p1=__builtin_amdgcn_mfma_f32_32x32x16_bf16(b1,qr[0],negm,0,0,0);}
    else{p0=__builtin_amdgcn_mfma_f32_32x32x16_bf16(b0,qr[d0],p0,0,0,0);p1=__builtin_amdgcn_mfma_f32_32x32x16_bf16(b1,qr[d0],p1,0,0,0);}}
}
__device__ __forceinline__ float rowmax(const f32x16&p0,const f32x16&p1){
  float a=__builtin_fmaxf(__builtin_fmaxf(p0[0],p0[1]),p1[0]),b=__builtin_fmaxf(__builtin_fmaxf(p0[2],p0[3]),p1[1]);a=__builtin_fmaxf(__builtin_fmaxf(a,p1[2]),p1[3]);
  #pragma unroll
  for(int r=4;r<16;r+=4){a=__builtin_fmaxf(__builtin_fmaxf(a,p0[r]),p0[r+1]);b=__builtin_fmaxf(__builtin_fmaxf(b,p0[r+2]),p0[r+3]);a=__builtin_fmaxf(__builtin_fmaxf(a,p1[r]),p1[r+1]);b=__builtin_fmaxf(__builtin_fmaxf(b,p1[r+2]),p1[r+3]);}
  const float m=__builtin_fmaxf(a,b);
  auto rr=__builtin_amdgcn_permlane32_swap(__float_as_uint(m),__float_as_uint(m),false,false);
  return __builtin_fmaxf(__uint_as_float(rr[0]),__uint_as_float(rr[1]));
}
__device__ __forceinline__ void pv(f32x16*o,int vb,bf16x8 pa0,bf16x8 pa1,bf16x8 pa2,bf16x8 pa3){
  #pragma unroll
  for(int d0=0;d0<2;++d0){s16x4 lo[4],hi[4];
    #pragma unroll
    for(int ks=0;ks<4;++ks){
      asm volatile("ds_read_b64_tr_b16 %0,%1 offset:%c2":"=&v"(lo[ks]):"v"(vb),"i"(d0*4096+ks*1024):"memory");
      asm volatile("ds_read_b64_tr_b16 %0,%1 offset:%c2":"=&v"(hi[ks]):"v"(vb),"i"(d0*4096+ks*1024+512):"memory");}
    asm volatile("s_waitcnt lgkmcnt(0)":::"memory");__builtin_amdgcn_sched_barrier(0);
    #define PK(k) (bf16x8){lo[k][0],lo[k][1],lo[k][2],lo[k][3],hi[k][0],hi[k][1],hi[k][2],hi[k][3]}
    o[d0]=__builtin_amdgcn_mfma_f32_32x32x16_bf16(pa0,PK(0),o[d0],0,0,0);
    o[d0]=__builtin_amdgcn_mfma_f32_32x32x16_bf16(pa1,PK(1),o[d0],0,0,0);
    o[d0]=__builtin_amdgcn_mfma_f32_32x32x16_bf16(pa2,PK(2),o[d0],0,0,0);
    o[d0]=__builtin_amdgcn_mfma_f32_32x32x16_bf16(pa3,PK(3),o[d0],0,0,0);
    #undef PK
  }
}
constexpr int QPITCH=1536,KVPITCH=2048,KRPITCH=32,OPITCH=1024,SEQ_=4096;
template<int THRL> __device__ __forceinline__ void attn_unit(int b,int h,int qb,const unsigned short*Q,const unsigned short*KV,const unsigned short*KR,const float*COS,const float*SIN,unsigned short*O,char*shm){
  const int tid=threadIdx.x,lane=tid&63,r32=lane&31,hi=lane>>5; const int wid=__builtin_amdgcn_readfirstlane(tid>>6);
  const long rowbase=(long)b*SEQ_; const int q0=qb*QB;
  const unsigned short*Qw=Q+(rowbase+q0+wid*QBLK)*QPITCH+h*96;
  const unsigned short*Kh=KV+rowbase*KVPITCH+h*128,*Vh=Kh+64,*KRb=KR+rowbase*KRPITCH;
  const unsigned lds0=(unsigned)(uintptr_t)shm;
  float*wsf=(float*)(shm+LDS_WS)+wid*64;
  const unsigned short*ksrc0=Kh+(long)lane*KVPITCH+wid*8;
  const unsigned short*ksrc1=KRb+(long)lane*KRPITCH+(wid&3)*8;
  const unsigned short*vsrc=Vh+(long)(16*(wid&3)+(lane>>2))*KVPITCH+(wid>>2)*32+(lane&3)*8;
  const unsigned kdst0=lds0+LDS_K+wid*1024,kdst1=lds0+LDS_K+(8+(wid&3))*1024,vdst=lds0+LDS_V+wid*1024;
  #define DMA_T(t,sl) do{ glds16(ksrc0+(long)(t)*KVBLK*KVPITCH,(unsigned)__builtin_amdgcn_readfirstlane(kdst0+(sl)*KSLOT)); \
                          glds16(ksrc1+(long)(t)*KVBLK*KRPITCH,(unsigned)__builtin_amdgcn_readfirstlane(kdst1+(sl)*KSLOT)); \
                          glds16(vsrc+(long)(t)*KVBLK*KVPITCH,(unsigned)__builtin_amdgcn_readfirstlane(vdst+(sl)*VSLOT)); }while(0)
  const int vb0=(int)(lds0+LDS_V)+((lane>>4)&1)*32+(lane&3)*8+(4*hi+((lane&15)>>2))*64;
  const lds_cptr shm3=(lds_cptr)(__attribute__((address_space(3))) char*)shm;
  const int NT=(q0+QB)/KVBLK;
  bf16x8 qr[6];
  #pragma unroll
  for(int d0=0;d0<6;++d0)qr[d0]=*reinterpret_cast<const bf16x8*>(&Qw[(long)r32*QPITCH+d0*16+hi*8]);
  {
    const float*cp=COS+(rowbase+q0+wid*QBLK+r32)*16+hi*8,*sp=SIN+(rowbase+q0+wid*QBLK+r32)*16+hi*8;
    float cs[8],sn[8];
    #pragma unroll
    for(int j=0;j<8;++j){cs[j]=cp[j];sn[j]=sp[j];}
    const float sc=0.10206207261596577f*1.4426950408889634f;
    float x1[8],x2[8];
    #pragma unroll
    for(int j=0;j<8;++j){x1[j]=__uint_as_float(((unsigned)(unsigned short)qr[4][j])<<16);x2[j]=__uint_as_float(((unsigned)(unsigned short)qr[5][j])<<16);}
    #pragma unroll
    for(int j=0;j<8;j+=2){
      const unsigned a=cvtpk_s((x1[j]*cs[j]-x2[j]*sn[j])*sc,(x1[j+1]*cs[j+1]-x2[j+1]*sn[j+1])*sc), c=cvtpk_s((x2[j]*cs[j]+x1[j]*sn[j])*sc,(x2[j+1]*cs[j+1]+x1[j+1]*sn[j+1])*sc);
      qr[4][j]=(short)(a&0xffffu);qr[4][j+1]=(short)(a>>16);qr[5][j]=(short)(c&0xffffu);qr[5][j+1]=(short)(c>>16);}
    #pragma unroll
    for(int d0=0;d0<4;++d0)
      #pragma unroll
      for(int j=0;j<8;j+=2){const unsigned a=cvtpk_s(__uint_as_float(((unsigned)(unsigned short)qr[d0][j])<<16)*sc,__uint_as_float(((unsigned)(unsigned short)qr[d0][j+1])<<16)*sc);
        qr[d0][j]=(short)(a&0xffffu);qr[d0][j+1]=(short)(a>>16);}
  }
  asm volatile("s_waitcnt vmcnt(0)":::"memory");
  DMA_T(0,0); DMA_T(1,1);
  float mhat=0.f,l_reg=0.f;f32x16 o[2];o[0]=f32x16{};o[1]=f32x16{};f32x16 negm=f32x16{};
  const int qrel=wid*QBLK+r32;
  int sl=0;
  for(int t=0;t<NT;++t){
    if(t+1<NT){MLA_WAIT_BAR(3);}else{MLA_WAIT_BAR(0);}
    if(t+2<NT){const int s2=(sl==0)?2:sl-1; DMA_T(t+2,s2);}
    f32x16 p0,p1;
    qkt6(p0,p1,shm3+LDS_K+sl*KSLOT,qr,negm,r32,hi);
    if(t>=NT-4)cmask(p0,p1,t-(NT-4),qrel,hi);
    const float rm=rowmax(p0,p1);
    bool resc=false;
    if(t==0){ const float dl=rm; mhat+=dl;
      #pragma unroll
      for(int r=0;r<16;++r){p0[r]-=dl;p1[r]-=dl;}
      #pragma unroll
      for(int r=0;r<16;++r)negm[r]=-mhat;
    } else if(__any(rm>(float)THRL)){ const float dl=__builtin_fmaxf(rm,0.f); mhat+=dl;
      #pragma unroll
      for(int r=0;r<16;++r){p0[r]-=dl;p1[r]-=dl;}
      #pragma unroll
      for(int r=0;r<16;++r)negm[r]=-mhat;
      const float f=__builtin_amdgcn_exp2f(-dl); l_reg*=f; if(hi==0)wsf[r32]=f; resc=true; }
    float sacc=0.f;
    #pragma unroll
    for(int r=0;r<16;++r){p0[r]=__builtin_amdgcn_exp2f(p0[r]);p1[r]=__builtin_amdgcn_exp2f(p1[r]);sacc+=p0[r]+p1[r];}
    l_reg+=sacc;
    if(resc){ asm volatile("s_waitcnt lgkmcnt(0)":::"memory");
      #pragma unroll
      for(int d_=0;d_<2;++d_)
        #pragma unroll
        for(int r=0;r<16;++r)o[d_][r]*=wsf[crow(r,hi)]; }
    u32x4 pw0,pw1,pw2,pw3;
    pw0=(u32x4){cvtpk_s(p0[0],p0[1]),cvtpk_s(p0[2],p0[3]),cvtpk_s(p0[4],p0[5]),cvtpk_s(p0[6],p0[7])};
    pw1=(u32x4){cvtpk_s(p0[8],p0[9]),cvtpk_s(p0[10],p0[11]),cvtpk_s(p0[12],p0[13]),cvtpk_s(p0[14],p0[15])};
    pw2=(u32x4){cvtpk_s(p1[0],p1[1]),cvtpk_s(p1[2],p1[3]),cvtpk_s(p1[4],p1[5]),cvtpk_s(p1[6],p1[7])};
    pw3=(u32x4){cvtpk_s(p1[8],p1[9]),cvtpk_s(p1[10],p1[11]),cvtpk_s(p1[12],p1[13]),cvtpk_s(p1[14],p1[15])};
    pv(o,vb0+sl*VSLOT,__builtin_bit_cast(bf16x8,pw0),__builtin_bit_cast(bf16x8,pw1),__builtin_bit_cast(bf16x8,pw2),__builtin_bit_cast(bf16x8,pw3));
    sl=(sl==2)?0:sl+1;
  }
  {auto rr=__builtin_amdgcn_permlane32_swap(__float_as_uint(l_reg),__float_as_uint(l_reg),false,false);l_reg=__uint_as_float(rr[0])+__uint_as_float(rr[1]);}
  if(hi==0)wsf[32+r32]=l_reg;asm volatile("s_waitcnt lgkmcnt(0)":::"memory");
  float rli[16];
  #pragma unroll
  for(int r=0;r<16;++r)rli[r]=__builtin_amdgcn_rcpf(wsf[32+crow(r,hi)]);
  unsigned short*Ow=O+(rowbase+q0+wid*QBLK)*OPITCH+h*64;
  { unsigned short*stg=(unsigned short*)(shm+LDS_OST)+wid*2048;
    #pragma unroll
    for(int r=0;r<16;++r){const int orow=crow(r,hi);
      #pragma unroll
      for(int d0=0;d0<2;++d0)stg[orow*64+d0*32+r32]=(unsigned short)(cvtpk_s(o[d0][r]*rli[r],0.f)&0xffffu);}
    asm volatile("s_waitcnt lgkmcnt(0)":::"memory");
    #pragma unroll
    for(int i=0;i<4;++i){const int row=i*8+(lane>>3),ch=lane&7; const u32x4 v=*(const u32x4*)(stg+row*64+ch*8); *(u32x4*)(Ow+(long)row*OPITCH+ch*8)=v;} }
  asm volatile("s_waitcnt vmcnt(0) lgkmcnt(0)\n\ts_barrier":::"memory");
  #undef DMA_T
}

typedef short v4i16_t __attribute__((ext_vector_type(4)));
__device__ __forceinline__ s16x4 vtr(lds_cptr p){ return __builtin_bit_cast(s16x4,__builtin_amdgcn_ds_read_tr16_b64_v4i16((__attribute__((address_space(3))) v4i16_t*)p)); }
template<int THRL> __device__ __forceinline__ void attn_unit2(int b,int h,int qb,const unsigned short*Q,const unsigned short*KV,const unsigned short*KR,const float*COS,const float*SIN,unsigned short*O,char*shm){
  const int tid=threadIdx.x,lane=tid&63,r32=lane&31,hi=lane>>5; const int wid=__builtin_amdgcn_readfirstlane(tid>>6);
  const long rowbase=(long)b*SEQ_; const int q0=qb*QB;
  const unsigned short*Qw=Q+(rowbase+q0+wid*QBLK)*QPITCH+h*96;
  const unsigned short*Kh=KV+rowbase*KVPITCH+h*128,*Vh=Kh+64,*KRb=KR+rowbase*KRPITCH;
  const unsigned lds0=(unsigned)(uintptr_t)shm;
  float*wsf=(float*)(shm+LDS_WS)+wid*64;
  const unsigned koff0=(unsigned)(lane*KVPITCH+wid*8)*2u, koff1=(unsigned)(lane*KRPITCH+(wid&3)*8)*2u, voffv=(unsigned)((16*(wid&3)+(lane>>2))*KVPITCH+(wid>>2)*32+(lane&3)*8)*2u;
  const unsigned kdst0=lds0+LDS_K+wid*1024,kdst1=lds0+LDS_K+(8+(wid&3))*1024,vdst=lds0+LDS_V+wid*1024;
  #define DMA_K2(t,sl) do{ glds16s(Kh+(long)(t)*KVBLK*KVPITCH,koff0,(unsigned)__builtin_amdgcn_readfirstlane(kdst0+(sl)*KSLOT)); \
                           glds16s(KRb+(long)(t)*KVBLK*KRPITCH,koff1,(unsigned)__builtin_amdgcn_readfirstlane(kdst1+(sl)*KSLOT)); }while(0)
  #define DMA_V2(t,sl) glds16s(Vh+(long)(t)*KVBLK*KVPITCH,voffv,(unsigned)__builtin_amdgcn_readfirstlane(vdst+(sl)*VSLOT))
  const lds_cptr shm3=(lds_cptr)(__attribute__((address_space(3))) char*)shm;
  const lds_cptr vp0=shm3+LDS_V+((lane>>4)&1)*32+(lane&3)*8+(4*hi+((lane&15)>>2))*64;
  const int NT=(q0+QB)/KVBLK;
  DMA_K2(0,0); DMA_V2(0,0); DMA_K2(1,1);
  bf16x8 qr[6];
  #pragma unroll
  for(int d0=0;d0<6;++d0)qr[d0]=*reinterpret_cast<const bf16x8*>(&Qw[(long)r32*QPITCH+d0*16+hi*8]);
  { const float*cp=COS+(rowbase+q0+wid*QBLK+r32)*16+hi*8,*sp=SIN+(rowbase+q0+wid*QBLK+r32)*16+hi*8;
    float cs[8],sn[8];
    #pragma unroll
    for(int j=0;j<8;++j){cs[j]=cp[j];sn[j]=sp[j];}
    const float sc=0.10206207261596577f*1.4426950408889634f;
    float x1[8],x2[8];
    #pragma unroll
    for(int j=0;j<8;++j){x1[j]=__uint_as_float(((unsigned)(unsigned short)qr[4][j])<<16);x2[j]=__uint_as_float(((unsigned)(unsigned short)qr[5][j])<<16);}
    #pragma unroll
    for(int j=0;j<8;j+=2){
      const unsigned a=cvtpk_s((x1[j]*cs[j]-x2[j]*sn[j])*sc,(x1[j+1]*cs[j+1]-x2[j+1]*sn[j+1])*sc), c=cvtpk_s((x2[j]*cs[j]+x1[j]*sn[j])*sc,(x2[j+1]*cs[j+1]+x1[j+1]*sn[j+1])*sc);
      qr[4][j]=(short)(a&0xffffu);qr[4][j+1]=(short)(a>>16);qr[5][j]=(short)(c&0xffffu);qr[5][j+1]=(short)(c>>16);}
    #pragma unroll
    for(int d0=0;d0<4;++d0)
      #pragma unroll
      for(int j=0;j<8;j+=2){const unsigned a=cvtpk_s(__uint_as_float(((unsigned)(unsigned short)qr[d0][j])<<16)*sc,__uint_as_float(((unsigned)(unsigned short)qr[d0][j+1])<<16)*sc);
        qr[d0][j]=(short)(a&0xffffu);qr[d0][j+1]=(short)(a>>16);}
  }
  float mhat=0.f,l_reg=0.f;f32x16 o[2];o[0]=f32x16{};o[1]=f32x16{};f32x16 negm=f32x16{};
  const int qrel=wid*QBLK+r32;
  f32x16 p0,p1;
  MLA_WAIT_BAR(3);
  DMA_K2(2,2); DMA_V2(1,1);
  qkt6(p0,p1,shm3+LDS_K,qr,negm,r32,hi);
  if(NT==4)cmask(p0,p1,0,qrel,hi);
  { const float dl=rowmax(p0,p1); mhat+=dl;
    #pragma unroll
    for(int r=0;r<16;++r){p0[r]=__builtin_amdgcn_exp2f(p0[r]-dl);p1[r]=__builtin_amdgcn_exp2f(p1[r]-dl);}
    #pragma unroll
    for(int r=0;r<16;++r)negm[r]=-mhat; }
  int sk=1,sv=0;
  auto step=[&](const int t,f32x16&p0,f32x16&p1,f32x16&c0,f32x16&c1) __attribute__((always_inline)) {
    if(t+1<NT){MLA_WAIT_BAR(3);}else{MLA_WAIT_BAR(1);}
    if(t+2<NT){DMA_K2(t+2,(sk==0)?2:sk-1);}
    if(t+1<NT){DMA_V2(t+1,(sv==0)?2:sv-1);}
    s16x4 vlo[8],vhi[8];
    u32x4 pwa[4];
    float sacc=0.f;
    const lds_cptr vp_=vp0+sv*VSLOT;
    const lds_cptr kbp=shm3+LDS_K+sk*KSLOT+hi*1024+r32*16;
    #define SB_() __builtin_amdgcn_sched_barrier(0)
    #define PINV(x) asm volatile("":"+v"(x))
    #define KF(g) (*(const __attribute__((address_space(3))) bf16x8*)(kbp+((g)>>1)*2048+((g)&1)*512))
    #define PFLAT(i) ((i)<16?p0[(i)&15]:p1[(i)&15])
    #define VRD_(i) do{ vlo[i]=vtr(vp_+(((i)>>2)*4096+((i)&3)*1024)); vhi[i]=vtr(vp_+(((i)>>2)*4096+((i)&3)*1024+512)); }while(0)
    #define FILL(i) do{ if(((i)&3)<2){VRD_(i);} \
        sacc+=(PFLAT(4*(i))+PFLAT(4*(i)+1))+(PFLAT(4*(i)+2)+PFLAT(4*(i)+3)); PINV(sacc); \
        pwa[(i)>>1][2*((i)&1)]=cvtpk_s(PFLAT(4*(i)),PFLAT(4*(i)+1)); pwa[(i)>>1][2*((i)&1)+1]=cvtpk_s(PFLAT(4*(i)+2),PFLAT(4*(i)+3)); PINV(pwa[(i)>>1]); }while(0)
    bf16x8 k0=KF(0),k1=KF(1),k2=KF(2),k3=KF(3);
    SB_();
    __builtin_amdgcn_s_setprio(1);
    c0=__builtin_amdgcn_mfma_f32_32x32x16_bf16(k0,qr[0],negm,0,0,0); k0=KF(4);  FILL(0); SB_();
    c1=__builtin_amdgcn_mfma_f32_32x32x16_bf16(k1,qr[0],negm,0,0,0); k1=KF(5);  FILL(1); SB_();
    c0=__builtin_amdgcn_mfma_f32_32x32x16_bf16(k2,qr[1],c0,0,0,0);   k2=KF(6);  FILL(2); SB_();
    c1=__builtin_amdgcn_mfma_f32_32x32x16_bf16(k3,qr[1],c1,0,0,0);   k3=KF(7);  FILL(3); SB_();
    c0=__builtin_amdgcn_mfma_f32_32x32x16_bf16(k0,qr[2],c0,0,0,0);   k0=KF(8);  FILL(4); SB_();
    c1=__builtin_amdgcn_mfma_f32_32x32x16_bf16(k1,qr[2],c1,0,0,0);   k1=KF(9);  FILL(5); SB_();
    c0=__builtin_amdgcn_mfma_f32_32x32x16_bf16(k2,qr[3],c0,0,0,0);   k2=KF(10); FILL(6); SB_();
    c1=__builtin_amdgcn_mfma_f32_32x32x16_bf16(k3,qr[3],c1,0,0,0);   k3=KF(11); FILL(7); SB_();
    c0=__builtin_amdgcn_mfma_f32_32x32x16_bf16(k0,qr[4],c0,0,0,0);
    c1=__builtin_amdgcn_mfma_f32_32x32x16_bf16(k1,qr[4],c1,0,0,0);
    c0=__builtin_amdgcn_mfma_f32_32x32x16_bf16(k2,qr[5],c0,0,0,0);
    c1=__builtin_amdgcn_mfma_f32_32x32x16_bf16(k3,qr[5],c1,0,0,0);
    SB_();
    l_reg+=sacc;
    if(t>=NT-4)cmask(c0,c1,t-(NT-4),qrel,hi);
    #define VFRG(i) (bf16x8){vlo[i][0],vlo[i][1],vlo[i][2],vlo[i][3],vhi[i][0],vhi[i][1],vhi[i][2],vhi[i][3]}
    #define MX3_(a,b,c) __builtin_fmaxf(__builtin_fmaxf((a),(b)),(c))
    #define EXN(X,B,N) do{ _Pragma("unroll") for(int e_=0;e_<(N);++e_) X[(B)+e_]=__builtin_amdgcn_exp2f(X[(B)+e_]); PINV(X); SB_(); }while(0)
    float ma,mb;
    o[0]=__builtin_amdgcn_mfma_f32_32x32x16_bf16(__builtin_bit_cast(bf16x8,pwa[0]),VFRG(0),o[0],0,0,0);
    ma=MX3_(c0[0],c0[1],c1[0]); mb=MX3_(c0[2],c0[3],c1[1]); ma=MX3_(ma,c1[2],c1[3]);
    ma=MX3_(ma,c0[4],c0[5]); mb=MX3_(mb,c0[6],c0[7]); ma=MX3_(ma,c1[4],c1[5]); mb=MX3_(mb,c1[6],c1[7]); PINV(ma); PINV(mb); VRD_(2); VRD_(6); SB_();
    o[1]=__builtin_amdgcn_mfma_f32_32x32x16_bf16(__builtin_bit_cast(bf16x8,pwa[0]),VFRG(4),o[1],0,0,0);
    ma=MX3_(ma,c0[8],c0[9]); mb=MX3_(mb,c0[10],c0[11]); ma=MX3_(ma,c1[8],c1[9]); mb=MX3_(mb,c1[10],c1[11]);
    ma=MX3_(ma,c0[12],c0[13]); mb=MX3_(mb,c0[14],c0[15]); ma=MX3_(ma,c1[12],c1[13]); mb=MX3_(mb,c1[14],c1[15]);
    float rm=__builtin_fmaxf(ma,mb);
    { auto rr=__builtin_amdgcn_permlane32_swap(__float_as_uint(rm),__float_as_uint(rm),false,false); rm=__builtin_fmaxf(__uint_as_float(rr[0]),__uint_as_float(rr[1])); }
    PINV(rm); VRD_(3); VRD_(7); __builtin_amdgcn_s_setprio(0); SB_();
    bool resc=false;
    if(__any(rm>(float)THRL)){ const float dl=__builtin_fmaxf(rm,0.f); mhat+=dl;
      #pragma unroll
      for(int r=0;r<16;++r){c0[r]-=dl;c1[r]-=dl;}
      #pragma unroll
      for(int r=0;r<16;++r)negm[r]=-mhat;
      const float f=__builtin_amdgcn_exp2f(-dl); l_reg*=f; if(hi==0)wsf[r32]=f; resc=true; }
    SB_();
    o[0]=__builtin_amdgcn_mfma_f32_32x32x16_bf16(__builtin_bit_cast(bf16x8,pwa[1]),VFRG(1),o[0],0,0,0); EXN(c0,0,5);
    o[1]=__builtin_amdgcn_mfma_f32_32x32x16_bf16(__builtin_bit_cast(bf16x8,pwa[1]),VFRG(5),o[1],0,0,0); EXN(c0,5,5);
    o[0]=__builtin_amdgcn_mfma_f32_32x32x16_bf16(__builtin_bit_cast(bf16x8,pwa[2]),VFRG(2),o[0],0,0,0); EXN(c0,10,6);
    o[1]=__builtin_amdgcn_mfma_f32_32x32x16_bf16(__builtin_bit_cast(bf16x8,pwa[2]),VFRG(6),o[1],0,0,0); EXN(c1,0,5);
    o[0]=__builtin_amdgcn_mfma_f32_32x32x16_bf16(__builtin_bit_cast(bf16x8,pwa[3]),VFRG(3),o[0],0,0,0); EXN(c1,5,5);
    o[1]=__builtin_amdgcn_mfma_f32_32x32x16_bf16(__builtin_bit_cast(bf16x8,pwa[3]),VFRG(7),o[1],0,0,0); EXN(c1,10,6);
    #undef MX3_
    #undef EXN
    #undef KF
    #undef FILL
    #undef VRD_
    if(resc){ asm volatile("s_waitcnt lgkmcnt(0)":::"memory");
      #pragma unroll
      for(int d_=0;d_<2;++d_)
        #pragma unroll
        for(int r=0;r<16;++r)o[d_][r]*=wsf[crow(r,hi)]; }
    sk=(sk==2)?0:sk+1; sv=(sv==2)?0:sv+1;
  };
  { f32x16 c0,c1; int t=1;
    for(;t+1<NT;t+=2){ step(t,p0,p1,c0,c1); step(t+1,c0,c1,p0,p1); }
    if(t<NT){ step(t,p0,p1,c0,c1); p0=c0; p1=c1; } }
  MLA_WAIT_BAR(0);
  { s16x4 vlo[8],vhi[8]; const lds_cptr vp_=vp0+sv*VSLOT;
    #pragma unroll
    for(int i=0;i<8;++i){ vlo[i]=vtr(vp_+((i>>2)*4096+(i&3)*1024)); vhi[i]=vtr(vp_+((i>>2)*4096+(i&3)*1024+512)); }
    float sacc=0.f;
    #pragma unroll
    for(int r=0;r<16;++r)sacc+=p0[r]+p1[r];
    l_reg+=sacc;
    u32x4 pw0,pw1,pw2,pw3;
    pw0=(u32x4){cvtpk_s(p0[0],p0[1]),cvtpk_s(p0[2],p0[3]),cvtpk_s(p0[4],p0[5]),cvtpk_s(p0[6],p0[7])};
    pw1=(u32x4){cvtpk_s(p0[8],p0[9]),cvtpk_s(p0[10],p0[11]),cvtpk_s(p0[12],p0[13]),cvtpk_s(p0[14],p0[15])};
    pw2=(u32x4){cvtpk_s(p1[0],p1[1]),cvtpk_s(p1[2],p1[3]),cvtpk_s(p1[4],p1[5]),cvtpk_s(p1[6],p1[7])};
    pw3=(u32x4){cvtpk_s(p1[8],p1[9]),cvtpk_s(p1[10],p1[11]),cvtpk_s(p1[12],p1[13]),cvtpk_s(p1[14],p1[15])};
    o[0]=__builtin_amdgcn_mfma_f32_32x32x16_bf16(__builtin_bit_cast(bf16x8,pw0),VFRG(0),o[0],0,0,0);
    o[1]=__builtin_amdgcn_mfma_f32_32x32x16_bf16(__builtin_bit_cast(bf16x8,pw0),VFRG(4),o[1],0,0,0);
    o[0]=__builtin_amdgcn_mfma_f32_32x32x16_bf16(__builtin_bit_cast(bf16x8,pw1),VFRG(1),o[0],0,0,0);
    o[1]=__builtin_amdgcn_mfma_f32_32x32x16_bf16(__builtin_bit_cast(bf16x8,pw1),VFRG(5),o[1],0,0,0);
    o[0]=__builtin_amdgcn_mfma_f32_32x32x16_bf16(__builtin_bit_cast(bf16x8,pw2),VFRG(2),o[0],0,0,0);
    o[1]=__builtin_amdgcn_mfma_f32_32x32x16_bf16(__builtin_bit_cast(bf16x8,pw2),VFRG(6),o[1],0,0,0);
    o[0]=__builtin_amdgcn_mfma_f32_32x32x16_bf16(__builtin_bit_cast(bf16x8,pw3),VFRG(3),o[0],0,0,0);
    o[1]=__builtin_amdgcn_mfma_f32_32x32x16_bf16(__builtin_bit_cast(bf16x8,pw3),VFRG(7),o[1],0,0,0);
    #undef VFRG
  }
  {auto rr=__builtin_amdgcn_permlane32_swap(__float_as_uint(l_reg),__float_as_uint(l_reg),false,false);l_reg=__uint_as_float(rr[0])+__uint_as_float(rr[1]);}
  if(hi==0)wsf[32+r32]=l_reg;asm volatile("s_waitcnt lgkmcnt(0)":::"memory");
  float rli[16];
  #pragma unroll
  for(int r=0;r<16;++r)rli[r]=__builtin_amdgcn_rcpf(wsf[32+crow(r,hi)]);
  unsigned char*Ow=(unsigned char*)O+(rowbase+q0+wid*QBLK)*OPITCH+h*64;
  { unsigned char*stg=(unsigned char*)(shm+LDS_OST)+wid*2048;
    #pragma unroll
    for(int r=0;r<16;++r){const int orow=crow(r,hi);
      const float s_=rli[r]*64.f;
      const int pk=__builtin_amdgcn_cvt_pk_fp8_f32(__builtin_amdgcn_fmed3f(o[0][r]*s_,-448.f,448.f),__builtin_amdgcn_fmed3f(o[1][r]*s_,-448.f,448.f),0,false);
      stg[orow*64+r32]=(unsigned char)(pk&0xff); stg[orow*64+32+r32]=(unsigned char)((pk>>8)&0xff);}
    asm volatile("s_waitcnt lgkmcnt(0)":::"memory");
    #pragma unroll
    for(int i=0;i<2;++i){const int row=i*16+(lane>>2),ch=lane&3; const u32x4 v=*(const u32x4*)(stg+row*64+ch*16); pg8::st_wt16(Ow+(long)row*OPITCH+ch*16,v);} }
  asm volatile("s_waitcnt lgkmcnt(0)\n\ts_barrier":::"memory");
  #undef DMA_K2
  #undef DMA_V2
  #undef PFLAT
  #undef SB_
  #undef PINV
}
}


namespace hg {
typedef float f32x4 __attribute__((ext_vector_type(4)));
typedef short bf16x8 __attribute__((ext_vector_type(8)));
typedef unsigned u32x4 __attribute__((ext_vector_type(4)));
typedef unsigned u32x2 __attribute__((ext_vector_type(2)));
#define HLAS __attribute__((address_space(3)))
constexpr int NSEG = 8, CPS = 64 / NSEG;
constexpr int L_Q = 0, L_F = 16384, L_V = 32768, L_K1T = 49152, L_VT = 67584, L_A = 86016, L_ST = 95232, L_TOT = L_A, L_END = 130048;
constexpr int L_CM = 132096, L_CL = 132608;
constexpr int P144 = 144, P272 = 272;
__device__ __forceinline__ float bf2f_(unsigned short b) { return __uint_as_float((unsigned)b << 16); }
__device__ __forceinline__ unsigned pk_(float lo, float hi) { return pk2(lo, hi); }
__device__ __forceinline__ unsigned f2bf_(float f) { return pk_(f, 0.f) & 0xffffu; }
__device__ __forceinline__ int swz(int t, int c) { return t * 256 + ((c ^ (t & 15)) << 4); }
__device__ __forceinline__ int swz_e(int t, int k) { return swz(t, k >> 3) + (k & 7) * 2; }
#define HG_BAR() do { asm volatile("s_waitcnt lgkmcnt(0)" ::: "memory"); __builtin_amdgcn_s_barrier(); asm volatile("" ::: "memory"); } while (0)
#define HG_MFMA(a, b, c) __builtin_amdgcn_mfma_f32_16x16x32_bf16((a), (b), (c), 0, 0, 0)

__device__ __forceinline__ int hg_unit(int it, int G) { if (G != 32 * NSEG || NSEG != 8) return it; const int x = it & 7, j = it >> 3; return (x * 4 + (j & 3)) * NSEG + (j >> 2); }
struct P1Args { const unsigned short* HP; const float* lbp; unsigned short* OL; unsigned short* Q1G; float* WN; float* SS; float* DSEG; };
__device__ __forceinline__ void hg_pass1(HLAS unsigned char* L, const P1Args& a, int G) {
    const int tid = threadIdx.x, lane = tid & 63, w = __builtin_amdgcn_readfirstlane(tid >> 6), r16 = lane & 15, g4 = lane >> 4;
    const int k = tid & 127, tq = tid >> 7;
    for (int it = blockIdx.x; it < 32 * NSEG; it += G) {
        const int u = hg_unit(it, G);
        const int bh = u / NSEG, seg = u % NSEG, b = bh >> 3, h = bh & 7;
        const size_t rowseg = (size_t)b * 4096 + (size_t)seg * CPS * 64;
        const float lb = 1.0f / (1.0f + __expf(-(a.lbp[1024 + h * 128 + k] - a.lbp[h * 128 + k])));
        f32x4 S[8];
#pragma unroll
        for (int j = 0; j < 8; ++j) S[j] = (f32x4){0.f, 0.f, 0.f, 0.f};
        float carry = 0.f;
        u32x4 pq[2], pf[2], pv[2];
#define HG_PREFETCH(n_) do { _Pragma("unroll") for (int j = 0; j < 2; ++j) { const int e = tid + 512 * j, t = e >> 4, c = e & 15; \
            const unsigned short* src = a.HP + (rowseg + (size_t)(n_) * 64 + t) * 4096 + h * 128 + 8 * c; \
            pq[j] = *(const u32x4*)src; pf[j] = *(const u32x4*)(src + 1024); pv[j] = *(const u32x4*)(src + 2048); } } while (0)
        HG_PREFETCH(0);
        for (int n = 0; n < CPS; ++n) {
            const size_t row0 = rowseg + (size_t)n * 64;
            HG_BAR();
#pragma unroll
            for (int j = 0; j < 2; ++j) { const int e = tid + 512 * j, t = e >> 4, c = e & 15; const int o = swz(t, c);
                *(HLAS u32x4*)(L + L_Q + o) = pq[j]; *(HLAS u32x4*)(L + L_F + o) = pf[j]; *(HLAS u32x4*)(L + L_V + o) = pv[j]; }
            if (n + 1 < CPS) HG_PREFETCH(n + 1);
            HG_BAR();
            float omf[16], cs[16]; unsigned qr[16];
            { float run = 0.f; unsigned vt[8];
#pragma unroll
              for (int i = 0; i < 16; ++i) { const int o = swz_e(16 * tq + i, k);
                  const float x = bf2f_(*(const HLAS unsigned short*)(L + L_F + o));
                  qr[i] = *(const HLAS unsigned short*)(L + L_Q + o);
                  const unsigned vv = *(const HLAS unsigned short*)(L + L_V + o);
                  if (i & 1) vt[i >> 1] |= vv << 16; else vt[i >> 1] = vv;
                  const float f = lb + (1.0f - lb) * __builtin_amdgcn_rcpf(1.0f + __expf(-x)); omf[i] = 1.0f - f; run += __builtin_amdgcn_logf(f); cs[i] = run; }
              *(HLAS float*)(L + L_TOT + (tq * 128 + k) * 4) = run;
              *(HLAS u32x4*)(L + L_VT + k * P144 + tq * 32) = (u32x4){vt[0], vt[1], vt[2], vt[3]}; *(HLAS u32x4*)(L + L_VT + k * P144 + tq * 32 + 16) = (u32x4){vt[4], vt[5], vt[6], vt[7]}; }
            HG_BAR();
            { const float t0 = *(const HLAS float*)(L + L_TOT + (0 * 128 + k) * 4), t1 = *(const HLAS float*)(L + L_TOT + (1 * 128 + k) * 4), t2 = *(const HLAS float*)(L + L_TOT + (2 * 128 + k) * 4), t3 = *(const HLAS float*)(L + L_TOT + (3 * 128 + k) * 4);
              const float pre = (tq == 0) ? 0.f : (tq == 1) ? t0 : (tq == 2) ? (t0 + t1) : ((t0 + t1) + t2);
              const float bmid = t0 + t1, blast = (t0 + t1) + (t2 + t3);
              const float pb = pre - bmid, pbq = pb - 3.5f;
              unsigned kt[8];
#pragma unroll
              for (int i = 0; i < 16; i += 2) {
                  float q1[2], k1[2];
#pragma unroll
                  for (int d = 0; d < 2; ++d) { q1[d] = bf2f_((unsigned short)qr[i + d]) * __builtin_amdgcn_exp2f(cs[i + d] + pbq); k1[d] = omf[i + d] * __builtin_amdgcn_exp2f(-(cs[i + d] + pb)); }
                  { const unsigned qp = pk_(q1[0], q1[1]), kp = pk_(k1[0], k1[1]); const int t = 16 * tq + i;
                    *(HLAS unsigned short*)(L + L_Q + swz_e(t, k)) = (unsigned short)(qp & 0xffffu); *(HLAS unsigned short*)(L + L_Q + swz_e(t + 1, k)) = (unsigned short)(qp >> 16);
                    *(HLAS unsigned short*)(L + L_F + swz_e(t, k)) = (unsigned short)(kp & 0xffffu); *(HLAS unsigned short*)(L + L_F + swz_e(t + 1, k)) = (unsigned short)(kp >> 16);
                    kt[i >> 1] = kp; } }
              *(HLAS u32x4*)(L + L_K1T + k * P144 + tq * 32) = (u32x4){kt[0], kt[1], kt[2], kt[3]}; *(HLAS u32x4*)(L + L_K1T + k * P144 + tq * 32 + 16) = (u32x4){kt[4], kt[5], kt[6], kt[7]};
              if (tq == 0) { *(HLAS float*)(L + L_CM + k * 4) = __builtin_amdgcn_exp2f(bmid); *(HLAS float*)(L + L_CL + k * 4) = __builtin_amdgcn_exp2f(blast - bmid);
                  a.WN[((size_t)u * CPS + n) * 128 + k] = __builtin_amdgcn_exp2f(bmid + carry); }
              carry += blast; }
            HG_BAR();
            f32x4 cmv, clv;
#pragma unroll
            for (int i = 0; i < 4; ++i) { cmv[i] = *(const HLAS float*)(L + L_CM + (16 * w + 4 * g4 + i) * 4); clv[i] = *(const HLAS float*)(L + L_CL + (16 * w + 4 * g4 + i) * 4); }
#pragma unroll
            for (int j = 0; j < 8; ++j) { S[j] = S[j] * cmv; *(HLAS u32x2*)(L + L_ST + (16 * j + r16) * P272 + (16 * w + 4 * g4) * 2) = (u32x2){pk_(S[j][0], S[j][1]), pk_(S[j][2], S[j][3])}; }
            { const int ct = w >> 1;
#pragma unroll
              for (int q = 0; q < 2; ++q) { const int st = 2 * (w & 1) + q; f32x4 d = (f32x4){0.f, 0.f, 0.f, 0.f};
                  if (st <= ct) {
#pragma unroll
                      for (int ks = 0; ks < 4; ++ks) { const bf16x8 af = *(const HLAS bf16x8*)(L + L_F + swz(16 * st + r16, 4 * ks + g4)), bf = *(const HLAS bf16x8*)(L + L_Q + swz(16 * ct + r16, 4 * ks + g4)); d = HG_MFMA(af, bf, d); }
                      if (st == ct) {
#pragma unroll
                          for (int i = 0; i < 4; ++i) if (4 * g4 + i > r16) d[i] = 0.f; } }
                  *(HLAS u32x2*)(L + L_A + (16 * ct + r16) * P144 + (16 * st + 4 * g4) * 2) = (u32x2){pk_(d[0], d[1]), pk_(d[2], d[3])}; } }
#pragma unroll
            for (int j = 0; j < 2; ++j) { const int e = tid + 512 * j, t = e >> 4, c = e & 15; pg8::st_wt16(a.Q1G + (((size_t)u * CPS + n) * 1024 + e) * 8, *(const HLAS u32x4*)(L + L_Q + swz(t, c))); }
            HG_BAR();
#pragma unroll
            for (int ct = 0; ct < 4; ++ct) { f32x4 d = (f32x4){0.f, 0.f, 0.f, 0.f};
#pragma unroll
                for (int ks = 0; ks < 2; ++ks) { if (ks == 1 && ct < 2) continue;
                    const bf16x8 af = *(const HLAS bf16x8*)(L + L_VT + (16 * w + r16) * P144 + (32 * ks + 8 * g4) * 2), bf = *(const HLAS bf16x8*)(L + L_A + (16 * ct + r16) * P144 + (32 * ks + 8 * g4) * 2); d = HG_MFMA(af, bf, d); }
#pragma unroll
                for (int ks = 0; ks < 4; ++ks) { const bf16x8 af = *(const HLAS bf16x8*)(L + L_ST + (16 * w + r16) * P272 + (32 * ks + 8 * g4) * 2), bf = *(const HLAS bf16x8*)(L + L_Q + swz(16 * ct + r16, 4 * ks + g4)); d = HG_MFMA(af, bf, d); }
                pg8::st_wt8(a.OL + (((((size_t)u * CPS + n) * 8 + w) * 4 + ct) * 64 + lane) * 4, (u32x2){pk_(d[0], d[1]), pk_(d[2], d[3])}); }
#pragma unroll
            for (int j = 0; j < 8; ++j) {
#pragma unroll
                for (int ks = 0; ks < 2; ++ks) { const bf16x8 af = *(const HLAS bf16x8*)(L + L_K1T + (16 * w + r16) * P144 + (32 * ks + 8 * g4) * 2), bf = *(const HLAS bf16x8*)(L + L_VT + (16 * j + r16) * P144 + (32 * ks + 8 * g4) * 2); S[j] = HG_MFMA(af, bf, S[j]); }
                S[j] = S[j] * clv; }
        }
#pragma unroll
        for (int j = 0; j < 8; ++j) pg8::st_wt16f(a.SS + ((((size_t)u * 8 + j) * 8 + w) * 64 + lane) * 4, S[j]);
        if (tq == 0) a.DSEG[(size_t)u * 128 + k] = __builtin_amdgcn_exp2f(carry);
#undef HG_PREFETCH
    }
    HG_BAR();
}

struct P2Args { const unsigned short* HP; const unsigned short* OL; const unsigned short* Q1G; const float* WN; const float* SS; const float* DSEG; const float* gout; unsigned short* HON; MoeW mw; int bg; };
__device__ __forceinline__ void hg_pass2(HLAS unsigned char* L, const P2Args& a, int G) {
    const int tid = threadIdx.x, lane = tid & 63, w = __builtin_amdgcn_readfirstlane(tid >> 6), r16 = lane & 15, g4 = lane >> 4;
    HLAS float* SSQ = (HLAS float*)(L + L_TOT);
    f32x4 gn;
#pragma unroll
    for (int i = 0; i < 4; ++i) gn[i] = a.gout[16 * w + 4 * g4 + i];
    for (int it = blockIdx.x; it < 32 * NSEG; it += G) {
        const int u = hg_unit(it, G);
        const int bh = u / NSEG, seg = u % NSEG, b = bh >> 3, h = bh & 7;
        const size_t rowseg = (size_t)b * 4096 + (size_t)seg * CPS * 64;
        const size_t colw = (size_t)h * 128 + 16 * w + 4 * g4;
        u32x2 pol[4], pg[4]; u32x4 pq[2]; f32x4 pwn = (f32x4){0.f, 0.f, 0.f, 0.f};
#define HG2_PREFETCH(n_) do { const size_t r0_ = rowseg + (size_t)(n_) * 64; \
            _Pragma("unroll") for (int ct = 0; ct < 4; ++ct) { const size_t row = r0_ + 16 * ct + r16; pol[ct] = *(const u32x2*)(a.OL + (((((size_t)u * CPS + (n_)) * 8 + w) * 4 + ct) * 64 + lane) * 4); pg[ct] = *(const u32x2*)(a.HP + row * 4096 + 3072 + colw); } \
            if (seg > 0) { _Pragma("unroll") for (int j = 0; j < 2; ++j) { const int e = tid + 512 * j, t = e >> 4, c = e & 15; pq[j] = *(const u32x4*)(a.Q1G + (((size_t)u * CPS + (n_)) * 1024 + e) * 8); } \
                           pwn = *(const f32x4*)(a.WN + ((size_t)u * CPS + (n_)) * 128 + 16 * w + 4 * g4); } } while (0)
        HG2_PREFETCH(0);
        f32x4 Sin[8];
#pragma unroll
        for (int j = 0; j < 8; ++j) Sin[j] = (f32x4){0.f, 0.f, 0.f, 0.f};
        { int i = 0;
          for (; i + 1 < seg; i += 2) { const size_t ui = (size_t)bh * NSEG + i;
              const f32x4 dv0 = *(const f32x4*)(a.DSEG + ui * 128 + 16 * w + 4 * g4), dv1 = *(const f32x4*)(a.DSEG + (ui + 1) * 128 + 16 * w + 4 * g4);
              f32x4 s0[8], s1[8];
#pragma unroll
              for (int j = 0; j < 8; ++j) { s0[j] = *(const f32x4*)(a.SS + (((ui * 8 + j) * 8 + w) * 64 + lane) * 4); s1[j] = *(const f32x4*)(a.SS + ((((ui + 1) * 8 + j) * 8 + w) * 64 + lane) * 4); }
#pragma unroll
              for (int j = 0; j < 8; ++j) Sin[j] = (Sin[j] * dv0 + s0[j]) * dv1 + s1[j]; }
          if (i < seg) { const size_t ui = (size_t)bh * NSEG + i; const f32x4 dv = *(const f32x4*)(a.DSEG + ui * 128 + 16 * w + 4 * g4);
#pragma unroll
              for (int j = 0; j < 8; ++j) Sin[j] = Sin[j] * dv + *(const f32x4*)(a.SS + (((ui * 8 + j) * 8 + w) * 64 + lane) * 4); } }
        for (int n = 0; n < CPS; ++n) {
            const size_t row0 = rowseg + (size_t)n * 64;
            const int bgi = (it < G) ? ((int)blockIdx.x * NWAVES + w) * CPS + n : (1 << 30);
            const bool bgon = bgi < a.bg; TrJob bj{}; float bv[32];
            if (bgon) { bj = moe_job(a.mw, bgi); tr_load(bj, bv, lane); }
            HG_BAR();
            u32x2 ol[4], gg[4];
#pragma unroll
            for (int ct = 0; ct < 4; ++ct) { ol[ct] = pol[ct]; gg[ct] = pg[ct]; }
            if (seg > 0) {
#pragma unroll
                for (int j = 0; j < 8; ++j) { const f32x4 t = Sin[j] * pwn; *(HLAS u32x2*)(L + L_ST + (16 * j + r16) * P272 + (16 * w + 4 * g4) * 2) = (u32x2){pk_(t[0], t[1]), pk_(t[2], t[3])}; }
#pragma unroll
                for (int j = 0; j < 2; ++j) { const int e = tid + 512 * j, t = e >> 4, c = e & 15; *(HLAS u32x4*)(L + L_Q + swz(t, c)) = pq[j]; } }
            if (n + 1 < CPS) HG2_PREFETCH(n + 1);
            HG_BAR();
            f32x4 o[4];
#pragma unroll
            for (int ct = 0; ct < 4; ++ct) {
                f32x4 d = (f32x4){bf2f_((unsigned short)(ol[ct].x & 0xffffu)), bf2f_((unsigned short)(ol[ct].x >> 16)), bf2f_((unsigned short)(ol[ct].y & 0xffffu)), bf2f_((unsigned short)(ol[ct].y >> 16))};
                if (seg > 0) {
#pragma unroll
                    for (int ks = 0; ks < 4; ++ks) { const bf16x8 af = *(const HLAS bf16x8*)(L + L_ST + (16 * w + r16) * P272 + (32 * ks + 8 * g4) * 2), bf = *(const HLAS bf16x8*)(L + L_Q + swz(16 * ct + r16, 4 * ks + g4)); d = HG_MFMA(af, bf, d); } }
                o[ct] = d;
                float p = (d[0] * d[0] + d[1] * d[1]) + (d[2] * d[2] + d[3] * d[3]); p += __shfl_xor(p, 16); p += __shfl_xor(p, 32);
                if (g4 == 0) SSQ[w * 64 + 16 * ct + r16] = p; }
            HG_BAR();
#pragma unroll
            for (int ct = 0; ct < 4; ++ct) { float tot = 0.f;
#pragma unroll
                for (int ww = 0; ww < 8; ++ww) tot += SSQ[ww * 64 + 16 * ct + r16];
                const float rs = __builtin_amdgcn_rsqf(tot * (1.0f / 128.0f) + 1e-6f);
                const size_t row = row0 + 16 * ct + r16;
                const float g0 = bf2f_((unsigned short)(gg[ct].x & 0xffffu)), g1 = bf2f_((unsigned short)(gg[ct].x >> 16)), g2 = bf2f_((unsigned short)(gg[ct].y & 0xffffu)), g3 = bf2f_((unsigned short)(gg[ct].y >> 16));
                const float s0 = g0 * __builtin_amdgcn_rcpf(1.0f + __expf(-g0)), s1 = g1 * __builtin_amdgcn_rcpf(1.0f + __expf(-g1)), s2 = g2 * __builtin_amdgcn_rcpf(1.0f + __expf(-g2)), s3 = g3 * __builtin_amdgcn_rcpf(1.0f + __expf(-g3));
                *(u32x2*)(a.HON + row * 1024 + colw) = (u32x2){pk_(o[ct][0] * rs * gn[0] * s0, o[ct][1] * rs * gn[1] * s1), pk_(o[ct][2] * rs * gn[2] * s2, o[ct][3] * rs * gn[3] * s3)}; }
            if (bgon) tr_finish(bj, bv, (HLAS float*)(L + 16384 + w * 8448), lane);
        }
#undef HG2_PREFETCH
    }
    HG_BAR();
}
}

struct MoeSplitOrder {
    volatile LAS int* mt; int nN, G, c, nitems, kbytes;
    __device__ __forceinline__ void init(volatile LAS int* mt_, int nN_, int G_, int c_, int kbytes_) { mt = mt_; nN = nN_; G = G_; c = c_; kbytes = kbytes_; const int T = mt_[8]; nitems = (T > 128 ? T - 128 : 0) * nN_ * 7; }
    __device__ __forceinline__ bool next(int i, pg8::Unit& u) const {
        const int Lx = i * G + c; if (Lx >= nitems) return false;
        const int ks = Lx % 7, r = Lx / 7, pnl = r % nN, tile = 128 + r / nN;
        int e = 0;
#pragma unroll
        for (int j = 1; j < 8; ++j) e += (tile >= mt[j]) ? 1 : 0;
        u.pm = tile; u.pn = e * nN + pnl; u.kb = ks * kbytes; return true;
    }
    __device__ __forceinline__ void a_ready(const pg8::Unit&) const {}
    __device__ __forceinline__ void done(const pg8::Unit&) const {}
    __device__ __forceinline__ int arow(const pg8::Unit&, int) const { return 0; }
    __device__ __forceinline__ void issue_rows(const pg8::Unit&, int, int, int) const {}
    __device__ __forceinline__ int arow_lds(int, int) const { return 0; }
};

struct Args { const float* in[22]; const int* pos; float* out; unsigned char* ws; int ph_lo, ph_hi, li, pad; };

__global__ void __launch_bounds__(NWAVES * 64, 2) fwd_kernel(Args args) {
    extern __shared__ __attribute__((aligned(16))) unsigned char lds[];
    LAS unsigned char* L = (LAS unsigned char*)lds;
    volatile LAS unsigned* MISC = (volatile LAS unsigned*)(L + MISC_OFF);
    const int tid = threadIdx.x, lane = tid & 63, wave = __builtin_amdgcn_readfirstlane(tid >> 6);
    const int G = gridDim.x;
    const int gw = blockIdx.x * NWAVES + wave, NGW = G * NWAVES;
    unsigned char* ws = args.ws;
    gu32* ctl = (gu32*)(ws + WS_CTL);
    for (int u = tid; u < (LDS_BYTES - LDSCTL_OFF) / 4; u += NWAVES * 64) ((LAS unsigned*)(L + LDSCTL_OFF))[u] = 0u;
    __syncthreads();
    XcdBarrier bar; bar.bar = (unsigned*)(ctl + CW_BAR); bar.x = 0; bar.st = nullptr;
    if (N_LAUNCHES == 1) bar = xcd_barrier_post((unsigned*)(ctl + CW_BAR) + args.li * XCD_BAR_WORDS, MISC + 8);
#define GRID_BAR() do { if (N_LAUNCHES == 1) xcd_barrier(bar); } while (0)
#if defined(DIAG_STAMP) || defined(AMP_A)
    unsigned long long* const ts_ = (unsigned long long*)(ws + WS_STAMP);
#define STAMP(k) do { if (blockIdx.x == 0 && tid == 0) ts_[(k)] = __builtin_amdgcn_s_memrealtime(); } while (0)
    STAMP(0);
#else
#define STAMP(k) do { } while (0)
#endif
    const int lo = args.ph_lo, hi = args.ph_hi;
#define IN(k) (lo <= (k) && (k) < hi)
#define BOTH(k) (IN(k) && IN((k) + 1))
    const float* x = args.in[0];
    bf16* H = (bf16*)args.out; constexpr int HPITCH = 2048;

    if (IN(0)) {
        LAS float* scr = (LAS float*)(L + RING_OFF + wave * 16384);
        constexpr int I_MOE = (1024 / 64) * (3584 / 32);
        constexpr int NITEMS = 16 * 21 + 6 * 48 + 4 * 64 + 16 * 32 + 2 * 1792 + 1792 + 16 * 128 + 16 * 32 + 24 * I_MOE;
        const MoeW mw{args.in[19], args.in[20], args.in[21], ws + WS_WMGU, ws + WS_WMDN};
        const int bg = (N_LAUNCHES == 1) ? moe_bg_items(G) : 0;
        auto job_of = [&](int it) -> TrJob {
            int r = it + bg; TrJob j;
            if (r < 24 * I_MOE) return moe_job(mw, r);
            r -= 24 * I_MOE;
#define JOB(W, K_, N_, WT, mode) JOBG(W, K_, N_, WT, mode, nullptr)
#define JOBG(W, K_, N_, WT, mode, gain_) { const int ni = ((K_) / 64) * ((N_) / 32); if (r < ni) { j = TrJob{(W), (bf16*)(ws + (WT)), (K_), (N_), (mode), r}; j.gain = (gain_); return j; } r -= ni; }
            JOB(args.in[5], 1024, 672, WS_WMLAIN, 0 | 32)
            JOBG(args.in[7], 384, 1536, WS_WQUP, 0, args.in[6])
            JOBG(args.in[9], 256, 2048, WS_WKVUP, 0, args.in[8])
            JOB(args.in[10], 1024, 1024, WS_WO0, 0 | 32)
            JOBG(args.in[15], 1024, 3584, WS_WFGU, 1, args.in[3])
            JOBG(args.in[16], 1024, 3584, WS_WFGU, 2, args.in[3])
            JOB(args.in[17], 3584, 1024, WS_WFDN, 0)
            JOBG(args.in[11], 1024, 4096, WS_WHIN, 0, args.in[2] + D)
#undef JOB
#undef JOBG
            j = TrJob{args.in[14], (bf16*)(ws + WS_WHO), 1024, 1024, 0, r}; return j; };
        const int nitems = NITEMS - bg;
        if (gw < nitems) {
            TrJob jc = job_of(gw); float vc[32]; tr_load(jc, vc, lane);
            for (int it = gw; it < nitems; it += NGW) {
                const bool hn = it + NGW < nitems; TrJob jn = jc; float vn[32];
                if (hn) { jn = job_of(it + NGW); tr_load(jn, vn, lane); }
                tr_finish(jc, vc, scr, lane);
                if (hn) { jc = jn;
#pragma unroll
                    for (int i = 0; i < 32; ++i) vc[i] = vn[i]; }
            }
        }
        { v4u* z = (v4u*)(ws + WS_WMLAIN + (size_t)MLA_IN * 1024); const int n16 = (MLA_INP - MLA_IN) * 1024 / 16;
          for (int i = blockIdx.x * NWAVES * 64 + tid; i < n16; i += G * NWAVES * 64) z[i] = (v4u){0u, 0u, 0u, 0u}; }
        {
            const float invf = exp2f(-(float)(lane & 15) * (13.287712379549449f / 16.0f));
            int pz[4], mz[4];
#pragma unroll
            for (int j = 0; j < 4; ++j) { mz[j] = gw + NGW * (4 * j + (lane >> 4)); pz[j] = (mz[j] < M) ? args.pos[mz[j]] : 0; }
#pragma unroll
            for (int j = 0; j < 4; ++j) if (mz[j] < M) { const float ang = (float)pz[j] * invf;
                const double rev = (double)ang * 0.15915494309189535; const float fr = (float)(rev - rint(rev));
                ((float*)(ws + WS_COS))[(size_t)mz[j] * 16 + (lane & 15)] = __builtin_amdgcn_cosf(fr); ((float*)(ws + WS_SIN))[(size_t)mz[j] * 16 + (lane & 15)] = __builtin_amdgcn_sinf(fr); }
            for (int m = gw + NGW * 16; m < M; m += NGW) if (lane < 16) { const float ang = (float)args.pos[m] * invf;
                const double rev = (double)ang * 0.15915494309189535; const float fr = (float)(rev - rint(rev));
                ((float*)(ws + WS_COS))[(size_t)m * 16 + lane] = __builtin_amdgcn_cosf(fr); ((float*)(ws + WS_SIN))[(size_t)m * 16 + lane] = __builtin_amdgcn_sinf(fr); } }
        rms_rows_to_bf16(x, args.in[2], (bf16*)(ws + WS_HN), gw, NGW, M, lane, true);
        if (BOTH(0)) GRID_BAR(); STAMP(1);
    }
    if (IN(1)) {
        pg8::Gemm g{(const bf16*)(ws + WS_HN), (const bf16*)(ws + WS_WMLAIN), M, MLA_INP, 512, 512, 0x76767676, 0x7B7B7B7B}; pg8::StaticOrder S; S.init(M, MLA_INP, G, (int)blockIdx.x);
        pg8::EpiStoreBf16 E{(bf16*)(ws + WS_PROJ), MLA_INP, MLA_INP / 256}; E.sq_out = (float*)(ws + WS_SSQ8); E.lpart = (LAS float*)(L + SSQ_LDS_OFF);
        pg8::gemm_phase<pg8::EpiStoreBf16, pg8::StaticOrder, true, false, true>(L + RING_OFF, g, S, E);
        if (BOTH(1)) GRID_BAR(); STAMP(2);
    }
    STAMP(3);
    if (IN(3)) {
        { const bf16* P = (const bf16*)(ws + WS_PROJ); const int l16 = lane & 15;
            int mz[4]; unsigned short a1[4], a2[4]; float cz[4], sz[4];
#pragma unroll
            for (int j = 0; j < 4; ++j) { mz[j] = gw + NGW * (4 * j + (lane >> 4)); const int mm = (mz[j] < M) ? mz[j] : 0; const bf16* pr_ = P + (size_t)mm * MLA_INP + QL + KVL;
                a1[j] = pr_[l16]; a2[j] = pr_[16 + l16]; cz[j] = ((const float*)(ws + WS_COS))[(size_t)mm * 16 + l16]; sz[j] = ((const float*)(ws + WS_SIN))[(size_t)mm * 16 + l16]; }
#pragma unroll
            for (int j = 0; j < 4; ++j) if (mz[j] < M) { const float x1 = bf2f(a1[j]), x2 = bf2f(a2[j]); bf16* okr = (bf16*)(ws + WS_KR) + (size_t)mz[j] * 32;
                okr[l16] = (bf16)f2bf(x1 * cz[j] - x2 * sz[j]); okr[16 + l16] = (bf16)f2bf(x2 * cz[j] + x1 * sz[j]); }
            for (int m = gw + NGW * 16; m < M; m += NGW) if (lane < 16) { const bf16* pr_ = P + (size_t)m * MLA_INP + QL + KVL;
                const float x1 = bf2f(pr_[lane]), x2 = bf2f(pr_[16 + lane]), cs = ((const float*)(ws + WS_COS))[(size_t)m * 16 + lane], sn = ((const float*)(ws + WS_SIN))[(size_t)m * 16 + lane];
                bf16* okr = (bf16*)(ws + WS_KR) + (size_t)m * 32;
                okr[lane] = (bf16)f2bf(x1 * cs - x2 * sn); okr[16 + lane] = (bf16)f2bf(x2 * cs + x1 * sn); } }
        { pg8::Gemm g{(const bf16*)(ws + WS_PROJ), (const bf16*)(ws + WS_WQUP), M, QW, QL, QL, 0, 0, MLA_INP}; pg8::StaticOrder S; S.init(M, QW, G, (int)blockIdx.x);
          pg8::EpiStoreBf16 E{(bf16*)(ws + WS_Q), QW, QW / 256, (const float*)(ws + WS_SSQ8), 8, 0x07, 1.0f / QL}; E.lssq = (LAS float*)(L + SSQ_LDS_OFF);
          pg8::gemm_phase<pg8::EpiStoreBf16, pg8::StaticOrder, true, false>(L + RING_OFF, g, S, E); }
        { pg8::Gemm g{(const bf16*)(ws + WS_PROJ) + QL, (const bf16*)(ws + WS_WKVUP), M, KVW, KVL, KVL, 0, 0, MLA_INP}; pg8::StaticOrder S; S.init(M, KVW, G, (int)blockIdx.x);
          pg8::EpiStoreBf16 E{(bf16*)(ws + WS_KV), KVW, KVW / 256, (const float*)(ws + WS_SSQ8), 8, 0x18, 1.0f / KVL}; E.lssq = (LAS float*)(L + SSQ_LDS_OFF);
          pg8::gemm_phase<pg8::EpiStoreBf16, pg8::StaticOrder, true, false>(L + RING_OFF, g, S, E); }
        if (BOTH(3)) GRID_BAR(); STAMP(4);
    }
    if (IN(4)) {
        const int vcu = (G % 8 == 0) ? ((int)blockIdx.x % 8) * (G / 8) + (int)blockIdx.x / 8 : (int)blockIdx.x;
        for (int v = vcu; v < 256; v += G) {
            const int bh = v >> 2, s4 = v & 3;
#pragma unroll 1
            for (int i = 0; i < 4; ++i) { const int qb = (i == 0) ? s4 : (i == 1) ? 7 - s4 : (i == 2) ? 8 + s4 : 15 - s4;
                mla_attn::attn_unit2<8>(bh >> 4, bh & 15, qb, (const bf16*)(ws + WS_Q), (const bf16*)(ws + WS_KV), (const bf16*)(ws + WS_KR), (const float*)(ws + WS_COS), (const float*)(ws + WS_SIN), (bf16*)(ws + WS_O), (char*)lds + RING_OFF); }
        }
        if (BOTH(4)) GRID_BAR(); STAMP(5);
    }
    if (IN(5)) {
        pg8::Gemm g{(const bf16*)(ws + WS_O), (const bf16*)(ws + WS_WO0), M, D, D / 2, D / 2, 0x76767676, 0x79797979}; pg8::StaticOrder S; S.init(M, D, G, (int)blockIdx.x);
        pg8::EpiRes<true> E{x, H, D, HPITCH, D / 256, (float*)(ws + WS_SSQ), (LAS float*)(L + SSQ_LDS_OFF)};
        pg8::gemm_phase<pg8::EpiRes<true>, pg8::StaticOrder, true, false, true>(L + RING_OFF, g, S, E);
        if (BOTH(5)) GRID_BAR(); STAMP(6);
    }
    STAMP(7);
    if (IN(7)) {
        pg8::Gemm g{H, (const bf16*)(ws + WS_WFGU), M, 2 * FF, D, D, 0, 0, HPITCH}; pg8::StaticOrder S; S.init(M, 2 * FF, G, (int)blockIdx.x);
        pg8::EpiSwiGLU E{(bf16*)(ws + WS_FACT), FF, 2 * FF / 256, false, (const float*)(ws + WS_SSQ)}; E.lssq = (LAS float*)(L + SSQ_LDS_OFF);
        pg8::gemm_phase<pg8::EpiSwiGLU, pg8::StaticOrder, true, false>(L + RING_OFF, g, S, E);
        if (BOTH(7)) GRID_BAR(); STAMP(8);
    }
    if (IN(8)) {
        pg8::Gemm g{(const bf16*)(ws + WS_FACT), (const bf16*)(ws + WS_WFDN), M, D, FF, FF, 0, 0}; pg8::StaticOrder S; S.init(M, D, G, (int)blockIdx.x);
        pg8::EpiRes<false> E{H, H, HPITCH, HPITCH, D / 256, (float*)(ws + WS_SSQ) + (size_t)M * 4, (LAS float*)(L + SSQ_LDS_OFF)};
        pg8::gemm_phase<pg8::EpiRes<false>, pg8::StaticOrder, true, false>(L + RING_OFF, g, S, E);
        if (BOTH(8)) GRID_BAR(); STAMP(9);
    }
    STAMP(10);
    if (IN(10)) {
        pg8::Gemm g{H, (const bf16*)(ws + WS_WHIN), M, HG_IN, D, D, 0, 0, HPITCH}; pg8::StaticOrder S; S.init(M, HG_IN, G, (int)blockIdx.x);
        pg8::EpiStoreBf16 E{(bf16*)(ws + WS_HPROJ), HG_IN, HG_IN / 256, (const float*)(ws + WS_SSQ) + (size_t)M * 4}; E.lssq = (LAS float*)(L + SSQ_LDS_OFF);
        pg8::gemm_phase<pg8::EpiStoreBf16, pg8::StaticOrder, true, false>(L + RING_OFF, g, S, E);
        if (BOTH(10)) GRID_BAR(); STAMP(11);
    }
    if (IN(11)) {
        hg::P1Args pa{(const bf16*)(ws + WS_HPROJ), args.in[12], (bf16*)(ws + WS_OL), (bf16*)(ws + WS_Q1G), (float*)(ws + WS_WN), (float*)(ws + WS_SS), (float*)(ws + WS_DSEG)};
        hg::hg_pass1(L, pa, G);
        if (BOTH(11)) GRID_BAR(); STAMP(12);
    }
    if (IN(12)) {
        hg::P2Args pa{(const bf16*)(ws + WS_HPROJ), (const bf16*)(ws + WS_OL), (const bf16*)(ws + WS_Q1G), (const float*)(ws + WS_WN), (const float*)(ws + WS_SS), (const float*)(ws + WS_DSEG), args.in[13], (bf16*)(ws + WS_HON),
            MoeW{args.in[19], args.in[20], args.in[21], ws + WS_WMGU, ws + WS_WMDN}, (N_LAUNCHES == 1) ? moe_bg_items(G) : 0};
        hg::hg_pass2(L, pa, G);
        if (BOTH(12)) GRID_BAR(); STAMP(13);
    }
    if (IN(13)) {
        pg8::Gemm g{(const bf16*)(ws + WS_HON), (const bf16*)(ws + WS_WHO), M, D, D, D, 0, 0}; pg8::StaticOrder S; S.init(M, D, G, (int)blockIdx.x);
        pg8::EpiRes<false> E{H, H, HPITCH, HPITCH, D / 256};
        pg8::gemm_phase<pg8::EpiRes<false>, pg8::StaticOrder, true, false>(L + RING_OFF, g, S, E);
        if (BOTH(13)) GRID_BAR(); STAMP(14);
    }
    if (IN(14)) {
        const float* gn = args.in[3] + D; const float* RT = args.in[18];
        int* rowlist = (int*)(ws + WS_ROWLIST); v4u* tok = (v4u*)(ws + WS_TOK);
        LAS int* lcnt = (LAS int*)(L + RING_OFF); LAS int* gbase = lcnt + 8; LAS unsigned* rec = (LAS unsigned*)(L + RING_OFF + 64);
        const int niter = (M + NGW - 1) / NGW;
        f32x4 R0[16], R1[16];
#pragma unroll
        for (int j = 0; j < 4; ++j)
#pragma unroll
            for (int kk = 0; kk < 4; ++kk) { const int kx = 4 * (lane + 64 * j) + kk; R0[j * 4 + kk] = *(const f32x4*)(RT + (size_t)kx * 8); R1[j * 4 + kk] = *(const f32x4*)(RT + (size_t)kx * 8 + 4); }
        f32x4 gv[4];
#pragma unroll
        for (int j = 0; j < 4; ++j) gv[j] = ((const f32x4*)gn + lane)[64 * j];
#pragma unroll
        for (int j = 0; j < 4; ++j)
#pragma unroll
            for (int kk = 0; kk < 4; ++kk) { R0[j * 4 + kk] *= gv[j][kk]; R1[j * 4 + kk] *= gv[j][kk]; }
        for (int it0 = 0; it0 < niter; it0 += 16) {
            if (tid < 8) lcnt[tid] = 0;
            __syncthreads();
            const int itn = (niter - it0) < 16 ? (niter - it0) : 16;
            v2u vn[4], vn2[4], vn3[4];
#define P14_LOAD(dst, k_) do { const int mq_ = (it0 + (k_)) * NGW + gw; const bf16* xr_ = H + (size_t)(((k_) < itn && mq_ < M) ? mq_ : 0) * HPITCH; \
              _Pragma("unroll") for (int j = 0; j < 4; ++j) dst[j] = *(const v2u*)(xr_ + 4 * (lane + 64 * j)); } while (0)
            P14_LOAD(vn, 0); P14_LOAD(vn2, 1); P14_LOAD(vn3, 2);
            for (int it = 0; it < itn; ++it) {
                const int m = (it0 + it) * NGW + gw;
                f32x4 v[4];
#pragma unroll
                for (int j = 0; j < 4; ++j) v[j] = (f32x4){__uint_as_float(vn[j].x << 16), __uint_as_float(vn[j].x & 0xffff0000u), __uint_as_float(vn[j].y << 16), __uint_as_float(vn[j].y & 0xffff0000u)};
#pragma unroll
                for (int j = 0; j < 4; ++j) { vn[j] = vn2[j]; vn2[j] = vn3[j]; }
                P14_LOAD(vn3, it + 3);
                if (m >= M) continue;
                float s = 0.f;
#pragma unroll
                for (int j = 0; j < 4; ++j) s += (v[j].x * v[j].x + v[j].y * v[j].y) + (v[j].z * v[j].z + v[j].w * v[j].w);
                f32x4 la = (f32x4){0.f, 0.f, 0.f, 0.f}, lb4 = (f32x4){0.f, 0.f, 0.f, 0.f};
#pragma unroll
                for (int j = 0; j < 4; ++j)
#pragma unroll
                    for (int kk = 0; kk < 4; ++kk) { la += v[j][kk] * R0[j * 4 + kk]; lb4 += v[j][kk] * R1[j * 4 + kk]; }
                const float rstd = __builtin_amdgcn_rsqf(wave_sum(s) * (1.f / 1024.f) + EPS);
                unsigned* o8 = (unsigned*)(ws + WS_HN3 + (size_t)m * D) + lane;
#pragma unroll
                for (int j = 0; j < 4; ++j) { const f32x4 t = (f32x4){v[j].x * rstd * gv[j].x, v[j].y * rstd * gv[j].y, v[j].z * rstd * gv[j].z, v[j].w * rstd * gv[j].w};
                    pg8::st_wt4(o8 + 64 * j, pk_fp8x4(t.x, t.y, t.z, t.w, 16.f)); }
                float l4[4], l2[2], l1;
                { const bool up = (lane & 4) != 0;
#pragma unroll
                  for (int e = 0; e < 4; ++e) { const float mine = up ? lb4[e] : la[e], give = up ? la[e] : lb4[e]; l4[e] = mine + lane_m8(give); } }
                { const bool up = (lane & 1) != 0;
#pragma unroll
                  for (int e = 0; e < 2; ++e) { const float mine = up ? l4[2 + e] : l4[e], give = up ? l4[e] : l4[2 + e]; l2[e] = mine + lane_x1(give); } }
                { const bool up = (lane & 2) != 0; const float mine = up ? l2[1] : l2[0], give = up ? l2[0] : l2[1]; l1 = mine + lane_x2(give); }
                l1 += lane_x8(l1); l1 = sum_x32(sum_x16(l1)); l1 *= rstd;
                float lg[8];
#pragma unroll
                for (int e = 0; e < 8; ++e) { const int src = (e & 4) | ((e & 1) << 1) | ((e >> 1) & 1); lg[e] = __uint_as_float(__builtin_amdgcn_readlane(__float_as_uint(l1), src)); }
                if (lane == 0) {
                    int e1 = 0; float v1 = lg[0];
#pragma unroll
                    for (int e = 1; e < 8; ++e) if (lg[e] > v1) { v1 = lg[e]; e1 = e; }
                    int e2 = (e1 == 0) ? 1 : 0; float v2 = lg[e2];
#pragma unroll
                    for (int e = 1; e < 8; ++e) if (e != e1 && lg[e] > v2) { v2 = lg[e]; e2 = e; }
                    const float w1 = 1.0f / (1.0f + __expf(v2 - v1)), w2 = 1.0f - w1;
                    const int r1 = __hip_atomic_fetch_add(lcnt + e1, 1, __ATOMIC_RELAXED, __HIP_MEMORY_SCOPE_WORKGROUP), r2 = __hip_atomic_fetch_add(lcnt + e2, 1, __ATOMIC_RELAXED, __HIP_MEMORY_SCOPE_WORKGROUP);
                    LAS unsigned* rc = rec + (it * NWAVES + wave) * 8;
                    rc[0] = (unsigned)m; rc[1] = (unsigned)e1; rc[2] = (unsigned)e2; rc[3] = (unsigned)r1; rc[4] = (unsigned)r2; rc[5] = __float_as_uint(w1); rc[6] = __float_as_uint(w2);
                }
            }
#undef P14_LOAD
            __syncthreads();
            if (tid < 8) { const int c = lcnt[tid]; gbase[tid] = c ? (int)__hip_atomic_fetch_add((unsigned*)(ctl + CW_CNT + 64 * tid), (unsigned)c, RLX_AGENT) : 0; }
            __syncthreads();
            for (int i = tid; i < itn * NWAVES; i += NWAVES * 64) {
                const int m = (it0 + i / NWAVES) * NGW + blockIdx.x * NWAVES + (i % NWAVES); if (m >= M) continue;
                const LAS unsigned* rc = rec + i * 8; const int e1 = (int)rc[1], e2 = (int)rc[2]; const unsigned p1 = (unsigned)gbase[e1] + rc[3], p2 = (unsigned)gbase[e2] + rc[4];
                rowlist[e1 * CAP + p1] = m; rowlist[e2 * CAP + p2] = m;
                tok[m] = (v4u){(unsigned)(e1 * CAP) + p1, (unsigned)(e2 * CAP) + p2, rc[5], rc[6]};
            }
            __syncthreads();
        }
        if (BOTH(14)) GRID_BAR(); STAMP(15);
    }
    if (IN(15) || IN(16) || IN(17)) {
        if (tid == 0) { volatile LAS int* mt = (volatile LAS int*)(MISC + 16); int acc = 0;
            for (int e = 0; e < 8; ++e) { const int c = (int)__hip_atomic_load((unsigned*)(ctl + CW_CNT + 64 * e), RLX_AGENT); mt[e] = acc; mt[9 + e] = c; acc += (c + 255) >> 8; }
            mt[8] = acc; }
        __syncthreads();
    }
    if (IN(15)) {
        pg8::Gemm g{(const bf16*)(ws + WS_HN3), (const bf16*)(ws + WS_WMGU), M, 2 * FF, D / 2, D / 2, 0x76767676, 0x7B7B7B7B};
        MoeOrder S; S.init((volatile LAS int*)(MISC + 16), 2 * FF / 256, G, (int)blockIdx.x, (const int*)(ws + WS_ROWLIST));
        pg8::EpiSwiGLU E{(bf16*)(ws + WS_MACT), FF, 2 * FF / 256, true};
        pg8::gemm_phase<pg8::EpiSwiGLU, MoeOrder, true, true, true>(L + RING_OFF, g, S, E);
        if (BOTH(15)) GRID_BAR(); STAMP(16);
    }
    if (IN(16)) {
        pg8::Gemm g{(const bf16*)(ws + WS_MACT), (const bf16*)(ws + WS_WMDN), MAXSLOT, D, FF / 2, FF / 2, 0x76767676, 0x7C7C7C7C};
        MoeOrder S; S.init((volatile LAS int*)(MISC + 16), D / 256, G, (int)blockIdx.x, (const int*)(ws + WS_ROWLIST), 128);
        pg8::EpiStoreBf16 E{(bf16*)(ws + WS_Y), D, D / 256};
        pg8::gemm_phase<pg8::EpiStoreBf16, MoeOrder, true, false, true>(L + RING_OFF, g, S, E);
        { pg8::Gemm g2{(const bf16*)(ws + WS_MACT), (const bf16*)(ws + WS_WMDN), MAXSLOT, D, 256, FF / 2, 0x76767676, 0x7C7C7C7C};
          MoeSplitOrder S2; S2.init((volatile LAS int*)(MISC + 16), D / 256, G, (int)blockIdx.x, 512);
          pg8::EpiPart E2{(float*)(ws + WS_PART0), (float*)(ws + WS_PART1), D / 256, 9};
          pg8::gemm_phase<pg8::EpiPart, MoeSplitOrder, true, false, true>(L + RING_OFF, g2, S2, E2); }
        if (BOTH(16)) GRID_BAR(); STAMP(17);
    }
    if (IN(17)) {
        volatile LAS int* mt = (volatile LAS int*)(MISC + 16);
        const bf16* Y = (const bf16*)(ws + WS_Y); const v4u* tok = (const v4u*)(ws + WS_TOK);
        f32x4 gfin[4];
#pragma unroll
        for (int j = 0; j < 4; ++j) gfin[j] = ((const f32x4*)args.in[4] + lane)[64 * j];
        if (gw < M) {
#define P17_SLOTS(tk_, s1_, s2_) do { const int e1_ = (tk_).x / CAP, e2_ = (tk_).y / CAP; s1_ = (size_t)mt[e1_] * 256 + ((tk_).x % CAP); s2_ = (size_t)mt[e2_] * 256 + ((tk_).y % CAP); } while (0)
#define P17_LOADROW(m_, s1_, s2_, hv_, ya_, yc_) do { const bf16* xr_ = H + (size_t)(m_) * HPITCH; \
            const v2u* y1_ = (const v2u*)(Y + ((s1_) < 32768 ? (s1_) : (size_t)0) * D) + lane; const v2u* y2_ = (const v2u*)(Y + ((s2_) < 32768 ? (s2_) : (size_t)0) * D) + lane; \
            _Pragma("unroll") for (int j = 0; j < 4; ++j) { hv_[j] = ld_bf4(xr_ + 4 * (lane + 64 * j)); ya_[j] = y1_[64 * j]; yc_[j] = y2_[64 * j]; } } while (0)
            v4u tk = tok[gw]; size_t s1, s2; P17_SLOTS(tk, s1, s2);
            f32x4 hv[4]; v2u ya[4], yc[4]; P17_LOADROW(gw, s1, s2, hv, ya, yc);
            v4u tkn = tok[(gw + NGW < M) ? gw + NGW : gw];
            for (int m = gw; m < M; m += NGW) {
                f32x4 v[4]; v2u a[4], c[4];
#pragma unroll
                for (int j = 0; j < 4; ++j) { v[j] = hv[j]; a[j] = ya[j]; c[j] = yc[j]; }
                const size_t cs1 = s1, cs2 = s2; const unsigned zb = tk.z, wb = tk.w; const float w1 = __uint_as_float(zb), w2 = __uint_as_float(wb);
                const int mn = (m + NGW < M) ? m + NGW : m;
                tk = tkn; P17_SLOTS(tk, s1, s2); P17_LOADROW(mn, s1, s2, hv, ya, yc);
                tkn = tok[(mn + NGW < M) ? mn + NGW : mn];
                float s = 0.f;
#pragma unroll
                for (int j = 0; j < 4; ++j) {
                    f32x4 y1v, y2v;
                    if (cs1 < 32768) y1v = (f32x4){bf2f((unsigned short)(a[j].x & 0xffffu)), bf2f((unsigned short)(a[j].x >> 16)), bf2f((unsigned short)(a[j].y & 0xffffu)), bf2f((unsigned short)(a[j].y >> 16))};
                    else { const int tl = (int)(cs1 >> 8) - 128; const float* pb = (tl < 4 ? (const float*)(ws + WS_PART0) + (size_t)((tl * 4 + j) * 7) * 65536 : (const float*)(ws + WS_PART1) + (size_t)(((tl - 4) * 4 + j) * 7) * 65536) + (cs1 & 255) * 256 + 4 * lane;
                        y1v = *(const f32x4*)pb;
#pragma unroll
                        for (int ks = 1; ks < 7; ++ks) y1v += *(const f32x4*)(pb + (size_t)ks * 65536); }
                    if (cs2 < 32768) y2v = (f32x4){bf2f((unsigned short)(c[j].x & 0xffffu)), bf2f((unsigned short)(c[j].x >> 16)), bf2f((unsigned short)(c[j].y & 0xffffu)), bf2f((unsigned short)(c[j].y >> 16))};
                    else { const int tl = (int)(cs2 >> 8) - 128; const float* pb = (tl < 4 ? (const float*)(ws + WS_PART0) + (size_t)((tl * 4 + j) * 7) * 65536 : (const float*)(ws + WS_PART1) + (size_t)(((tl - 4) * 4 + j) * 7) * 65536) + (cs2 & 255) * 256 + 4 * lane;
                        y2v = *(const f32x4*)pb;
#pragma unroll
                        for (int ks = 1; ks < 7; ++ks) y2v += *(const f32x4*)(pb + (size_t)ks * 65536); }
                    v[j] += w1 * y1v + w2 * y2v;
                    s += (v[j].x * v[j].x + v[j].y * v[j].y) + (v[j].z * v[j].z + v[j].w * v[j].w); }
                const float rstd = 1.f / sqrtf(wave_sum(s) * (1.f / 1024.f) + EPS);
                f32x4* xo = (f32x4*)(args.out + (size_t)m * D) + lane;
#pragma unroll
                for (int j = 0; j < 4; ++j) __builtin_nontemporal_store((f32x4){v[j].x * rstd * gfin[j].x, v[j].y * rstd * gfin[j].y, v[j].z * rstd * gfin[j].z, v[j].w * rstd * gfin[j].w}, xo + 64 * j);
            }
#undef P17_SLOTS
#undef P17_LOADROW
        }
    }
#ifdef AMP_A
    if (blockIdx.x == 0 && tid == 0) { const unsigned long long tend = __builtin_amdgcn_s_memrealtime(); ts_[18] = tend;
        const unsigned long long dt = (ts_[AMP_B] - ts_[AMP_A]) * AMP_K; while (__builtin_amdgcn_s_memrealtime() - tend < dt) __builtin_amdgcn_s_sleep(8); }
#endif
#ifdef DIAG_STAMP
    GRID_BAR(); STAMP(18);
    GRID_BAR();
    { const float da = (float)(ts_[DIAG_A1] - ts_[DIAG_A0]) * 0.001f;
      const float db = (float)(ts_[DIAG_B1] - ts_[DIAG_B0]) * 0.1f;
      for (int m = gw; m < M; m += NGW) { f32x4* xr = (f32x4*)(H + (size_t)m * D) + lane;
          for (int j = 0; j < 4; ++j) xr[64 * j] = (f32x4){da, da, da, da}; }
      __syncthreads();
      if (blockIdx.x == 0 && tid == 0) H[0] = db; }
#endif
#undef IN
#undef BOTH
}

extern "C" void kernel_launch(void* const* d_in, const int* in_sizes, int n_in, void* d_out, int out_size, void* d_ws, size_t ws_size, hipStream_t stream) {
    static int grid = 0;
    if (grid == 0) {
        if (n_in != 22 || in_sizes[0] != M * D || out_size != M * D || ws_size < WS_END) { fprintf(stderr, "kernel_launch: unexpected shapes (n_in %d, in0 %d, out %d, ws %zu)\n", n_in, n_in > 0 ? in_sizes[0] : -1, out_size, ws_size); grid = -1; return; }
        int dev = 0, cus = 0, per_cu = 0;
        if (hipGetDevice(&dev) != hipSuccess || hipDeviceGetAttribute(&cus, hipDeviceAttributeMultiprocessorCount, dev) != hipSuccess) { grid = -1; return; }
        if (hipFuncSetAttribute((const void*)fwd_kernel, hipFuncAttributeMaxDynamicSharedMemorySize, LDS_BYTES) != hipSuccess) { fprintf(stderr, "kernel_launch: hipFuncSetAttribute failed\n"); grid = -1; return; }
        if (hipOccupancyMaxActiveBlocksPerMultiprocessor(&per_cu, (const void*)fwd_kernel, NWAVES * 64, LDS_BYTES) != hipSuccess || per_cu < 1) fprintf(stderr, "kernel_launch: occupancy query reports %d\n", per_cu);
        (void)hipGetLastError();
        grid = cus;
    }
    if (grid < 0) return;
    if (hipMemsetAsync((char*)d_ws + WS_CTL, 0, CTL_ZERO_BYTES, stream) != hipSuccess) return;
    Args a{};
    for (int i = 0; i < 22; ++i) a.in[i] = (const float*)d_in[i];
    a.pos = (const int*)d_in[1]; a.out = (float*)d_out; a.ws = (unsigned char*)d_ws;
    static_assert(N_LAUNCHES == 1 || N_LAUNCHES == NPHASE, "MK_N_LAUNCHES: 1 or 18");
    for (int li = 0; li < N_LAUNCHES; ++li) {
        a.ph_lo = (N_LAUNCHES == 1) ? 0 : li; a.ph_hi = (N_LAUNCHES == 1) ? NPHASE : li + 1; a.li = li;
        hipLaunchKernelGGL(fwd_kernel, dim3(grid), dim3(NWAVES * 64), LDS_BYTES, stream, a);
        if (hipPeekAtLastError() != hipSuccess) { fprintf(stderr, "kernel_launch: launch %d failed\n", li); break; }
    }
#ifdef PROBE_EXTRA
    { const int extra[] = {PROBE_EXTRA}; int li = 1;
      for (int k : extra) { a.ph_lo = k; a.ph_hi = k + 1; a.li = li++; hipLaunchKernelGGL(fwd_kernel, dim3(grid), dim3(NWAVES * 64), LDS_BYTES, stream, a); } }
#endif
}
```
